# Optimizing an MI355X kernel written in HIP

```python
import math
import jax, jax.numpy as jnp
from jax import lax
import numpy as np

D_MODEL = 1024
BATCH = 32
SEQ = 2048
DEPTH = 1

FOX_HEADS = 8
FOX_HEAD_DIM = 128
FOX_WIDTH = FOX_HEADS * FOX_HEAD_DIM
FOX_BLOCK = 128
GDN_HEADS = 8
GDN_HEAD_K = 128
GDN_HEAD_V = 128
GDN_K_WIDTH = GDN_HEADS * GDN_HEAD_K
GDN_V_WIDTH = GDN_HEADS * GDN_HEAD_V
GDN_CONV = 4
GDN_CONV_CH = 2 * GDN_K_WIDTH + GDN_V_WIDTH
GDN_CHUNK = 64
D_FF = 2816
FFN_CONV = 3
EPS = 1e-6

IN_SIZES = (FOX_WIDTH, FOX_WIDTH, FOX_WIDTH, FOX_HEADS,
            GDN_K_WIDTH, GDN_K_WIDTH, GDN_V_WIDTH, GDN_HEADS, GDN_HEADS, GDN_V_WIDTH,
            D_MODEL, D_MODEL)
D_IN = sum(IN_SIZES)

kernel_name = "fox_gdn_parallel_hybrid_convffn"


def rmsnorm(x, g):
    xf = x.astype(jnp.float32)
    xf = xf * lax.rsqrt(jnp.mean(xf * xf, axis=-1, keepdims=True) + EPS)
    return (xf * g.astype(jnp.float32)).astype(x.dtype)


def l2norm(x):
    xf = x.astype(jnp.float32)
    return xf * lax.rsqrt(jnp.sum(xf * xf, axis=-1, keepdims=True) + EPS)


def causal_dwconv(x, w):
    K = w.shape[0]
    S = x.shape[1]
    xp = jnp.pad(x, ((0, 0), (K - 1, 0), (0, 0)))
    return sum(xp[:, i:i + S, :] * w[i] for i in range(K))


def split_in(h):
    idx = np.cumsum(np.array(IN_SIZES))[:-1].tolist()
    return jnp.split(h, idx, axis=-1)


def fox_attention(q, k, v, log_f):
    B, S, H, Dh = q.shape
    nb = S // FOX_BLOCK
    scale = Dh ** -0.5
    c = jnp.cumsum(log_f.astype(jnp.float32), axis=1).transpose(0, 2, 1)
    kh = k.transpose(0, 2, 1, 3)
    vh = v.transpose(0, 2, 1, 3)
    qb = q.reshape(B, nb, FOX_BLOCK, H, Dh).transpose(1, 0, 3, 2, 4)
    cb = c.reshape(B, H, nb, FOX_BLOCK).transpose(2, 0, 1, 3)
    key_pos = jnp.arange(S)

    def block(args):
        qi, ci, i = args
        s = jnp.einsum('bhqd,bhkd->bhqk', qi, kh).astype(jnp.float32) * scale
        s = s + (ci[..., :, None] - c[..., None, :])
        q_pos = i * FOX_BLOCK + jnp.arange(FOX_BLOCK)
        causal = key_pos[None, :] <= q_pos[:, None]
        p = jax.nn.softmax(jnp.where(causal, s, -jnp.inf), axis=-1)
        return jnp.einsum('bhqk,bhkd->bhqd', p.astype(vh.dtype), vh)

    o = lax.map(block, (qb, cb, jnp.arange(nb)))
    return o.transpose(1, 0, 3, 2, 4).reshape(B, S, H * Dh)


def gated_delta_rule(q, k, v, g, beta):
    B, S, H, dk = q.shape
    dv = v.shape[-1]
    C = GDN_CHUNK
    N = S // C
    f32 = jnp.float32

    def chunk4(t):
        return t.astype(f32).reshape(B, N, C, H, t.shape[-1]).transpose(0, 3, 1, 2, 4)

    def chunk3(t):
        return t.astype(f32).reshape(B, N, C, H).transpose(0, 3, 1, 2)

    qc = chunk4(q) * (dk ** -0.5)
    kc = chunk4(k)
    vc = chunk4(v)
    bc = chunk3(beta)
    gc = jnp.cumsum(chunk3(g), axis=-1)

    tri_incl = jnp.tril(jnp.ones((C, C), dtype=bool))
    tri_strict = jnp.tril(jnp.ones((C, C), dtype=bool), k=-1)
    diff = gc[..., :, None] - gc[..., None, :]
    decay = jnp.exp(jnp.where(tri_incl, diff, -jnp.inf))

    kb = kc * bc[..., None]
    A = jnp.where(tri_strict, jnp.einsum('bhncd,bhnmd->bhncm', kb, kc) * decay, 0.0)
    lhs = A + jnp.eye(C, dtype=f32)
    rhs = jnp.concatenate([vc * bc[..., None], kb * jnp.exp(gc)[..., None]], axis=-1)
    sol = lax.linalg.triangular_solve(lhs, rhs, left_side=True, lower=True, unit_diagonal=True)
    u_hat, w = sol[..., :dv], sol[..., dv:]

    attn = jnp.einsum('bhncd,bhnmd->bhncm', qc, kc) * decay
    q_dec = qc * jnp.exp(gc)[..., None]
    k_dec = kc * jnp.exp(gc[..., -1:] - gc)[..., None]
    g_last = jnp.exp(gc[..., -1])

    xs = tuple(jnp.moveaxis(t, 2, 0) for t in (u_hat, w, attn, q_dec, k_dec, g_last))

    def step(state, inp):
        u_hat_i, w_i, attn_i, q_dec_i, k_dec_i, gl_i = inp
        u = u_hat_i - jnp.einsum('bhcd,bhdv->bhcv', w_i, state)
        o = jnp.einsum('bhcd,bhdv->bhcv', q_dec_i, state) + jnp.einsum('bhcm,bhmv->bhcv', attn_i, u)
        state = state * gl_i[..., None, None] + jnp.einsum('bhcd,bhcv->bhdv', k_dec_i, u)
        return state, o

    s0 = jnp.zeros((B, H, dk, dv), f32)
    _, o = lax.scan(step, s0, xs)
    return o.transpose(1, 0, 3, 2, 4).reshape(B, S, H, dv).astype(v.dtype)


def setup_inputs(seed: int = 0) -> dict:
    key = jax.random.key(seed)
    ks = jax.random.split(key, 20)
    L, D = DEPTH, D_MODEL
    nrm = jax.random.normal
    x = nrm(ks[0], (BATCH, SEQ, D), jnp.float32)
    norm_mix = 1.0 + 0.05 * nrm(ks[1], (L, D), jnp.float32)
    w_in = nrm(ks[2], (L, D, D_IN), jnp.float32) * D ** -0.5
    fox_f_bias = 3.0 + 0.5 * nrm(ks[3], (L, FOX_HEADS), jnp.float32)
    gdn_conv_w = nrm(ks[4], (L, GDN_CONV, GDN_CONV_CH), jnp.float32) * GDN_CONV ** -0.5
    gdn_a_log = jnp.log(jax.random.uniform(ks[5], (L, GDN_HEADS), jnp.float32, 1.0, 16.0))
    dt = jnp.exp(jax.random.uniform(ks[6], (L, GDN_HEADS), jnp.float32, math.log(1e-3), math.log(1e-1)))
    gdn_dt_bias = dt + jnp.log(-jnp.expm1(-dt))
    gdn_norm = 1.0 + 0.05 * nrm(ks[7], (L, GDN_HEAD_V), jnp.float32)
    w_branch_fox = nrm(ks[8], (L, FOX_WIDTH, D), jnp.float32) * FOX_WIDTH ** -0.5
    w_branch_gdn = nrm(ks[9], (L, GDN_V_WIDTH, D), jnp.float32) * GDN_V_WIDTH ** -0.5
    w_out = nrm(ks[10], (L, D, D), jnp.float32) * D ** -0.5
    norm_ffn = 1.0 + 0.05 * nrm(ks[11], (L, D), jnp.float32)
    w_up = nrm(ks[12], (L, D, 2 * D_FF), jnp.float32) * D ** -0.5
    ffn_conv_w = nrm(ks[13], (L, FFN_CONV, 2 * D_FF), jnp.float32) * FFN_CONV ** -0.5
    w_down = nrm(ks[14], (L, D_FF, D), jnp.float32) * D_FF ** -0.5
    norm_final = 1.0 + 0.05 * nrm(ks[15], (D,), jnp.float32)
    return {"x": x, "norm_mix": norm_mix, "w_in": w_in, "fox_f_bias": fox_f_bias,
            "gdn_conv_w": gdn_conv_w, "gdn_a_log": gdn_a_log, "gdn_dt_bias": gdn_dt_bias,
            "gdn_norm": gdn_norm, "w_branch_fox": w_branch_fox, "w_branch_gdn": w_branch_gdn,
            "w_out": w_out, "norm_ffn": norm_ffn, "w_up": w_up, "ffn_conv_w": ffn_conv_w,
            "w_down": w_down, "norm_final": norm_final}


def reference(x, norm_mix, w_in, fox_f_bias, gdn_conv_w, gdn_a_log, gdn_dt_bias, gdn_norm,
              w_branch_fox, w_branch_gdn, w_out, norm_ffn, w_up, ffn_conv_w, w_down, norm_final):
    B, S, D = x.shape
    h = x
    for l in range(DEPTH):
        hn = rmsnorm(h, norm_mix[l])
        proj = jnp.einsum('bsd,de->bse', hn, w_in[l])
        (fq, fk, fv, ff, gq, gk, gv, ga, gb, gz, gate_fox, gate_gdn) = split_in(proj)

        log_f = jax.nn.log_sigmoid(ff.astype(jnp.float32) + fox_f_bias[l].astype(jnp.float32))
        y_fox = fox_attention(fq.reshape(B, S, FOX_HEADS, FOX_HEAD_DIM),
                              fk.reshape(B, S, FOX_HEADS, FOX_HEAD_DIM),
                              fv.reshape(B, S, FOX_HEADS, FOX_HEAD_DIM), log_f)

        qkv = jax.nn.silu(causal_dwconv(jnp.concatenate([gq, gk, gv], axis=-1), gdn_conv_w[l]))
        cq, ck, cv = jnp.split(qkv, [GDN_K_WIDTH, 2 * GDN_K_WIDTH], axis=-1)
        q = l2norm(cq.reshape(B, S, GDN_HEADS, GDN_HEAD_K))
        k = l2norm(ck.reshape(B, S, GDN_HEADS, GDN_HEAD_K))
        v = cv.reshape(B, S, GDN_HEADS, GDN_HEAD_V)
        g = -jnp.exp(gdn_a_log[l].astype(jnp.float32)) * jax.nn.softplus(
            ga.astype(jnp.float32) + gdn_dt_bias[l].astype(jnp.float32))
        beta = jax.nn.sigmoid(gb.astype(jnp.float32))
        o = gated_delta_rule(q, k, v, g, beta)
        o = rmsnorm(o, gdn_norm[l]) * jax.nn.silu(gz.reshape(B, S, GDN_HEADS, GDN_HEAD_V))
        y_gdn = o.reshape(B, S, GDN_V_WIDTH)

        y = (jax.nn.sigmoid(gate_fox) * jnp.einsum('bse,ed->bsd', y_fox, w_branch_fox[l])
             + jax.nn.sigmoid(gate_gdn) * jnp.einsum('bse,ed->bsd', y_gdn, w_branch_gdn[l]))
        h = h + jnp.einsum('bsd,de->bse', y, w_out[l])

        hn = rmsnorm(h, norm_ffn[l])
        up = causal_dwconv(jnp.einsum('bsd,df->bsf', hn, w_up[l]), ffn_conv_w[l])
        u_gate, u_val = jnp.split(up, 2, axis=-1)
        h = h + jnp.einsum('bsf,fd->bsd', jax.nn.silu(u_gate) * u_val, w_down[l])
    return rmsnorm(h, norm_final)
```

```cpp
#include <hip/hip_runtime.h>
#include <hip/hip_bf16.h>
#include <hip/hip_cooperative_groups.h>
#include <cstdio>
#include <cstdint>
namespace cg = cooperative_groups;

#ifndef MK_ONE_LAUNCH
#define MK_ONE_LAUNCH 1
#endif

namespace pg8 {
#define PG8_LAS __attribute__((address_space(3)))
typedef unsigned short bf16_t;
typedef short bf16x8 __attribute__((ext_vector_type(8)));
typedef float f32x4 __attribute__((ext_vector_type(4)));
typedef unsigned u32x4 __attribute__((ext_vector_type(4)));
constexpr int BM = 256, BK = 64, HALF = 128, HTB = HALF * BK * 2  , STAGE_BYTES = 8 * HTB, NXCD = 8, WGM = 8;

__host__ __device__ __forceinline__ int lds_byte(int r, int c) { const int st = (r >> 4) * 2 + (c >> 5), rr = r & 15, cc = c & 31, ob = rr * 64 + cc * 2; return st * 1024 + (ob ^ (((ob >> 9) & 1) << 5)); }
__host__ __device__ __forceinline__ void stage_rc(int b, int& R, int& C) { const int st = b / 1024, sb = b % 1024, swz = sb ^ (((sb >> 9) & 1) << 5); R = (st >> 1) * 16 + swz / 64; C = (st & 1) * 32 + (swz % 64) / 2; }
__host__ __device__ __forceinline__ int perm32(int rho) { const int n = rho >> 4, i = rho & 15; return 8 * (i >> 2) + 4 * n + (i & 3); }

struct Unit { int pm, pn, sel; };
struct Gemm { const bf16_t* A0; const bf16_t* A1; const bf16_t* B0; const bf16_t* B1; int M, N, K; };

struct StaticOrder {
    int nM, nN, nwg, G, c;
    __host__ __device__ __forceinline__ void init(int M, int N, int G_, int c_) { nM = M / BM; nN = N / BM; nwg = nM * nN; G = G_; c = c_; }
    __host__ __device__ __forceinline__ bool next(int i, Unit& u) const {
        const long L = (long)i * G + c; if (L >= nwg) return false;
        int wgid = (int)L; { const int q = nwg / NXCD, r = nwg % NXCD, xcd = wgid % NXCD, off = wgid / NXCD; wgid = (xcd < r ? xcd * (q + 1) : r * (q + 1) + (xcd - r) * q) + off; }
        const int nig = WGM * nN, gid = wgid / nig, fm = gid * WGM, gsz = (nM - fm) < WGM ? (nM - fm) : WGM;
        u.pm = fm + ((wgid % nig) % gsz); u.pn = (wgid % nig) / gsz; u.sel = 0; return true;
    }
    __device__ __forceinline__ void a_ready(const Unit&) const {}
    __device__ __forceinline__ void done(const Unit&) const {}
};

__device__ __forceinline__ unsigned cvt_pk_bf16(float lo, float hi) { unsigned r; asm volatile("v_cvt_pk_bf16_f32 %0, %1, %2" : "=v"(r) : "v"(lo), "v"(hi)); return r; }
typedef unsigned u32x2 __attribute__((ext_vector_type(2)));
__device__ __forceinline__ float bflo(unsigned w) { return __uint_as_float(w << 16); }
__device__ __forceinline__ float bfhi(unsigned w) { return __uint_as_float(w & 0xffff0000u); }
__device__ __forceinline__ float sigm(float x) { return 1.0f / (1.0f + __expf(-x)); }
constexpr int GM = 16384;
constexpr int LDP = 1024;

struct EpiIn {
    static constexpr bool PERM = true, AFTER_DRAIN = false;
    bf16_t* proj; float* small;
    __device__ __forceinline__ void operator()(const f32x4 (&acc)[2][2][4][2], const Unit& u, int wr, int wc, int fr, int fq) const {
        const int row0 = u.pm * BM + wr * 64 + fr;
        if (u.pn < 36) {
            bf16_t* base = proj + (size_t)(u.pn >> 2) * ((size_t)GM * LDP) + (u.pn & 3) * 256 + wc * 32 + 8 * fq;
#pragma unroll
            for (int ai = 0; ai < 2; ++ai)
#pragma unroll
                for (int m = 0; m < 4; ++m) { bf16_t* rowp = base + (size_t)(row0 + ai * HALF + m * 16) * LDP;
#pragma unroll
                    for (int bj = 0; bj < 2; ++bj) { const f32x4 v0 = acc[ai][bj][m][0], v1 = acc[ai][bj][m][1];
                        u32x4 w; w.x = cvt_pk_bf16(v0[0], v0[1]); w.y = cvt_pk_bf16(v0[2], v0[3]); w.z = cvt_pk_bf16(v1[0], v1[1]); w.w = cvt_pk_bf16(v1[2], v1[3]);
                        *(u32x4*)(rowp + bj * HALF) = w; } }
        } else if (wc == 0 && fq < 3) {
#pragma unroll
            for (int ai = 0; ai < 2; ++ai)
#pragma unroll
                for (int m = 0; m < 4; ++m) { float* p = small + (size_t)(row0 + ai * HALF + m * 16) * 32 + 8 * fq;
                    *(f32x4*)p = acc[ai][0][m][0]; *(f32x4*)(p + 4) = acc[ai][0][m][1]; }
        }
    }
};
struct EpiY {
    static constexpr bool PERM = true, AFTER_DRAIN = false;
    const bf16_t* gf; const bf16_t* gg; bf16_t* t1; bf16_t* y;
    __device__ __forceinline__ void operator()(const f32x4 (&acc)[2][2][4][2], const Unit& u, int wr, int wc, int fr, int fq) const {
        const int row0 = u.pm * BM + wr * 64 + fr, col0 = u.pn * BM + wc * 32 + 8 * fq;
        const bf16_t* const gf_ = gf; const bf16_t* const gg_ = gg; bf16_t* const t1_ = t1; bf16_t* const y_ = y;
        const bf16_t* gate = u.sel ? gg_ : gf_; bf16_t* dst = u.sel ? y_ : t1_;
        if (u.sel) asm volatile("s_waitcnt vmcnt(0)" ::: "memory");
#pragma unroll
        for (int ai = 0; ai < 2; ++ai)
#pragma unroll
            for (int m = 0; m < 4; ++m) { const size_t ro = (size_t)(row0 + ai * HALF + m * 16) * LDP + col0;
#pragma unroll
                for (int bj = 0; bj < 2; ++bj) { const size_t o = ro + bj * HALF;
                    const u32x4 gw = *(const u32x4*)(gate + o); const f32x4 v0 = acc[ai][bj][m][0], v1 = acc[ai][bj][m][1];
                    float r0 = sigm(bflo(gw.x)) * v0[0], r1 = sigm(bfhi(gw.x)) * v0[1], r2 = sigm(bflo(gw.y)) * v0[2], r3 = sigm(bfhi(gw.y)) * v0[3];
                    float r4 = sigm(bflo(gw.z)) * v1[0], r5 = sigm(bfhi(gw.z)) * v1[1], r6 = sigm(bflo(gw.w)) * v1[2], r7 = sigm(bfhi(gw.w)) * v1[3];
                    if (u.sel) { const u32x4 tw = *(const u32x4*)(t1_ + o);
                        r0 += bflo(tw.x); r1 += bfhi(tw.x); r2 += bflo(tw.y); r3 += bfhi(tw.y); r4 += bflo(tw.z); r5 += bfhi(tw.z); r6 += bflo(tw.w); r7 += bfhi(tw.w); }
                    u32x4 w; w.x = cvt_pk_bf16(r0, r1); w.y = cvt_pk_bf16(r2, r3); w.z = cvt_pk_bf16(r4, r5); w.w = cvt_pk_bf16(r6, r7);
                    *(u32x4*)(dst + o) = w; } }
    }
};
struct EpiOut {
    static constexpr bool PERM = false, AFTER_DRAIN = false;
    const float* xin; float* hout; bf16_t* h1b; float* rowss;
    __device__ __forceinline__ void operator()(const f32x4 (&acc)[2][2][4][2], const Unit& u, int wr, int wc, int fr, int fq) const {
        const int col0 = u.pn * BM + wc * 32 + 4 * fq;
#pragma unroll
        for (int ai = 0; ai < 2; ++ai)
#pragma unroll
            for (int m = 0; m < 4; ++m) { const int row = u.pm * BM + ai * HALF + wr * 64 + m * 16 + fr; const size_t ro = (size_t)row * LDP + col0; float ss = 0.f;
#pragma unroll
                for (int bj = 0; bj < 2; ++bj)
#pragma unroll
                    for (int n = 0; n < 2; ++n) { const size_t o = ro + bj * HALF + n * 16; const f32x4 hv = *(const f32x4*)(xin + o) + acc[ai][bj][m][n];
                        *(f32x4*)(hout + o) = hv; u32x2 w; w.x = cvt_pk_bf16(hv[0], hv[1]); w.y = cvt_pk_bf16(hv[2], hv[3]); *(u32x2*)(h1b + o) = w;
                        ss += (hv[0] * hv[0] + hv[1] * hv[1]) + (hv[2] * hv[2] + hv[3] * hv[3]); }
                ss += __shfl_xor(ss, 16); ss += __shfl_xor(ss, 32);
                if (fq == 0) atomicAdd(rowss + row, ss); }
    }
};
struct EpiUp {
    static constexpr bool PERM = true, AFTER_DRAIN = false;
    bf16_t* up; const float* rowss; int ldc;
    __device__ __forceinline__ void operator()(const f32x4 (&acc)[2][2][4][2], const Unit& u, int wr, int wc, int fr, int fq) const {
        const int row0 = u.pm * BM + wr * 64 + fr, col0 = u.pn * BM + wc * 32 + 8 * fq;
#pragma unroll
        for (int ai = 0; ai < 2; ++ai)
#pragma unroll
            for (int m = 0; m < 4; ++m) { const int row = row0 + ai * HALF + m * 16; const float rs = rsqrtf(rowss[row] * (1.0f / 1024.0f) + 1e-6f); bf16_t* rowp = up + (size_t)row * ldc + col0;
#pragma unroll
                for (int bj = 0; bj < 2; ++bj) { const f32x4 v0 = acc[ai][bj][m][0] * rs, v1 = acc[ai][bj][m][1] * rs;
                    u32x4 w; w.x = cvt_pk_bf16(v0[0], v0[1]); w.y = cvt_pk_bf16(v0[2], v0[3]); w.z = cvt_pk_bf16(v1[0], v1[1]); w.w = cvt_pk_bf16(v1[2], v1[3]);
                    *(u32x4*)(rowp + bj * HALF) = w; } }
    }
};
struct EpiDown {
    static constexpr bool PERM = false, AFTER_DRAIN = false;
    float* hio; float* rowss;
    __device__ __forceinline__ void operator()(const f32x4 (&acc)[2][2][4][2], const Unit& u, int wr, int wc, int fr, int fq) const {
        const int col0 = u.pn * BM + wc * 32 + 4 * fq;
#pragma unroll
        for (int ai = 0; ai < 2; ++ai)
#pragma unroll
            for (int m = 0; m < 4; ++m) { const int row = u.pm * BM + ai * HALF + wr * 64 + m * 16 + fr; const size_t ro = (size_t)row * LDP + col0; float ss = 0.f;
#pragma unroll
                for (int bj = 0; bj < 2; ++bj)
#pragma unroll
                    for (int n = 0; n < 2; ++n) { const size_t o = ro + bj * HALF + n * 16; const f32x4 hv = *(const f32x4*)(hio + o) + acc[ai][bj][m][n];
                        *(f32x4*)(hio + o) = hv; ss += (hv[0] * hv[0] + hv[1] * hv[1]) + (hv[2] * hv[2] + hv[3] * hv[3]); }
                ss += __shfl_xor(ss, 16); ss += __shfl_xor(ss, 32);
                if (fq == 0) atomicAdd(rowss + row, ss); }
    }
};
struct PairOrder {
    int nM, nN, nwg, G, c;
    __host__ __device__ __forceinline__ void init(int M, int N, int G_, int c_) { nM = M / BM; nN = N / BM; nwg = nM * nN; G = G_; c = c_; }
    __host__ __device__ __forceinline__ bool next(int i, Unit& u) const {
        const long L = (long)(i >> 1) * G + c; if (L >= nwg) return false;
        int wgid = (int)L; { const int q = nwg / NXCD, r = nwg % NXCD, xcd = wgid % NXCD, off = wgid / NXCD; wgid = (xcd < r ? xcd * (q + 1) : r * (q + 1) + (xcd - r) * q) + off; }
        const int nig = WGM * nN, gid = wgid / nig, fm = gid * WGM, gsz = (nM - fm) < WGM ? (nM - fm) : WGM;
        u.pm = fm + ((wgid % nig) % gsz); u.pn = (wgid % nig) / gsz; u.sel = i & 1; return true;
    }
    __device__ __forceinline__ void a_ready(const Unit&) const {}
    __device__ __forceinline__ void done(const Unit&) const {}
};
template <class Epi, class Sched, bool ALIGN_EPI = false, bool SP2 = false>
__device__ __forceinline__ void gemm_phase(PG8_LAS unsigned char* lds, const Gemm g, const Sched& S, const Epi& E) {
    int tid_l = threadIdx.x; asm volatile("" : "+v"(tid_l));
    const int tid = tid_l, wid = __builtin_amdgcn_readfirstlane(tid >> 6), lane = tid & 63, wr = wid >> 2, wc = wid & 3, fr = lane & 15, fq = lane >> 4;
    const int K = g.K, nt = K / BK;
    unsigned voffA[2], voffB[2];
#pragma unroll
    for (int i = 0; i < 2; ++i) { int R, C; stage_rc(tid * 16 + i * 8192, R, C); const int Rb = Epi::PERM ? ((R & ~31) + perm32(R & 31)) : R;
        voffA[i] = (unsigned)(R * K + C) * 2u; voffB[i] = (unsigned)(Rb * K + C) * 2u; }
    const size_t kstep = (size_t)(BK * 2);
    const size_t hstep = (size_t)HALF * K * 2;
    const size_t tstep = 2 * hstep;
    const unsigned ldsw = (unsigned)wid * 1024u;
    const int aoff = lds_byte(wr * 64 + fr, fq * 8), boff = lds_byte(wc * 32 + fr, fq * 8);
#define PG8_SA(b, h) (((b) * 2 + (h)) * HTB)
#define PG8_SB(b, h) ((4 + (b) * 2 + (h)) * HTB)
#define PG8_STAGE(bufoff, gbase, voff) do { _Pragma("unroll") for (int _i = 0; _i < 2; ++_i) \
        __builtin_amdgcn_global_load_lds((const unsigned*)((const char*)(gbase) + (voff)[_i]), (PG8_LAS unsigned*)(lds + (bufoff) + ldsw + _i * 8192), 16, 0, 0); } while (0)
#define PG8_LDA(dst, b, h) do { _Pragma("unroll") for (int m = 0; m < 4; ++m) _Pragma("unroll") for (int k = 0; k < 2; ++k) dst[m][k] = *(const PG8_LAS bf16x8*)(lds + PG8_SA(b, h) + aoff + m * 2048 + k * 1024); } while (0)
#define PG8_LDB(dst, b, h) do { _Pragma("unroll") for (int n = 0; n < 2; ++n) _Pragma("unroll") for (int k = 0; k < 2; ++k) dst[n][k] = *(const PG8_LAS bf16x8*)(lds + PG8_SB(b, h) + boff + n * 2048 + k * 1024); } while (0)
#define PG8_MMA(ai, bj, At, Bt) do { __builtin_amdgcn_s_setprio(1); _Pragma("unroll") for (int m = 0; m < 4; ++m) _Pragma("unroll") for (int n = 0; n < 2; ++n) _Pragma("unroll") for (int k = 0; k < 2; ++k) \
        acc[ai][bj][m][n] = __builtin_amdgcn_mfma_f32_16x16x32_bf16(Bt[n][k], At[m][k], acc[ai][bj][m][n], 0, 0, 0); __builtin_amdgcn_s_setprio(0); } while (0)
#define PG8_WAIT_V(n) asm volatile("s_waitcnt vmcnt(" #n ")" ::: "memory")
#define PG8_WAIT_L(n) asm volatile("s_waitcnt lgkmcnt(" #n ")" ::: "memory")
#define PG8_BAR __builtin_amdgcn_s_barrier()
#define PG8_SCHED __builtin_amdgcn_sched_barrier(0)
    Unit cur, nxt; int ui = 0;
    if (!S.next(0, cur)) return;
    f32x4 acc[2][2][4][2];
#pragma unroll
    for (int a = 0; a < 2; ++a)
#pragma unroll
        for (int b = 0; b < 2; ++b)
#pragma unroll
            for (int m = 0; m < 4; ++m)
#pragma unroll
                for (int n = 0; n < 2; ++n) acc[a][b][m][n] = (f32x4){0.f, 0.f, 0.f, 0.f};
    bf16x8 At[4][2], B0[2][2], B1[2][2];
    const char* cA = (const char*)(cur.sel ? g.A1 : g.A0) + (size_t)cur.pm * tstep; const char* cB = (const char*)(cur.sel ? g.B1 : g.B0) + (size_t)cur.pn * tstep;
    S.a_ready(cur);
    if constexpr (SP2) {
        PG8_STAGE(PG8_SB(0, 0), cB, voffB); PG8_STAGE(PG8_SB(0, 1), cB + hstep, voffB); PG8_STAGE(PG8_SA(0, 0), cA, voffA); PG8_STAGE(PG8_SA(0, 1), cA + hstep, voffA);
        if (wr == 1) PG8_BAR;
        PG8_WAIT_V(2); PG8_BAR;
        PG8_STAGE(PG8_SB(1, 0), cB + kstep, voffB); PG8_STAGE(PG8_SA(1, 0), cA + kstep, voffA); PG8_STAGE(PG8_SB(1, 1), cB + hstep + kstep, voffB);
        PG8_WAIT_V(6); PG8_BAR;
    } else {
        PG8_STAGE(PG8_SB(0, 0), cB, voffB); PG8_STAGE(PG8_SA(0, 0), cA, voffA); PG8_STAGE(PG8_SB(0, 1), cB + hstep, voffB); PG8_STAGE(PG8_SA(0, 1), cA + hstep, voffA);
        if (wr == 1) PG8_BAR;
        PG8_WAIT_V(4); PG8_BAR;
        PG8_STAGE(PG8_SB(1, 0), cB + kstep, voffB); PG8_STAGE(PG8_SA(1, 0), cA + kstep, voffA); PG8_STAGE(PG8_SB(1, 1), cB + hstep + kstep, voffB);
        PG8_WAIT_V(6); PG8_BAR;
    }
    for (;;) {
        const bool has_next = S.next(ui + 1, nxt);
        const char* nA = has_next ? (const char*)(nxt.sel ? g.A1 : g.A0) + (size_t)nxt.pm * tstep : cA; const char* nB = has_next ? (const char*)(nxt.sel ? g.B1 : g.B0) + (size_t)nxt.pn * tstep : cB;
        for (int t = 0; t < nt; t += 2) {
            const bool last = (t == nt - 2);
            const char* a1 = cA + (size_t)(t + 1) * kstep;
            const char* a2 = last ? nA : cA + (size_t)(t + 2) * kstep; const char* b2 = last ? nB : cB + (size_t)(t + 2) * kstep;
            const char* a3 = a2 + kstep; const char* b3 = b2 + kstep;
            if (last && has_next) S.a_ready(nxt);
            if constexpr (SP2) {
            PG8_LDB(B0, 0, 0); PG8_LDB(B1, 0, 1); PG8_SCHED; PG8_LDA(At, 0, 0); PG8_STAGE(PG8_SA(1, 1), a1 + hstep, voffA);
            PG8_WAIT_V(8); PG8_WAIT_L(0); PG8_BAR; PG8_MMA(0, 0, At, B0); PG8_MMA(0, 1, At, B1); PG8_BAR; PG8_SCHED;
            PG8_LDA(At, 0, 1); PG8_STAGE(PG8_SB(0, 0), b2, voffB); PG8_STAGE(PG8_SB(0, 1), b2 + hstep, voffB); PG8_STAGE(PG8_SA(0, 0), a2, voffA);
            PG8_WAIT_V(8); PG8_WAIT_L(0); PG8_BAR; PG8_MMA(1, 0, At, B0); PG8_MMA(1, 1, At, B1); PG8_BAR; PG8_SCHED;
            PG8_LDB(B0, 1, 0); PG8_LDB(B1, 1, 1); PG8_SCHED; PG8_LDA(At, 1, 0); PG8_STAGE(PG8_SA(0, 1), a2 + hstep, voffA);
            PG8_WAIT_V(8); PG8_WAIT_L(0); PG8_BAR; PG8_MMA(0, 0, At, B0); PG8_MMA(0, 1, At, B1); PG8_BAR; PG8_SCHED;
            PG8_LDA(At, 1, 1); PG8_STAGE(PG8_SB(1, 0), b3, voffB); PG8_STAGE(PG8_SB(1, 1), b3 + hstep, voffB); PG8_STAGE(PG8_SA(1, 0), a3, voffA);
            PG8_WAIT_V(8); PG8_WAIT_L(0); PG8_BAR; PG8_MMA(1, 0, At, B0); PG8_MMA(1, 1, At, B1); PG8_BAR; PG8_SCHED;
            } else {
            PG8_LDB(B0, 0, 0); PG8_SCHED; PG8_LDA(At, 0, 0); PG8_STAGE(PG8_SA(1, 1), a1 + hstep, voffA);
            PG8_WAIT_L(8); PG8_BAR; PG8_WAIT_L(0); PG8_MMA(0, 0, At, B0); PG8_BAR; PG8_SCHED;
            PG8_LDB(B1, 0, 1); PG8_STAGE(PG8_SB(0, 0), b2, voffB);
            PG8_BAR; PG8_WAIT_L(0); PG8_MMA(0, 1, At, B1); PG8_BAR;
            PG8_LDA(At, 0, 1); PG8_STAGE(PG8_SA(0, 0), a2, voffA);
            PG8_BAR; PG8_WAIT_L(0); PG8_MMA(1, 0, At, B0); PG8_BAR; PG8_SCHED;
            PG8_STAGE(PG8_SB(0, 1), b2 + hstep, voffB);
            PG8_WAIT_V(6); PG8_BAR; PG8_MMA(1, 1, At, B1); PG8_BAR;
            PG8_LDB(B0, 1, 0); PG8_SCHED; PG8_LDA(At, 1, 0); PG8_STAGE(PG8_SA(0, 1), a2 + hstep, voffA);
            PG8_WAIT_L(8); PG8_BAR; PG8_WAIT_L(0); PG8_MMA(0, 0, At, B0); PG8_BAR; PG8_SCHED;
            PG8_LDB(B1, 1, 1); PG8_STAGE(PG8_SB(1, 0), b3, voffB);
            PG8_BAR; PG8_WAIT_L(0); PG8_MMA(0, 1, At, B1); PG8_BAR;
            PG8_LDA(At, 1, 1); PG8_STAGE(PG8_SA(1, 0), a3, voffA);
            PG8_BAR; PG8_WAIT_L(0); PG8_MMA(1, 0, At, B0); PG8_BAR; PG8_SCHED;
            PG8_STAGE(PG8_SB(1, 1), b3 + hstep, voffB);
            PG8_WAIT_V(6); PG8_BAR; PG8_MMA(1, 1, At, B1); PG8_BAR;
            }
        }
        if constexpr (ALIGN_EPI) { if (wr == 0) PG8_BAR; }
        if constexpr (!Epi::AFTER_DRAIN) { E(acc, cur, wr, wc, fr, fq); S.done(cur); }
        if (!has_next) break;
#pragma unroll
        for (int a = 0; a < 2; ++a)
#pragma unroll
            for (int b = 0; b < 2; ++b)
#pragma unroll
                for (int m = 0; m < 4; ++m)
#pragma unroll
                    for (int n = 0; n < 2; ++n) acc[a][b][m][n] = (f32x4){0.f, 0.f, 0.f, 0.f};
        cur = nxt; cA = nA; cB = nB; ++ui;
        if constexpr (ALIGN_EPI) { if (wr == 1) PG8_BAR; }
    }
    PG8_WAIT_V(0);
    if constexpr (!ALIGN_EPI) { if (wr == 0) PG8_BAR; }
    PG8_BAR;
    if constexpr (Epi::AFTER_DRAIN) { E.fused(acc, cur, wr, wc, fr, fq, lds, wid, lane); S.done(cur); }
#undef PG8_SA
#undef PG8_SB
#undef PG8_STAGE
#undef PG8_LDA
#undef PG8_LDB
#undef PG8_MMA
#undef PG8_WAIT_V
#undef PG8_WAIT_L
#undef PG8_BAR
#undef PG8_SCHED
}
}

namespace fox {
constexpr int D = 128, PITCH = 1024;
constexpr bool WSKIP = false;
constexpr float THR = 8.f;
constexpr float SCALE = 0.08838834764831845f;
constexpr int NW = 8, QBLK = 32, KVBLK = 64, QB = NW * QBLK;
constexpr int SHM_V = KVBLK * D * 2, SHM_K = KVBLK * D * 2;
constexpr int LDS_BYTES = 2 * SHM_V + 2 * SHM_K + NW * 64 * 4;
using bf16 = __hip_bfloat16;
typedef short bf16x8 __attribute__((ext_vector_type(8)));
typedef short s16x4 __attribute__((ext_vector_type(4)));
typedef float f32x16 __attribute__((ext_vector_type(16)));
typedef float f32x4 __attribute__((ext_vector_type(4)));
typedef unsigned u32x4 __attribute__((ext_vector_type(4)));
template <class A, class Bt> struct same_t { static constexpr bool v = false; };
template <class A> struct same_t<A, A> { static constexpr bool v = true; };
__device__ __forceinline__ void bias_tile(f32x16& p0, f32x16& p1, const float* cbp) {
#pragma unroll
    for (int rr = 0; rr < 4; ++rr) { const f32x4 a = *(const f32x4*)(cbp + 8 * rr), b = *(const f32x4*)(cbp + 32 + 8 * rr);
#pragma unroll
        for (int e = 0; e < 4; ++e) { p0[4 * rr + e] += a[e]; p1[4 * rr + e] += b[e]; } }
}
#define KSWZ(row, colB) ((row) * 256 + ((colB) ^ (((row) & 7) << 4)))
#define SBAR() __builtin_amdgcn_sched_barrier(0)
__device__ __forceinline__ int v_st(int k, int c) { const int kk = (k & ~0xC) | ((k & 4) << 1) | ((k & 8) >> 1); return ((kk >> 3) * 4 + (c >> 5)) * 512 + ((kk & 7) * 32 + (c & 31)) * 2; }
__device__ __forceinline__ int v_rd_base(int lane) { return ((lane & 3) << 3) | (((lane >> 2) & 3) << 6) | (((lane >> 4) & 1) << 5) | (((lane >> 5) & 1) << 8); }
constexpr int v_rd_off(int d0, int ks, int half) { return d0 * 512 + ks * 4096 + half * 2048; }
__device__ __forceinline__ int crow(int r, int hi) { return (r & 3) + 8 * (r >> 2) + 4 * hi; }
__device__ __forceinline__ unsigned cvtpk(float lo, float hi) {
    unsigned r; asm volatile("v_cvt_pk_bf16_f32 %0, %1, %2" : "=v"(r) : "v"(lo), "v"(hi)); return r;
}
__device__ __forceinline__ bf16x8 pack8(f32x4 a, f32x4 b) {
    u32x4 w = {cvtpk(a[0], a[1]), cvtpk(a[2], a[3]), cvtpk(b[0], b[1]), cvtpk(b[2], b[3])};
    return *reinterpret_cast<bf16x8*>(&w);
}
template <class T> __device__ __forceinline__ bf16x8 load8(const T* p) {
    if constexpr (same_t<T, float>::v) { return pack8(*(const f32x4*)p, *(const f32x4*)(p + 4)); }
    else { return *reinterpret_cast<const bf16x8*>(p); }
}
__device__ __forceinline__ void mask_tile(f32x16& p0, f32x16& p1, int dq, unsigned W) {
    const float NEG = -__builtin_inff();
#pragma unroll
    for (int r = 0; r < 16; ++r) {
        const int c = (r & 3) + 8 * (r >> 2);
        if ((unsigned)(dq - c) >= W) p0[r] = NEG;
        if ((unsigned)(dq - c - 32) >= W) p1[r] = NEG;
    }
}
__device__ __forceinline__ void partialSM(f32x16& p0, f32x16& p1, float& m_reg, float& mn, float& alpha) {
    float pmax = p0[0]; for (int r = 1; r < 16; ++r) pmax = fmaxf(pmax, p0[r]); for (int r = 0; r < 16; ++r) pmax = fmaxf(pmax, p1[r]);
    { auto rr = __builtin_amdgcn_permlane32_swap(__float_as_uint(pmax), __float_as_uint(pmax), false, false);
      pmax = fmaxf(__uint_as_float(rr[0]), __uint_as_float(rr[1])); }
    constexpr float C2 = 1.4426950408889634f * SCALE;
    if (__builtin_expect(__all((pmax - m_reg) * SCALE <= THR), 1)) { mn = m_reg; alpha = 1.f; }
    else { mn = fmaxf(m_reg, pmax); alpha = __builtin_amdgcn_exp2f((m_reg - mn) * C2); m_reg = mn; }
    const float mnL = -mn * C2;
    for (int r = 0; r < 16; ++r) p0[r] = fmaf(p0[r], C2, mnL); for (int r = 0; r < 16; ++r) p1[r] = fmaf(p1[r], C2, mnL);
    for (int r = 0; r < 16; ++r) p0[r] = __builtin_amdgcn_exp2f(p0[r]);
}
__device__ __forceinline__ void finishSM(f32x16& p0, f32x16& p1, float alpha, float& l_reg, bf16x8& pa0, bf16x8& pa1, bf16x8& pa2, bf16x8& pa3) {
    for (int r = 0; r < 16; ++r) p1[r] = __builtin_amdgcn_exp2f(p1[r]);
    float ps = 0; for (int r = 0; r < 16; ++r) ps += p0[r]; for (int r = 0; r < 16; ++r) ps += p1[r];
    { auto rr = __builtin_amdgcn_permlane32_swap(__float_as_uint(ps), __float_as_uint(ps), false, false);
      ps = __uint_as_float(rr[0]) + __uint_as_float(rr[1]); }
    l_reg = l_reg * alpha + ps;
#define PK4(P, B_, OUT) do { unsigned a0 = cvtpk(P[B_+0], P[B_+1]), a1 = cvtpk(P[B_+2], P[B_+3]);                          \
        unsigned b0 = cvtpk(P[B_+4], P[B_+5]), b1 = cvtpk(P[B_+6], P[B_+7]);                                             \
        auto r0 = __builtin_amdgcn_permlane32_swap(a0, b0, false, false); auto r1 = __builtin_amdgcn_permlane32_swap(a1, b1, false, false); \
        u32x4 w = {r0[0], r1[0], r0[1], r1[1]}; OUT = *reinterpret_cast<bf16x8*>(&w); } while (0)
    PK4(p0, 0, pa0); PK4(p0, 8, pa1); PK4(p1, 0, pa2); PK4(p1, 8, pa3);
#undef PK4
}
template <int KB, bool SK>
__device__ __forceinline__ void qkt(f32x16& p0, f32x16& p1, const char* K_lds, int r32, int hi, const bf16x8* qr, bool act, const float* cbp) {
    if (SK && !act) { const float NEG = -__builtin_inff();
#pragma unroll
        for (int r = 0; r < 16; ++r) { p0[r] = NEG; p1[r] = NEG; } return; }
    { const f32x4* c4 = (const f32x4*)cbp; const f32x4 a0 = c4[0], a1 = c4[2], a2 = c4[4], a3 = c4[6], b0 = c4[8], b1 = c4[10], b2 = c4[12], b3 = c4[14];
      p0 = (f32x16){a0[0], a0[1], a0[2], a0[3], a1[0], a1[1], a1[2], a1[3], a2[0], a2[1], a2[2], a2[3], a3[0], a3[1], a3[2], a3[3]};
      p1 = (f32x16){b0[0], b0[1], b0[2], b0[3], b1[0], b1[1], b1[2], b1[3], b2[0], b2[1], b2[2], b2[3], b3[0], b3[1], b3[2], b3[3]}; }
    const char* kb[4];
#pragma unroll
    for (int dd = 0; dd < 4; ++dd) kb[dd] = K_lds + KB * SHM_K + KSWZ(r32, (dd * 16 + hi * 8) * 2);
#pragma unroll
    for (int d0 = 0; d0 < 8; ++d0) { const char* a = kb[d0 & 3] + (d0 >> 2) * 128;
        bf16x8 b0 = *reinterpret_cast<const bf16x8*>(a);
        bf16x8 b1 = *reinterpret_cast<const bf16x8*>(a + 32 * 256);
        p0 = __builtin_amdgcn_mfma_f32_32x32x16_bf16(b0, qr[d0], p0, 0, 0, 0);
        p1 = __builtin_amdgcn_mfma_f32_32x32x16_bf16(b1, qr[d0], p1, 0, 0, 0); }
}
template <int VB, bool SK>
__device__ __forceinline__ void pv_tile(f32x16* o, int vb0, bf16x8 pa0, bf16x8 pa1, bf16x8 pa2, bf16x8 pa3, bool act) {
    if (SK && !act) return;
#define TRRD(dst, off) asm volatile("ds_read_b64_tr_b16 %0, %1 offset:%2" : "=&v"(dst) : "v"(vb0), "i"(off) : "memory")
#define PV_D0(d0) do { s16x4 l0, l1, l2, l3, h0, h1, h2, h3; constexpr int b_ = VB * SHM_V + v_rd_off(d0, 0, 0);     \
        TRRD(l0, b_); TRRD(h0, b_ + 2048); TRRD(l1, b_ + 4096); TRRD(h1, b_ + 6144); TRRD(l2, b_ + 8192); TRRD(h2, b_ + 10240); TRRD(l3, b_ + 12288); TRRD(h3, b_ + 14336); \
        asm volatile("s_waitcnt lgkmcnt(0)" ::: "memory"); SBAR();                 \
        o[d0] = __builtin_amdgcn_mfma_f32_32x32x16_bf16(pa0, (bf16x8){l0[0], l0[1], l0[2], l0[3], h0[0], h0[1], h0[2], h0[3]}, o[d0], 0, 0, 0);   \
        o[d0] = __builtin_amdgcn_mfma_f32_32x32x16_bf16(pa1, (bf16x8){l1[0], l1[1], l1[2], l1[3], h1[0], h1[1], h1[2], h1[3]}, o[d0], 0, 0, 0);   \
        o[d0] = __builtin_amdgcn_mfma_f32_32x32x16_bf16(pa2, (bf16x8){l2[0], l2[1], l2[2], l2[3], h2[0], h2[1], h2[2], h2[3]}, o[d0], 0, 0, 0);   \
        o[d0] = __builtin_amdgcn_mfma_f32_32x32x16_bf16(pa3, (bf16x8){l3[0], l3[1], l3[2], l3[3], h3[0], h3[1], h3[2], h3[3]}, o[d0], 0, 0, 0); } while (0)
    PV_D0(0); PV_D0(1); PV_D0(2); PV_D0(3);
#undef PV_D0
#undef TRRD
}

template <class TIn, class TOut> struct BlockRef { const TIn* Q; const TIn* K; const TIn* V; TOut* O; int P0; };
template <class TIn> struct Seam {
    bf16x8 qr[8];
    bf16x8 st_v0, st_v1, st_k0, st_k1; f32x4 sf0, sf1, sf2, sf3;
    f32x4 tq[16];
};
__device__ __forceinline__ int swa_jlo(int P0, int W) { const int lowk = P0 - W + 1; return lowk > 0 ? lowk / KVBLK : 0; }
#define ROW(p, k0, rr) ((p) + (size_t)((k0) + (rr)) * PITCH + sc)
#define VMW() asm volatile("s_waitcnt vmcnt(0)" ::: "memory")
#define VMWN(n) asm volatile("s_waitcnt vmcnt(%0)" :: "i"(n) : "memory")
#define SLOAD_H(Kp, Vp, k0) do { S.st_v0 = load8<TIn>(ROW(Vp, k0, sr)); S.st_v1 = load8<TIn>(ROW(Vp, k0, 32 + sr));              \
                         S.st_k0 = load8<TIn>(ROW(Kp, k0, sr)); S.st_k1 = load8<TIn>(ROW(Kp, k0, 32 + sr)); } while (0)
#define SWRITE_HK(bf) do { *(bf16x8*)(K_lds + (bf) * SHM_K + kws) = S.st_k0; *(bf16x8*)(K_lds + (bf) * SHM_K + kws + 32 * 256) = S.st_k1; } while (0)
#define SWRITE_HV(bf) do { *(bf16x8*)(V_lds + (bf) * SHM_V + vst0) = S.st_v0; *(bf16x8*)(V_lds + (bf) * SHM_V + vst1) = S.st_v1; } while (0)
#define SWRITE_H(bf) do { SWRITE_HV(bf); SWRITE_HK(bf); } while (0)
#define SLOAD_F(p, k0) do { S.sf0 = *(const f32x4*)ROW(p, k0, sr); S.sf1 = *(const f32x4*)(ROW(p, k0, sr) + 4);                \
                            S.sf2 = *(const f32x4*)ROW(p, k0, 32 + sr); S.sf3 = *(const f32x4*)(ROW(p, k0, 32 + sr) + 4); } while (0)
#define SWRITE_KF(bf) do { *(bf16x8*)(K_lds + (bf) * SHM_K + kws) = pack8(S.sf0, S.sf1); *(bf16x8*)(K_lds + (bf) * SHM_K + kws + 32 * 256) = pack8(S.sf2, S.sf3); } while (0)
#define SWRITE_VF(bf) do { *(bf16x8*)(V_lds + (bf) * SHM_V + vst0) = pack8(S.sf0, S.sf1); *(bf16x8*)(V_lds + (bf) * SHM_V + vst1) = pack8(S.sf2, S.sf3); } while (0)
template <class TIn, class TOut>
__device__ __forceinline__ void causal_swa_prime(const BlockRef<TIn, TOut>& cur, int W, char* lds, Seam<TIn>& S) {
    constexpr bool F32 = same_t<TIn, float>::v;
    int tid_l = threadIdx.x; asm volatile("" : "+v"(tid_l));
    const int tid = tid_l, wid = __builtin_amdgcn_readfirstlane(tid >> 6), lane = tid & 63, r32 = lane & 31, hi = lane >> 5;
    const int sr = tid >> 4, sc = (tid & 15) * 8, kws = KSWZ(sr, sc * 2); char* K_lds = lds + 2 * SHM_V;
    const int kb0 = swa_jlo(cur.P0, W) * KVBLK;
    for (int d0 = 0; d0 < 8; ++d0) S.qr[d0] = load8<TIn>(cur.Q + (size_t)(wid * QBLK + r32) * PITCH + d0 * 16 + hi * 8);
    if constexpr (F32) { SLOAD_F((const float*)cur.K, kb0); VMW(); SWRITE_KF(0); SBAR(); SLOAD_F((const float*)cur.V, kb0); }
    else { SLOAD_H(cur.K, cur.V, kb0); VMW(); SWRITE_HK(0); }
    __syncthreads();
}
template <class TIn, class TOut>
__device__ __forceinline__ void causal_swa_block(const BlockRef<TIn, TOut>& cur, const BlockRef<TIn, TOut>& nxt, int skv, int W, char* lds, Seam<TIn>& S, const float* cbias) {
    constexpr bool F32 = same_t<TIn, float>::v;
    int tid_l = threadIdx.x; asm volatile("" : "+v"(tid_l));
    const int tid = tid_l, wid = __builtin_amdgcn_readfirstlane(tid >> 6), lane = tid & 63, r32 = lane & 31, hi = lane >> 5;
    const int j_lo = swa_jlo(cur.P0, W);
    int j_hi = (cur.P0 + QB - 1) / KVBLK + 1; if (j_hi > skv / KVBLK) j_hi = skv / KVBLK;
    const int NT = j_hi - j_lo;
    const int kbn = swa_jlo(nxt.P0, W) * KVBLK;
    const int qlo = cur.P0 + wid * QBLK, qm = qlo + r32 - 4 * hi;
    char* V_lds = lds; char* K_lds = lds + 2 * SHM_V;
    float* ws = (float*)(lds + 2 * SHM_V + 2 * SHM_K) + wid * 64; float* li_l = ws, * al_l = ws + 32;
    float m_reg = -1e30f, l_reg = 0; f32x16 o[4] = {};
    const int sr = tid >> 4, sc = (tid & 15) * 8, vst0 = v_st(sr, sc), vst1 = v_st(32 + sr, sc), kws = KSWZ(sr, sc * 2);
    const int vb0 = (int)(uintptr_t)V_lds + v_rd_base(lane);
    const TIn* Kh = cur.K; const TIn* Vh = cur.V;
#define RESC(a) do { if (__any((a) < 1.f)) { if (hi == 0) al_l[r32] = (a); asm volatile("s_waitcnt lgkmcnt(0)" ::: "memory");              \
                     for (int d_ = 0; d_ < 4; ++d_) for (int r = 0; r < 16; ++r) o[d_][r] *= al_l[crow(r, hi)]; } } while (0)
#define KBASE(t) ((j_lo + (t)) * KVBLK)
#define ACT(t) (KBASE(t) <= qlo + QBLK - 1 && KBASE(t) + KVBLK - 1 >= qlo - W + 1)
#define MASKT(P0_, P1_, t) do { const int kb_ = KBASE(t); if ((!SK || ACT(t)) && (kb_ + KVBLK - 1 > qlo || kb_ <= qlo + QBLK - 1 - W)) mask_tile(P0_, P1_, qm - kb_, (unsigned)W); } while (0)
    constexpr int NQL = F32 ? 16 : 8;
    constexpr bool SK = WSKIP && !F32;
#define SEAM_K0() do { VMWN(NQL); if constexpr (F32) { SWRITE_KF(0); SBAR(); SLOAD_F((const float*)nxt.V, kbn); } else { SWRITE_HK(0); } SBAR(); } while (0)
    f32x16 pA0, pA1, pB0, pB1; float mnA, mnB, alA, alB; bf16x8 pa0, pa1, pa2, pa3;
    if constexpr (F32) { VMW(); SWRITE_VF(0); SBAR(); } else { SWRITE_HV(0); SBAR(); }
    if (NT > 1) { if constexpr (F32) SLOAD_F((const float*)Kh, KBASE(1)); else SLOAD_H(Kh, Vh, KBASE(1)); }
    SBAR(); qkt<0, SK>(pA0, pA1, K_lds, r32, hi, S.qr, ACT(0), cbias + KBASE(0) + 4 * hi);
    if constexpr (F32) { if (NT > 1) { VMW(); SWRITE_KF(1); SBAR(); SLOAD_F((const float*)Vh, KBASE(1)); } }
    MASKT(pA0, pA1, 0); partialSM(pA0, pA1, m_reg, mnA, alA);
    if (NT > 1) { VMW(); if constexpr (F32) { SWRITE_VF(1); SBAR(); if (NT > 2) SLOAD_F((const float*)Kh, KBASE(2)); } else SWRITE_H(1); }
    __syncthreads();
#define HALF_STEP(PX0, PX1, mnX, alX, PY0, PY1, alY, t, KB, VB, SB) do {                                                      \
        SBAR(); qkt<KB, SK>(PX0, PX1, K_lds, r32, hi, S.qr, ACT(t), cbias + KBASE(t) + 4 * hi);                                             \
        finishSM(PY0, PY1, alY, l_reg, pa0, pa1, pa2, pa3); SBAR();                                                           \
        if ((t) + 1 < NT) { if constexpr (F32) { VMW(); SWRITE_KF(SB); SBAR(); SLOAD_F((const float*)Vh, KBASE((t) + 1)); }  \
                            else { SLOAD_H(Kh, Vh, KBASE((t) + 1)); } SBAR(); }                                               \
        pv_tile<VB, SK>(o, vb0, pa0, pa1, pa2, pa3, ACT((t) - 1)); MASKT(PX0, PX1, (t)); partialSM(PX0, PX1, m_reg, mnX, alX);                                        \
        __syncthreads();                                                                                                      \
        if ((t) + 1 < NT) { VMW(); if constexpr (F32) { SWRITE_VF(SB); SBAR(); if ((t) + 2 < NT) SLOAD_F((const float*)Kh, KBASE((t) + 2)); } \
                            else { SWRITE_H(SB); } }                                                                          \
        RESC(alX); __syncthreads(); } while (0)
    for (int t = 1; t + 1 < NT; t += 2) {
        HALF_STEP(pB0, pB1, mnB, alB, pA0, pA1, alA, t, 1, 0, 0);
        HALF_STEP(pA0, pA1, mnA, alA, pB0, pB1, alB, t + 1, 0, 1, 1);
    }
    const bool even = (NT & 1) == 0;
    if (even) { SBAR(); qkt<1, SK>(pB0, pB1, K_lds, r32, hi, S.qr, ACT(NT - 1), cbias + KBASE(NT - 1) + 4 * hi); SBAR(); }
#define QROW(e) (nxt.Q + (size_t)(wid * QBLK + r32) * PITCH + ((e) >> 1) * 16 + hi * 8 + ((e) & 1) * 4)
    if constexpr (F32) { SLOAD_F((const float*)nxt.K, kbn); SBAR();
#pragma unroll
        for (int e = 0; e < 8; ++e) S.tq[e] = *(const f32x4*)QROW(e); }
    else { SLOAD_H(nxt.K, nxt.V, kbn); SBAR();
#pragma unroll
        for (int d0 = 0; d0 < 8; ++d0) S.qr[d0] = load8<TIn>(nxt.Q + (size_t)(wid * QBLK + r32) * PITCH + d0 * 16 + hi * 8); }
    SBAR();
    finishSM(pA0, pA1, alA, l_reg, pa0, pa1, pa2, pa3); SBAR();
    if constexpr (F32) {
#pragma unroll
        for (int e = 8; e < 16; ++e) S.tq[e] = *(const f32x4*)QROW(e); SBAR(); }
#undef QROW
    pv_tile<0, SK>(o, vb0, pa0, pa1, pa2, pa3, ACT(even ? NT - 2 : NT - 1));
    if (even) { MASKT(pB0, pB1, NT - 1); partialSM(pB0, pB1, m_reg, mnB, alB); __syncthreads(); RESC(alB);
        finishSM(pB0, pB1, alB, l_reg, pa0, pa1, pa2, pa3); SBAR(); pv_tile<1, SK>(o, vb0, pa0, pa1, pa2, pa3, ACT(NT - 1)); }
    SBAR(); SEAM_K0();
    if (hi == 0) li_l[r32] = l_reg; asm volatile("s_waitcnt lgkmcnt(0)" ::: "memory");
    float rli[16];
#pragma unroll
    for (int r = 0; r < 16; ++r) rli[r] = __builtin_amdgcn_rcpf(li_l[crow(r, hi)]);
    TOut* Ow = cur.O + (size_t)(wid * QBLK) * PITCH;
#pragma unroll
    for (int r = 0; r < 16; ++r) { const int orow = crow(r, hi);
#pragma unroll
        for (int d0 = 0; d0 < 4; ++d0) { const float v = o[d0][r] * rli[r];
            if constexpr (same_t<TOut, float>::v) { Ow[(size_t)orow * PITCH + d0 * 32 + r32] = v; }
            else { const float vn = __shfl_xor(v, 1);
                   if ((r32 & 1) == 0) *(unsigned*)(Ow + (size_t)orow * PITCH + d0 * 32 + r32) = cvtpk(v, vn); } } }
    if constexpr (F32) {
#pragma unroll
        for (int d0 = 0; d0 < 8; ++d0) S.qr[d0] = pack8(S.tq[2 * d0], S.tq[2 * d0 + 1]); }
    __syncthreads();
#undef RESC
#undef KBASE
#undef ACT
#undef MASKT
#undef SEAM_K0
#undef HALF_STEP
}
#undef ROW
#undef VMW
#undef VMWN
#undef SLOAD_H
#undef SWRITE_HK
#undef SWRITE_HV
#undef SWRITE_H
#undef SLOAD_F
#undef SWRITE_KF
#undef SWRITE_VF
}

typedef unsigned short bf16_t;
typedef short bf16x8 __attribute__((ext_vector_type(8)));
typedef float f32x4 __attribute__((ext_vector_type(4)));
typedef unsigned u32x4 __attribute__((ext_vector_type(4)));
typedef unsigned u32x2 __attribute__((ext_vector_type(2)));
constexpr int DM = 1024, NB = 32, SEQ = 2048, NH = 8, HD = 128, DFF = 2816, NUP = 2 * DFF;
constexpr int MTOK = NB * SEQ;
constexpr int NG = 4, BG = NB / NG, GM = BG * SEQ;
constexpr int NIN = 37 * 256;
constexpr int NCH = BG * NH * 32;
static_assert(GM == pg8::GM, "group rows");
constexpr size_t MiB = 1u << 20;
constexpr size_t WS_CTL = 0;
constexpr size_t WS_WIN = 1 * MiB, WS_WBF = 20 * MiB, WS_WBG = 22 * MiB, WS_WOUT = 24 * MiB, WS_WUP = 26 * MiB, WS_WDN = 37 * MiB;
constexpr size_t WS_XN = 44 * MiB;
constexpr size_t WS_PROJ = 172 * MiB;
constexpr size_t WS_SMALL = 460 * MiB;
constexpr size_t WS_PREP = 462 * MiB;
constexpr size_t WS_T1 = 607 * MiB, WS_Y = 639 * MiB, WS_H1B = 671 * MiB, WS_END = 703 * MiB;
constexpr size_t WS_UP = WS_PROJ;
constexpr size_t WS_ACT = WS_PREP;
constexpr size_t PROJ_STRIDE = (size_t)GM * 1024;
constexpr int LDS_BYTES = 147456;

__device__ __forceinline__ float bf2f(bf16_t b) { return __uint_as_float((unsigned)b << 16); }
__device__ __forceinline__ float bflo(unsigned w) { return __uint_as_float(w << 16); }
__device__ __forceinline__ float bfhi(unsigned w) { return __uint_as_float(w & 0xffff0000u); }
__device__ __forceinline__ bf16_t f2bf(float f) { unsigned u = __float_as_uint(f); return (bf16_t)((u + 0x7fffu + ((u >> 16) & 1u)) >> 16); }
__device__ __forceinline__ unsigned pk2(float lo, float hi) { return (unsigned)f2bf(lo) | ((unsigned)f2bf(hi) << 16); }
__device__ __forceinline__ float siluf(float y) { return y / (1.0f + __expf(-y)); }
__device__ __forceinline__ float wave_sum(float v) {
#pragma unroll
    for (int o = 1; o < 64; o <<= 1) v += __shfl_xor(v, o);
    return v;
}

struct Args { const float* in[16]; float* out; unsigned char* ws; int ph_lo, ph_hi; };
struct Ptrs {
    const float *x, *norm_mix, *w_in, *fox_f_bias, *gdn_conv_w, *gdn_a_log, *gdn_dt_bias, *gdn_norm, *w_bf, *w_bg, *w_out, *norm_ffn, *w_up, *ffn_conv_w, *w_down, *norm_final;
    float* out; unsigned char* ws;
};

template <int MODE> __device__ __forceinline__ int srccol(int n) {
    if (MODE == 0) return n;
    if (MODE == 1) {
        if (n < 3072) return n;
        if (n < 6144) return 3080 + (n - 3072);
        if (n < 9216) return 6168 + (n - 6144);
        const int s = n - 9216;
        if (s < 8) return 3072 + s;
        if (s < 16) return 6152 + (s - 8);
        if (s < 24) return 6160 + (s - 16);
        return -1;
    }
    { const int p = n >> 8, s = (n >> 7) & 1, i = n & 127; return s * DFF + 128 * p + i; }
}
template <int MODE> __device__ __forceinline__ void transpose_item(const float* W, int K, int N, const float* ksc, bf16_t* WT, float* scr, int item, int nblk, int lane) {
    const int kb = item / nblk, nb = item % nblk, k0 = 64 * kb, n0 = 32 * nb;
    const int sc = srccol<MODE>(n0 + (lane & 31));
#pragma unroll 8
    for (int i = 0; i < 32; ++i) { const int kk = 2 * i + (lane >> 5); float v = 0.f; if (sc >= 0) { v = W[(size_t)(k0 + kk) * N + sc]; if (ksc) v *= ksc[k0 + kk]; } scr[kk * 33 + (lane & 31)] = v; }
    asm volatile("s_waitcnt lgkmcnt(0)" ::: "memory");
    const int c = lane & 7;
#pragma unroll
    for (int j = 0; j < 4; ++j) { const int n = (lane >> 3) + 8 * j; const float* s = scr + (8 * c) * 33 + n;
        u32x4 o; o.x = pk2(s[0 * 33], s[1 * 33]); o.y = pk2(s[2 * 33], s[3 * 33]); o.z = pk2(s[4 * 33], s[5 * 33]); o.w = pk2(s[6 * 33], s[7 * 33]);
        *(u32x4*)(WT + (size_t)(n0 + n) * K + k0 + 8 * c) = o; }
    asm volatile("s_waitcnt lgkmcnt(0)" ::: "memory");
}
__device__ __forceinline__ void phase_prologue(const Ptrs& P, char* lds, int tid) {
    const int lane = tid & 63, wave = tid >> 6;
    float* scr = (float*)(lds + wave * 16384);
    const int gw = blockIdx.x * 8 + wave, NGW = gridDim.x * 8;
    bf16_t* win_t = (bf16_t*)(P.ws + WS_WIN); bf16_t* wbf_t = (bf16_t*)(P.ws + WS_WBF); bf16_t* wbg_t = (bf16_t*)(P.ws + WS_WBG);
    bf16_t* wout_t = (bf16_t*)(P.ws + WS_WOUT); bf16_t* wup_t = (bf16_t*)(P.ws + WS_WUP); bf16_t* wdn_t = (bf16_t*)(P.ws + WS_WDN);
    constexpr int I_IN = 16 * (NIN / 32), I_SQ = 16 * 32, I_UP = 16 * (NUP / 32), I_DN = (DFF / 64) * 32;
    constexpr int NITEMS = I_IN + 3 * I_SQ + I_UP + I_DN;
    for (int it = gw; it < NITEMS; it += NGW) {
        int r = it;
        if (r < I_IN) { transpose_item<1>(P.w_in, DM, 9240, nullptr, win_t, scr, r, NIN / 32, lane); continue; } r -= I_IN;
        if (r < I_SQ) { transpose_item<0>(P.w_bf, DM, DM, nullptr, wbf_t, scr, r, 32, lane); continue; } r -= I_SQ;
        if (r < I_SQ) { transpose_item<0>(P.w_bg, DM, DM, nullptr, wbg_t, scr, r, 32, lane); continue; } r -= I_SQ;
        if (r < I_SQ) { transpose_item<0>(P.w_out, DM, DM, nullptr, wout_t, scr, r, 32, lane); continue; } r -= I_SQ;
        if (r < I_UP) { transpose_item<2>(P.w_up, DM, NUP, P.norm_ffn, wup_t, scr, r, NUP / 32, lane); continue; } r -= I_UP;
        transpose_item<0>(P.w_down, DFF, DM, nullptr, wdn_t, scr, r, 32, lane);
    }
    bf16_t* xn = (bf16_t*)(P.ws + WS_XN);
    f32x4 gv[4];
#pragma unroll
    for (int j = 0; j < 4; ++j) gv[j] = ((const f32x4*)P.norm_mix)[lane + 64 * j];
    for (int m = gw; m < MTOK; m += NGW) {
        const f32x4* xr = (const f32x4*)(P.x + (size_t)m * DM) + lane;
        f32x4 v[4]; float s = 0.f;
#pragma unroll
        for (int j = 0; j < 4; ++j) { v[j] = xr[64 * j]; s += (v[j][0] * v[j][0] + v[j][1] * v[j][1]) + (v[j][2] * v[j][2] + v[j][3] * v[j][3]); }
        const float rstd = rsqrtf(wave_sum(s) * (1.f / DM) + 1e-6f);
        u32x2* o8 = (u32x2*)(xn + (size_t)m * DM) + lane;
#pragma unroll
        for (int j = 0; j < 4; ++j) { const f32x4 t = v[j] * rstd * gv[j]; u32x2 w; w.x = pk2(t[0], t[1]); w.y = pk2(t[2], t[3]); o8[64 * j] = w; }
    }
}

__device__ __forceinline__ f32x4 mma16(const bf16_t* A, int lda, const bf16_t* Bt, int ldb, int ksteps, f32x4 acc, int lane) {
    const int r = lane & 15, q = lane >> 4;
    const bf16_t* ap = A + r * lda + q * 8; const bf16_t* bp = Bt + r * ldb + q * 8;
    for (int ks = 0; ks < ksteps; ++ks) { const bf16x8 a = *(const bf16x8*)(ap + ks * 32); const bf16x8 b = *(const bf16x8*)(bp + ks * 32); acc = __builtin_amdgcn_mfma_f32_16x16x32_bf16(a, b, acc, 0, 0, 0); }
    return acc;
}
constexpr int PQ = 136, PC = 72;
struct PrepBufs { bf16_t *W, *QD, *KDT, *UHT, *AT; float* GL; };
__device__ __forceinline__ PrepBufs prep_bufs(unsigned char* ws) {
    PrepBufs b; b.W = (bf16_t*)(ws + WS_PREP); b.QD = (bf16_t*)(ws + WS_PREP + 32 * MiB); b.KDT = (bf16_t*)(ws + WS_PREP + 64 * MiB); b.UHT = (bf16_t*)(ws + WS_PREP + 96 * MiB);
    b.AT = (bf16_t*)(ws + WS_PREP + 128 * MiB); b.GL = (float*)(ws + WS_PREP + 144 * MiB); return b;
}
__device__ __forceinline__ void gdn_prep_unit(char* lds, int unit, const Ptrs& P, int tid) {
    const int lane = tid & 63, wid = tid >> 6, c16 = lane & 15, q4 = lane >> 4;
    const int n = unit & 31, h = (unit >> 5) & 7, bl = unit >> 8;
    const int R0 = bl * SEQ + n * 64;
    bf16_t* Qs = (bf16_t*)lds; bf16_t* Ks = Qs + 64 * PQ; bf16_t* KBs = Ks + 64 * PQ; bf16_t* KDTs = KBs + 64 * PQ;
    bf16_t* RT = KDTs + 128 * PC;
    float* gcs = (float*)(RT + 256 * PC); float* bts = gcs + 64;
    bf16_t* CH = (bf16_t*)lds;
    const PrepBufs G = prep_bufs(P.ws);
    const bf16_t* proj = (const bf16_t*)(P.ws + WS_PROJ); const float* small = (const float*)(P.ws + WS_SMALL);
    if (wid == 0) {
        const float* sm = small + (size_t)(R0 + lane) * 32;
        const float xx = sm[8 + h] + P.gdn_dt_bias[h];
        const float sp = xx > 20.f ? xx : log1pf(__expf(xx));
        float cum = -__expf(P.gdn_a_log[h]) * sp;
        const float beta = 1.0f / (1.0f + __expf(-sm[16 + h]));
#pragma unroll
        for (int o = 1; o < 64; o <<= 1) { const float t = __shfl_up(cum, o); if (lane >= o) cum += t; }
        gcs[lane] = cum; bts[lane] = beta;
    }
    __syncthreads();
    {
        const int r = tid >> 3, d0 = (tid & 7) * 16;
        const float gcr = gcs[r], btr = bts[r], glast = gcs[63];
        const float eg = __expf(gcr), egl = __expf(glast - gcr);
        const int tseq = n * 64 + r;
#pragma unroll
        for (int part = 0; part < 3; ++part) {
            const bf16_t* src = proj + (size_t)(3 + part) * PROJ_STRIDE + (size_t)(R0 + r) * 1024 + h * HD + d0;
            const float* cw = P.gdn_conv_w + part * 1024 + h * HD + d0;
            float y[16];
#pragma unroll
            for (int j = 0; j < 16; ++j) y[j] = 0.f;
#pragma unroll
            for (int i = 0; i < 4; ++i) {
                if (tseq + i - 3 >= 0) {
                    const u32x4 a = *(const u32x4*)(src + (i - 3) * 1024), b = *(const u32x4*)(src + (i - 3) * 1024 + 8);
                    const float* w = cw + i * 3072;
                    const f32x4 w0 = *(const f32x4*)w, w1 = *(const f32x4*)(w + 4), w2 = *(const f32x4*)(w + 8), w3 = *(const f32x4*)(w + 12);
                    y[0] += w0[0] * bflo(a.x); y[1] += w0[1] * bfhi(a.x); y[2] += w0[2] * bflo(a.y); y[3] += w0[3] * bfhi(a.y);
                    y[4] += w1[0] * bflo(a.z); y[5] += w1[1] * bfhi(a.z); y[6] += w1[2] * bflo(a.w); y[7] += w1[3] * bfhi(a.w);
                    y[8] += w2[0] * bflo(b.x); y[9] += w2[1] * bfhi(b.x); y[10] += w2[2] * bflo(b.y); y[11] += w2[3] * bfhi(b.y);
                    y[12] += w3[0] * bflo(b.z); y[13] += w3[1] * bfhi(b.z); y[14] += w3[2] * bflo(b.w); y[15] += w3[3] * bfhi(b.w);
                }
            }
            float ss = 0.f;
#pragma unroll
            for (int j = 0; j < 16; ++j) { y[j] = siluf(y[j]); ss += y[j] * y[j]; }
            if (part < 2) { ss += __shfl_xor(ss, 1); ss += __shfl_xor(ss, 2); ss += __shfl_xor(ss, 4); }
            const float inv = rsqrtf(ss + 1e-6f);
            if (part == 0) {
                const float sc = inv * 0.08838834764831845f;
                unsigned pq[8], pd[8];
#pragma unroll
                for (int j = 0; j < 8; ++j) { const float a0 = y[2 * j] * sc, a1 = y[2 * j + 1] * sc; pq[j] = pk2(a0, a1); pd[j] = pk2(a0 * eg, a1 * eg); }
                *(u32x4*)(Qs + r * PQ + d0) = (u32x4){pq[0], pq[1], pq[2], pq[3]}; *(u32x4*)(Qs + r * PQ + d0 + 8) = (u32x4){pq[4], pq[5], pq[6], pq[7]};
                bf16_t* qd = G.QD + (size_t)unit * 8192 + r * 128 + d0;
                *(u32x4*)qd = (u32x4){pd[0], pd[1], pd[2], pd[3]}; *(u32x4*)(qd + 8) = (u32x4){pd[4], pd[5], pd[6], pd[7]};
            } else if (part == 1) {
                unsigned pk[8], pb[8];
#pragma unroll
                for (int j = 0; j < 8; ++j) { const float a0 = y[2 * j] * inv, a1 = y[2 * j + 1] * inv; pk[j] = pk2(a0, a1); pb[j] = pk2(a0 * btr, a1 * btr); }
                *(u32x4*)(Ks + r * PQ + d0) = (u32x4){pk[0], pk[1], pk[2], pk[3]}; *(u32x4*)(Ks + r * PQ + d0 + 8) = (u32x4){pk[4], pk[5], pk[6], pk[7]};
                *(u32x4*)(KBs + r * PQ + d0) = (u32x4){pb[0], pb[1], pb[2], pb[3]}; *(u32x4*)(KBs + r * PQ + d0 + 8) = (u32x4){pb[4], pb[5], pb[6], pb[7]};
#pragma unroll
                for (int j = 0; j < 16; ++j) { const float kn = y[j] * inv; RT[(128 + d0 + j) * PC + r] = f2bf(kn * btr * eg); KDTs[(d0 + j) * PC + r] = f2bf(kn * egl); }
            } else {
#pragma unroll
                for (int j = 0; j < 16; ++j) RT[(d0 + j) * PC + r] = f2bf(y[j] * btr);
            }
        }
    }
    __syncthreads();
    {
#pragma unroll
        for (int i = 0; i < 2; ++i) { const int idx = tid + 512 * i, row = idx >> 3, ch = idx & 7; *(u32x4*)(G.KDT + (size_t)unit * 8192 + row * 64 + ch * 8) = *(const u32x4*)(KDTs + row * PC + ch * 8); }
    }
    const int mat = wid >> 2, ti = wid & 3;
    f32x4 res[4];
#pragma unroll
    for (int tj = 0; tj < 4; ++tj) { f32x4 acc = {0.f, 0.f, 0.f, 0.f}; if (tj <= ti) acc = mma16((mat ? Qs : KBs) + ti * 16 * PQ, PQ, Ks + tj * 16 * PQ, PQ, 4, acc, lane); res[tj] = acc; }
    __syncthreads();
#pragma unroll
    for (int tj = 0; tj < 4; ++tj)
#pragma unroll
        for (int jj = 0; jj < 4; ++jj) { const int ii = ti * 16 + 4 * q4 + jj, jc = tj * 16 + c16;
            const float dec = (ii >= jc) ? __expf(gcs[ii] - gcs[jc]) : 0.f;
            if (mat == 0) { const bf16_t nv = f2bf((ii > jc) ? -res[tj][jj] * dec : 0.f); CH[ii * PC + jc] = nv; CH[2 * 64 * PC + jc * PC + ii] = nv; }
            else G.AT[(size_t)unit * 4096 + ii * 64 + jc] = f2bf((ii >= jc) ? res[tj][jj] * dec : 0.f); }
    __syncthreads();
    f32x4 pacc[4];
    if (wid >= 4) {
#pragma unroll
        for (int tj = 0; tj < 4; ++tj)
#pragma unroll
            for (int jj = 0; jj < 4; ++jj) { const int ii = ti * 16 + 4 * q4 + jj, jc = tj * 16 + c16; pacc[tj][jj] = bf2f(CH[ii * PC + jc]) + (ii == jc ? 1.f : 0.f); }
    }
    for (int s = 0; s < 6; ++s) {
        const int cur = s & 1, nxt = cur ^ 1;
        bf16_t* Qr_c = CH + cur * 64 * PC; bf16_t* Qt_c = CH + (2 + cur) * 64 * PC; bf16_t* Qr_n = CH + nxt * 64 * PC; bf16_t* Qt_n = CH + (2 + nxt) * 64 * PC;
        bf16_t* Pr_c = CH + (4 + cur) * 64 * PC; bf16_t* Pr_p = CH + (4 + nxt) * 64 * PC;
        if (wid < 4) {
            if (s < 5) {
#pragma unroll
                for (int tj = 0; tj < 4; ++tj) { f32x4 acc = {0.f, 0.f, 0.f, 0.f}; acc = mma16(Qr_c + ti * 16 * PC, PC, Qt_c + tj * 16 * PC, PC, 2, acc, lane);
#pragma unroll
                    for (int jj = 0; jj < 4; ++jj) { const int ii = ti * 16 + 4 * q4 + jj, jc = tj * 16 + c16; const bf16_t v = f2bf(acc[jj]); Qr_n[ii * PC + jc] = v; Qt_n[jc * PC + ii] = v; } }
            }
        } else {
#pragma unroll
            for (int tj = 0; tj < 4; ++tj) { if (s >= 1) pacc[tj] = mma16(Pr_p + ti * 16 * PC, PC, Qt_c + tj * 16 * PC, PC, 2, pacc[tj], lane);
#pragma unroll
                for (int jj = 0; jj < 4; ++jj) { const int ii = ti * 16 + 4 * q4 + jj, jc = tj * 16 + c16; Pr_c[ii * PC + jc] = f2bf(pacc[tj][jj]); } }
        }
        __syncthreads();
    }
    {
        const bf16_t* Tm = CH + 5 * 64 * PC;
#pragma unroll
        for (int t2 = 0; t2 < 2; ++t2) { const int tch = 2 * wid + t2;
#pragma unroll
            for (int tj = 0; tj < 4; ++tj) { f32x4 acc = {0.f, 0.f, 0.f, 0.f}; acc = mma16(RT + tch * 16 * PC, PC, Tm + tj * 16 * PC, PC, 2, acc, lane);
                const int ci = tj * 16 + c16, ch0 = tch * 16 + 4 * q4;
                if (tch < 8) {
#pragma unroll
                    for (int jj = 0; jj < 4; ++jj) G.UHT[(size_t)unit * 8192 + (ch0 + jj) * 64 + ci] = f2bf(acc[jj]);
                } else { u32x2 w; w.x = pk2(acc[0], acc[1]); w.y = pk2(acc[2], acc[3]); *(u32x2*)(G.W + (size_t)unit * 8192 + ci * 128 + (ch0 - 128)) = w; }
            } }
        if (tid == 0) G.GL[unit] = __expf(gcs[63]);
    }
    __syncthreads();
}

__device__ __forceinline__ void gdn_seq_unit(char* lds, int bh, const Ptrs& P, int tid) {
    const int lane = tid & 63, wid = tid >> 6, c16 = lane & 15, q4 = lane >> 4;
    const int bl = bh >> 3, h = bh & 7;
    bf16_t* ST = (bf16_t*)lds;
    bf16_t* Wl = ST + 128 * PQ;
    bf16_t* QDl = Wl + 64 * PQ;
    bf16_t* ATl = QDl + 64 * PQ;
    bf16_t* KDTl = ATl + 64 * PC;
    bf16_t* UTl = KDTl + 128 * PC;
    float* SSl = (float*)(UTl + 128 * PC);
    const PrepBufs G = prep_bufs(P.ws);
    const bf16_t* gz = (const bf16_t*)(P.ws + WS_PROJ) + 6 * PROJ_STRIDE;
    bf16_t* yg = (bf16_t*)(P.ws + WS_PROJ) + 3 * PROJ_STRIDE;
    f32x4 Sacc[8];
#pragma unroll
    for (int t = 0; t < 8; ++t) Sacc[t] = (f32x4){0.f, 0.f, 0.f, 0.f};
    for (int i = lane; i < 16 * PQ / 2; i += 64) ((unsigned*)(ST + wid * 16 * PQ))[i] = 0u;
    const float gn = P.gdn_norm[16 * wid + c16];
    u32x4 sW[2], sQ[2], sA, sK[2];
    {
        const size_t ub = (size_t)(bh * 32) * 8192;
#pragma unroll
        for (int i = 0; i < 2; ++i) { const int idx = tid + 512 * i; sW[i] = *(const u32x4*)(G.W + ub + idx * 8); sQ[i] = *(const u32x4*)(G.QD + ub + idx * 8); sK[i] = *(const u32x4*)(G.KDT + ub + idx * 8); }
        sA = *(const u32x4*)(G.AT + (size_t)(bh * 32) * 4096 + tid * 8);
    }
    for (int n = 0; n < 32; ++n) {
        const int unit = bh * 32 + n;
        const size_t ub = (size_t)unit * 8192;
#pragma unroll
        for (int i = 0; i < 2; ++i) { const int idx = tid + 512 * i;
            *(u32x4*)(Wl + (idx >> 4) * PQ + (idx & 15) * 8) = sW[i]; *(u32x4*)(QDl + (idx >> 4) * PQ + (idx & 15) * 8) = sQ[i]; *(u32x4*)(KDTl + (idx >> 3) * PC + (idx & 7) * 8) = sK[i]; }
        *(u32x4*)(ATl + (tid >> 3) * PC + (tid & 7) * 8) = sA;
        const float gl = G.GL[unit];
        u32x2 uh[4];
#pragma unroll
        for (int t = 0; t < 4; ++t) uh[t] = *(const u32x2*)(G.UHT + ub + (16 * wid + c16) * 64 + 16 * t + 4 * q4);
        __syncthreads();
        if (n + 1 < 32) { const size_t un = ub + 8192;
#pragma unroll
            for (int i = 0; i < 2; ++i) { const int idx = tid + 512 * i; sW[i] = *(const u32x4*)(G.W + un + idx * 8); sQ[i] = *(const u32x4*)(G.QD + un + idx * 8); sK[i] = *(const u32x4*)(G.KDT + un + idx * 8); }
            sA = *(const u32x4*)(G.AT + (size_t)(unit + 1) * 4096 + tid * 8); }
        f32x4 ws[4], os[4];
#pragma unroll
        for (int t = 0; t < 4; ++t) { ws[t] = (f32x4){0.f, 0.f, 0.f, 0.f}; os[t] = (f32x4){0.f, 0.f, 0.f, 0.f}; }
#pragma unroll
        for (int ks = 0; ks < 4; ++ks) { const bf16x8 b = *(const bf16x8*)(ST + (16 * wid + c16) * PQ + ks * 32 + q4 * 8);
#pragma unroll
            for (int t = 0; t < 4; ++t) { const bf16x8 a = *(const bf16x8*)(Wl + (16 * t + c16) * PQ + ks * 32 + q4 * 8); ws[t] = __builtin_amdgcn_mfma_f32_16x16x32_bf16(a, b, ws[t], 0, 0, 0);
                const bf16x8 a2 = *(const bf16x8*)(QDl + (16 * t + c16) * PQ + ks * 32 + q4 * 8); os[t] = __builtin_amdgcn_mfma_f32_16x16x32_bf16(a2, b, os[t], 0, 0, 0); } }
#pragma unroll
        for (int t = 0; t < 4; ++t) { u32x2 w; w.x = pk2(bflo(uh[t].x) - ws[t][0], bfhi(uh[t].x) - ws[t][1]); w.y = pk2(bflo(uh[t].y) - ws[t][2], bfhi(uh[t].y) - ws[t][3]);
            *(u32x2*)(UTl + (16 * wid + c16) * PC + 16 * t + 4 * q4) = w; }
        __syncthreads();
#pragma unroll
        for (int ks = 0; ks < 2; ++ks) { const bf16x8 b = *(const bf16x8*)(UTl + (16 * wid + c16) * PC + ks * 32 + q4 * 8);
#pragma unroll
            for (int t = 0; t < 4; ++t) { const bf16x8 a = *(const bf16x8*)(ATl + (16 * t + c16) * PC + ks * 32 + q4 * 8); os[t] = __builtin_amdgcn_mfma_f32_16x16x32_bf16(a, b, os[t], 0, 0, 0); } }
#pragma unroll
        for (int t = 0; t < 8; ++t) Sacc[t] = Sacc[t] * gl;
#pragma unroll
        for (int ks = 0; ks < 2; ++ks) { const bf16x8 a = *(const bf16x8*)(UTl + (16 * wid + c16) * PC + ks * 32 + q4 * 8);
#pragma unroll
            for (int t = 0; t < 8; ++t) { const bf16x8 b = *(const bf16x8*)(KDTl + (16 * t + c16) * PC + ks * 32 + q4 * 8); Sacc[t] = __builtin_amdgcn_mfma_f32_16x16x32_bf16(a, b, Sacc[t], 0, 0, 0); } }
#pragma unroll
        for (int t = 0; t < 8; ++t)
#pragma unroll
            for (int jj = 0; jj < 4; ++jj) ST[(16 * wid + 4 * q4 + jj) * PQ + 16 * t + c16] = f2bf(Sacc[t][jj]);
#pragma unroll
        for (int t = 0; t < 4; ++t)
#pragma unroll
            for (int jj = 0; jj < 4; ++jj) { float s = os[t][jj] * os[t][jj]; s += __shfl_xor(s, 1); s += __shfl_xor(s, 2); s += __shfl_xor(s, 4); s += __shfl_xor(s, 8);
                if (c16 == 0) SSl[wid * 64 + 16 * t + 4 * q4 + jj] = s; }
        __syncthreads();
        float tot = 0.f;
#pragma unroll
        for (int w = 0; w < 8; ++w) tot += SSl[w * 64 + lane];
        const float rstd_l = rsqrtf(tot * (1.0f / 128.0f) + 1e-6f);
        const size_t rowb = (size_t)(bl * SEQ + n * 64) * 1024 + h * HD + 16 * wid + c16;
#pragma unroll
        for (int t = 0; t < 4; ++t)
#pragma unroll
            for (int jj = 0; jj < 4; ++jj) { const int row = 16 * t + 4 * q4 + jj; const float rs = __shfl(rstd_l, row);
                const float g = bf2f(gz[rowb + (size_t)row * 1024]);
                yg[rowb + (size_t)row * 1024] = f2bf(os[t][jj] * rs * gn * siluf(g)); }
    }
    __syncthreads();
}

__device__ __forceinline__ void fox_item(char* lds, int item, const Ptrs& P, int tid) {
    using bf = fox::bf16;
    const int lane = tid & 63, wid = tid >> 6;
    const int bh = item >> 2, xq = item & 3, bl = bh >> 3, h = bh & 7;
    float* cb = (float*)(lds + fox::LDS_BYTES);
    float* tmp = cb + SEQ;
    const float* small = (const float*)(P.ws + WS_SMALL);
    {
        const float fb = P.fox_f_bias[h];
        float lf[4]; float run = 0.f;
#pragma unroll
        for (int e = 0; e < 4; ++e) { const float xv = small[(size_t)(bl * SEQ + 4 * tid + e) * 32 + h] + fb;
            const float l = (xv < -20.f) ? xv : -log1pf(__expf(-xv)); run += l; lf[e] = run; }
        float inc = run;
#pragma unroll
        for (int o = 1; o < 64; o <<= 1) { const float t = __shfl_up(inc, o); if (lane >= o) inc += t; }
        if (lane == 63) tmp[wid] = inc;
        __syncthreads();
        float off = inc - run;
        for (int w = 0; w < wid; ++w) off += tmp[w];
#pragma unroll
        for (int e = 0; e < 4; ++e) cb[4 * tid + e] = -(off + lf[e]) * 11.313708498984761f;
        __syncthreads();
    }
    bf* fq = (bf*)(P.ws + WS_PROJ); const bf* fk = fq + PROJ_STRIDE; const bf* fv = fq + 2 * PROJ_STRIDE;
    const size_t hb = (size_t)(bl * SEQ) * 1024 + h * HD;
    fox::BlockRef<bf, bf> b0, b1;
    b0.Q = fq + hb + (size_t)(xq * 256) * 1024; b0.O = fq + hb + (size_t)(xq * 256) * 1024; b0.K = fk + hb; b0.V = fv + hb; b0.P0 = xq * 256;
    b1.Q = fq + hb + (size_t)((7 - xq) * 256) * 1024; b1.O = fq + hb + (size_t)((7 - xq) * 256) * 1024; b1.K = fk + hb; b1.V = fv + hb; b1.P0 = (7 - xq) * 256;
    fox::Seam<bf> S;
    fox::causal_swa_prime<bf, bf>(b0, 1 << 20, lds, S);
    fox::causal_swa_block<bf, bf>(b0, b1, SEQ, 1 << 20, lds, S, cb);
    fox::causal_swa_block<bf, bf>(b1, b1, SEQ, 1 << 20, lds, S, cb);
    __syncthreads();
}

__device__ __forceinline__ void phase_convgate(const Ptrs& P, int tid) {
    const bf16_t* up = (const bf16_t*)(P.ws + WS_UP); bf16_t* act = (bf16_t*)(P.ws + WS_ACT);
    constexpr int NFG = DFF / 8, RB = 32, NRB = GM / RB;
    const int total = NFG * NRB;
    for (int it = blockIdx.x * 512 + tid; it < total; it += gridDim.x * 512) {
        const int fg = it % NFG, rb = it / NFG;
        const int p = fg >> 4, i0 = (fg & 15) * 8, f0 = p * 128 + i0;
        const int cg0 = p * 256 + i0, cv0 = cg0 + 128;
        float wg[3][8], wv[3][8];
#pragma unroll
        for (int i = 0; i < 3; ++i)
#pragma unroll
            for (int j = 0; j < 8; ++j) { wg[i][j] = P.ffn_conv_w[i * NUP + f0 + j]; wv[i][j] = P.ffn_conv_w[i * NUP + DFF + f0 + j]; }
        const int r0 = rb * RB;
        float g1[8], g2[8], v1[8], v2[8];
#pragma unroll
        for (int j = 0; j < 8; ++j) { g1[j] = 0.f; g2[j] = 0.f; v1[j] = 0.f; v2[j] = 0.f; }
        if ((r0 & (SEQ - 1)) != 0) {
            const u32x4 a1 = *(const u32x4*)(up + (size_t)(r0 - 1) * NUP + cg0), a2 = *(const u32x4*)(up + (size_t)(r0 - 2) * NUP + cg0);
            const u32x4 b1 = *(const u32x4*)(up + (size_t)(r0 - 1) * NUP + cv0), b2 = *(const u32x4*)(up + (size_t)(r0 - 2) * NUP + cv0);
            g1[0] = bflo(a1.x); g1[1] = bfhi(a1.x); g1[2] = bflo(a1.y); g1[3] = bfhi(a1.y); g1[4] = bflo(a1.z); g1[5] = bfhi(a1.z); g1[6] = bflo(a1.w); g1[7] = bfhi(a1.w);
            g2[0] = bflo(a2.x); g2[1] = bfhi(a2.x); g2[2] = bflo(a2.y); g2[3] = bfhi(a2.y); g2[4] = bflo(a2.z); g2[5] = bfhi(a2.z); g2[6] = bflo(a2.w); g2[7] = bfhi(a2.w);
            v1[0] = bflo(b1.x); v1[1] = bfhi(b1.x); v1[2] = bflo(b1.y); v1[3] = bfhi(b1.y); v1[4] = bflo(b1.z); v1[5] = bfhi(b1.z); v1[6] = bflo(b1.w); v1[7] = bfhi(b1.w);
            v2[0] = bflo(b2.x); v2[1] = bfhi(b2.x); v2[2] = bflo(b2.y); v2[3] = bfhi(b2.y); v2[4] = bflo(b2.z); v2[5] = bfhi(b2.z); v2[6] = bflo(b2.w); v2[7] = bfhi(b2.w);
        }
#pragma unroll 4
        for (int r = 0; r < RB; ++r) {
            const u32x4 a = *(const u32x4*)(up + (size_t)(r0 + r) * NUP + cg0), b = *(const u32x4*)(up + (size_t)(r0 + r) * NUP + cv0);
            float g0[8], v0[8];
            g0[0] = bflo(a.x); g0[1] = bfhi(a.x); g0[2] = bflo(a.y); g0[3] = bfhi(a.y); g0[4] = bflo(a.z); g0[5] = bfhi(a.z); g0[6] = bflo(a.w); g0[7] = bfhi(a.w);
            v0[0] = bflo(b.x); v0[1] = bfhi(b.x); v0[2] = bflo(b.y); v0[3] = bfhi(b.y); v0[4] = bflo(b.z); v0[5] = bfhi(b.z); v0[6] = bflo(b.w); v0[7] = bfhi(b.w);
            float o[8];
#pragma unroll
            for (int j = 0; j < 8; ++j) { const float cgv = wg[0][j] * g2[j] + wg[1][j] * g1[j] + wg[2][j] * g0[j]; const float cvv = wv[0][j] * v2[j] + wv[1][j] * v1[j] + wv[2][j] * v0[j];
                o[j] = siluf(cgv) * cvv; g2[j] = g1[j]; g1[j] = g0[j]; v2[j] = v1[j]; v1[j] = v0[j]; }
            u32x4 w; w.x = pk2(o[0], o[1]); w.y = pk2(o[2], o[3]); w.z = pk2(o[4], o[5]); w.w = pk2(o[6], o[7]);
            *(u32x4*)(act + (size_t)(r0 + r) * DFF + f0) = w;
        }
    }
}

__device__ __forceinline__ void phase_final(const Ptrs& P, int tid) {
    const int lane = tid & 63, wave = tid >> 6;
    const int gw = blockIdx.x * 8 + wave, NGW = gridDim.x * 8;
    const float* rowss2 = (const float*)(P.ws + WS_CTL) + MTOK;
    f32x4 gv[4];
#pragma unroll
    for (int j = 0; j < 4; ++j) gv[j] = ((const f32x4*)P.norm_final)[lane + 64 * j];
    for (int m = gw; m < MTOK; m += NGW) {
        const float rstd = rsqrtf(rowss2[m] * (1.f / DM) + 1e-6f);
        f32x4* o = (f32x4*)(P.out + (size_t)m * DM) + lane;
#pragma unroll
        for (int j = 0; j < 4; ++j) o[64 * j] = o[64 * j] * rstd * gv[j];
    }
}

constexpr int N_PHASES = 2 + 8 * NG;
#ifndef PHM
#define PHM 2047
#endif
__global__ void __launch_bounds__(512, 2) mk_fwd(Args args) {
    extern __shared__ __attribute__((aligned(16))) unsigned char lds_raw[];
    char* lds = (char*)lds_raw;
    Ptrs P;
    P.x = args.in[0]; P.norm_mix = args.in[1]; P.w_in = args.in[2]; P.fox_f_bias = args.in[3]; P.gdn_conv_w = args.in[4]; P.gdn_a_log = args.in[5]; P.gdn_dt_bias = args.in[6]; P.gdn_norm = args.in[7];
    P.w_bf = args.in[8]; P.w_bg = args.in[9]; P.w_out = args.in[10]; P.norm_ffn = args.in[11]; P.w_up = args.in[12]; P.ffn_conv_w = args.in[13]; P.w_down = args.in[14]; P.norm_final = args.in[15];
    P.out = args.out; P.ws = args.ws;
    cg::grid_group grid = cg::this_grid();
    const int G = gridDim.x;
    for (int ph = args.ph_lo; ph < args.ph_hi; ++ph) {
        int tid = threadIdx.x; asm volatile("" : "+v"(tid));
        int cid = blockIdx.x; asm volatile("" : "+s"(cid));
        size_t zoff = 0; asm volatile("" : "+s"(zoff)); unsigned char* ws = args.ws + zoff; P.ws = ws;
        float* rowss1 = (float*)(ws + WS_CTL); float* rowss2 = rowss1 + MTOK;
        if (ph == 0) { if (PHM & 1) phase_prologue(P, lds, tid); }
        else if (ph == N_PHASES - 1) { if (PHM & 2) phase_final(P, tid); }
        else {
            const int grp = (ph - 1) >> 3, sub = (ph - 1) & 7;
            const size_t r0g = (size_t)grp * GM;
            pg8::bf16_t* proj = (pg8::bf16_t*)(ws + WS_PROJ);
            if (sub == 0 && (PHM & 4)) {
                pg8::Gemm g{(const pg8::bf16_t*)(ws + WS_XN) + r0g * DM, nullptr, (const pg8::bf16_t*)(ws + WS_WIN), nullptr, GM, NIN, DM};
                pg8::StaticOrder S; S.init(GM, NIN, G, cid);
                pg8::EpiIn E{proj, (float*)(ws + WS_SMALL)};
                pg8::gemm_phase<pg8::EpiIn, pg8::StaticOrder, true, true>((PG8_LAS unsigned char*)lds_raw, g, S, E);
            } else if (sub == 1 && (PHM & 8)) {
                for (int u = cid; u < NCH; u += G) gdn_prep_unit(lds, u, P, tid);
            } else if (sub == 2) {
                if (PHM & 16) for (int it = cid; it < BG * NH * 4; it += G) fox_item(lds, it, P, tid);
                if (PHM & 32) for (int bh = cid; bh < BG * NH; bh += G) gdn_seq_unit(lds, bh, P, tid);
            } else if (sub == 3 && (PHM & 64)) {
                pg8::Gemm g{proj, proj + 3 * PROJ_STRIDE, (const pg8::bf16_t*)(ws + WS_WBF), (const pg8::bf16_t*)(ws + WS_WBG), GM, DM, DM};
                pg8::PairOrder S; S.init(GM, DM, G, cid);
                pg8::EpiY E{proj + 7 * PROJ_STRIDE, proj + 8 * PROJ_STRIDE, (pg8::bf16_t*)(ws + WS_T1), (pg8::bf16_t*)(ws + WS_Y)};
                pg8::gemm_phase<pg8::EpiY, pg8::PairOrder, true, true>((PG8_LAS unsigned char*)lds_raw, g, S, E);
            } else if (sub == 4 && (PHM & 128)) {
                pg8::Gemm g{(const pg8::bf16_t*)(ws + WS_Y), nullptr, (const pg8::bf16_t*)(ws + WS_WOUT), nullptr, GM, DM, DM};
                pg8::StaticOrder S; S.init(GM, DM, G, cid);
                pg8::EpiOut E{P.x + r0g * DM, P.out + r0g * DM, (pg8::bf16_t*)(ws + WS_H1B), rowss1 + r0g};
                pg8::gemm_phase<pg8::EpiOut, pg8::StaticOrder, true, true>((PG8_LAS unsigned char*)lds_raw, g, S, E);
            } else if (sub == 5 && (PHM & 256)) {
                pg8::Gemm g{(const pg8::bf16_t*)(ws + WS_H1B), nullptr, (const pg8::bf16_t*)(ws + WS_WUP), nullptr, GM, NUP, DM};
                pg8::StaticOrder S; S.init(GM, NUP, G, cid);
                pg8::EpiUp E{(pg8::bf16_t*)(ws + WS_UP), rowss1 + r0g, NUP};
                pg8::gemm_phase<pg8::EpiUp, pg8::StaticOrder, true, true>((PG8_LAS unsigned char*)lds_raw, g, S, E);
            } else if (sub == 6) {
                if (PHM & 512) phase_convgate(P, tid);
            } else if (PHM & 1024) {
                pg8::Gemm g{(const pg8::bf16_t*)(ws + WS_ACT), nullptr, (const pg8::bf16_t*)(ws + WS_WDN), nullptr, GM, DM, DFF};
                pg8::StaticOrder S; S.init(GM, DM, G, cid);
                pg8::EpiDown E{P.out + r0g * DM, rowss2 + r0g};
                pg8::gemm_phase<pg8::EpiDown, pg8::StaticOrder, true, true>((PG8_LAS unsigned char*)lds_raw, g, S, E);
            }
        }
        if (ph + 1 < args.ph_hi) grid.sync();
    }
}

extern "C" void kernel_launch(void* const* d_in, const int* in_sizes, int n_in, void* d_out, int out_size, void* d_ws, size_t ws_size, hipStream_t stream) {
    static int ready = 0;
    if (ready == 0) {
        if (n_in != 16 || in_sizes[0] != MTOK * DM || out_size != MTOK * DM || ws_size < WS_END) {
            fprintf(stderr, "kernel_launch: unexpected shapes (n_in %d, in0 %d, out %d, ws %zu; need ws >= %zu)\n", n_in, n_in > 0 ? in_sizes[0] : -1, out_size, ws_size, (size_t)WS_END); ready = -1; return; }
        if (hipFuncSetAttribute((const void*)mk_fwd, hipFuncAttributeMaxDynamicSharedMemorySize, LDS_BYTES) != hipSuccess) { fprintf(stderr, "kernel_launch: hipFuncSetAttribute failed\n"); ready = -1; return; }
        int per_cu = 0;
        if (hipOccupancyMaxActiveBlocksPerMultiprocessor(&per_cu, (const void*)mk_fwd, 512, LDS_BYTES) != hipSuccess || per_cu < 1) fprintf(stderr, "kernel_launch: occupancy query says %d blocks per CU\n", per_cu);
        (void)hipGetLastError();
        ready = 1;
    }
    if (ready < 0) return;
    (void)hipMemsetAsync((char*)d_ws + WS_CTL, 0, 1 * MiB, stream);
    Args a{};
    for (int i = 0; i < 16; ++i) a.in[i] = (const float*)d_in[i];
    a.out = (float*)d_out; a.ws = (unsigned char*)d_ws;
#if MK_ONE_LAUNCH
    a.ph_lo = 0; a.ph_hi = N_PHASES;
    void* kargs[] = {&a};
    hipError_t e = hipLaunchCooperativeKernel((const void*)mk_fwd, dim3(256), dim3(512), kargs, LDS_BYTES, stream);
    if (e != hipSuccess) fprintf(stderr, "kernel_launch: cooperative launch failed: %s\n", hipGetErrorString(e));
#else
    for (int ph = 0; ph < N_PHASES; ++ph) { a.ph_lo = ph; a.ph_hi = ph + 1; hipLaunchKernelGGL(mk_fwd, dim3(256), dim3(512), LDS_BYTES, stream, a); }
#endif
}
```

```cpp
#include <hip/hip_runtime.h>
#include <hip/hip_bf16.h>
#include <hip/hip_cooperative_groups.h>
#include <cstdio>
#include <cstdint>
namespace cg = cooperative_groups;

#ifndef MK_ONE_LAUNCH
#define MK_ONE_LAUNCH 1
#endif

namespace pg8 {
#define PG8_LAS __attribute__((address_space(3)))
typedef unsigned short bf16_t;
typedef short bf16x8 __attribute__((ext_vector_type(8)));
typedef float f32x4 __attribute__((ext_vector_type(4)));
typedef unsigned u32x4 __attribute__((ext_vector_type(4)));
constexpr int BM = 256, BK = 64, HALF = 128, HTB = HALF * BK * 2  , STAGE_BYTES = 8 * HTB, NXCD = 8, WGM = 8;

__host__ __device__ __forceinline__ int lds_byte(int r, int c) { const int st = (r >> 4) * 2 + (c >> 5), rr = r & 15, cc = c & 31, ob = rr * 64 + cc * 2; return st * 1024 + (ob ^ (((ob >> 9) & 1) << 5)); }
__host__ __device__ __forceinline__ void stage_rc(int b, int& R, int& C) { const int st = b / 1024, sb = b % 1024, swz = sb ^ (((sb >> 9) & 1) << 5); R = (st >> 1) * 16 + swz / 64; C = (st & 1) * 32 + (swz % 64) / 2; }
__host__ __device__ __forceinline__ int perm32(int rho) { const int n = rho >> 4, i = rho & 15; return 8 * (i >> 2) + 4 * n + (i & 3); }

struct Unit { int pm, pn, sel; };
struct Gemm { const bf16_t* A0; const bf16_t* A1; const bf16_t* B0; const bf16_t* B1; int M, N, K; };

struct StaticOrder {
    int nM, nN, nwg, G, c;
    __host__ __device__ __forceinline__ void init(int M, int N, int G_, int c_) { nM = M / BM; nN = N / BM; nwg = nM * nN; G = G_; c = c_; }
    __host__ __device__ __forceinline__ bool next(int i, Unit& u) const {
        const long L = (long)i * G + c; if (L >= nwg) return false;
        int wgid = (int)L; { const int q = nwg / NXCD, r = nwg % NXCD, xcd = wgid % NXCD, off = wgid / NXCD; wgid = (xcd < r ? xcd * (q + 1) : r * (q + 1) + (xcd - r) * q) + off; }
        const int nig = WGM * nN, gid = wgid / nig, fm = gid * WGM, gsz = (nM - fm) < WGM ? (nM - fm) : WGM;
        u.pm = fm + ((wgid % nig) % gsz); u.pn = (wgid % nig) / gsz; u.sel = 0; return true;
    }
    __device__ __forceinline__ void a_ready(const Unit&) const {}
    __device__ __forceinline__ void done(const Unit&) const {}
};

__device__ __forceinline__ unsigned cvt_pk_bf16(float lo, float hi) { unsigned r; asm volatile("v_cvt_pk_bf16_f32 %0, %1, %2" : "=v"(r) : "v"(lo), "v"(hi)); return r; }
typedef unsigned u32x2 __attribute__((ext_vector_type(2)));
__device__ __forceinline__ float bflo(unsigned w) { return __uint_as_float(w << 16); }
__device__ __forceinline__ float bfhi(unsigned w) { return __uint_as_float(w & 0xffff0000u); }
__device__ __forceinline__ float sigm(float x) { return 1.0f / (1.0f + __expf(-x)); }
constexpr int GM = 32768;
constexpr int LDP = 1024;

struct EpiIn {
    static constexpr bool PERM = true, AFTER_DRAIN = false;
    bf16_t* proj; float* small;
    __device__ __forceinline__ void operator()(const f32x4 (&acc)[2][2][4][2], const Unit& u, int wr, int wc, int fr, int fq) const {
        const int row0 = u.pm * BM + wr * 64 + fr;
        if (u.pn < 36) {
            bf16_t* base = proj + (size_t)(u.pn >> 2) * ((size_t)GM * LDP) + (u.pn & 3) * 256 + wc * 32 + 8 * fq;
#pragma unroll
            for (int ai = 0; ai < 2; ++ai)
#pragma unroll
                for (int m = 0; m < 4; ++m) { bf16_t* rowp = base + (size_t)(row0 + ai * HALF + m * 16) * LDP;
#pragma unroll
                    for (int bj = 0; bj < 2; ++bj) { const f32x4 v0 = acc[ai][bj][m][0], v1 = acc[ai][bj][m][1];
                        u32x4 w; w.x = cvt_pk_bf16(v0[0], v0[1]); w.y = cvt_pk_bf16(v0[2], v0[3]); w.z = cvt_pk_bf16(v1[0], v1[1]); w.w = cvt_pk_bf16(v1[2], v1[3]);
                        *(u32x4*)(rowp + bj * HALF) = w; } }
        } else if (wc == 0 && fq < 3) {
#pragma unroll
            for (int ai = 0; ai < 2; ++ai)
#pragma unroll
                for (int m = 0; m < 4; ++m) { float* p = small + (size_t)(row0 + ai * HALF + m * 16) * 32 + 8 * fq;
                    *(f32x4*)p = acc[ai][0][m][0]; *(f32x4*)(p + 4) = acc[ai][0][m][1]; }
        }
    }
};
struct EpiY {
    static constexpr bool PERM = true, AFTER_DRAIN = false;
    const bf16_t* gf; const bf16_t* gg; bf16_t* t1; bf16_t* y;
    __device__ __forceinline__ void operator()(const f32x4 (&acc)[2][2][4][2], const Unit& u, int wr, int wc, int fr, int fq) const {
        const int row0 = u.pm * BM + wr * 64 + fr, col0 = u.pn * BM + wc * 32 + 8 * fq;
        const bf16_t* const gf_ = gf; const bf16_t* const gg_ = gg; bf16_t* const t1_ = t1; bf16_t* const y_ = y;
        const bf16_t* gate = u.sel ? gg_ : gf_; bf16_t* dst = u.sel ? y_ : t1_;
        if (u.sel) asm volatile("s_waitcnt vmcnt(0)" ::: "memory");
#pragma unroll
        for (int ai = 0; ai < 2; ++ai)
#pragma unroll
            for (int m = 0; m < 4; ++m) { const size_t ro = (size_t)(row0 + ai * HALF + m * 16) * LDP + col0;
#pragma unroll
                for (int bj = 0; bj < 2; ++bj) { const size_t o = ro + bj * HALF;
                    const u32x4 gw = *(const u32x4*)(gate + o); const f32x4 v0 = acc[ai][bj][m][0], v1 = acc[ai][bj][m][1];
                    float r0 = sigm(bflo(gw.x)) * v0[0], r1 = sigm(bfhi(gw.x)) * v0[1], r2 = sigm(bflo(gw.y)) * v0[2], r3 = sigm(bfhi(gw.y)) * v0[3];
                    float r4 = sigm(bflo(gw.z)) * v1[0], r5 = sigm(bfhi(gw.z)) * v1[1], r6 = sigm(bflo(gw.w)) * v1[2], r7 = sigm(bfhi(gw.w)) * v1[3];
                    if (u.sel) { const u32x4 tw = *(const u32x4*)(t1_ + o);
                        r0 += bflo(tw.x); r1 += bfhi(tw.x); r2 += bflo(tw.y); r3 += bfhi(tw.y); r4 += bflo(tw.z); r5 += bfhi(tw.z); r6 += bflo(tw.w); r7 += bfhi(tw.w); }
                    u32x4 w; w.x = cvt_pk_bf16(r0, r1); w.y = cvt_pk_bf16(r2, r3); w.z = cvt_pk_bf16(r4, r5); w.w = cvt_pk_bf16(r6, r7);
                    *(u32x4*)(dst + o) = w; } }
    }
};
struct EpiOut {
    static constexpr bool PERM = false, AFTER_DRAIN = false;
    const float* xin; float* hout; bf16_t* h1b; float* rowss;
    __device__ __forceinline__ void operator()(const f32x4 (&acc)[2][2][4][2], const Unit& u, int wr, int wc, int fr, int fq) const {
        const int col0 = u.pn * BM + wc * 32 + 4 * fq;
#pragma unroll
        for (int ai = 0; ai < 2; ++ai)
#pragma unroll
            for (int m = 0; m < 4; ++m) { const int row = u.pm * BM + ai * HALF + wr * 64 + m * 16 + fr; const size_t ro = (size_t)row * LDP + col0; float ss = 0.f;
#pragma unroll
                for (int bj = 0; bj < 2; ++bj)
#pragma unroll
                    for (int n = 0; n < 2; ++n) { const size_t o = ro + bj * HALF + n * 16; const f32x4 hv = *(const f32x4*)(xin + o) + acc[ai][bj][m][n];
                        *(f32x4*)(hout + o) = hv; u32x2 w; w.x = cvt_pk_bf16(hv[0], hv[1]); w.y = cvt_pk_bf16(hv[2], hv[3]); *(u32x2*)(h1b + o) = w;
                        ss += (hv[0] * hv[0] + hv[1] * hv[1]) + (hv[2] * hv[2] + hv[3] * hv[3]); }
                ss += __shfl_xor(ss, 16); ss += __shfl_xor(ss, 32);
                if (fq == 0) atomicAdd(rowss + row, ss); }
    }
};
struct EpiUp {
    static constexpr bool PERM = true, AFTER_DRAIN = false;
    bf16_t* up; const float* rowss; int ldc;
    __device__ __forceinline__ void operator()(const f32x4 (&acc)[2][2][4][2], const Unit& u, int wr, int wc, int fr, int fq) const {
        const int row0 = u.pm * BM + wr * 64 + fr, col0 = u.pn * BM + wc * 32 + 8 * fq;
#pragma unroll
        for (int ai = 0; ai < 2; ++ai)
#pragma unroll
            for (int m = 0; m < 4; ++m) { const int row = row0 + ai * HALF + m * 16; const float rs = rsqrtf(rowss[row] * (1.0f / 1024.0f) + 1e-6f); bf16_t* rowp = up + (size_t)row * ldc + col0;
#pragma unroll
                for (int bj = 0; bj < 2; ++bj) { const f32x4 v0 = acc[ai][bj][m][0] * rs, v1 = acc[ai][bj][m][1] * rs;
                    u32x4 w; w.x = cvt_pk_bf16(v0[0], v0[1]); w.y = cvt_pk_bf16(v0[2], v0[3]); w.z = cvt_pk_bf16(v1[0], v1[1]); w.w = cvt_pk_bf16(v1[2], v1[3]);
                    *(u32x4*)(rowp + bj * HALF) = w; } }
    }
};
struct EpiDown {
    static constexpr bool PERM = false, AFTER_DRAIN = false;
    float* hio; float* rowss;
    __device__ __forceinline__ void operator()(const f32x4 (&acc)[2][2][4][2], const Unit& u, int wr, int wc, int fr, int fq) const {
        const int col0 = u.pn * BM + wc * 32 + 4 * fq;
#pragma unroll
        for (int ai = 0; ai < 2; ++ai)
#pragma unroll
            for (int m = 0; m < 4; ++m) { const int row = u.pm * BM + ai * HALF + wr * 64 + m * 16 + fr; const size_t ro = (size_t)row * LDP + col0; float ss = 0.f;
#pragma unroll
                for (int bj = 0; bj < 2; ++bj)
#pragma unroll
                    for (int n = 0; n < 2; ++n) { const size_t o = ro + bj * HALF + n * 16; const f32x4 hv = *(const f32x4*)(hio + o) + acc[ai][bj][m][n];
                        *(f32x4*)(hio + o) = hv; ss += (hv[0] * hv[0] + hv[1] * hv[1]) + (hv[2] * hv[2] + hv[3] * hv[3]); }
                ss += __shfl_xor(ss, 16); ss += __shfl_xor(ss, 32);
                if (fq == 0) atomicAdd(rowss + row, ss); }
    }
};
struct PairOrder {
    int nM, nN, nwg, G, c;
    __host__ __device__ __forceinline__ void init(int M, int N, int G_, int c_) { nM = M / BM; nN = N / BM; nwg = nM * nN; G = G_; c = c_; }
    __host__ __device__ __forceinline__ bool next(int i, Unit& u) const {
        const long L = (long)(i >> 1) * G + c; if (L >= nwg) return false;
        int wgid = (int)L; { const int q = nwg / NXCD, r = nwg % NXCD, xcd = wgid % NXCD, off = wgid / NXCD; wgid = (xcd < r ? xcd * (q + 1) : r * (q + 1) + (xcd - r) * q) + off; }
        const int nig = WGM * nN, gid = wgid / nig, fm = gid * WGM, gsz = (nM - fm) < WGM ? (nM - fm) : WGM;
        u.pm = fm + ((wgid % nig) % gsz); u.pn = (wgid % nig) / gsz; u.sel = i & 1; return true;
    }
    __device__ __forceinline__ void a_ready(const Unit&) const {}
    __device__ __forceinline__ void done(const Unit&) const {}
};
template <class Epi, class Sched, bool ALIGN_EPI = false, bool SP2 = false>
__device__ __forceinline__ void gemm_phase(PG8_LAS unsigned char* lds, const Gemm g, const Sched& S, const Epi& E) {
    int tid_l = threadIdx.x; asm volatile("" : "+v"(tid_l));
    const int tid = tid_l, wid = __builtin_amdgcn_readfirstlane(tid >> 6), lane = tid & 63, wr = wid >> 2, wc = wid & 3, fr = lane & 15, fq = lane >> 4;
    const int K = g.K, nt = K / BK;
    unsigned voffA[2], voffB[2];
#pragma unroll
    for (int i = 0; i < 2; ++i) { int R, C; stage_rc(tid * 16 + i * 8192, R, C); const int Rb = Epi::PERM ? ((R & ~31) + perm32(R & 31)) : R;
        voffA[i] = (unsigned)(R * K + C) * 2u; voffB[i] = (unsigned)(Rb * K + C) * 2u; }
    const size_t kstep = (size_t)(BK * 2);
    const size_t hstep = (size_t)HALF * K * 2;
    const size_t tstep = 2 * hstep;
    const unsigned ldsw = (unsigned)wid * 1024u;
    const int aoff = lds_byte(wr * 64 + fr, fq * 8), boff = lds_byte(wc * 32 + fr, fq * 8);
#define PG8_SA(b, h) (((b) * 2 + (h)) * HTB)
#define PG8_SB(b, h) ((4 + (b) * 2 + (h)) * HTB)
#define PG8_STAGE(bufoff, gbase, voff) do { _Pragma("unroll") for (int _i = 0; _i < 2; ++_i) \
        __builtin_amdgcn_global_load_lds((const unsigned*)((const char*)(gbase) + (voff)[_i]), (PG8_LAS unsigned*)(lds + (bufoff) + ldsw + _i * 8192), 16, 0, 0); } while (0)
#define PG8_LDA(dst, b, h) do { _Pragma("unroll") for (int m = 0; m < 4; ++m) _Pragma("unroll") for (int k = 0; k < 2; ++k) dst[m][k] = *(const PG8_LAS bf16x8*)(lds + PG8_SA(b, h) + aoff + m * 2048 + k * 1024); } while (0)
#define PG8_LDB(dst, b, h) do { _Pragma("unroll") for (int n = 0; n < 2; ++n) _Pragma("unroll") for (int k = 0; k < 2; ++k) dst[n][k] = *(const PG8_LAS bf16x8*)(lds + PG8_SB(b, h) + boff + n * 2048 + k * 1024); } while (0)
#define PG8_MMA(ai, bj, At, Bt) do { __builtin_amdgcn_s_setprio(1); _Pragma("unroll") for (int m = 0; m < 4; ++m) _Pragma("unroll") for (int n = 0; n < 2; ++n) _Pragma("unroll") for (int k = 0; k < 2; ++k) \
        acc[ai][bj][m][n] = __builtin_amdgcn_mfma_f32_16x16x32_bf16(Bt[n][k], At[m][k], acc[ai][bj][m][n], 0, 0, 0); __builtin_amdgcn_s_setprio(0); } while (0)
#define PG8_WAIT_V(n) asm volatile("s_waitcnt vmcnt(" #n ")" ::: "memory")
#define PG8_WAIT_L(n) asm volatile("s_waitcnt lgkmcnt(" #n ")" ::: "memory")
#define PG8_BAR __builtin_amdgcn_s_barrier()
#define PG8_SCHED __builtin_amdgcn_sched_barrier(0)
    Unit cur, nxt; int ui = 0;
    if (!S.next(0, cur)) return;
    f32x4 acc[2][2][4][2];
#pragma unroll
    for (int a = 0; a < 2; ++a)
#pragma unroll
        for (int b = 0; b < 2; ++b)
#pragma unroll
            for (int m = 0; m < 4; ++m)
#pragma unroll
                for (int n = 0; n < 2; ++n) acc[a][b][m][n] = (f32x4){0.f, 0.f, 0.f, 0.f};
    bf16x8 At[4][2], B0[2][2], B1[2][2];
    const char* cA = (const char*)(cur.sel ? g.A1 : g.A0) + (size_t)cur.pm * tstep; const char* cB = (const char*)(cur.sel ? g.B1 : g.B0) + (size_t)cur.pn * tstep;
    S.a_ready(cur);
    if constexpr (SP2) {
        PG8_STAGE(PG8_SB(0, 0), cB, voffB); PG8_STAGE(PG8_SB(0, 1), cB + hstep, voffB); PG8_STAGE(PG8_SA(0, 0), cA, voffA); PG8_STAGE(PG8_SA(0, 1), cA + hstep, voffA);
        if (wr == 1) PG8_BAR;
        PG8_WAIT_V(2); PG8_BAR;
        PG8_STAGE(PG8_SB(1, 0), cB + kstep, voffB); PG8_STAGE(PG8_SA(1, 0), cA + kstep, voffA); PG8_STAGE(PG8_SB(1, 1), cB + hstep + kstep, voffB);
        PG8_WAIT_V(6); PG8_BAR;
    } else {
        PG8_STAGE(PG8_SB(0, 0), cB, voffB); PG8_STAGE(PG8_SA(0, 0), cA, voffA); PG8_STAGE(PG8_SB(0, 1), cB + hstep, voffB); PG8_STAGE(PG8_SA(0, 1), cA + hstep, voffA);
        if (wr == 1) PG8_BAR;
        PG8_WAIT_V(4); PG8_BAR;
        PG8_STAGE(PG8_SB(1, 0), cB + kstep, voffB); PG8_STAGE(PG8_SA(1, 0), cA + kstep, voffA); PG8_STAGE(PG8_SB(1, 1), cB + hstep + kstep, voffB);
        PG8_WAIT_V(6); PG8_BAR;
    }
    for (;;) {
        const bool has_next = S.next(ui + 1, nxt);
        const char* nA = has_next ? (const char*)(nxt.sel ? g.A1 : g.A0) + (size_t)nxt.pm * tstep : cA; const char* nB = has_next ? (const char*)(nxt.sel ? g.B1 : g.B0) + (size_t)nxt.pn * tstep : cB;
        for (int t = 0; t < nt; t += 2) {
            const bool last = (t == nt - 2);
            const char* a1 = cA + (size_t)(t + 1) * kstep;
            const char* a2 = last ? nA : cA + (size_t)(t + 2) * kstep; const char* b2 = last ? nB : cB + (size_t)(t + 2) * kstep;
            const char* a3 = a2 + kstep; const char* b3 = b2 + kstep;
            if (last && has_next) S.a_ready(nxt);
            if constexpr (SP2) {
            PG8_LDB(B0, 0, 0); PG8_LDB(B1, 0, 1); PG8_SCHED; PG8_LDA(At, 0, 0); PG8_STAGE(PG8_SA(1, 1), a1 + hstep, voffA);
            PG8_WAIT_V(8); PG8_WAIT_L(0); PG8_BAR; PG8_MMA(0, 0, At, B0); PG8_MMA(0, 1, At, B1); PG8_BAR; PG8_SCHED;
            PG8_LDA(At, 0, 1); PG8_STAGE(PG8_SB(0, 0), b2, voffB); PG8_STAGE(PG8_SB(0, 1), b2 + hstep, voffB); PG8_STAGE(PG8_SA(0, 0), a2, voffA);
            PG8_WAIT_V(8); PG8_WAIT_L(0); PG8_BAR; PG8_MMA(1, 0, At, B0); PG8_MMA(1, 1, At, B1); PG8_BAR; PG8_SCHED;
            PG8_LDB(B0, 1, 0); PG8_LDB(B1, 1, 1); PG8_SCHED; PG8_LDA(At, 1, 0); PG8_STAGE(PG8_SA(0, 1), a2 + hstep, voffA);
            PG8_WAIT_V(8); PG8_WAIT_L(0); PG8_BAR; PG8_MMA(0, 0, At, B0); PG8_MMA(0, 1, At, B1); PG8_BAR; PG8_SCHED;
            PG8_LDA(At, 1, 1); PG8_STAGE(PG8_SB(1, 0), b3, voffB); PG8_STAGE(PG8_SB(1, 1), b3 + hstep, voffB); PG8_STAGE(PG8_SA(1, 0), a3, voffA);
            PG8_WAIT_V(8); PG8_WAIT_L(0); PG8_BAR; PG8_MMA(1, 0, At, B0); PG8_MMA(1, 1, At, B1); PG8_BAR; PG8_SCHED;
            } else {
            PG8_LDB(B0, 0, 0); PG8_SCHED; PG8_LDA(At, 0, 0); PG8_STAGE(PG8_SA(1, 1), a1 + hstep, voffA);
            PG8_WAIT_L(8); PG8_BAR; PG8_WAIT_L(0); PG8_MMA(0, 0, At, B0); PG8_BAR; PG8_SCHED;
            PG8_LDB(B1, 0, 1); PG8_STAGE(PG8_SB(0, 0), b2, voffB);
            PG8_BAR; PG8_WAIT_L(0); PG8_MMA(0, 1, At, B1); PG8_BAR;
            PG8_LDA(At, 0, 1); PG8_STAGE(PG8_SA(0, 0), a2, voffA);
            PG8_BAR; PG8_WAIT_L(0); PG8_MMA(1, 0, At, B0); PG8_BAR; PG8_SCHED;
            PG8_STAGE(PG8_SB(0, 1), b2 + hstep, voffB);
            PG8_WAIT_V(6); PG8_BAR; PG8_MMA(1, 1, At, B1); PG8_BAR;
            PG8_LDB(B0, 1, 0); PG8_SCHED; PG8_LDA(At, 1, 0); PG8_STAGE(PG8_SA(0, 1), a2 + hstep, voffA);
            PG8_WAIT_L(8); PG8_BAR; PG8_WAIT_L(0); PG8_MMA(0, 0, At, B0); PG8_BAR; PG8_SCHED;
            PG8_LDB(B1, 1, 1); PG8_STAGE(PG8_SB(1, 0), b3, voffB);
            PG8_BAR; PG8_WAIT_L(0); PG8_MMA(0, 1, At, B1); PG8_BAR;
            PG8_LDA(At, 1, 1); PG8_STAGE(PG8_SA(1, 0), a3, voffA);
            PG8_BAR; PG8_WAIT_L(0); PG8_MMA(1, 0, At, B0); PG8_BAR; PG8_SCHED;
            PG8_STAGE(PG8_SB(1, 1), b3 + hstep, voffB);
            PG8_WAIT_V(6); PG8_BAR; PG8_MMA(1, 1, At, B1); PG8_BAR;
            }
        }
        if constexpr (ALIGN_EPI) { if (wr == 0) PG8_BAR; }
        if constexpr (!Epi::AFTER_DRAIN) { E(acc, cur, wr, wc, fr, fq); S.done(cur); }
        if (!has_next) break;
#pragma unroll
        for (int a = 0; a < 2; ++a)
#pragma unroll
            for (int b = 0; b < 2; ++b)
#pragma unroll
                for (int m = 0; m < 4; ++m)
#pragma unroll
                    for (int n = 0; n < 2; ++n) acc[a][b][m][n] = (f32x4){0.f, 0.f, 0.f, 0.f};
        cur = nxt; cA = nA; cB = nB; ++ui;
        if constexpr (ALIGN_EPI) { if (wr == 1) PG8_BAR; }
    }
    PG8_WAIT_V(0);
    if constexpr (!ALIGN_EPI) { if (wr == 0) PG8_BAR; }
    PG8_BAR;
    if constexpr (Epi::AFTER_DRAIN) { E.fused(acc, cur, wr, wc, fr, fq, lds, wid, lane); S.done(cur); }
#undef PG8_SA
#undef PG8_SB
#undef PG8_STAGE
#undef PG8_LDA
#undef PG8_LDB
#undef PG8_MMA
#undef PG8_WAIT_V
#undef PG8_WAIT_L
#undef PG8_BAR
#undef PG8_SCHED
}
}

namespace fox {
constexpr int D = 128, PITCH = 1024;
constexpr bool WSKIP = false;
constexpr float THR = 8.f;
constexpr float SCALE = 0.08838834764831845f;
constexpr int NW = 8, QBLK = 32, KVBLK = 64, QB = NW * QBLK;
constexpr int SHM_V = KVBLK * D * 2, SHM_K = KVBLK * D * 2;
constexpr int LDS_BYTES = 2 * SHM_V + 2 * SHM_K + NW * 64 * 4;
using bf16 = __hip_bfloat16;
typedef short bf16x8 __attribute__((ext_vector_type(8)));
typedef short s16x4 __attribute__((ext_vector_type(4)));
typedef float f32x16 __attribute__((ext_vector_type(16)));
typedef float f32x4 __attribute__((ext_vector_type(4)));
typedef unsigned u32x4 __attribute__((ext_vector_type(4)));
template <class A, class Bt> struct same_t { static constexpr bool v = false; };
template <class A> struct same_t<A, A> { static constexpr bool v = true; };
__device__ __forceinline__ void bias_tile(f32x16& p0, f32x16& p1, const float* cbp) {
#pragma unroll
    for (int rr = 0; rr < 4; ++rr) { const f32x4 a = *(const f32x4*)(cbp + 8 * rr), b = *(const f32x4*)(cbp + 32 + 8 * rr);
#pragma unroll
        for (int e = 0; e < 4; ++e) { p0[4 * rr + e] += a[e]; p1[4 * rr + e] += b[e]; } }
}
#define KSWZ(row, colB) ((row) * 256 + ((colB) ^ (((row) & 7) << 4)))
#define SBAR() __builtin_amdgcn_sched_barrier(0)
__device__ __forceinline__ int v_st(int k, int c) { const int kk = (k & ~0xC) | ((k & 4) << 1) | ((k & 8) >> 1); return ((kk >> 3) * 4 + (c >> 5)) * 512 + ((kk & 7) * 32 + (c & 31)) * 2; }
__device__ __forceinline__ int v_rd_base(int lane) { return ((lane & 3) << 3) | (((lane >> 2) & 3) << 6) | (((lane >> 4) & 1) << 5) | (((lane >> 5) & 1) << 8); }
constexpr int v_rd_off(int d0, int ks, int half) { return d0 * 512 + ks * 4096 + half * 2048; }
__device__ __forceinline__ int crow(int r, int hi) { return (r & 3) + 8 * (r >> 2) + 4 * hi; }
__device__ __forceinline__ unsigned cvtpk(float lo, float hi) {
    unsigned r; asm volatile("v_cvt_pk_bf16_f32 %0, %1, %2" : "=v"(r) : "v"(lo), "v"(hi)); return r;
}
__device__ __forceinline__ bf16x8 pack8(f32x4 a, f32x4 b) {
    u32x4 w = {cvtpk(a[0], a[1]), cvtpk(a[2], a[3]), cvtpk(b[0], b[1]), cvtpk(b[2], b[3])};
    return *reinterpret_cast<bf16x8*>(&w);
}
template <class T> __device__ __forceinline__ bf16x8 load8(const T* p) {
    if constexpr (same_t<T, float>::v) { return pack8(*(const f32x4*)p, *(const f32x4*)(p + 4)); }
    else { return *reinterpret_cast<const bf16x8*>(p); }
}
__device__ __forceinline__ void mask_tile(f32x16& p0, f32x16& p1, int dq, unsigned W) {
    const float NEG = -__builtin_inff();
#pragma unroll
    for (int r = 0; r < 16; ++r) {
        const int c = (r & 3) + 8 * (r >> 2);
        if ((unsigned)(dq - c) >= W) p0[r] = NEG;
        if ((unsigned)(dq - c - 32) >= W) p1[r] = NEG;
    }
}
__device__ __forceinline__ void partialSM(f32x16& p0, f32x16& p1, float& m_reg, float& mn, float& alpha) {
    float pmax = p0[0]; for (int r = 1; r < 16; ++r) pmax = fmaxf(pmax, p0[r]); for (int r = 0; r < 16; ++r) pmax = fmaxf(pmax, p1[r]);
    { auto rr = __builtin_amdgcn_permlane32_swap(__float_as_uint(pmax), __float_as_uint(pmax), false, false);
      pmax = fmaxf(__uint_as_float(rr[0]), __uint_as_float(rr[1])); }
    constexpr float C2 = 1.4426950408889634f * SCALE;
    if (__builtin_expect(__all((pmax - m_reg) * SCALE <= THR), 1)) { mn = m_reg; alpha = 1.f; }
    else { mn = fmaxf(m_reg, pmax); alpha = __builtin_amdgcn_exp2f((m_reg - mn) * C2); m_reg = mn; }
    const float mnL = -mn * C2;
    for (int r = 0; r < 16; ++r) p0[r] = fmaf(p0[r], C2, mnL); for (int r = 0; r < 16; ++r) p1[r] = fmaf(p1[r], C2, mnL);
    for (int r = 0; r < 16; ++r) p0[r] = __builtin_amdgcn_exp2f(p0[r]);
}
__device__ __forceinline__ void finishSM(f32x16& p0, f32x16& p1, float alpha, float& l_reg, bf16x8& pa0, bf16x8& pa1, bf16x8& pa2, bf16x8& pa3) {
    for (int r = 0; r < 16; ++r) p1[r] = __builtin_amdgcn_exp2f(p1[r]);
    float ps = 0; for (int r = 0; r < 16; ++r) ps += p0[r]; for (int r = 0; r < 16; ++r) ps += p1[r];
    { auto rr = __builtin_amdgcn_permlane32_swap(__float_as_uint(ps), __float_as_uint(ps), false, false);
      ps = __uint_as_float(rr[0]) + __uint_as_float(rr[1]); }
    l_reg = l_reg * alpha + ps;
#define PK4(P, B_, OUT) do { unsigned a0 = cvtpk(P[B_+0], P[B_+1]), a1 = cvtpk(P[B_+2], P[B_+3]);                          \
        unsigned b0 = cvtpk(P[B_+4], P[B_+5]), b1 = cvtpk(P[B_+6], P[B_+7]);                                             \
        auto r0 = __builtin_amdgcn_permlane32_swap(a0, b0, false, false); auto r1 = __builtin_amdgcn_permlane32_swap(a1, b1, false, false); \
        u32x4 w = {r0[0], r1[0], r0[1], r1[1]}; OUT = *reinterpret_cast<bf16x8*>(&w); } while (0)
    PK4(p0, 0, pa0); PK4(p0, 8, pa1); PK4(p1, 0, pa2); PK4(p1, 8, pa3);
#undef PK4
}
template <int KB, bool SK>
__device__ __forceinline__ void qkt(f32x16& p0, f32x16& p1, const char* K_lds, int r32, int hi, const bf16x8* qr, bool act, const float* cbp) {
    if (SK && !act) { const float NEG = -__builtin_inff();
#pragma unroll
        for (int r = 0; r < 16; ++r) { p0[r] = NEG; p1[r] = NEG; } return; }
    { const f32x4* c4 = (const f32x4*)cbp; const f32x4 a0 = c4[0], a1 = c4[2], a2 = c4[4], a3 = c4[6], b0 = c4[8], b1 = c4[10], b2 = c4[12], b3 = c4[14];
      p0 = (f32x16){a0[0], a0[1], a0[2], a0[3], a1[0], a1[1], a1[2], a1[3], a2[0], a2[1], a2[2], a2[3], a3[0], a3[1], a3[2], a3[3]};
      p1 = (f32x16){b0[0], b0[1], b0[2], b0[3], b1[0], b1[1], b1[2], b1[3], b2[0], b2[1], b2[2], b2[3], b3[0], b3[1], b3[2], b3[3]}; }
    const char* kb[4];
#pragma unroll
    for (int dd = 0; dd < 4; ++dd) kb[dd] = K_lds + KB * SHM_K + KSWZ(r32, (dd * 16 + hi * 8) * 2);
#pragma unroll
    for (int d0 = 0; d0 < 8; ++d0) { const char* a = kb[d0 & 3] + (d0 >> 2) * 128;
        bf16x8 b0 = *reinterpret_cast<const bf16x8*>(a);
        bf16x8 b1 = *reinterpret_cast<const bf16x8*>(a + 32 * 256);
        p0 = __builtin_amdgcn_mfma_f32_32x32x16_bf16(b0, qr[d0], p0, 0, 0, 0);
        p1 = __builtin_amdgcn_mfma_f32_32x32x16_bf16(b1, qr[d0], p1, 0, 0, 0); }
}
template <int VB, bool SK>
__device__ __forceinline__ void pv_tile(f32x16* o, int vb0, bf16x8 pa0, bf16x8 pa1, bf16x8 pa2, bf16x8 pa3, bool act) {
    if (SK && !act) return;
#define TRRD(dst, off) asm volatile("ds_read_b64_tr_b16 %0, %1 offset:%2" : "=&v"(dst) : "v"(vb0), "i"(off) : "memory")
#define PV_D0(d0) do { s16x4 l0, l1, l2, l3, h0, h1, h2, h3; constexpr int b_ = VB * SHM_V + v_rd_off(d0, 0, 0);     \
        TRRD(l0, b_); TRRD(h0, b_ + 2048); TRRD(l1, b_ + 4096); TRRD(h1, b_ + 6144); TRRD(l2, b_ + 8192); TRRD(h2, b_ + 10240); TRRD(l3, b_ + 12288); TRRD(h3, b_ + 14336); \
        asm volatile("s_waitcnt lgkmcnt(0)" ::: "memory"); SBAR();                 \
        o[d0] = __builtin_amdgcn_mfma_f32_32x32x16_bf16(pa0, (bf16x8){l0[0], l0[1], l0[2], l0[3], h0[0], h0[1], h0[2], h0[3]}, o[d0], 0, 0, 0);   \
        o[d0] = __builtin_amdgcn_mfma_f32_32x32x16_bf16(pa1, (bf16x8){l1[0], l1[1], l1[2], l1[3], h1[0], h1[1], h1[2], h1[3]}, o[d0], 0, 0, 0);   \
        o[d0] = __builtin_amdgcn_mfma_f32_32x32x16_bf16(pa2, (bf16x8){l2[0], l2[1], l2[2], l2[3], h2[0], h2[1], h2[2], h2[3]}, o[d0], 0, 0, 0);   \
        o[d0] = __builtin_amdgcn_mfma_f32_32x32x16_bf16(pa3, (bf16x8){l3[0], l3[1], l3[2], l3[3], h3[0], h3[1], h3[2], h3[3]}, o[d0], 0, 0, 0); } while (0)
    PV_D0(0); PV_D0(1); PV_D0(2); PV_D0(3);
#undef PV_D0
#undef TRRD
}

template <class TIn, class TOut> struct BlockRef { const TIn* Q; const TIn* K; const TIn* V; TOut* O; int P0; };
template <class TIn> struct Seam {
    bf16x8 qr[8];
    bf16x8 st_v0, st_v1, st_k0, st_k1; f32x4 sf0, sf1, sf2, sf3;
    f32x4 tq[16];
};
__device__ __forceinline__ int swa_jlo(int P0, int W) { const int lowk = P0 - W + 1; return lowk > 0 ? lowk / KVBLK : 0; }
#define ROW(p, k0, rr) ((p) + (size_t)((k0) + (rr)) * PITCH + sc)
#define VMW() asm volatile("s_waitcnt vmcnt(0)" ::: "memory")
#define VMWN(n) asm volatile("s_waitcnt vmcnt(%0)" :: "i"(n) : "memory")
#define SLOAD_H(Kp, Vp, k0) do { S.st_v0 = load8<TIn>(ROW(Vp, k0, sr)); S.st_v1 = load8<TIn>(ROW(Vp, k0, 32 + sr));              \
                         S.st_k0 = load8<TIn>(ROW(Kp, k0, sr)); S.st_k1 = load8<TIn>(ROW(Kp, k0, 32 + sr)); } while (0)
#define SWRITE_HK(bf) do { *(bf16x8*)(K_lds + (bf) * SHM_K + kws) = S.st_k0; *(bf16x8*)(K_lds + (bf) * SHM_K + kws + 32 * 256) = S.st_k1; } while (0)
#define SWRITE_HV(bf) do { *(bf16x8*)(V_lds + (bf) * SHM_V + vst0) = S.st_v0; *(bf16x8*)(V_lds + (bf) * SHM_V + vst1) = S.st_v1; } while (0)
#define SWRITE_H(bf) do { SWRITE_HV(bf); SWRITE_HK(bf); } while (0)
#define SLOAD_F(p, k0) do { S.sf0 = *(const f32x4*)ROW(p, k0, sr); S.sf1 = *(const f32x4*)(ROW(p, k0, sr) + 4);                \
                            S.sf2 = *(const f32x4*)ROW(p, k0, 32 + sr); S.sf3 = *(const f32x4*)(ROW(p, k0, 32 + sr) + 4); } while (0)
#define SWRITE_KF(bf) do { *(bf16x8*)(K_lds + (bf) * SHM_K + kws) = pack8(S.sf0, S.sf1); *(bf16x8*)(K_lds + (bf) * SHM_K + kws + 32 * 256) = pack8(S.sf2, S.sf3); } while (0)
#define SWRITE_VF(bf) do { *(bf16x8*)(V_lds + (bf) * SHM_V + vst0) = pack8(S.sf0, S.sf1); *(bf16x8*)(V_lds + (bf) * SHM_V + vst1) = pack8(S.sf2, S.sf3); } while (0)
template <class TIn, class TOut>
__device__ __forceinline__ void causal_swa_prime(const BlockRef<TIn, TOut>& cur, int W, char* lds, Seam<TIn>& S) {
    constexpr bool F32 = same_t<TIn, float>::v;
    int tid_l = threadIdx.x; asm volatile("" : "+v"(tid_l));
    const int tid = tid_l, wid = __builtin_amdgcn_readfirstlane(tid >> 6), lane = tid & 63, r32 = lane & 31, hi = lane >> 5;
    const int sr = tid >> 4, sc = (tid & 15) * 8, kws = KSWZ(sr, sc * 2); char* K_lds = lds + 2 * SHM_V;
    const int kb0 = swa_jlo(cur.P0, W) * KVBLK;
    for (int d0 = 0; d0 < 8; ++d0) S.qr[d0] = load8<TIn>(cur.Q + (size_t)(wid * QBLK + r32) * PITCH + d0 * 16 + hi * 8);
    if constexpr (F32) { SLOAD_F((const float*)cur.K, kb0); VMW(); SWRITE_KF(0); SBAR(); SLOAD_F((const float*)cur.V, kb0); }
    else { SLOAD_H(cur.K, cur.V, kb0); VMW(); SWRITE_HK(0); }
    __syncthreads();
}
template <class TIn, class TOut>
__device__ __forceinline__ void causal_swa_block(const BlockRef<TIn, TOut>& cur, const BlockRef<TIn, TOut>& nxt, int skv, int W, char* lds, Seam<TIn>& S, const float* cbias) {
    constexpr bool F32 = same_t<TIn, float>::v;
    int tid_l = threadIdx.x; asm volatile("" : "+v"(tid_l));
    const int tid = tid_l, wid = __builtin_amdgcn_readfirstlane(tid >> 6), lane = tid & 63, r32 = lane & 31, hi = lane >> 5;
    const int j_lo = swa_jlo(cur.P0, W);
    int j_hi = (cur.P0 + QB - 1) / KVBLK + 1; if (j_hi > skv / KVBLK) j_hi = skv / KVBLK;
    const int NT = j_hi - j_lo;
    const int kbn = swa_jlo(nxt.P0, W) * KVBLK;
    const int qlo = cur.P0 + wid * QBLK, qm = qlo + r32 - 4 * hi;
    char* V_lds = lds; char* K_lds = lds + 2 * SHM_V;
    float* ws = (float*)(lds + 2 * SHM_V + 2 * SHM_K) + wid * 64; float* li_l = ws, * al_l = ws + 32;
    float m_reg = -1e30f, l_reg = 0; f32x16 o[4] = {};
    const int sr = tid >> 4, sc = (tid & 15) * 8, vst0 = v_st(sr, sc), vst1 = v_st(32 + sr, sc), kws = KSWZ(sr, sc * 2);
    const int vb0 = (int)(uintptr_t)V_lds + v_rd_base(lane);
    const TIn* Kh = cur.K; const TIn* Vh = cur.V;
#define RESC(a) do { if (__any((a) < 1.f)) { if (hi == 0) al_l[r32] = (a); asm volatile("s_waitcnt lgkmcnt(0)" ::: "memory");              \
                     for (int d_ = 0; d_ < 4; ++d_) for (int r = 0; r < 16; ++r) o[d_][r] *= al_l[crow(r, hi)]; } } while (0)
#define KBASE(t) ((j_lo + (t)) * KVBLK)
#define ACT(t) (KBASE(t) <= qlo + QBLK - 1 && KBASE(t) + KVBLK - 1 >= qlo - W + 1)
#define MASKT(P0_, P1_, t) do { const int kb_ = KBASE(t); if ((!SK || ACT(t)) && (kb_ + KVBLK - 1 > qlo || kb_ <= qlo + QBLK - 1 - W)) mask_tile(P0_, P1_, qm - kb_, (unsigned)W); } while (0)
    constexpr int NQL = F32 ? 16 : 8;
    constexpr bool SK = WSKIP && !F32;
#define SEAM_K0() do { VMWN(NQL); if constexpr (F32) { SWRITE_KF(0); SBAR(); SLOAD_F((const float*)nxt.V, kbn); } else { SWRITE_HK(0); } SBAR(); } while (0)
    f32x16 pA0, pA1, pB0, pB1; float mnA, mnB, alA, alB; bf16x8 pa0, pa1, pa2, pa3;
    if constexpr (F32) { VMW(); SWRITE_VF(0); SBAR(); } else { SWRITE_HV(0); SBAR(); }
    if (NT > 1) { if constexpr (F32) SLOAD_F((const float*)Kh, KBASE(1)); else SLOAD_H(Kh, Vh, KBASE(1)); }
    SBAR(); qkt<0, SK>(pA0, pA1, K_lds, r32, hi, S.qr, ACT(0), cbias + KBASE(0) + 4 * hi);
    if constexpr (F32) { if (NT > 1) { VMW(); SWRITE_KF(1); SBAR(); SLOAD_F((const float*)Vh, KBASE(1)); } }
    MASKT(pA0, pA1, 0); partialSM(pA0, pA1, m_reg, mnA, alA);
    if (NT > 1) { VMW(); if constexpr (F32) { SWRITE_VF(1); SBAR(); if (NT > 2) SLOAD_F((const float*)Kh, KBASE(2)); } else SWRITE_H(1); }
    __syncthreads();
#define HALF_STEP(PX0, PX1, mnX, alX, PY0, PY1, alY, t, KB, VB, SB) do {                                                      \
        SBAR(); qkt<KB, SK>(PX0, PX1, K_lds, r32, hi, S.qr, ACT(t), cbias + KBASE(t) + 4 * hi);                                             \
        finishSM(PY0, PY1, alY, l_reg, pa0, pa1, pa2, pa3); SBAR();                                                           \
        if ((t) + 1 < NT) { if constexpr (F32) { VMW(); SWRITE_KF(SB); SBAR(); SLOAD_F((const float*)Vh, KBASE((t) + 1)); }  \
                            else { SLOAD_H(Kh, Vh, KBASE((t) + 1)); } SBAR(); }                                               \
        pv_tile<VB, SK>(o, vb0, pa0, pa1, pa2, pa3, ACT((t) - 1)); MASKT(PX0, PX1, (t)); partialSM(PX0, PX1, m_reg, mnX, alX);                                        \
        __syncthreads();                                                                                                      \
        if ((t) + 1 < NT) { VMW(); if constexpr (F32) { SWRITE_VF(SB); SBAR(); if ((t) + 2 < NT) SLOAD_F((const float*)Kh, KBASE((t) + 2)); } \
                            else { SWRITE_H(SB); } }                                                                          \
        RESC(alX); __syncthreads(); } while (0)
    for (int t = 1; t + 1 < NT; t += 2) {
        HALF_STEP(pB0, pB1, mnB, alB, pA0, pA1, alA, t, 1, 0, 0);
        HALF_STEP(pA0, pA1, mnA, alA, pB0, pB1, alB, t + 1, 0, 1, 1);
    }
    const bool even = (NT & 1) == 0;
    if (even) { SBAR(); qkt<1, SK>(pB0, pB1, K_lds, r32, hi, S.qr, ACT(NT - 1), cbias + KBASE(NT - 1) + 4 * hi); SBAR(); }
#define QROW(e) (nxt.Q + (size_t)(wid * QBLK + r32) * PITCH + ((e) >> 1) * 16 + hi * 8 + ((e) & 1) * 4)
    if constexpr (F32) { SLOAD_F((const float*)nxt.K, kbn); SBAR();
#pragma unroll
        for (int e = 0; e < 8; ++e) S.tq[e] = *(const f32x4*)QROW(e); }
    else { SLOAD_H(nxt.K, nxt.V, kbn); SBAR();
#pragma unroll
        for (int d0 = 0; d0 < 8; ++d0) S.qr[d0] = load8<TIn>(nxt.Q + (size_t)(wid * QBLK + r32) * PITCH + d0 * 16 + hi * 8); }
    SBAR();
    finishSM(pA0, pA1, alA, l_reg, pa0, pa1, pa2, pa3); SBAR();
    if constexpr (F32) {
#pragma unroll
        for (int e = 8; e < 16; ++e) S.tq[e] = *(const f32x4*)QROW(e); SBAR(); }
#undef QROW
    pv_tile<0, SK>(o, vb0, pa0, pa1, pa2, pa3, ACT(even ? NT - 2 : NT - 1));
    if (even) { MASKT(pB0, pB1, NT - 1); partialSM(pB0, pB1, m_reg, mnB, alB); __syncthreads(); RESC(alB);
        finishSM(pB0, pB1, alB, l_reg, pa0, pa1, pa2, pa3); SBAR(); pv_tile<1, SK>(o, vb0, pa0, pa1, pa2, pa3, ACT(NT - 1)); }
    SBAR(); SEAM_K0();
    if (hi == 0) li_l[r32] = l_reg; asm volatile("s_waitcnt lgkmcnt(0)" ::: "memory");
    float rli[16];
#pragma unroll
    for (int r = 0; r < 16; ++r) rli[r] = __builtin_amdgcn_rcpf(li_l[crow(r, hi)]);
    TOut* Ow = cur.O + (size_t)(wid * QBLK) * PITCH;
#pragma unroll
    for (int r = 0; r < 16; ++r) { const int orow = crow(r, hi);
#pragma unroll
        for (int d0 = 0; d0 < 4; ++d0) { const float v = o[d0][r] * rli[r];
            if constexpr (same_t<TOut, float>::v) { Ow[(size_t)orow * PITCH + d0 * 32 + r32] = v; }
            else { const float vn = __shfl_xor(v, 1);
                   if ((r32 & 1) == 0) *(unsigned*)(Ow + (size_t)orow * PITCH + d0 * 32 + r32) = cvtpk(v, vn); } } }
    if constexpr (F32) {
#pragma unroll
        for (int d0 = 0; d0 < 8; ++d0) S.qr[d0] = pack8(S.tq[2 * d0], S.tq[2 * d0 + 1]); }
    __syncthreads();
#undef RESC
#undef KBASE
#undef ACT
#undef MASKT
#undef SEAM_K0
#undef HALF_STEP
}
#undef ROW
#undef VMW
#undef VMWN
#undef SLOAD_H
#undef SWRITE_HK
#undef SWRITE_HV
#undef SWRITE_H
#undef SLOAD_F
#undef SWRITE_KF
#undef SWRITE_VF
}

typedef unsigned short bf16_t;
typedef short bf16x8 __attribute__((ext_vector_type(8)));
typedef float f32x4 __attribute__((ext_vector_type(4)));
typedef unsigned u32x4 __attribute__((ext_vector_type(4)));
typedef unsigned u32x2 __attribute__((ext_vector_type(2)));
constexpr int DM = 1024, NB = 32, SEQ = 2048, NH = 8, HD = 128, DFF = 2816, NUP = 2 * DFF;
constexpr int MTOK = NB * SEQ;
constexpr int NG = 2, BG = NB / NG, GM = BG * SEQ;
constexpr int NIN = 37 * 256;
constexpr int NCH = BG * NH * 32;
static_assert(GM == pg8::GM, "group rows");
constexpr size_t MiB = 1u << 20;
constexpr size_t WS_CTL = 0;
constexpr size_t WS_WIN = 1 * MiB, WS_WBF = 20 * MiB, WS_WBG = 22 * MiB, WS_WOUT = 24 * MiB, WS_WUP = 26 * MiB, WS_WDN = 37 * MiB;
constexpr size_t WS_PROJ = 44 * MiB;
constexpr size_t WS_SMALL = 620 * MiB;
constexpr size_t WS_PREP = 624 * MiB;
constexpr size_t WS_END = 913 * MiB;
constexpr size_t PBUF = 64 * MiB;
constexpr size_t WS_H1B = WS_PROJ + 0 * PBUF;
constexpr size_t WS_T1 = WS_PROJ + 1 * PBUF;
constexpr size_t WS_Y = WS_PROJ + 2 * PBUF;
constexpr size_t WS_YGDN = WS_PROJ + 3 * PBUF;
constexpr size_t WS_YFOX = WS_PROJ + 5 * PBUF;
constexpr size_t WS_UP = WS_PROJ + 3 * PBUF;
constexpr size_t WS_ACT = WS_PREP;
constexpr size_t PROJ_STRIDE = (size_t)GM * 1024;
constexpr int LDS_BYTES = 147456;

__device__ __forceinline__ float bf2f(bf16_t b) { return __uint_as_float((unsigned)b << 16); }
__device__ __forceinline__ float bflo(unsigned w) { return __uint_as_float(w << 16); }
__device__ __forceinline__ float bfhi(unsigned w) { return __uint_as_float(w & 0xffff0000u); }
typedef float f32x2_t __attribute__((ext_vector_type(2))); typedef __bf16 bf16x2_t __attribute__((ext_vector_type(2)));
__device__ __forceinline__ unsigned pk2(float lo, float hi) { f32x2_t v = {lo, hi}; bf16x2_t b = __builtin_convertvector(v, bf16x2_t); return __builtin_bit_cast(unsigned, b); }
__device__ __forceinline__ bf16_t f2bf(float f) { return (bf16_t)(pk2(f, 0.f) & 0xffffu); }
__device__ __forceinline__ float siluf(float y) { return y / (1.0f + __expf(-y)); }
__device__ __forceinline__ float wave_sum(float v) {
#pragma unroll
    for (int o = 1; o < 64; o <<= 1) v += __shfl_xor(v, o);
    return v;
}

struct Args { const float* in[16]; float* out; unsigned char* ws; int ph_lo, ph_hi; };
struct Ptrs {
    const float *x, *norm_mix, *w_in, *fox_f_bias, *gdn_conv_w, *gdn_a_log, *gdn_dt_bias, *gdn_norm, *w_bf, *w_bg, *w_out, *norm_ffn, *w_up, *ffn_conv_w, *w_down, *norm_final;
    float* out; unsigned char* ws;
};

template <int MODE> __device__ __forceinline__ int srccol(int n) {
    if (MODE == 0) return n;
    if (MODE == 1) {
        if (n < 3072) return n;
        if (n < 6144) return 3080 + (n - 3072);
        if (n < 9216) return 6168 + (n - 6144);
        const int s = n - 9216;
        if (s < 8) return 3072 + s;
        if (s < 16) return 6152 + (s - 8);
        if (s < 24) return 6160 + (s - 16);
        return -1;
    }
    { const int p = n >> 8, s = (n >> 7) & 1, i = n & 127; return s * DFF + 128 * p + i; }
}
template <int MODE> __device__ __forceinline__ void transpose_item(const float* W, int K, int N, const float* ksc, bf16_t* WT, float* scr, int item, int nblk, int lane) {
    const int kb = item / nblk, nb = item % nblk, k0 = 64 * kb, n0 = 32 * nb;
    const int sc = srccol<MODE>(n0 + (lane & 31));
#pragma unroll 8
    for (int i = 0; i < 32; ++i) { const int kk = 2 * i + (lane >> 5); float v = 0.f; if (sc >= 0) { v = W[(size_t)(k0 + kk) * N + sc]; if (ksc) v *= ksc[k0 + kk]; } scr[kk * 33 + (lane & 31)] = v; }
    asm volatile("s_waitcnt lgkmcnt(0)" ::: "memory");
    const int c = lane & 7;
#pragma unroll
    for (int j = 0; j < 4; ++j) { const int n = (lane >> 3) + 8 * j; const float* s = scr + (8 * c) * 33 + n;
        u32x4 o; o.x = pk2(s[0 * 33], s[1 * 33]); o.y = pk2(s[2 * 33], s[3 * 33]); o.z = pk2(s[4 * 33], s[5 * 33]); o.w = pk2(s[6 * 33], s[7 * 33]);
        *(u32x4*)(WT + (size_t)(n0 + n) * K + k0 + 8 * c) = o; }
    asm volatile("s_waitcnt lgkmcnt(0)" ::: "memory");
}
__device__ __forceinline__ void phase_prologue(const Ptrs& P, char* lds, int tid) {
    const int lane = tid & 63, wave = tid >> 6;
    float* scr = (float*)(lds + wave * 16384);
    const int gw = blockIdx.x * 8 + wave, NGW = gridDim.x * 8;
    bf16_t* win_t = (bf16_t*)(P.ws + WS_WIN); bf16_t* wbf_t = (bf16_t*)(P.ws + WS_WBF); bf16_t* wbg_t = (bf16_t*)(P.ws + WS_WBG);
    bf16_t* wout_t = (bf16_t*)(P.ws + WS_WOUT); bf16_t* wup_t = (bf16_t*)(P.ws + WS_WUP); bf16_t* wdn_t = (bf16_t*)(P.ws + WS_WDN);
    constexpr int I_IN = 16 * (NIN / 32), I_SQ = 16 * 32, I_UP = 16 * (NUP / 32), I_DN = (DFF / 64) * 32;
    constexpr int NITEMS = I_IN + 3 * I_SQ + I_UP + I_DN;
    for (int it = gw; it < NITEMS; it += NGW) {
        int r = it;
        if (r < I_IN) { transpose_item<1>(P.w_in, DM, 9240, nullptr, win_t, scr, r, NIN / 32, lane); continue; } r -= I_IN;
        if (r < I_SQ) { transpose_item<0>(P.w_bf, DM, DM, nullptr, wbf_t, scr, r, 32, lane); continue; } r -= I_SQ;
        if (r < I_SQ) { transpose_item<0>(P.w_bg, DM, DM, nullptr, wbg_t, scr, r, 32, lane); continue; } r -= I_SQ;
        if (r < I_SQ) { transpose_item<0>(P.w_out, DM, DM, nullptr, wout_t, scr, r, 32, lane); continue; } r -= I_SQ;
        if (r < I_UP) { transpose_item<2>(P.w_up, DM, NUP, P.norm_ffn, wup_t, scr, r, NUP / 32, lane); continue; } r -= I_UP;
        transpose_item<0>(P.w_down, DFF, DM, nullptr, wdn_t, scr, r, 32, lane);
    }
    f32x4 gv[4];
#pragma unroll
    for (int j = 0; j < 4; ++j) gv[j] = ((const f32x4*)P.norm_mix)[lane + 64 * j];
    for (int m = gw; m < MTOK; m += NGW) {
        const f32x4* xr = (const f32x4*)(P.x + (size_t)m * DM) + lane;
        f32x4 v[4]; float s = 0.f;
#pragma unroll
        for (int j = 0; j < 4; ++j) { v[j] = xr[64 * j]; s += (v[j][0] * v[j][0] + v[j][1] * v[j][1]) + (v[j][2] * v[j][2] + v[j][3] * v[j][3]); }
        const float rstd = rsqrtf(wave_sum(s) * (1.f / DM) + 1e-6f);
        const int mg = m / GM; bf16_t* xn = (bf16_t*)(P.out + (size_t)mg * GM * DM) + (size_t)(m - mg * GM) * DM;
        u32x2* o8 = (u32x2*)xn + lane;
#pragma unroll
        for (int j = 0; j < 4; ++j) { const f32x4 t = v[j] * rstd * gv[j]; u32x2 w; w.x = pk2(t[0], t[1]); w.y = pk2(t[2], t[3]); o8[64 * j] = w; }
    }
}

__device__ __forceinline__ f32x4 mma16(const bf16_t* A, int lda, const bf16_t* Bt, int ldb, int ksteps, f32x4 acc, int lane) {
    const int r = lane & 15, q = lane >> 4;
    const bf16_t* ap = A + r * lda + q * 8; const bf16_t* bp = Bt + r * ldb + q * 8;
    for (int ks = 0; ks < ksteps; ++ks) { const bf16x8 a = *(const bf16x8*)(ap + ks * 32); const bf16x8 b = *(const bf16x8*)(bp + ks * 32); acc = __builtin_amdgcn_mfma_f32_16x16x32_bf16(a, b, acc, 0, 0, 0); }
    return acc;
}
#define LBAR() do { asm volatile("s_waitcnt lgkmcnt(0)" ::: "memory"); __builtin_amdgcn_s_barrier(); asm volatile("" ::: "memory"); } while (0)
constexpr int PQ = 136, PC = 72;
struct PrepBufs { bf16_t *W, *QD, *KDT, *UHT, *AT; float* GL; };
__device__ __forceinline__ PrepBufs prep_bufs(unsigned char* ws) {
    PrepBufs b; b.W = (bf16_t*)(ws + WS_PREP); b.QD = (bf16_t*)(ws + WS_PREP + 64 * MiB); b.KDT = (bf16_t*)(ws + WS_PREP + 128 * MiB); b.UHT = (bf16_t*)(ws + WS_PREP + 192 * MiB);
    b.AT = (bf16_t*)(ws + WS_PREP + 256 * MiB); b.GL = (float*)(ws + WS_PREP + 288 * MiB); return b;
}
__device__ __forceinline__ void gdn_prep_unit(char* lds, int unit, const Ptrs& P, int tid) {
    const int lane = tid & 63, wid = tid >> 6, c16 = lane & 15, q4 = lane >> 4;
    const int n = unit & 31, h = (unit >> 5) & 7, bl = unit >> 8;
    const int R0 = bl * SEQ + n * 64;
    bf16_t* Qs = (bf16_t*)lds; bf16_t* Ks = Qs + 64 * PQ; bf16_t* KBs = Ks + 64 * PQ; bf16_t* KDTs = KBs + 64 * PQ;
    bf16_t* RT = KDTs + 128 * PC;
    float* gcs = (float*)(RT + 256 * PC); float* bts = gcs + 64;
    bf16_t* CH = (bf16_t*)lds;
    const PrepBufs G = prep_bufs(P.ws);
    const bf16_t* proj = (const bf16_t*)(P.ws + WS_PROJ); const float* small = (const float*)(P.ws + WS_SMALL);
    if (wid == 0) {
        const float* sm = small + (size_t)(R0 + lane) * 32;
        const float xx = sm[8 + h] + P.gdn_dt_bias[h];
        const float sp = xx > 20.f ? xx : log1pf(__expf(xx));
        float cum = -__expf(P.gdn_a_log[h]) * sp;
        const float beta = 1.0f / (1.0f + __expf(-sm[16 + h]));
#pragma unroll
        for (int o = 1; o < 64; o <<= 1) { const float t = __shfl_up(cum, o); if (lane >= o) cum += t; }
        gcs[lane] = cum; bts[lane] = beta;
    }
    LBAR();
    {
        const int r = tid >> 3, d0 = (tid & 7) * 16;
        const float gcr = gcs[r], btr = bts[r], glast = gcs[63];
        const float eg = __expf(gcr), egl = __expf(glast - gcr);
        const int tseq = n * 64 + r;
#pragma unroll
        for (int part = 0; part < 3; ++part) {
            const bf16_t* src = proj + (size_t)(3 + part) * PROJ_STRIDE + (size_t)(R0 + r) * 1024 + h * HD + d0;
            const float* cw = P.gdn_conv_w + part * 1024 + h * HD + d0;
            float y[16];
#pragma unroll
            for (int j = 0; j < 16; ++j) y[j] = 0.f;
#pragma unroll
            for (int i = 0; i < 4; ++i) {
                if (tseq + i - 3 >= 0) {
                    const u32x4 a = *(const u32x4*)(src + (i - 3) * 1024), b = *(const u32x4*)(src + (i - 3) * 1024 + 8);
                    const float* w = cw + i * 3072;
                    const f32x4 w0 = *(const f32x4*)w, w1 = *(const f32x4*)(w + 4), w2 = *(const f32x4*)(w + 8), w3 = *(const f32x4*)(w + 12);
                    y[0] += w0[0] * bflo(a.x); y[1] += w0[1] * bfhi(a.x); y[2] += w0[2] * bflo(a.y); y[3] += w0[3] * bfhi(a.y);
                    y[4] += w1[0] * bflo(a.z); y[5] += w1[1] * bfhi(a.z); y[6] += w1[2] * bflo(a.w); y[7] += w1[3] * bfhi(a.w);
                    y[8] += w2[0] * bflo(b.x); y[9] += w2[1] * bfhi(b.x); y[10] += w2[2] * bflo(b.y); y[11] += w2[3] * bfhi(b.y);
                    y[12] += w3[0] * bflo(b.z); y[13] += w3[1] * bfhi(b.z); y[14] += w3[2] * bflo(b.w); y[15] += w3[3] * bfhi(b.w);
                }
            }
            float ss = 0.f;
#pragma unroll
            for (int j = 0; j < 16; ++j) { y[j] = siluf(y[j]); ss += y[j] * y[j]; }
            if (part < 2) { ss += __shfl_xor(ss, 1); ss += __shfl_xor(ss, 2); ss += __shfl_xor(ss, 4); }
            const float inv = rsqrtf(ss + 1e-6f);
            if (part == 0) {
                const float sc = inv * 0.08838834764831845f;
                unsigned pq[8], pd[8];
#pragma unroll
                for (int j = 0; j < 8; ++j) { const float a0 = y[2 * j] * sc, a1 = y[2 * j + 1] * sc; pq[j] = pk2(a0, a1); pd[j] = pk2(a0 * eg, a1 * eg); }
                *(u32x4*)(Qs + r * PQ + d0) = (u32x4){pq[0], pq[1], pq[2], pq[3]}; *(u32x4*)(Qs + r * PQ + d0 + 8) = (u32x4){pq[4], pq[5], pq[6], pq[7]};
                bf16_t* qd = G.QD + (size_t)unit * 8192 + r * 128 + d0;
                *(u32x4*)qd = (u32x4){pd[0], pd[1], pd[2], pd[3]}; *(u32x4*)(qd + 8) = (u32x4){pd[4], pd[5], pd[6], pd[7]};
            } else if (part == 1) {
                unsigned pk[8], pb[8];
#pragma unroll
                for (int j = 0; j < 8; ++j) { const float a0 = y[2 * j] * inv, a1 = y[2 * j + 1] * inv; pk[j] = pk2(a0, a1); pb[j] = pk2(a0 * btr, a1 * btr); }
                *(u32x4*)(Ks + r * PQ + d0) = (u32x4){pk[0], pk[1], pk[2], pk[3]}; *(u32x4*)(Ks + r * PQ + d0 + 8) = (u32x4){pk[4], pk[5], pk[6], pk[7]};
                *(u32x4*)(KBs + r * PQ + d0) = (u32x4){pb[0], pb[1], pb[2], pb[3]}; *(u32x4*)(KBs + r * PQ + d0 + 8) = (u32x4){pb[4], pb[5], pb[6], pb[7]};
#pragma unroll
                for (int j = 0; j < 16; ++j) { const float kn = y[j] * inv; RT[(128 + d0 + j) * PC + r] = f2bf(kn * btr * eg); KDTs[(d0 + j) * PC + r] = f2bf(kn * egl); }
            } else {
#pragma unroll
                for (int j = 0; j < 16; ++j) RT[(d0 + j) * PC + r] = f2bf(y[j] * btr);
            }
        }
    }
    LBAR();
    {
#pragma unroll
        for (int i = 0; i < 2; ++i) { const int idx = tid + 512 * i, row = idx >> 3, ch = idx & 7; *(u32x4*)(G.KDT + (size_t)unit * 8192 + row * 64 + ch * 8) = *(const u32x4*)(KDTs + row * PC + ch * 8); }
    }
    const int mat = wid >> 2, ti = wid & 3;
    f32x4 res[4];
#pragma unroll
    for (int tj = 0; tj < 4; ++tj) { f32x4 acc = {0.f, 0.f, 0.f, 0.f}; if (tj <= ti) acc = mma16((mat ? Qs : KBs) + ti * 16 * PQ, PQ, Ks + tj * 16 * PQ, PQ, 4, acc, lane); res[tj] = acc; }
    LBAR();
#pragma unroll
    for (int tj = 0; tj < 4; ++tj)
#pragma unroll
        for (int jj = 0; jj < 4; ++jj) { const int ii = ti * 16 + 4 * q4 + jj, jc = tj * 16 + c16;
            const float dec = (ii >= jc) ? __expf(gcs[ii] - gcs[jc]) : 0.f;
            if (mat == 0) { const bf16_t nv = f2bf((ii > jc) ? -res[tj][jj] * dec : 0.f); CH[ii * PC + jc] = nv; CH[2 * 64 * PC + jc * PC + ii] = nv; }
            else G.AT[(size_t)unit * 4096 + ii * 64 + jc] = f2bf((ii >= jc) ? res[tj][jj] * dec : 0.f); }
    LBAR();
    f32x4 pacc[4];
    if (wid >= 4) {
#pragma unroll
        for (int tj = 0; tj < 4; ++tj)
#pragma unroll
            for (int jj = 0; jj < 4; ++jj) { const int ii = ti * 16 + 4 * q4 + jj, jc = tj * 16 + c16; pacc[tj][jj] = bf2f(CH[ii * PC + jc]) + (ii == jc ? 1.f : 0.f); }
    }
    for (int s = 0; s < 6; ++s) {
        const int cur = s & 1, nxt = cur ^ 1;
        bf16_t* Qr_c = CH + cur * 64 * PC; bf16_t* Qt_c = CH + (2 + cur) * 64 * PC; bf16_t* Qr_n = CH + nxt * 64 * PC; bf16_t* Qt_n = CH + (2 + nxt) * 64 * PC;
        bf16_t* Pr_c = CH + (4 + cur) * 64 * PC; bf16_t* Pr_p = CH + (4 + nxt) * 64 * PC;
        if (wid < 4) {
            if (s < 5) {
#pragma unroll
                for (int tj = 0; tj < 4; ++tj) { f32x4 acc = {0.f, 0.f, 0.f, 0.f}; acc = mma16(Qr_c + ti * 16 * PC, PC, Qt_c + tj * 16 * PC, PC, 2, acc, lane);
#pragma unroll
                    for (int jj = 0; jj < 4; ++jj) { const int ii = ti * 16 + 4 * q4 + jj, jc = tj * 16 + c16; const bf16_t v = f2bf(acc[jj]); Qr_n[ii * PC + jc] = v; Qt_n[jc * PC + ii] = v; } }
            }
        } else {
#pragma unroll
            for (int tj = 0; tj < 4; ++tj) { if (s >= 1) pacc[tj] = mma16(Pr_p + ti * 16 * PC, PC, Qt_c + tj * 16 * PC, PC, 2, pacc[tj], lane);
#pragma unroll
                for (int jj = 0; jj < 4; ++jj) { const int ii = ti * 16 + 4 * q4 + jj, jc = tj * 16 + c16; Pr_c[ii * PC + jc] = f2bf(pacc[tj][jj]); } }
        }
        LBAR();
    }
    {
        const bf16_t* Tm = CH + 5 * 64 * PC;
#pragma unroll
        for (int t2 = 0; t2 < 2; ++t2) { const int tch = 2 * wid + t2;
#pragma unroll
            for (int tj = 0; tj < 4; ++tj) { f32x4 acc = {0.f, 0.f, 0.f, 0.f}; acc = mma16(RT + tch * 16 * PC, PC, Tm + tj * 16 * PC, PC, 2, acc, lane);
                const int ci = tj * 16 + c16, ch0 = tch * 16 + 4 * q4;
                if (tch < 8) {
#pragma unroll
                    for (int jj = 0; jj < 4; ++jj) G.UHT[(size_t)unit * 8192 + (ch0 + jj) * 64 + ci] = f2bf(acc[jj]);
                } else { u32x2 w; w.x = pk2(acc[0], acc[1]); w.y = pk2(acc[2], acc[3]); *(u32x2*)(G.W + (size_t)unit * 8192 + ci * 128 + (ch0 - 128)) = w; }
            } }
        if (tid == 0) G.GL[unit] = __expf(gcs[63]);
    }
    LBAR();
}

__device__ __forceinline__ void gdn_seq_unit(char* lds, int bh, const Ptrs& P, int tid) {
    const int lane = tid & 63, wid = tid >> 6, c16 = lane & 15, q4 = lane >> 4;
    const int bl = bh >> 3, h = bh & 7;
    bf16_t* ST = (bf16_t*)lds;
    bf16_t* Wl = ST + 128 * PQ;
    bf16_t* QDl = Wl + 64 * PQ;
    bf16_t* ATl = QDl + 64 * PQ;
    bf16_t* KDTl = ATl + 64 * PC;
    bf16_t* UTl = KDTl + 128 * PC;
    bf16_t* GZl = UTl + 128 * PC;
    float* SSl = (float*)(GZl + 64 * PQ);
    const PrepBufs G = prep_bufs(P.ws);
    const bf16_t* gz = (const bf16_t*)(P.ws + WS_PROJ) + 6 * PROJ_STRIDE + (size_t)(bl * SEQ) * 1024 + h * HD;
    bf16_t* yg = (bf16_t*)(P.ws + WS_YGDN) + (size_t)(bl * SEQ) * 1024 + h * HD;
    f32x4 Sacc[8];
#pragma unroll
    for (int t = 0; t < 8; ++t) Sacc[t] = (f32x4){0.f, 0.f, 0.f, 0.f};
    for (int i = lane; i < 16 * PQ / 2; i += 64) ((unsigned*)(ST + wid * 16 * PQ))[i] = 0u;
    const f32x4 gn = *(const f32x4*)(P.gdn_norm + 16 * wid + 4 * q4);
    const int r16 = tid >> 4, ch16 = (tid & 15) * 8;
    const int r8 = tid >> 3, ch8 = (tid & 7) * 8;
    u32x4 sW[2], sQ[2], sA, sK[2], sG[2]; u32x2 uhn[4];
    {
        const size_t ub = (size_t)(bh * 32) * 8192;
#pragma unroll
        for (int i = 0; i < 2; ++i) { const int idx = tid + 512 * i; sW[i] = *(const u32x4*)(G.W + ub + idx * 8); sQ[i] = *(const u32x4*)(G.QD + ub + idx * 8); sK[i] = *(const u32x4*)(G.KDT + ub + idx * 8);
            sG[i] = *(const u32x4*)(gz + (size_t)(r16 + 32 * i) * 1024 + ch16); }
        sA = *(const u32x4*)(G.AT + (size_t)(bh * 32) * 4096 + tid * 8);
#pragma unroll
        for (int t = 0; t < 4; ++t) uhn[t] = *(const u32x2*)(G.UHT + ub + (16 * wid + c16) * 64 + 16 * t + 4 * q4);
    }
    for (int n = 0; n < 32; ++n) {
        const int unit = bh * 32 + n;
        const size_t ub = (size_t)unit * 8192;
#pragma unroll
        for (int i = 0; i < 2; ++i) { const int idx = tid + 512 * i;
            *(u32x4*)(Wl + (idx >> 4) * PQ + (idx & 15) * 8) = sW[i]; *(u32x4*)(QDl + (idx >> 4) * PQ + (idx & 15) * 8) = sQ[i]; *(u32x4*)(KDTl + (idx >> 3) * PC + (idx & 7) * 8) = sK[i]; }
        *(u32x4*)(ATl + r8 * PC + ch8) = sA;
        const float gl = G.GL[unit];
        u32x2 uh[4];
#pragma unroll
        for (int t = 0; t < 4; ++t) uh[t] = uhn[t];
        LBAR();
        if (n + 1 < 32) { const size_t un = ub + 8192;
#pragma unroll
            for (int i = 0; i < 2; ++i) { const int idx = tid + 512 * i; sW[i] = *(const u32x4*)(G.W + un + idx * 8); sQ[i] = *(const u32x4*)(G.QD + un + idx * 8); sK[i] = *(const u32x4*)(G.KDT + un + idx * 8); }
            sA = *(const u32x4*)(G.AT + (size_t)(unit + 1) * 4096 + tid * 8);
#pragma unroll
            for (int t = 0; t < 4; ++t) uhn[t] = *(const u32x2*)(G.UHT + un + (16 * wid + c16) * 64 + 16 * t + 4 * q4); }
        if (n > 0) {
#pragma unroll
            for (int i = 0; i < 2; ++i) { const u32x4 v = *(const u32x4*)(GZl + (r16 + 32 * i) * PQ + ch16); *(u32x4*)(yg + (size_t)((n - 1) * 64 + r16 + 32 * i) * 1024 + ch16) = v; } }
        f32x4 ws[4], os[4];
#pragma unroll
        for (int t = 0; t < 4; ++t) { ws[t] = (f32x4){0.f, 0.f, 0.f, 0.f}; os[t] = (f32x4){0.f, 0.f, 0.f, 0.f}; }
#pragma unroll
        for (int ks = 0; ks < 4; ++ks) { const bf16x8 b = *(const bf16x8*)(ST + (16 * wid + c16) * PQ + ks * 32 + q4 * 8);
#pragma unroll
            for (int t = 0; t < 4; ++t) { const bf16x8 a = *(const bf16x8*)(Wl + (16 * t + c16) * PQ + ks * 32 + q4 * 8); ws[t] = __builtin_amdgcn_mfma_f32_16x16x32_bf16(a, b, ws[t], 0, 0, 0);
                const bf16x8 a2 = *(const bf16x8*)(QDl + (16 * t + c16) * PQ + ks * 32 + q4 * 8); os[t] = __builtin_amdgcn_mfma_f32_16x16x32_bf16(b, a2, os[t], 0, 0, 0); } }
#pragma unroll
        for (int t = 0; t < 4; ++t) { u32x2 w; w.x = pk2(bflo(uh[t].x) - ws[t][0], bfhi(uh[t].x) - ws[t][1]); w.y = pk2(bflo(uh[t].y) - ws[t][2], bfhi(uh[t].y) - ws[t][3]);
            *(u32x2*)(UTl + (16 * wid + c16) * PC + 16 * t + 4 * q4) = w; }
        LBAR();
#pragma unroll
        for (int i = 0; i < 2; ++i) *(u32x4*)(GZl + (r16 + 32 * i) * PQ + ch16) = sG[i];
        if (n + 1 < 32) {
#pragma unroll
            for (int i = 0; i < 2; ++i) sG[i] = *(const u32x4*)(gz + (size_t)((n + 1) * 64 + r16 + 32 * i) * 1024 + ch16); }
#pragma unroll
        for (int ks = 0; ks < 2; ++ks) { const bf16x8 b = *(const bf16x8*)(UTl + (16 * wid + c16) * PC + ks * 32 + q4 * 8);
#pragma unroll
            for (int t = 0; t < 4; ++t) { const bf16x8 a = *(const bf16x8*)(ATl + (16 * t + c16) * PC + ks * 32 + q4 * 8); os[t] = __builtin_amdgcn_mfma_f32_16x16x32_bf16(b, a, os[t], 0, 0, 0); } }
#pragma unroll
        for (int t = 0; t < 8; ++t) Sacc[t] = Sacc[t] * gl;
#pragma unroll
        for (int ks = 0; ks < 2; ++ks) { const bf16x8 a = *(const bf16x8*)(UTl + (16 * wid + c16) * PC + ks * 32 + q4 * 8);
#pragma unroll
            for (int t = 0; t < 8; ++t) { const bf16x8 b = *(const bf16x8*)(KDTl + (16 * t + c16) * PC + ks * 32 + q4 * 8); Sacc[t] = __builtin_amdgcn_mfma_f32_16x16x32_bf16(b, a, Sacc[t], 0, 0, 0); } }
#pragma unroll
        for (int t = 0; t < 8; ++t) { u32x2 w; w.x = pk2(Sacc[t][0], Sacc[t][1]); w.y = pk2(Sacc[t][2], Sacc[t][3]); *(u32x2*)(ST + (16 * wid + c16) * PQ + 16 * t + 4 * q4) = w; }
#pragma unroll
        for (int t = 0; t < 4; ++t) { float s = (os[t][0] * os[t][0] + os[t][1] * os[t][1]) + (os[t][2] * os[t][2] + os[t][3] * os[t][3]); s += __shfl_xor(s, 16); s += __shfl_xor(s, 32);
            if (q4 == 0) SSl[wid * 64 + 16 * t + c16] = s; }
        LBAR();
        float tot = 0.f;
#pragma unroll
        for (int w = 0; w < 8; ++w) tot += SSl[w * 64 + lane];
        const float rstd_l = rsqrtf(tot * (1.0f / 128.0f) + 1e-6f);
#pragma unroll
        for (int t = 0; t < 4; ++t) { const int row = 16 * t + c16; const float rs = __shfl(rstd_l, row);
            u32x2* gp = (u32x2*)(GZl + row * PQ + 16 * wid + 4 * q4); const u32x2 gw = *gp; u32x2 w;
            w.x = pk2(os[t][0] * rs * gn[0] * siluf(bflo(gw.x)), os[t][1] * rs * gn[1] * siluf(bfhi(gw.x)));
            w.y = pk2(os[t][2] * rs * gn[2] * siluf(bflo(gw.y)), os[t][3] * rs * gn[3] * siluf(bfhi(gw.y))); *gp = w; }
    }
    LBAR();
#pragma unroll
    for (int i = 0; i < 2; ++i) { const u32x4 v = *(const u32x4*)(GZl + (r16 + 32 * i) * PQ + ch16); *(u32x4*)(yg + (size_t)(31 * 64 + r16 + 32 * i) * 1024 + ch16) = v; }
    __syncthreads();
}

__device__ __forceinline__ void fox_item(char* lds, int item, const Ptrs& P, int tid) {
    using bf = fox::bf16;
    const int lane = tid & 63, wid = tid >> 6;
    const int bh = item >> 2, xq = item & 3, bl = bh >> 3, h = bh & 7;
    float* cb = (float*)(lds + fox::LDS_BYTES);
    float* tmp = cb + SEQ;
    const float* small = (const float*)(P.ws + WS_SMALL);
    {
        const float fb = P.fox_f_bias[h];
        float lf[4]; float run = 0.f;
#pragma unroll
        for (int e = 0; e < 4; ++e) { const float xv = small[(size_t)(bl * SEQ + 4 * tid + e) * 32 + h] + fb;
            const float l = (xv < -20.f) ? xv : -log1pf(__expf(-xv)); run += l; lf[e] = run; }
        float inc = run;
#pragma unroll
        for (int o = 1; o < 64; o <<= 1) { const float t = __shfl_up(inc, o); if (lane >= o) inc += t; }
        if (lane == 63) tmp[wid] = inc;
        __syncthreads();
        float off = inc - run;
        for (int w = 0; w < wid; ++w) off += tmp[w];
#pragma unroll
        for (int e = 0; e < 4; ++e) cb[4 * tid + e] = -(off + lf[e]) * 11.313708498984761f;
        __syncthreads();
    }
    bf* fq = (bf*)(P.ws + WS_PROJ); const bf* fk = fq + PROJ_STRIDE; const bf* fv = fq + 2 * PROJ_STRIDE;
    const size_t hb = (size_t)(bl * SEQ) * 1024 + h * HD;
    fox::BlockRef<bf, bf> b0, b1;
    bf* yo = (bf*)(P.ws + WS_YFOX);
    b0.Q = fq + hb + (size_t)(xq * 256) * 1024; b0.O = yo + hb + (size_t)(xq * 256) * 1024; b0.K = fk + hb; b0.V = fv + hb; b0.P0 = xq * 256;
    b1.Q = fq + hb + (size_t)((7 - xq) * 256) * 1024; b1.O = yo + hb + (size_t)((7 - xq) * 256) * 1024; b1.K = fk + hb; b1.V = fv + hb; b1.P0 = (7 - xq) * 256;
    fox::Seam<bf> S;
    fox::causal_swa_prime<bf, bf>(b0, 1 << 20, lds, S);
    fox::causal_swa_block<bf, bf>(b0, b1, SEQ, 1 << 20, lds, S, cb);
    fox::causal_swa_block<bf, bf>(b1, b1, SEQ, 1 << 20, lds, S, cb);
    __syncthreads();
}

__device__ __forceinline__ void phase_convgate(const Ptrs& P, int tid) {
    const bf16_t* up = (const bf16_t*)(P.ws + WS_UP); bf16_t* act = (bf16_t*)(P.ws + WS_ACT);
    constexpr int NFG = DFF / 8, RB = 32, NRB = GM / RB;
    const int total = NFG * NRB;
    for (int it = blockIdx.x * 512 + tid; it < total; it += gridDim.x * 512) {
        const int fg = it % NFG, rb = it / NFG;
        const int p = fg >> 4, i0 = (fg & 15) * 8, f0 = p * 128 + i0;
        const int cg0 = p * 256 + i0, cv0 = cg0 + 128;
        float wg[3][8], wv[3][8];
#pragma unroll
        for (int i = 0; i < 3; ++i)
#pragma unroll
            for (int j = 0; j < 8; ++j) { wg[i][j] = P.ffn_conv_w[i * NUP + f0 + j]; wv[i][j] = P.ffn_conv_w[i * NUP + DFF + f0 + j]; }
        const int r0 = rb * RB;
        float g1[8], g2[8], v1[8], v2[8];
#pragma unroll
        for (int j = 0; j < 8; ++j) { g1[j] = 0.f; g2[j] = 0.f; v1[j] = 0.f; v2[j] = 0.f; }
        if ((r0 & (SEQ - 1)) != 0) {
            const u32x4 a1 = *(const u32x4*)(up + (size_t)(r0 - 1) * NUP + cg0), a2 = *(const u32x4*)(up + (size_t)(r0 - 2) * NUP + cg0);
            const u32x4 b1 = *(const u32x4*)(up + (size_t)(r0 - 1) * NUP + cv0), b2 = *(const u32x4*)(up + (size_t)(r0 - 2) * NUP + cv0);
            g1[0] = bflo(a1.x); g1[1] = bfhi(a1.x); g1[2] = bflo(a1.y); g1[3] = bfhi(a1.y); g1[4] = bflo(a1.z); g1[5] = bfhi(a1.z); g1[6] = bflo(a1.w); g1[7] = bfhi(a1.w);
            g2[0] = bflo(a2.x); g2[1] = bfhi(a2.x); g2[2] = bflo(a2.y); g2[3] = bfhi(a2.y); g2[4] = bflo(a2.z); g2[5] = bfhi(a2.z); g2[6] = bflo(a2.w); g2[7] = bfhi(a2.w);
            v1[0] = bflo(b1.x); v1[1] = bfhi(b1.x); v1[2] = bflo(b1.y); v1[3] = bfhi(b1.y); v1[4] = bflo(b1.z); v1[5] = bfhi(b1.z); v1[6] = bflo(b1.w); v1[7] = bfhi(b1.w);
            v2[0] = bflo(b2.x); v2[1] = bfhi(b2.x); v2[2] = bflo(b2.y); v2[3] = bfhi(b2.y); v2[4] = bflo(b2.z); v2[5] = bfhi(b2.z); v2[6] = bflo(b2.w); v2[7] = bfhi(b2.w);
        }
#pragma unroll 4
        for (int r = 0; r < RB; ++r) {
            const u32x4 a = *(const u32x4*)(up + (size_t)(r0 + r) * NUP + cg0), b = *(const u32x4*)(up + (size_t)(r0 + r) * NUP + cv0);
            float g0[8], v0[8];
            g0[0] = bflo(a.x); g0[1] = bfhi(a.x); g0[2] = bflo(a.y); g0[3] = bfhi(a.y); g0[4] = bflo(a.z); g0[5] = bfhi(a.z); g0[6] = bflo(a.w); g0[7] = bfhi(a.w);
            v0[0] = bflo(b.x); v0[1] = bfhi(b.x); v0[2] = bflo(b.y); v0[3] = bfhi(b.y); v0[4] = bflo(b.z); v0[5] = bfhi(b.z); v0[6] = bflo(b.w); v0[7] = bfhi(b.w);
            float o[8];
#pragma unroll
            for (int j = 0; j < 8; ++j) { const float cgv = wg[0][j] * g2[j] + wg[1][j] * g1[j] + wg[2][j] * g0[j]; const float cvv = wv[0][j] * v2[j] + wv[1][j] * v1[j] + wv[2][j] * v0[j];
                o[j] = siluf(cgv) * cvv; g2[j] = g1[j]; g1[j] = g0[j]; v2[j] = v1[j]; v1[j] = v0[j]; }
            u32x4 w; w.x = pk2(o[0], o[1]); w.y = pk2(o[2], o[3]); w.z = pk2(o[4], o[5]); w.w = pk2(o[6], o[7]);
            *(u32x4*)(act + (size_t)(r0 + r) * DFF + f0) = w;
        }
    }
}

__device__ __forceinline__ void phase_final(const Ptrs& P, int tid) {
    const int lane = tid & 63, wave = tid >> 6;
    const int gw = blockIdx.x * 8 + wave, NGW = gridDim.x * 8;
    const float* rowss2 = (const float*)(P.ws + WS_CTL) + MTOK;
    f32x4 gv[4];
#pragma unroll
    for (int j = 0; j < 4; ++j) gv[j] = ((const f32x4*)P.norm_final)[lane + 64 * j];
    for (int m = gw; m < MTOK; m += NGW) {
        const float rstd = rsqrtf(rowss2[m] * (1.f / DM) + 1e-6f);
        f32x4* o = (f32x4*)(P.out + (size_t)m * DM) + lane;
#pragma unroll
        for (int j = 0; j < 4; ++j) o[64 * j] = o[64 * j] * rstd * gv[j];
    }
}

constexpr int N_PHASES = 2 + 8 * NG;
#ifndef PHM
#define PHM 2047
#endif
#ifndef DBL
#define DBL 0
#endif
#define DBLSEL 2
__global__ void __launch_bounds__(512, 2) mk_fwd(Args args) {
    extern __shared__ __attribute__((aligned(16))) unsigned char lds_raw[];
    char* lds = (char*)lds_raw;
    Ptrs P;
    P.x = args.in[0]; P.norm_mix = args.in[1]; P.w_in = args.in[2]; P.fox_f_bias = args.in[3]; P.gdn_conv_w = args.in[4]; P.gdn_a_log = args.in[5]; P.gdn_dt_bias = args.in[6]; P.gdn_norm = args.in[7];
    P.w_bf = args.in[8]; P.w_bg = args.in[9]; P.w_out = args.in[10]; P.norm_ffn = args.in[11]; P.w_up = args.in[12]; P.ffn_conv_w = args.in[13]; P.w_down = args.in[14]; P.norm_final = args.in[15];
    P.out = args.out; P.ws = args.ws;
    cg::grid_group grid = cg::this_grid();
    const int G = gridDim.x;
    for (int ph = args.ph_lo; ph < args.ph_hi; ++ph) {
      const int nrep = ((ph > 0 && ph < N_PHASES - 1 && ((DBL >> ((ph - 1) & 7)) & 1)) || (ph == 0 && (DBL & 256))) ? 2 : 1;
      for (int rep = 0; rep < nrep; ++rep) {
        int tid = threadIdx.x; asm volatile("" : "+v"(tid));
        int cid = blockIdx.x; asm volatile("" : "+s"(cid));
        size_t zoff = 0; asm volatile("" : "+s"(zoff)); unsigned char* ws = args.ws + zoff; P.ws = ws;
        float* rowss1 = (float*)(ws + WS_CTL); float* rowss2 = rowss1 + MTOK;
        if (ph == 0) { if (PHM & 1) phase_prologue(P, lds, tid); }
        else if (ph == N_PHASES - 1) { if (PHM & 2) phase_final(P, tid); }
        else {
            const int grp = (ph - 1) >> 3, sub = (ph - 1) & 7;
            const size_t r0g = (size_t)grp * GM;
            pg8::bf16_t* proj = (pg8::bf16_t*)(ws + WS_PROJ);
            if (sub == 0 && (PHM & 4)) {
                pg8::Gemm g{(const pg8::bf16_t*)(P.out + r0g * DM), nullptr, (const pg8::bf16_t*)(ws + WS_WIN), nullptr, GM, NIN, DM};
                pg8::StaticOrder S; S.init(GM, NIN, G, cid);
                pg8::EpiIn E{proj, (float*)(ws + WS_SMALL)};
                pg8::gemm_phase<pg8::EpiIn, pg8::StaticOrder, true, true>((PG8_LAS unsigned char*)lds_raw, g, S, E);
            } else if (sub == 1 && (PHM & 8)) {
                for (int u = cid; u < NCH; u += G) gdn_prep_unit(lds, u, P, tid);
            } else if (sub == 2) {
                if ((PHM & 16) && (rep == 0 || (DBLSEL & 1))) for (int it = cid; it < BG * NH * 4; it += G) fox_item(lds, it, P, tid);
                if ((PHM & 32) && (rep == 0 || (DBLSEL & 2))) for (int bh = cid; bh < BG * NH; bh += G) gdn_seq_unit(lds, bh, P, tid);
            } else if (sub == 3 && (PHM & 64)) {
                pg8::Gemm g{(const pg8::bf16_t*)(ws + WS_YFOX), (const pg8::bf16_t*)(ws + WS_YGDN), (const pg8::bf16_t*)(ws + WS_WBF), (const pg8::bf16_t*)(ws + WS_WBG), GM, DM, DM};
                pg8::PairOrder S; S.init(GM, DM, G, cid);
                pg8::EpiY E{proj + 7 * PROJ_STRIDE, proj + 8 * PROJ_STRIDE, (pg8::bf16_t*)(ws + WS_T1), (pg8::bf16_t*)(ws + WS_Y)};
                pg8::gemm_phase<pg8::EpiY, pg8::PairOrder, true, true>((PG8_LAS unsigned char*)lds_raw, g, S, E);
            } else if (sub == 4 && (PHM & 128)) {
                pg8::Gemm g{(const pg8::bf16_t*)(ws + WS_Y), nullptr, (const pg8::bf16_t*)(ws + WS_WOUT), nullptr, GM, DM, DM};
                pg8::StaticOrder S; S.init(GM, DM, G, cid);
                pg8::EpiOut E{P.x + r0g * DM, P.out + r0g * DM, (pg8::bf16_t*)(ws + WS_H1B), rowss1 + r0g};
                pg8::gemm_phase<pg8::EpiOut, pg8::StaticOrder, true, true>((PG8_LAS unsigned char*)lds_raw, g, S, E);
            } else if (sub == 5 && (PHM & 256)) {
                pg8::Gemm g{(const pg8::bf16_t*)(ws + WS_H1B), nullptr, (const pg8::bf16_t*)(ws + WS_WUP), nullptr, GM, NUP, DM};
                pg8::StaticOrder S; S.init(GM, NUP, G, cid);
                pg8::EpiUp E{(pg8::bf16_t*)(ws + WS_UP), rowss1 + r0g, NUP};
                pg8::gemm_phase<pg8::EpiUp, pg8::StaticOrder, true, true>((PG8_LAS unsigned char*)lds_raw, g, S, E);
            } else if (sub == 6) {
                if (PHM & 512) phase_convgate(P, tid);
            } else if (PHM & 1024) {
                pg8::Gemm g{(const pg8::bf16_t*)(ws + WS_ACT), nullptr, (const pg8::bf16_t*)(ws + WS_WDN), nullptr, GM, DM, DFF};
                pg8::StaticOrder S; S.init(GM, DM, G, cid);
                pg8::EpiDown E{P.out + r0g * DM, rowss2 + r0g};
                pg8::gemm_phase<pg8::EpiDown, pg8::StaticOrder, true, true>((PG8_LAS unsigned char*)lds_raw, g, S, E);
            }
        }
      }
        if (ph + 1 < args.ph_hi) grid.sync();
    }
}

extern "C" void kernel_launch(void* const* d_in, const int* in_sizes, int n_in, void* d_out, int out_size, void* d_ws, size_t ws_size, hipStream_t stream) {
    static int ready = 0;
    if (ready == 0) {
        if (n_in != 16 || in_sizes[0] != MTOK * DM || out_size != MTOK * DM || ws_size < WS_END) {
            fprintf(stderr, "kernel_launch: unexpected shapes (n_in %d, in0 %d, out %d, ws %zu; need ws >= %zu)\n", n_in, n_in > 0 ? in_sizes[0] : -1, out_size, ws_size, (size_t)WS_END); ready = -1; return; }
        if (hipFuncSetAttribute((const void*)mk_fwd, hipFuncAttributeMaxDynamicSharedMemorySize, LDS_BYTES) != hipSuccess) { fprintf(stderr, "kernel_launch: hipFuncSetAttribute failed\n"); ready = -1; return; }
        int per_cu = 0;
        if (hipOccupancyMaxActiveBlocksPerMultiprocessor(&per_cu, (const void*)mk_fwd, 512, LDS_BYTES) != hipSuccess || per_cu < 1) fprintf(stderr, "kernel_launch: occupancy query says %d blocks per CU\n", per_cu);
        (void)hipGetLastError();
        ready = 1;
    }
    if (ready < 0) return;
    (void)hipMemsetAsync((char*)d_ws + WS_CTL, 0, 1 * MiB, stream);
    Args a{};
    for (int i = 0; i < 16; ++i) a.in[i] = (const float*)d_in[i];
    a.out = (float*)d_out; a.ws = (unsigned char*)d_ws;
#if MK_ONE_LAUNCH
    a.ph_lo = 0; a.ph_hi = N_PHASES;
    void* kargs[] = {&a};
    hipError_t e = hipLaunchCooperativeKernel((const void*)mk_fwd, dim3(256), dim3(512), kargs, LDS_BYTES, stream);
    if (e != hipSuccess) fprintf(stderr, "kernel_launch: cooperative launch failed: %s\n", hipGetErrorString(e));
#else
    for (int ph = 0; ph < N_PHASES; ++ph) { a.ph_lo = ph; a.ph_hi = ph + 1; hipLaunchKernelGGL(mk_fwd, dim3(256), dim3(512), LDS_BYTES, stream, a); }
#endif
}
```

```cpp
#include <hip/hip_runtime.h>
#include <hip/hip_bf16.h>
#include <hip/hip_cooperative_groups.h>
#include <cstdio>
#include <cstdint>
namespace cg = cooperative_groups;

#ifndef MK_ONE_LAUNCH
#define MK_ONE_LAUNCH 1
#endif

namespace pg8 {
#define PG8_LAS __attribute__((address_space(3)))
typedef unsigned short bf16_t;
typedef short bf16x8 __attribute__((ext_vector_type(8)));
typedef float f32x4 __attribute__((ext_vector_type(4)));
typedef unsigned u32x4 __attribute__((ext_vector_type(4)));
constexpr int BM = 256, BK = 64, HALF = 128, HTB = HALF * BK * 2  , STAGE_BYTES = 8 * HTB, NXCD = 8, WGM = 8;

__host__ __device__ __forceinline__ int lds_byte(int r, int c) { const int st = (r >> 4) * 2 + (c >> 5), rr = r & 15, cc = c & 31, ob = rr * 64 + cc * 2; return st * 1024 + (ob ^ (((ob >> 9) & 1) << 5)); }
__host__ __device__ __forceinline__ void stage_rc(int b, int& R, int& C) { const int st = b / 1024, sb = b % 1024, swz = sb ^ (((sb >> 9) & 1) << 5); R = (st >> 1) * 16 + swz / 64; C = (st & 1) * 32 + (swz % 64) / 2; }
__host__ __device__ __forceinline__ int perm32(int rho) { const int n = rho >> 4, i = rho & 15; return 8 * (i >> 2) + 4 * n + (i & 3); }

struct Unit { int pm, pn, sel; };
struct Gemm { const bf16_t* A0; const bf16_t* A1; const bf16_t* B0; const bf16_t* B1; int M, N, K; };

struct StaticOrder {
    int nM, nN, nwg, G, c;
    __host__ __device__ __forceinline__ void init(int M, int N, int G_, int c_) { nM = M / BM; nN = N / BM; nwg = nM * nN; G = G_; c = c_; }
    __host__ __device__ __forceinline__ bool next(int i, Unit& u) const {
        const long L = (long)i * G + c; if (L >= nwg) return false;
        int wgid = (int)L; { const int q = nwg / NXCD, r = nwg % NXCD, xcd = wgid % NXCD, off = wgid / NXCD; wgid = (xcd < r ? xcd * (q + 1) : r * (q + 1) + (xcd - r) * q) + off; }
        const int nig = WGM * nN, gid = wgid / nig, fm = gid * WGM, gsz = (nM - fm) < WGM ? (nM - fm) : WGM;
        u.pm = fm + ((wgid % nig) % gsz); u.pn = (wgid % nig) / gsz; u.sel = 0; return true;
    }
    __device__ __forceinline__ void a_ready(const Unit&) const {}
    __device__ __forceinline__ void done(const Unit&) const {}
};

__device__ __forceinline__ unsigned cvt_pk_bf16(float lo, float hi) { unsigned r; asm volatile("v_cvt_pk_bf16_f32 %0, %1, %2" : "=v"(r) : "v"(lo), "v"(hi)); return r; }
typedef unsigned u32x2 __attribute__((ext_vector_type(2)));
__device__ __forceinline__ float bflo(unsigned w) { return __uint_as_float(w << 16); }
__device__ __forceinline__ float bfhi(unsigned w) { return __uint_as_float(w & 0xffff0000u); }
__device__ __forceinline__ float sigm(float x) { return 1.0f / (1.0f + __expf(-x)); }
constexpr int GM = 32768;
constexpr int LDP = 1024;

struct EpiIn {
    static constexpr bool PERM = true, AFTER_DRAIN = false;
    bf16_t* proj; float* small;
    __device__ __forceinline__ void operator()(const f32x4 (&acc)[2][2][4][2], const Unit& u, int wr, int wc, int fr, int fq) const {
        const int row0 = u.pm * BM + wr * 64 + fr;
        if (u.pn < 36) {
            bf16_t* base = proj + (size_t)(u.pn >> 2) * ((size_t)GM * LDP) + (u.pn & 3) * 256 + wc * 32 + 8 * fq;
#pragma unroll
            for (int ai = 0; ai < 2; ++ai)
#pragma unroll
                for (int m = 0; m < 4; ++m) { bf16_t* rowp = base + (size_t)(row0 + ai * HALF + m * 16) * LDP;
#pragma unroll
                    for (int bj = 0; bj < 2; ++bj) { const f32x4 v0 = acc[ai][bj][m][0], v1 = acc[ai][bj][m][1];
                        u32x4 w; w.x = cvt_pk_bf16(v0[0], v0[1]); w.y = cvt_pk_bf16(v0[2], v0[3]); w.z = cvt_pk_bf16(v1[0], v1[1]); w.w = cvt_pk_bf16(v1[2], v1[3]);
                        *(u32x4*)(rowp + bj * HALF) = w; } }
        } else if (wc == 0 && fq < 3) {
#pragma unroll
            for (int ai = 0; ai < 2; ++ai)
#pragma unroll
                for (int m = 0; m < 4; ++m) { float* p = small + (size_t)(row0 + ai * HALF + m * 16) * 32 + 8 * fq;
                    *(f32x4*)p = acc[ai][0][m][0]; *(f32x4*)(p + 4) = acc[ai][0][m][1]; }
        }
    }
};
struct EpiY {
    static constexpr bool PERM = true, AFTER_DRAIN = false;
    const bf16_t* gf; const bf16_t* gg; bf16_t* t1; bf16_t* y;
    __device__ __forceinline__ void operator()(const f32x4 (&acc)[2][2][4][2], const Unit& u, int wr, int wc, int fr, int fq) const {
        const int row0 = u.pm * BM + wr * 64 + fr, col0 = u.pn * BM + wc * 32 + 8 * fq;
        const bf16_t* const gf_ = gf; const bf16_t* const gg_ = gg; bf16_t* const t1_ = t1; bf16_t* const y_ = y;
        const bf16_t* gate = u.sel ? gg_ : gf_; bf16_t* dst = u.sel ? y_ : t1_;
        if (u.sel) asm volatile("s_waitcnt vmcnt(0)" ::: "memory");
#pragma unroll
        for (int ai = 0; ai < 2; ++ai) {
            u32x4 gw[4][2], tw[4][2];
#pragma unroll
            for (int m = 0; m < 4; ++m)
#pragma unroll
                for (int bj = 0; bj < 2; ++bj) { const size_t o = (size_t)(row0 + ai * HALF + m * 16) * LDP + col0 + bj * HALF;
                    gw[m][bj] = *(const u32x4*)(gate + o); tw[m][bj] = u.sel ? *(const u32x4*)(t1_ + o) : (u32x4){0u, 0u, 0u, 0u}; }
#pragma unroll
            for (int m = 0; m < 4; ++m)
#pragma unroll
                for (int bj = 0; bj < 2; ++bj) { const size_t o = (size_t)(row0 + ai * HALF + m * 16) * LDP + col0 + bj * HALF;
                    const u32x4 g = gw[m][bj], t = tw[m][bj]; const f32x4 v0 = acc[ai][bj][m][0], v1 = acc[ai][bj][m][1];
                    const float r0 = sigm(bflo(g.x)) * v0[0] + bflo(t.x), r1 = sigm(bfhi(g.x)) * v0[1] + bfhi(t.x), r2 = sigm(bflo(g.y)) * v0[2] + bflo(t.y), r3 = sigm(bfhi(g.y)) * v0[3] + bfhi(t.y);
                    const float r4 = sigm(bflo(g.z)) * v1[0] + bflo(t.z), r5 = sigm(bfhi(g.z)) * v1[1] + bfhi(t.z), r6 = sigm(bflo(g.w)) * v1[2] + bflo(t.w), r7 = sigm(bfhi(g.w)) * v1[3] + bfhi(t.w);
                    u32x4 w; w.x = cvt_pk_bf16(r0, r1); w.y = cvt_pk_bf16(r2, r3); w.z = cvt_pk_bf16(r4, r5); w.w = cvt_pk_bf16(r6, r7);
                    *(u32x4*)(dst + o) = w; }
        }
    }
};
struct EpiOut {
    static constexpr bool PERM = true, AFTER_DRAIN = false;
    const float* xin; float* hout; bf16_t* h1b; float* rowss;
    __device__ __forceinline__ void operator()(const f32x4 (&acc)[2][2][4][2], const Unit& u, int wr, int wc, int fr, int fq) const {
        const int col0 = u.pn * BM + wc * 32 + 8 * fq;
#pragma unroll
        for (int ai = 0; ai < 2; ++ai) {
            f32x4 pre[4][2][2];
#pragma unroll
            for (int m = 0; m < 4; ++m)
#pragma unroll
                for (int bj = 0; bj < 2; ++bj) { const size_t o = (size_t)(u.pm * BM + ai * HALF + wr * 64 + m * 16 + fr) * LDP + col0 + bj * HALF; pre[m][bj][0] = *(const f32x4*)(xin + o); pre[m][bj][1] = *(const f32x4*)(xin + o + 4); }
#pragma unroll
            for (int m = 0; m < 4; ++m) { const int row = u.pm * BM + ai * HALF + wr * 64 + m * 16 + fr; const size_t ro = (size_t)row * LDP + col0; float ss = 0.f;
#pragma unroll
                for (int bj = 0; bj < 2; ++bj) { const size_t o = ro + bj * HALF;
                    const f32x4 h0 = pre[m][bj][0] + acc[ai][bj][m][0], h1 = pre[m][bj][1] + acc[ai][bj][m][1];
                    *(f32x4*)(hout + o) = h0; *(f32x4*)(hout + o + 4) = h1;
                    u32x4 w; w.x = cvt_pk_bf16(h0[0], h0[1]); w.y = cvt_pk_bf16(h0[2], h0[3]); w.z = cvt_pk_bf16(h1[0], h1[1]); w.w = cvt_pk_bf16(h1[2], h1[3]); *(u32x4*)(h1b + o) = w;
                    ss += (h0[0] * h0[0] + h0[1] * h0[1]) + (h0[2] * h0[2] + h0[3] * h0[3]) + (h1[0] * h1[0] + h1[1] * h1[1]) + (h1[2] * h1[2] + h1[3] * h1[3]); }
                ss += __shfl_xor(ss, 16); ss += __shfl_xor(ss, 32);
                if (fq == 0) atomicAdd(rowss + row, ss); }
        }
    }
};
struct EpiUp {
    static constexpr bool PERM = true, AFTER_DRAIN = false;
    bf16_t* up; const float* rowss; int ldc;
    __device__ __forceinline__ void operator()(const f32x4 (&acc)[2][2][4][2], const Unit& u, int wr, int wc, int fr, int fq) const {
        const int row0 = u.pm * BM + wr * 64 + fr, col0 = u.pn * BM + wc * 32 + 8 * fq;
        float rsv[2][4];
#pragma unroll
        for (int ai = 0; ai < 2; ++ai)
#pragma unroll
            for (int m = 0; m < 4; ++m) rsv[ai][m] = rowss[row0 + ai * HALF + m * 16];
#pragma unroll
        for (int ai = 0; ai < 2; ++ai)
#pragma unroll
            for (int m = 0; m < 4; ++m) { const int row = row0 + ai * HALF + m * 16; const float rs = rsqrtf(rsv[ai][m] * (1.0f / 1024.0f) + 1e-6f); bf16_t* rowp = up + (size_t)row * ldc + col0;
#pragma unroll
                for (int bj = 0; bj < 2; ++bj) { const f32x4 v0 = acc[ai][bj][m][0] * rs, v1 = acc[ai][bj][m][1] * rs;
                    u32x4 w; w.x = cvt_pk_bf16(v0[0], v0[1]); w.y = cvt_pk_bf16(v0[2], v0[3]); w.z = cvt_pk_bf16(v1[0], v1[1]); w.w = cvt_pk_bf16(v1[2], v1[3]);
                    *(u32x4*)(rowp + bj * HALF) = w; } }
    }
};
struct EpiDown {
    static constexpr bool PERM = true, AFTER_DRAIN = false;
    float* hio; float* rowss;
    __device__ __forceinline__ void operator()(const f32x4 (&acc)[2][2][4][2], const Unit& u, int wr, int wc, int fr, int fq) const {
        const int col0 = u.pn * BM + wc * 32 + 8 * fq;
#pragma unroll
        for (int ai = 0; ai < 2; ++ai) {
            f32x4 pre[4][2][2];
#pragma unroll
            for (int m = 0; m < 4; ++m)
#pragma unroll
                for (int bj = 0; bj < 2; ++bj) { const size_t o = (size_t)(u.pm * BM + ai * HALF + wr * 64 + m * 16 + fr) * LDP + col0 + bj * HALF; pre[m][bj][0] = *(const f32x4*)(hio + o); pre[m][bj][1] = *(const f32x4*)(hio + o + 4); }
#pragma unroll
            for (int m = 0; m < 4; ++m) { const int row = u.pm * BM + ai * HALF + wr * 64 + m * 16 + fr; const size_t ro = (size_t)row * LDP + col0; float ss = 0.f;
#pragma unroll
                for (int bj = 0; bj < 2; ++bj) { const size_t o = ro + bj * HALF;
                    const f32x4 h0 = pre[m][bj][0] + acc[ai][bj][m][0], h1 = pre[m][bj][1] + acc[ai][bj][m][1];
                    *(f32x4*)(hio + o) = h0; *(f32x4*)(hio + o + 4) = h1;
                    ss += (h0[0] * h0[0] + h0[1] * h0[1]) + (h0[2] * h0[2] + h0[3] * h0[3]) + (h1[0] * h1[0] + h1[1] * h1[1]) + (h1[2] * h1[2] + h1[3] * h1[3]); }
                ss += __shfl_xor(ss, 16); ss += __shfl_xor(ss, 32);
                if (fq == 0) atomicAdd(rowss + row, ss); }
        }
    }
};
struct PairOrder {
    int nM, nN, nwg, G, c;
    __host__ __device__ __forceinline__ void init(int M, int N, int G_, int c_) { nM = M / BM; nN = N / BM; nwg = nM * nN; G = G_; c = c_; }
    __host__ __device__ __forceinline__ bool next(int i, Unit& u) const {
        const long L = (long)(i >> 1) * G + c; if (L >= nwg) return false;
        int wgid = (int)L; { const int q = nwg / NXCD, r = nwg % NXCD, xcd = wgid % NXCD, off = wgid / NXCD; wgid = (xcd < r ? xcd * (q + 1) : r * (q + 1) + (xcd - r) * q) + off; }
        const int nig = WGM * nN, gid = wgid / nig, fm = gid * WGM, gsz = (nM - fm) < WGM ? (nM - fm) : WGM;
        u.pm = fm + ((wgid % nig) % gsz); u.pn = (wgid % nig) / gsz; u.sel = i & 1; return true;
    }
    __device__ __forceinline__ void a_ready(const Unit&) const {}
    __device__ __forceinline__ void done(const Unit&) const {}
};
template <class Epi, class Sched, bool ALIGN_EPI = false, bool SP2 = false>
__device__ __forceinline__ void gemm_phase(PG8_LAS unsigned char* lds, const Gemm g, const Sched& S, const Epi& E) {
    int tid_l = threadIdx.x; asm volatile("" : "+v"(tid_l));
    const int tid = tid_l, wid = __builtin_amdgcn_readfirstlane(tid >> 6), lane = tid & 63, wr = wid >> 2, wc = wid & 3, fr = lane & 15, fq = lane >> 4;
    const int K = g.K, nt = K / BK;
    unsigned voffA[2], voffB[2];
#pragma unroll
    for (int i = 0; i < 2; ++i) { int R, C; stage_rc(tid * 16 + i * 8192, R, C); const int Rb = Epi::PERM ? ((R & ~31) + perm32(R & 31)) : R;
        voffA[i] = (unsigned)(R * K + C) * 2u; voffB[i] = (unsigned)(Rb * K + C) * 2u; }
    const size_t kstep = (size_t)(BK * 2);
    const size_t hstep = (size_t)HALF * K * 2;
    const size_t tstep = 2 * hstep;
    const unsigned ldsw = (unsigned)wid * 1024u;
    const int aoff = lds_byte(wr * 64 + fr, fq * 8), boff = lds_byte(wc * 32 + fr, fq * 8);
#define PG8_SA(b, h) (((b) * 2 + (h)) * HTB)
#define PG8_SB(b, h) ((4 + (b) * 2 + (h)) * HTB)
#define PG8_STAGE(bufoff, gbase, voff) do { _Pragma("unroll") for (int _i = 0; _i < 2; ++_i) \
        __builtin_amdgcn_global_load_lds((const unsigned*)((const char*)(gbase) + (voff)[_i]), (PG8_LAS unsigned*)(lds + (bufoff) + ldsw + _i * 8192), 16, 0, 0); } while (0)
#define PG8_LDA(dst, b, h) do { _Pragma("unroll") for (int m = 0; m < 4; ++m) _Pragma("unroll") for (int k = 0; k < 2; ++k) dst[m][k] = *(const PG8_LAS bf16x8*)(lds + PG8_SA(b, h) + aoff + m * 2048 + k * 1024); } while (0)
#define PG8_LDB(dst, b, h) do { _Pragma("unroll") for (int n = 0; n < 2; ++n) _Pragma("unroll") for (int k = 0; k < 2; ++k) dst[n][k] = *(const PG8_LAS bf16x8*)(lds + PG8_SB(b, h) + boff + n * 2048 + k * 1024); } while (0)
#define PG8_MMA(ai, bj, At, Bt) do { __builtin_amdgcn_s_setprio(1); _Pragma("unroll") for (int m = 0; m < 4; ++m) _Pragma("unroll") for (int n = 0; n < 2; ++n) _Pragma("unroll") for (int k = 0; k < 2; ++k) \
        acc[ai][bj][m][n] = __builtin_amdgcn_mfma_f32_16x16x32_bf16(Bt[n][k], At[m][k], acc[ai][bj][m][n], 0, 0, 0); __builtin_amdgcn_s_setprio(0); } while (0)
#define PG8_WAIT_V(n) asm volatile("s_waitcnt vmcnt(" #n ")" ::: "memory")
#define PG8_WAIT_L(n) asm volatile("s_waitcnt lgkmcnt(" #n ")" ::: "memory")
#define PG8_BAR __builtin_amdgcn_s_barrier()
#define PG8_SCHED __builtin_amdgcn_sched_barrier(0)
    Unit cur, nxt; int ui = 0;
    if (!S.next(0, cur)) return;
    f32x4 acc[2][2][4][2];
#pragma unroll
    for (int a = 0; a < 2; ++a)
#pragma unroll
        for (int b = 0; b < 2; ++b)
#pragma unroll
            for (int m = 0; m < 4; ++m)
#pragma unroll
                for (int n = 0; n < 2; ++n) acc[a][b][m][n] = (f32x4){0.f, 0.f, 0.f, 0.f};
    bf16x8 At[4][2], B0[2][2], B1[2][2];
    const char* cA = (const char*)(cur.sel ? g.A1 : g.A0) + (size_t)cur.pm * tstep; const char* cB = (const char*)(cur.sel ? g.B1 : g.B0) + (size_t)cur.pn * tstep;
    S.a_ready(cur);
    if constexpr (SP2) {
        PG8_STAGE(PG8_SB(0, 0), cB, voffB); PG8_STAGE(PG8_SB(0, 1), cB + hstep, voffB); PG8_STAGE(PG8_SA(0, 0), cA, voffA); PG8_STAGE(PG8_SA(0, 1), cA + hstep, voffA);
        if (wr == 1) PG8_BAR;
        PG8_WAIT_V(2); PG8_BAR;
        PG8_STAGE(PG8_SB(1, 0), cB + kstep, voffB); PG8_STAGE(PG8_SA(1, 0), cA + kstep, voffA); PG8_STAGE(PG8_SB(1, 1), cB + hstep + kstep, voffB);
        PG8_WAIT_V(6); PG8_BAR;
    } else {
        PG8_STAGE(PG8_SB(0, 0), cB, voffB); PG8_STAGE(PG8_SA(0, 0), cA, voffA); PG8_STAGE(PG8_SB(0, 1), cB + hstep, voffB); PG8_STAGE(PG8_SA(0, 1), cA + hstep, voffA);
        if (wr == 1) PG8_BAR;
        PG8_WAIT_V(4); PG8_BAR;
        PG8_STAGE(PG8_SB(1, 0), cB + kstep, voffB); PG8_STAGE(PG8_SA(1, 0), cA + kstep, voffA); PG8_STAGE(PG8_SB(1, 1), cB + hstep + kstep, voffB);
        PG8_WAIT_V(6); PG8_BAR;
    }
    for (;;) {
        const bool has_next = S.next(ui + 1, nxt);
        const char* nA = has_next ? (const char*)(nxt.sel ? g.A1 : g.A0) + (size_t)nxt.pm * tstep : cA; const char* nB = has_next ? (const char*)(nxt.sel ? g.B1 : g.B0) + (size_t)nxt.pn * tstep : cB;
        for (int t = 0; t < nt; t += 2) {
            const bool last = (t == nt - 2);
            const char* a1 = cA + (size_t)(t + 1) * kstep;
            const char* a2 = last ? nA : cA + (size_t)(t + 2) * kstep; const char* b2 = last ? nB : cB + (size_t)(t + 2) * kstep;
            const char* a3 = a2 + kstep; const char* b3 = b2 + kstep;
            if (last && has_next) S.a_ready(nxt);
            if constexpr (SP2) {
            PG8_LDB(B0, 0, 0); PG8_LDB(B1, 0, 1); PG8_SCHED; PG8_LDA(At, 0, 0); PG8_STAGE(PG8_SA(1, 1), a1 + hstep, voffA);
            PG8_WAIT_V(8); PG8_WAIT_L(0); PG8_BAR; PG8_MMA(0, 0, At, B0); PG8_MMA(0, 1, At, B1); PG8_BAR; PG8_SCHED;
            PG8_LDA(At, 0, 1); PG8_STAGE(PG8_SB(0, 0), b2, voffB); PG8_STAGE(PG8_SB(0, 1), b2 + hstep, voffB); PG8_STAGE(PG8_SA(0, 0), a2, voffA);
            PG8_WAIT_V(8); PG8_WAIT_L(0); PG8_BAR; PG8_MMA(1, 0, At, B0); PG8_MMA(1, 1, At, B1); PG8_BAR; PG8_SCHED;
            PG8_LDB(B0, 1, 0); PG8_LDB(B1, 1, 1); PG8_SCHED; PG8_LDA(At, 1, 0); PG8_STAGE(PG8_SA(0, 1), a2 + hstep, voffA);
            PG8_WAIT_V(8); PG8_WAIT_L(0); PG8_BAR; PG8_MMA(0, 0, At, B0); PG8_MMA(0, 1, At, B1); PG8_BAR; PG8_SCHED;
            PG8_LDA(At, 1, 1); PG8_STAGE(PG8_SB(1, 0), b3, voffB); PG8_STAGE(PG8_SB(1, 1), b3 + hstep, voffB); PG8_STAGE(PG8_SA(1, 0), a3, voffA);
            PG8_WAIT_V(8); PG8_WAIT_L(0); PG8_BAR; PG8_MMA(1, 0, At, B0); PG8_MMA(1, 1, At, B1); PG8_BAR; PG8_SCHED;
            } else {
            PG8_LDB(B0, 0, 0); PG8_SCHED; PG8_LDA(At, 0, 0); PG8_STAGE(PG8_SA(1, 1), a1 + hstep, voffA);
            PG8_WAIT_L(8); PG8_BAR; PG8_WAIT_L(0); PG8_MMA(0, 0, At, B0); PG8_BAR; PG8_SCHED;
            PG8_LDB(B1, 0, 1); PG8_STAGE(PG8_SB(0, 0), b2, voffB);
            PG8_BAR; PG8_WAIT_L(0); PG8_MMA(0, 1, At, B1); PG8_BAR;
            PG8_LDA(At, 0, 1); PG8_STAGE(PG8_SA(0, 0), a2, voffA);
            PG8_BAR; PG8_WAIT_L(0); PG8_MMA(1, 0, At, B0); PG8_BAR; PG8_SCHED;
            PG8_STAGE(PG8_SB(0, 1), b2 + hstep, voffB);
            PG8_WAIT_V(6); PG8_BAR; PG8_MMA(1, 1, At, B1); PG8_BAR;
            PG8_LDB(B0, 1, 0); PG8_SCHED; PG8_LDA(At, 1, 0); PG8_STAGE(PG8_SA(0, 1), a2 + hstep, voffA);
            PG8_WAIT_L(8); PG8_BAR; PG8_WAIT_L(0); PG8_MMA(0, 0, At, B0); PG8_BAR; PG8_SCHED;
            PG8_LDB(B1, 1, 1); PG8_STAGE(PG8_SB(1, 0), b3, voffB);
            PG8_BAR; PG8_WAIT_L(0); PG8_MMA(0, 1, At, B1); PG8_BAR;
            PG8_LDA(At, 1, 1); PG8_STAGE(PG8_SA(1, 0), a3, voffA);
            PG8_BAR; PG8_WAIT_L(0); PG8_MMA(1, 0, At, B0); PG8_BAR; PG8_SCHED;
            PG8_STAGE(PG8_SB(1, 1), b3 + hstep, voffB);
            PG8_WAIT_V(6); PG8_BAR; PG8_MMA(1, 1, At, B1); PG8_BAR;
            }
        }
        if constexpr (ALIGN_EPI) { if (wr == 0) PG8_BAR; }
        if constexpr (!Epi::AFTER_DRAIN) { E(acc, cur, wr, wc, fr, fq); S.done(cur); }
        if (!has_next) break;
#pragma unroll
        for (int a = 0; a < 2; ++a)
#pragma unroll
            for (int b = 0; b < 2; ++b)
#pragma unroll
                for (int m = 0; m < 4; ++m)
#pragma unroll
                    for (int n = 0; n < 2; ++n) acc[a][b][m][n] = (f32x4){0.f, 0.f, 0.f, 0.f};
        cur = nxt; cA = nA; cB = nB; ++ui;
        if constexpr (ALIGN_EPI) { if (wr == 1) PG8_BAR; }
    }
    PG8_WAIT_V(0);
    if constexpr (!ALIGN_EPI) { if (wr == 0) PG8_BAR; }
    PG8_BAR;
    if constexpr (Epi::AFTER_DRAIN) { E.fused(acc, cur, wr, wc, fr, fq, lds, wid, lane); S.done(cur); }
#undef PG8_SA
#undef PG8_SB
#undef PG8_STAGE
#undef PG8_LDA
#undef PG8_LDB
#undef PG8_MMA
#undef PG8_WAIT_V
#undef PG8_WAIT_L
#undef PG8_BAR
#undef PG8_SCHED
}
}

namespace fox {
constexpr int D = 128, PITCH = 1024;
constexpr bool WSKIP = false;
constexpr float THR = 8.f;
constexpr float SCALE = 0.08838834764831845f;
constexpr int NW = 8, QBLK = 32, KVBLK = 64, QB = NW * QBLK;
constexpr int SHM_V = KVBLK * D * 2, SHM_K = KVBLK * D * 2;
constexpr int LDS_BYTES = 2 * SHM_V + 2 * SHM_K + NW * 64 * 4;
using bf16 = __hip_bfloat16;
typedef short bf16x8 __attribute__((ext_vector_type(8)));
typedef short s16x4 __attribute__((ext_vector_type(4)));
typedef float f32x16 __attribute__((ext_vector_type(16)));
typedef float f32x4 __attribute__((ext_vector_type(4)));
typedef unsigned u32x4 __attribute__((ext_vector_type(4)));
template <class A, class Bt> struct same_t { static constexpr bool v = false; };
template <class A> struct same_t<A, A> { static constexpr bool v = true; };
__device__ __forceinline__ void bias_tile(f32x16& p0, f32x16& p1, const float* cbp) {
#pragma unroll
    for (int rr = 0; rr < 4; ++rr) { const f32x4 a = *(const f32x4*)(cbp + 8 * rr), b = *(const f32x4*)(cbp + 32 + 8 * rr);
#pragma unroll
        for (int e = 0; e < 4; ++e) { p0[4 * rr + e] += a[e]; p1[4 * rr + e] += b[e]; } }
}
#define KSWZ(row, colB) ((row) * 256 + ((colB) ^ (((row) & 7) << 4)))
#define SBAR() __builtin_amdgcn_sched_barrier(0)
__device__ __forceinline__ int v_st(int k, int c) { const int kk = (k & ~0xC) | ((k & 4) << 1) | ((k & 8) >> 1); return ((kk >> 3) * 4 + (c >> 5)) * 512 + ((kk & 7) * 32 + (c & 31)) * 2; }
__device__ __forceinline__ int v_rd_base(int lane) { return ((lane & 3) << 3) | (((lane >> 2) & 3) << 6) | (((lane >> 4) & 1) << 5) | (((lane >> 5) & 1) << 8); }
constexpr int v_rd_off(int d0, int ks, int half) { return d0 * 512 + ks * 4096 + half * 2048; }
__device__ __forceinline__ int crow(int r, int hi) { return (r & 3) + 8 * (r >> 2) + 4 * hi; }
__device__ __forceinline__ unsigned cvtpk(float lo, float hi) {
    unsigned r; asm volatile("v_cvt_pk_bf16_f32 %0, %1, %2" : "=v"(r) : "v"(lo), "v"(hi)); return r;
}
__device__ __forceinline__ bf16x8 pack8(f32x4 a, f32x4 b) {
    u32x4 w = {cvtpk(a[0], a[1]), cvtpk(a[2], a[3]), cvtpk(b[0], b[1]), cvtpk(b[2], b[3])};
    return *reinterpret_cast<bf16x8*>(&w);
}
template <class T> __device__ __forceinline__ bf16x8 load8(const T* p) {
    if constexpr (same_t<T, float>::v) { return pack8(*(const f32x4*)p, *(const f32x4*)(p + 4)); }
    else { return *reinterpret_cast<const bf16x8*>(p); }
}
__device__ __forceinline__ void mask_tile(f32x16& p0, f32x16& p1, int dq, unsigned W) {
    const float NEG = -__builtin_inff();
#pragma unroll
    for (int r = 0; r < 16; ++r) {
        const int c = (r & 3) + 8 * (r >> 2);
        if ((unsigned)(dq - c) >= W) p0[r] = NEG;
        if ((unsigned)(dq - c - 32) >= W) p1[r] = NEG;
    }
}
__device__ __forceinline__ void partialSM(f32x16& p0, f32x16& p1, float& m_reg, float& mn, float& alpha) {
    float pmax = p0[0]; for (int r = 1; r < 16; ++r) pmax = fmaxf(pmax, p0[r]); for (int r = 0; r < 16; ++r) pmax = fmaxf(pmax, p1[r]);
    { auto rr = __builtin_amdgcn_permlane32_swap(__float_as_uint(pmax), __float_as_uint(pmax), false, false);
      pmax = fmaxf(__uint_as_float(rr[0]), __uint_as_float(rr[1])); }
    constexpr float C2 = 1.4426950408889634f * SCALE;
    if (__builtin_expect(__all((pmax - m_reg) * SCALE <= THR), 1)) { mn = m_reg; alpha = 1.f; }
    else { mn = fmaxf(m_reg, pmax); alpha = __builtin_amdgcn_exp2f((m_reg - mn) * C2); m_reg = mn; }
    const float mnL = -mn * C2;
    for (int r = 0; r < 16; ++r) p0[r] = fmaf(p0[r], C2, mnL); for (int r = 0; r < 16; ++r) p1[r] = fmaf(p1[r], C2, mnL);
    for (int r = 0; r < 16; ++r) p0[r] = __builtin_amdgcn_exp2f(p0[r]);
}
__device__ __forceinline__ void finishSM(f32x16& p0, f32x16& p1, float alpha, float& l_reg, bf16x8& pa0, bf16x8& pa1, bf16x8& pa2, bf16x8& pa3) {
    for (int r = 0; r < 16; ++r) p1[r] = __builtin_amdgcn_exp2f(p1[r]);
    float ps = 0; for (int r = 0; r < 16; ++r) ps += p0[r]; for (int r = 0; r < 16; ++r) ps += p1[r];
    { auto rr = __builtin_amdgcn_permlane32_swap(__float_as_uint(ps), __float_as_uint(ps), false, false);
      ps = __uint_as_float(rr[0]) + __uint_as_float(rr[1]); }
    l_reg = l_reg * alpha + ps;
#define PK4(P, B_, OUT) do { unsigned a0 = cvtpk(P[B_+0], P[B_+1]), a1 = cvtpk(P[B_+2], P[B_+3]);                          \
        unsigned b0 = cvtpk(P[B_+4], P[B_+5]), b1 = cvtpk(P[B_+6], P[B_+7]);                                             \
        auto r0 = __builtin_amdgcn_permlane32_swap(a0, b0, false, false); auto r1 = __builtin_amdgcn_permlane32_swap(a1, b1, false, false); \
        u32x4 w = {r0[0], r1[0], r0[1], r1[1]}; OUT = *reinterpret_cast<bf16x8*>(&w); } while (0)
    PK4(p0, 0, pa0); PK4(p0, 8, pa1); PK4(p1, 0, pa2); PK4(p1, 8, pa3);
#undef PK4
}
template <int KB, bool SK>
__device__ __forceinline__ void qkt(f32x16& p0, f32x16& p1, const char* K_lds, int r32, int hi, const bf16x8* qr, bool act, const float* cbp) {
    if (SK && !act) { const float NEG = -__builtin_inff();
#pragma unroll
        for (int r = 0; r < 16; ++r) { p0[r] = NEG; p1[r] = NEG; } return; }
    { const f32x4* c4 = (const f32x4*)cbp; const f32x4 a0 = c4[0], a1 = c4[2], a2 = c4[4], a3 = c4[6], b0 = c4[8], b1 = c4[10], b2 = c4[12], b3 = c4[14];
      p0 = (f32x16){a0[0], a0[1], a0[2], a0[3], a1[0], a1[1], a1[2], a1[3], a2[0], a2[1], a2[2], a2[3], a3[0], a3[1], a3[2], a3[3]};
      p1 = (f32x16){b0[0], b0[1], b0[2], b0[3], b1[0], b1[1], b1[2], b1[3], b2[0], b2[1], b2[2], b2[3], b3[0], b3[1], b3[2], b3[3]}; }
    const char* kb[4];
#pragma unroll
    for (int dd = 0; dd < 4; ++dd) kb[dd] = K_lds + KB * SHM_K + KSWZ(r32, (dd * 16 + hi * 8) * 2);
#pragma unroll
    for (int d0 = 0; d0 < 8; ++d0) { const char* a = kb[d0 & 3] + (d0 >> 2) * 128;
        bf16x8 b0 = *reinterpret_cast<const bf16x8*>(a);
        bf16x8 b1 = *reinterpret_cast<const bf16x8*>(a + 32 * 256);
        p0 = __builtin_amdgcn_mfma_f32_32x32x16_bf16(b0, qr[d0], p0, 0, 0, 0);
        p1 = __builtin_amdgcn_mfma_f32_32x32x16_bf16(b1, qr[d0], p1, 0, 0, 0); }
}
template <int VB, bool SK>
__device__ __forceinline__ void pv_tile(f32x16* o, int vb0, bf16x8 pa0, bf16x8 pa1, bf16x8 pa2, bf16x8 pa3, bool act) {
    if (SK && !act) return;
#define TRRD(dst, off) asm volatile("ds_read_b64_tr_b16 %0, %1 offset:%2" : "=&v"(dst) : "v"(vb0), "i"(off) : "memory")
#define PV_D0(d0) do { s16x4 l0, l1, l2, l3, h0, h1, h2, h3; constexpr int b_ = VB * SHM_V + v_rd_off(d0, 0, 0);     \
        TRRD(l0, b_); TRRD(h0, b_ + 2048); TRRD(l1, b_ + 4096); TRRD(h1, b_ + 6144); TRRD(l2, b_ + 8192); TRRD(h2, b_ + 10240); TRRD(l3, b_ + 12288); TRRD(h3, b_ + 14336); \
        asm volatile("s_waitcnt lgkmcnt(0)" ::: "memory"); SBAR();                 \
        o[d0] = __builtin_amdgcn_mfma_f32_32x32x16_bf16(pa0, (bf16x8){l0[0], l0[1], l0[2], l0[3], h0[0], h0[1], h0[2], h0[3]}, o[d0], 0, 0, 0);   \
        o[d0] = __builtin_amdgcn_mfma_f32_32x32x16_bf16(pa1, (bf16x8){l1[0], l1[1], l1[2], l1[3], h1[0], h1[1], h1[2], h1[3]}, o[d0], 0, 0, 0);   \
        o[d0] = __builtin_amdgcn_mfma_f32_32x32x16_bf16(pa2, (bf16x8){l2[0], l2[1], l2[2], l2[3], h2[0], h2[1], h2[2], h2[3]}, o[d0], 0, 0, 0);   \
        o[d0] = __builtin_amdgcn_mfma_f32_32x32x16_bf16(pa3, (bf16x8){l3[0], l3[1], l3[2], l3[3], h3[0], h3[1], h3[2], h3[3]}, o[d0], 0, 0, 0); } while (0)
    PV_D0(0); PV_D0(1); PV_D0(2); PV_D0(3);
#undef PV_D0
#undef TRRD
}

template <class TIn, class TOut> struct BlockRef { const TIn* Q; const TIn* K; const TIn* V; TOut* O; int P0; };
template <class TIn> struct Seam {
    bf16x8 qr[8];
    bf16x8 st_v0, st_v1, st_k0, st_k1; f32x4 sf0, sf1, sf2, sf3;
    f32x4 tq[16];
};
__device__ __forceinline__ int swa_jlo(int P0, int W) { const int lowk = P0 - W + 1; return lowk > 0 ? lowk / KVBLK : 0; }
#define ROW(p, k0, rr) ((p) + (size_t)((k0) + (rr)) * PITCH + sc)
#define VMW() asm volatile("s_waitcnt vmcnt(0)" ::: "memory")
#define VMWN(n) asm volatile("s_waitcnt vmcnt(%0)" :: "i"(n) : "memory")
#define SLOAD_H(Kp, Vp, k0) do { S.st_v0 = load8<TIn>(ROW(Vp, k0, sr)); S.st_v1 = load8<TIn>(ROW(Vp, k0, 32 + sr));              \
                         S.st_k0 = load8<TIn>(ROW(Kp, k0, sr)); S.st_k1 = load8<TIn>(ROW(Kp, k0, 32 + sr)); } while (0)
#define SWRITE_HK(bf) do { *(bf16x8*)(K_lds + (bf) * SHM_K + kws) = S.st_k0; *(bf16x8*)(K_lds + (bf) * SHM_K + kws + 32 * 256) = S.st_k1; } while (0)
#define SWRITE_HV(bf) do { *(bf16x8*)(V_lds + (bf) * SHM_V + vst0) = S.st_v0; *(bf16x8*)(V_lds + (bf) * SHM_V + vst1) = S.st_v1; } while (0)
#define SWRITE_H(bf) do { SWRITE_HV(bf); SWRITE_HK(bf); } while (0)
#define SLOAD_F(p, k0) do { S.sf0 = *(const f32x4*)ROW(p, k0, sr); S.sf1 = *(const f32x4*)(ROW(p, k0, sr) + 4);                \
                            S.sf2 = *(const f32x4*)ROW(p, k0, 32 + sr); S.sf3 = *(const f32x4*)(ROW(p, k0, 32 + sr) + 4); } while (0)
#define SWRITE_KF(bf) do { *(bf16x8*)(K_lds + (bf) * SHM_K + kws) = pack8(S.sf0, S.sf1); *(bf16x8*)(K_lds + (bf) * SHM_K + kws + 32 * 256) = pack8(S.sf2, S.sf3); } while (0)
#define SWRITE_VF(bf) do { *(bf16x8*)(V_lds + (bf) * SHM_V + vst0) = pack8(S.sf0, S.sf1); *(bf16x8*)(V_lds + (bf) * SHM_V + vst1) = pack8(S.sf2, S.sf3); } while (0)
template <class TIn, class TOut>
__device__ __forceinline__ void causal_swa_prime(const BlockRef<TIn, TOut>& cur, int W, char* lds, Seam<TIn>& S) {
    constexpr bool F32 = same_t<TIn, float>::v;
    int tid_l = threadIdx.x; asm volatile("" : "+v"(tid_l));
    const int tid = tid_l, wid = __builtin_amdgcn_readfirstlane(tid >> 6), lane = tid & 63, r32 = lane & 31, hi = lane >> 5;
    const int sr = tid >> 4, sc = (tid & 15) * 8, kws = KSWZ(sr, sc * 2); char* K_lds = lds + 2 * SHM_V;
    const int kb0 = swa_jlo(cur.P0, W) * KVBLK;
    for (int d0 = 0; d0 < 8; ++d0) S.qr[d0] = load8<TIn>(cur.Q + (size_t)(wid * QBLK + r32) * PITCH + d0 * 16 + hi * 8);
    if constexpr (F32) { SLOAD_F((const float*)cur.K, kb0); VMW(); SWRITE_KF(0); SBAR(); SLOAD_F((const float*)cur.V, kb0); }
    else { SLOAD_H(cur.K, cur.V, kb0); VMW(); SWRITE_HK(0); }
    __syncthreads();
}
template <class TIn, class TOut>
__device__ __forceinline__ void causal_swa_block(const BlockRef<TIn, TOut>& cur, const BlockRef<TIn, TOut>& nxt, int skv, int W, char* lds, Seam<TIn>& S, const float* cbias) {
    constexpr bool F32 = same_t<TIn, float>::v;
    int tid_l = threadIdx.x; asm volatile("" : "+v"(tid_l));
    const int tid = tid_l, wid = __builtin_amdgcn_readfirstlane(tid >> 6), lane = tid & 63, r32 = lane & 31, hi = lane >> 5;
    const int j_lo = swa_jlo(cur.P0, W);
    int j_hi = (cur.P0 + QB - 1) / KVBLK + 1; if (j_hi > skv / KVBLK) j_hi = skv / KVBLK;
    const int NT = j_hi - j_lo;
    const int kbn = swa_jlo(nxt.P0, W) * KVBLK;
    const int qlo = cur.P0 + wid * QBLK, qm = qlo + r32 - 4 * hi;
    char* V_lds = lds; char* K_lds = lds + 2 * SHM_V;
    float* ws = (float*)(lds + 2 * SHM_V + 2 * SHM_K) + wid * 64; float* li_l = ws, * al_l = ws + 32;
    float m_reg = -1e30f, l_reg = 0; f32x16 o[4] = {};
    const int sr = tid >> 4, sc = (tid & 15) * 8, vst0 = v_st(sr, sc), vst1 = v_st(32 + sr, sc), kws = KSWZ(sr, sc * 2);
    const int vb0 = (int)(uintptr_t)V_lds + v_rd_base(lane);
    const TIn* Kh = cur.K; const TIn* Vh = cur.V;
#define RESC(a) do { if (__any((a) < 1.f)) { if (hi == 0) al_l[r32] = (a); asm volatile("s_waitcnt lgkmcnt(0)" ::: "memory");              \
                     for (int d_ = 0; d_ < 4; ++d_) for (int r = 0; r < 16; ++r) o[d_][r] *= al_l[crow(r, hi)]; } } while (0)
#define KBASE(t) ((j_lo + (t)) * KVBLK)
#define ACT(t) (KBASE(t) <= qlo + QBLK - 1 && KBASE(t) + KVBLK - 1 >= qlo - W + 1)
#define MASKT(P0_, P1_, t) do { const int kb_ = KBASE(t); if ((!SK || ACT(t)) && (kb_ + KVBLK - 1 > qlo || kb_ <= qlo + QBLK - 1 - W)) mask_tile(P0_, P1_, qm - kb_, (unsigned)W); } while (0)
    constexpr int NQL = F32 ? 16 : 8;
    constexpr bool SK = WSKIP && !F32;
#define SEAM_K0() do { VMWN(NQL); if constexpr (F32) { SWRITE_KF(0); SBAR(); SLOAD_F((const float*)nxt.V, kbn); } else { SWRITE_HK(0); } SBAR(); } while (0)
    f32x16 pA0, pA1, pB0, pB1; float mnA, mnB, alA, alB; bf16x8 pa0, pa1, pa2, pa3;
    if constexpr (F32) { VMW(); SWRITE_VF(0); SBAR(); } else { SWRITE_HV(0); SBAR(); }
    if (NT > 1) { if constexpr (F32) SLOAD_F((const float*)Kh, KBASE(1)); else SLOAD_H(Kh, Vh, KBASE(1)); }
    SBAR(); qkt<0, SK>(pA0, pA1, K_lds, r32, hi, S.qr, ACT(0), cbias + KBASE(0) + 4 * hi);
    if constexpr (F32) { if (NT > 1) { VMW(); SWRITE_KF(1); SBAR(); SLOAD_F((const float*)Vh, KBASE(1)); } }
    MASKT(pA0, pA1, 0); partialSM(pA0, pA1, m_reg, mnA, alA);
    if (NT > 1) { VMW(); if constexpr (F32) { SWRITE_VF(1); SBAR(); if (NT > 2) SLOAD_F((const float*)Kh, KBASE(2)); } else SWRITE_H(1); }
    __syncthreads();
#define HALF_STEP(PX0, PX1, mnX, alX, PY0, PY1, alY, t, KB, VB, SB) do {                                                      \
        SBAR(); qkt<KB, SK>(PX0, PX1, K_lds, r32, hi, S.qr, ACT(t), cbias + KBASE(t) + 4 * hi);                                             \
        finishSM(PY0, PY1, alY, l_reg, pa0, pa1, pa2, pa3); SBAR();                                                           \
        if ((t) + 1 < NT) { if constexpr (F32) { VMW(); SWRITE_KF(SB); SBAR(); SLOAD_F((const float*)Vh, KBASE((t) + 1)); }  \
                            else { SLOAD_H(Kh, Vh, KBASE((t) + 1)); } SBAR(); }                                               \
        pv_tile<VB, SK>(o, vb0, pa0, pa1, pa2, pa3, ACT((t) - 1)); MASKT(PX0, PX1, (t)); partialSM(PX0, PX1, m_reg, mnX, alX);                                        \
        __syncthreads();                                                                                                      \
        if ((t) + 1 < NT) { VMW(); if constexpr (F32) { SWRITE_VF(SB); SBAR(); if ((t) + 2 < NT) SLOAD_F((const float*)Kh, KBASE((t) + 2)); } \
                            else { SWRITE_H(SB); } }                                                                          \
        RESC(alX); __syncthreads(); } while (0)
    for (int t = 1; t + 1 < NT; t += 2) {
        HALF_STEP(pB0, pB1, mnB, alB, pA0, pA1, alA, t, 1, 0, 0);
        HALF_STEP(pA0, pA1, mnA, alA, pB0, pB1, alB, t + 1, 0, 1, 1);
    }
    const bool even = (NT & 1) == 0;
    if (even) { SBAR(); qkt<1, SK>(pB0, pB1, K_lds, r32, hi, S.qr, ACT(NT - 1), cbias + KBASE(NT - 1) + 4 * hi); SBAR(); }
#define QROW(e) (nxt.Q + (size_t)(wid * QBLK + r32) * PITCH + ((e) >> 1) * 16 + hi * 8 + ((e) & 1) * 4)
    if constexpr (F32) { SLOAD_F((const float*)nxt.K, kbn); SBAR();
#pragma unroll
        for (int e = 0; e < 8; ++e) S.tq[e] = *(const f32x4*)QROW(e); }
    else { SLOAD_H(nxt.K, nxt.V, kbn); SBAR();
#pragma unroll
        for (int d0 = 0; d0 < 8; ++d0) S.qr[d0] = load8<TIn>(nxt.Q + (size_t)(wid * QBLK + r32) * PITCH + d0 * 16 + hi * 8); }
    SBAR();
    finishSM(pA0, pA1, alA, l_reg, pa0, pa1, pa2, pa3); SBAR();
    if constexpr (F32) {
#pragma unroll
        for (int e = 8; e < 16; ++e) S.tq[e] = *(const f32x4*)QROW(e); SBAR(); }
#undef QROW
    pv_tile<0, SK>(o, vb0, pa0, pa1, pa2, pa3, ACT(even ? NT - 2 : NT - 1));
    if (even) { MASKT(pB0, pB1, NT - 1); partialSM(pB0, pB1, m_reg, mnB, alB); __syncthreads(); RESC(alB);
        finishSM(pB0, pB1, alB, l_reg, pa0, pa1, pa2, pa3); SBAR(); pv_tile<1, SK>(o, vb0, pa0, pa1, pa2, pa3, ACT(NT - 1)); }
    SBAR(); SEAM_K0();
    if (hi == 0) li_l[r32] = l_reg; asm volatile("s_waitcnt lgkmcnt(0)" ::: "memory");
    float rli[16];
#pragma unroll
    for (int r = 0; r < 16; ++r) rli[r] = __builtin_amdgcn_rcpf(li_l[crow(r, hi)]);
    TOut* Ow = cur.O + (size_t)(wid * QBLK) * PITCH;
#pragma unroll
    for (int r = 0; r < 16; ++r) { const int orow = crow(r, hi);
#pragma unroll
        for (int d0 = 0; d0 < 4; ++d0) { const float v = o[d0][r] * rli[r];
            if constexpr (same_t<TOut, float>::v) { Ow[(size_t)orow * PITCH + d0 * 32 + r32] = v; }
            else { const float vn = __shfl_xor(v, 1);
                   if ((r32 & 1) == 0) *(unsigned*)(Ow + (size_t)orow * PITCH + d0 * 32 + r32) = cvtpk(v, vn); } } }
    if constexpr (F32) {
#pragma unroll
        for (int d0 = 0; d0 < 8; ++d0) S.qr[d0] = pack8(S.tq[2 * d0], S.tq[2 * d0 + 1]); }
    __syncthreads();
#undef RESC
#undef KBASE
#undef ACT
#undef MASKT
#undef SEAM_K0
#undef HALF_STEP
}
#undef ROW
#undef VMW
#undef VMWN
#undef SLOAD_H
#undef SWRITE_HK
#undef SWRITE_HV
#undef SWRITE_H
#undef SLOAD_F
#undef SWRITE_KF
#undef SWRITE_VF
}

typedef unsigned short bf16_t;
typedef short bf16x8 __attribute__((ext_vector_type(8)));
typedef float f32x4 __attribute__((ext_vector_type(4)));
typedef unsigned u32x4 __attribute__((ext_vector_type(4)));
typedef unsigned u32x2 __attribute__((ext_vector_type(2)));
constexpr int DM = 1024, NB = 32, SEQ = 2048, NH = 8, HD = 128, DFF = 2816, NUP = 2 * DFF;
constexpr int MTOK = NB * SEQ;
constexpr int NG = 2, BG = NB / NG, GM = BG * SEQ;
constexpr int NIN = 37 * 256;
constexpr int NCH = BG * NH * 32;
static_assert(GM == pg8::GM, "group rows");
constexpr size_t MiB = 1u << 20;
constexpr size_t WS_CTL = 0;
constexpr size_t WS_WIN = 1 * MiB, WS_WBF = 20 * MiB, WS_WBG = 22 * MiB, WS_WOUT = 24 * MiB, WS_WUP = 26 * MiB, WS_WDN = 37 * MiB;
constexpr size_t WS_PROJ = 44 * MiB;
constexpr size_t WS_SMALL = 620 * MiB;
constexpr size_t WS_PREP = 624 * MiB;
constexpr size_t WS_END = 913 * MiB;
constexpr size_t PBUF = 64 * MiB;
constexpr size_t WS_H1B = WS_PROJ + 0 * PBUF;
constexpr size_t WS_T1 = WS_PROJ + 1 * PBUF;
constexpr size_t WS_Y = WS_PROJ + 2 * PBUF;
constexpr size_t WS_YGDN = WS_PROJ + 3 * PBUF;
constexpr size_t WS_YFOX = WS_PROJ + 5 * PBUF;
constexpr size_t WS_UP = WS_PROJ + 3 * PBUF;
constexpr size_t WS_ACT = WS_PREP;
constexpr size_t PROJ_STRIDE = (size_t)GM * 1024;
constexpr int LDS_BYTES = 163840;

__device__ __forceinline__ float bf2f(bf16_t b) { return __uint_as_float((unsigned)b << 16); }
__device__ __forceinline__ float bflo(unsigned w) { return __uint_as_float(w << 16); }
__device__ __forceinline__ float bfhi(unsigned w) { return __uint_as_float(w & 0xffff0000u); }
typedef float f32x2_t __attribute__((ext_vector_type(2))); typedef __bf16 bf16x2_t __attribute__((ext_vector_type(2)));
__device__ __forceinline__ unsigned pk2(float lo, float hi) { f32x2_t v = {lo, hi}; bf16x2_t b = __builtin_convertvector(v, bf16x2_t); return __builtin_bit_cast(unsigned, b); }
__device__ __forceinline__ bf16_t f2bf(float f) { return (bf16_t)(pk2(f, 0.f) & 0xffffu); }
__device__ __forceinline__ float siluf(float y) { return y / (1.0f + __expf(-y)); }
__device__ __forceinline__ float wave_sum(float v) {
#pragma unroll
    for (int o = 1; o < 64; o <<= 1) v += __shfl_xor(v, o);
    return v;
}

struct Args { const float* in[16]; float* out; unsigned char* ws; int ph_lo, ph_hi; };
struct Ptrs {
    const float *x, *norm_mix, *w_in, *fox_f_bias, *gdn_conv_w, *gdn_a_log, *gdn_dt_bias, *gdn_norm, *w_bf, *w_bg, *w_out, *norm_ffn, *w_up, *ffn_conv_w, *w_down, *norm_final;
    float* out; unsigned char* ws;
};

template <int MODE> __device__ __forceinline__ int srccol(int n) {
    if (MODE == 0) return n;
    if (MODE == 1) {
        if (n < 3072) return n;
        if (n < 6144) return 3080 + (n - 3072);
        if (n < 9216) return 6168 + (n - 6144);
        const int s = n - 9216;
        if (s < 8) return 3072 + s;
        if (s < 16) return 6152 + (s - 8);
        if (s < 24) return 6160 + (s - 16);
        return -1;
    }
    { const int p = n >> 8, s = (n >> 7) & 1, i = n & 127; return s * DFF + 128 * p + i; }
}
template <int MODE> __device__ __forceinline__ void transpose_item(const float* W, int K, int N, const float* ksc, bf16_t* WT, float* scr, int item, int nblk, int lane) {
    const int kb = item / nblk, nb = item % nblk, k0 = 64 * kb, n0 = 32 * nb;
    const int sc = srccol<MODE>(n0 + (lane & 31));
#pragma unroll 8
    for (int i = 0; i < 32; ++i) { const int kk = 2 * i + (lane >> 5); float v = 0.f; if (sc >= 0) { v = W[(size_t)(k0 + kk) * N + sc]; if (ksc) v *= ksc[k0 + kk]; } scr[kk * 33 + (lane & 31)] = v; }
    asm volatile("s_waitcnt lgkmcnt(0)" ::: "memory");
    const int c = lane & 7;
#pragma unroll
    for (int j = 0; j < 4; ++j) { const int n = (lane >> 3) + 8 * j; const float* s = scr + (8 * c) * 33 + n;
        u32x4 o; o.x = pk2(s[0 * 33], s[1 * 33]); o.y = pk2(s[2 * 33], s[3 * 33]); o.z = pk2(s[4 * 33], s[5 * 33]); o.w = pk2(s[6 * 33], s[7 * 33]);
        *(u32x4*)(WT + (size_t)(n0 + n) * K + k0 + 8 * c) = o; }
    asm volatile("s_waitcnt lgkmcnt(0)" ::: "memory");
}
__device__ __forceinline__ void phase_prologue(const Ptrs& P, char* lds, int tid, int cid) {
    const int lane = tid & 63, wave = tid >> 6;
    float* scr = (float*)(lds + wave * 16384);
    const int gw = cid * 8 + wave, NGW = 256 * 8;
    bf16_t* win_t = (bf16_t*)(P.ws + WS_WIN); bf16_t* wbf_t = (bf16_t*)(P.ws + WS_WBF); bf16_t* wbg_t = (bf16_t*)(P.ws + WS_WBG);
    bf16_t* wout_t = (bf16_t*)(P.ws + WS_WOUT); bf16_t* wup_t = (bf16_t*)(P.ws + WS_WUP); bf16_t* wdn_t = (bf16_t*)(P.ws + WS_WDN);
    constexpr int I_IN = 16 * (NIN / 32), I_SQ = 16 * 32, I_UP = 16 * (NUP / 32), I_DN = (DFF / 64) * 32;
    constexpr int NITEMS = I_IN + 3 * I_SQ + I_UP + I_DN;
    for (int it = gw; it < NITEMS; it += NGW) {
        int r = it;
        if (r < I_IN) { transpose_item<1>(P.w_in, DM, 9240, nullptr, win_t, scr, r, NIN / 32, lane); continue; } r -= I_IN;
        if (r < I_SQ) { transpose_item<0>(P.w_bf, DM, DM, nullptr, wbf_t, scr, r, 32, lane); continue; } r -= I_SQ;
        if (r < I_SQ) { transpose_item<0>(P.w_bg, DM, DM, nullptr, wbg_t, scr, r, 32, lane); continue; } r -= I_SQ;
        if (r < I_SQ) { transpose_item<0>(P.w_out, DM, DM, nullptr, wout_t, scr, r, 32, lane); continue; } r -= I_SQ;
        if (r < I_UP) { transpose_item<2>(P.w_up, DM, NUP, P.norm_ffn, wup_t, scr, r, NUP / 32, lane); continue; } r -= I_UP;
        transpose_item<0>(P.w_down, DFF, DM, nullptr, wdn_t, scr, r, 32, lane);
    }
    f32x4 gv[4];
#pragma unroll
    for (int j = 0; j < 4; ++j) gv[j] = ((const f32x4*)P.norm_mix)[lane + 64 * j];
    for (int m0 = gw; m0 < MTOK; m0 += 2 * NGW) {
        const int m1 = m0 + NGW;
        const f32x4* xr0 = (const f32x4*)(P.x + (size_t)m0 * DM) + lane; const f32x4* xr1 = (const f32x4*)(P.x + (size_t)m1 * DM) + lane;
        f32x4 v0[4], v1[4]; float s0 = 0.f, s1 = 0.f;
#pragma unroll
        for (int j = 0; j < 4; ++j) { v0[j] = xr0[64 * j]; v1[j] = xr1[64 * j]; }
#pragma unroll
        for (int j = 0; j < 4; ++j) { s0 += (v0[j][0] * v0[j][0] + v0[j][1] * v0[j][1]) + (v0[j][2] * v0[j][2] + v0[j][3] * v0[j][3]); s1 += (v1[j][0] * v1[j][0] + v1[j][1] * v1[j][1]) + (v1[j][2] * v1[j][2] + v1[j][3] * v1[j][3]); }
        const float rstd0 = rsqrtf(wave_sum(s0) * (1.f / DM) + 1e-6f), rstd1 = rsqrtf(wave_sum(s1) * (1.f / DM) + 1e-6f);
        const int g0 = m0 / GM, g1 = m1 / GM;
        u32x2* o0 = (u32x2*)((bf16_t*)(P.out + (size_t)g0 * GM * DM) + (size_t)(m0 - g0 * GM) * DM) + lane;
        u32x2* o1 = (u32x2*)((bf16_t*)(P.out + (size_t)g1 * GM * DM) + (size_t)(m1 - g1 * GM) * DM) + lane;
#pragma unroll
        for (int j = 0; j < 4; ++j) { const f32x4 t0 = v0[j] * rstd0 * gv[j], t1 = v1[j] * rstd1 * gv[j]; u32x2 w0, w1; w0.x = pk2(t0[0], t0[1]); w0.y = pk2(t0[2], t0[3]); w1.x = pk2(t1[0], t1[1]); w1.y = pk2(t1[2], t1[3]); o0[64 * j] = w0; o1[64 * j] = w1; }
    }
}

__device__ __forceinline__ f32x4 mma16(const bf16_t* A, int lda, const bf16_t* Bt, int ldb, int ksteps, f32x4 acc, int lane) {
    const int r = lane & 15, q = lane >> 4;
    const bf16_t* ap = A + r * lda + q * 8; const bf16_t* bp = Bt + r * ldb + q * 8;
    for (int ks = 0; ks < ksteps; ++ks) { const bf16x8 a = *(const bf16x8*)(ap + ks * 32); const bf16x8 b = *(const bf16x8*)(bp + ks * 32); acc = __builtin_amdgcn_mfma_f32_16x16x32_bf16(a, b, acc, 0, 0, 0); }
    return acc;
}
#define LBAR() do { asm volatile("s_waitcnt lgkmcnt(0)" ::: "memory"); __builtin_amdgcn_s_barrier(); asm volatile("" ::: "memory"); } while (0)
constexpr int PQ = 136, PC = 72;
struct PrepBufs { bf16_t *W, *QD, *KDT, *UHT, *AT; float* GL; };
__device__ __forceinline__ PrepBufs prep_bufs(unsigned char* ws) {
    PrepBufs b; b.W = (bf16_t*)(ws + WS_PREP); b.QD = (bf16_t*)(ws + WS_PREP + 64 * MiB); b.KDT = (bf16_t*)(ws + WS_PREP + 128 * MiB); b.UHT = (bf16_t*)(ws + WS_PREP + 192 * MiB);
    b.AT = (bf16_t*)(ws + WS_PREP + 256 * MiB); b.GL = (float*)(ws + WS_PREP + 288 * MiB); return b;
}
constexpr int PL_QS = 0, PL_KS = 17408, PL_KDT = 34816, PL_RAW = 53248, RAWP = 392  , PL_RT = PL_RAW + 67 * RAWP * 2, PL_GC = PL_RT + 256 * PC * 2, PL_CW = PL_GC + 512, PL_END = PL_CW + 6144;
constexpr int RAW_CHUNKS = 67 * 48;
struct PrepStage { u32x4 raw[7]; float ga, gb; };
__device__ __forceinline__ void prep_fetch(PrepStage& st, int unit, const Ptrs& P, int tid) {
    const int n = unit & 31, h = (unit >> 5) & 7, bl = unit >> 8;
    const int R0 = bl * SEQ + n * 64;
    const bf16_t* proj = (const bf16_t*)(P.ws + WS_PROJ); const float* small = (const float*)(P.ws + WS_SMALL);
#pragma unroll
    for (int i = 0; i < 7; ++i) { const int c = tid + 512 * i; const int row = c / 48, c16 = c - row * 48, part = c16 >> 4, ch = (c16 & 15) * 8;
        u32x4 v = {0u, 0u, 0u, 0u};
        if (c < RAW_CHUNKS && (n > 0 || row >= 3)) v = *(const u32x4*)(proj + (size_t)(3 + part) * PROJ_STRIDE + (size_t)(R0 - 3 + row) * 1024 + h * HD + ch);
        st.raw[i] = v; }
    st.ga = 0.f; st.gb = 0.f;
    if (tid < 64) { const float* sm = small + (size_t)(R0 + tid) * 32; st.ga = sm[8 + h]; st.gb = sm[16 + h]; }
}
__device__ __forceinline__ void gdn_prep_unit(char* lds, int unit, int unit_next, PrepStage& st, const Ptrs& P, int tid_in) {
    int tid = tid_in; asm volatile("" : "+v"(tid));
    const int lane = tid & 63, wid = tid >> 6, c16 = lane & 15, q4 = lane >> 4;
    const int h = (unit >> 5) & 7;
    bf16_t* Qs = (bf16_t*)(lds + PL_QS); bf16_t* Ks = (bf16_t*)(lds + PL_KS); bf16_t* KDTs = (bf16_t*)(lds + PL_KDT);
    bf16_t* RAW = (bf16_t*)(lds + PL_RAW);
    bf16_t* RT = (bf16_t*)(lds + PL_RT);
    float* gcs = (float*)(lds + PL_GC); float* bts = gcs + 64;
    bf16_t* UHs = (bf16_t*)(lds + PL_RAW + 4096); bf16_t* Wst = UHs + 8192; bf16_t* ATs = Wst + 64 * PQ;
    const float* CW = (const float*)(lds + PL_CW);
    bf16_t* CH = (bf16_t*)lds;
    const PrepBufs G = prep_bufs(P.ws);
#pragma unroll
    for (int i = 0; i < 7; ++i) { const int c = tid + 512 * i; const int row = c / 48, cc = c - row * 48; if (c < RAW_CHUNKS) *(u32x4*)(RAW + row * RAWP + cc * 8) = st.raw[i]; }
    if (wid == 0) {
        const float xx = st.ga + P.gdn_dt_bias[h];
        const float sp = xx > 20.f ? xx : log1pf(__expf(xx));
        float cum = -__expf(P.gdn_a_log[h]) * sp;
        const float beta = 1.0f / (1.0f + __expf(-st.gb));
#pragma unroll
        for (int o = 1; o < 64; o <<= 1) { const float t = __shfl_up(cum, o); if (lane >= o) cum += t; }
        gcs[lane] = cum; bts[lane] = beta;
    }
    LBAR();
    prep_fetch(st, unit_next, P, tid);
    {
        const int r = tid >> 3, d0 = (tid & 7) * 16;
        const float gcr = gcs[r], btr = bts[r], glast = gcs[63];
        const float eg = __expf(gcr), egl = __expf(glast - gcr);
#pragma unroll 1
        for (int part = 0; part < 3; ++part) {
            float y[16];
#pragma unroll
            for (int j = 0; j < 16; ++j) y[j] = 0.f;
#pragma unroll
            for (int i = 0; i < 4; ++i) {
                const bf16_t* src = RAW + (r + i) * RAWP + part * 128 + d0;
                const u32x4 a = *(const u32x4*)src, b = *(const u32x4*)(src + 8);
                const float* w = CW + (part * 4 + i) * 128 + d0;
                const f32x4 w0 = *(const f32x4*)w, w1 = *(const f32x4*)(w + 4), w2 = *(const f32x4*)(w + 8), w3 = *(const f32x4*)(w + 12);
                y[0] += w0[0] * bflo(a.x); y[1] += w0[1] * bfhi(a.x); y[2] += w0[2] * bflo(a.y); y[3] += w0[3] * bfhi(a.y);
                y[4] += w1[0] * bflo(a.z); y[5] += w1[1] * bfhi(a.z); y[6] += w1[2] * bflo(a.w); y[7] += w1[3] * bfhi(a.w);
                y[8] += w2[0] * bflo(b.x); y[9] += w2[1] * bfhi(b.x); y[10] += w2[2] * bflo(b.y); y[11] += w2[3] * bfhi(b.y);
                y[12] += w3[0] * bflo(b.z); y[13] += w3[1] * bfhi(b.z); y[14] += w3[2] * bflo(b.w); y[15] += w3[3] * bfhi(b.w);
            }
            float ss = 0.f;
#pragma unroll
            for (int j = 0; j < 16; ++j) { y[j] = siluf(y[j]); ss += y[j] * y[j]; }
            if (part < 2) { ss += __shfl_xor(ss, 1); ss += __shfl_xor(ss, 2); ss += __shfl_xor(ss, 4); }
            const float inv = rsqrtf(ss + 1e-6f);
            if (part == 0) {
                const float sc = inv * 0.08838834764831845f;
                unsigned pq[8], pd[8];
#pragma unroll
                for (int j = 0; j < 8; ++j) { const float a0 = y[2 * j] * sc, a1 = y[2 * j + 1] * sc; pq[j] = pk2(a0, a1); pd[j] = pk2(a0 * eg, a1 * eg); }
                *(u32x4*)(Qs + r * PQ + d0) = (u32x4){pq[0], pq[1], pq[2], pq[3]}; *(u32x4*)(Qs + r * PQ + d0 + 8) = (u32x4){pq[4], pq[5], pq[6], pq[7]};
                bf16_t* qd = G.QD + (size_t)unit * 8192 + r * 128 + d0;
                *(u32x4*)qd = (u32x4){pd[0], pd[1], pd[2], pd[3]}; *(u32x4*)(qd + 8) = (u32x4){pd[4], pd[5], pd[6], pd[7]};
            } else if (part == 1) {
                unsigned pk[8];
#pragma unroll
                for (int j = 0; j < 8; ++j) pk[j] = pk2(y[2 * j] * inv, y[2 * j + 1] * inv);
                *(u32x4*)(Ks + r * PQ + d0) = (u32x4){pk[0], pk[1], pk[2], pk[3]}; *(u32x4*)(Ks + r * PQ + d0 + 8) = (u32x4){pk[4], pk[5], pk[6], pk[7]};
                const float s1 = inv * btr * eg, s2 = inv * egl;
#pragma unroll
                for (int j = 0; j < 16; ++j) { RT[(128 + d0 + j) * PC + r] = f2bf(y[j] * s1); KDTs[(d0 + j) * PC + r] = f2bf(y[j] * s2); }
            } else {
#pragma unroll
                for (int j = 0; j < 16; ++j) RT[(d0 + j) * PC + r] = f2bf(y[j] * btr);
            }
        }
    }
    LBAR();
    {
#pragma unroll
        for (int i = 0; i < 2; ++i) { const int idx = tid + 512 * i, row = idx >> 3, ch = idx & 7; *(u32x4*)(G.KDT + (size_t)unit * 8192 + row * 64 + ch * 8) = *(const u32x4*)(KDTs + row * PC + ch * 8); }
    }
    const int mat = wid >> 2, ti = wid & 3;
    f32x4 res[4];
#pragma unroll
    for (int tj = 0; tj < 4; ++tj) { f32x4 acc = {0.f, 0.f, 0.f, 0.f}; if (tj <= ti) acc = mma16((mat ? Qs : Ks) + ti * 16 * PQ, PQ, Ks + tj * 16 * PQ, PQ, 4, acc, lane); res[tj] = acc; }
    LBAR();
#pragma unroll
    for (int tj = 0; tj < 4; ++tj)
#pragma unroll
        for (int jj = 0; jj < 4; ++jj) { const int ii = ti * 16 + 4 * q4 + jj, jc = tj * 16 + c16;
            const float dec = (ii >= jc) ? __expf(gcs[ii] - gcs[jc]) : 0.f;
            if (mat == 0) { const bf16_t nv = f2bf((ii > jc) ? -res[tj][jj] * dec * bts[ii] : 0.f); CH[ii * PC + jc] = nv; CH[2 * 64 * PC + jc * PC + ii] = nv; }
            else ATs[ii * PC + jc] = f2bf((ii >= jc) ? res[tj][jj] * dec : 0.f); }
    LBAR();
    f32x4 pacc[4];
    if (wid >= 4) {
#pragma unroll
        for (int tj = 0; tj < 4; ++tj)
#pragma unroll
            for (int jj = 0; jj < 4; ++jj) { const int ii = ti * 16 + 4 * q4 + jj, jc = tj * 16 + c16; pacc[tj][jj] = bf2f(CH[ii * PC + jc]) + (ii == jc ? 1.f : 0.f); }
    }
    for (int s = 0; s < 6; ++s) {
        const int cur = s & 1, nxt = cur ^ 1;
        bf16_t* Qr_c = CH + cur * 64 * PC; bf16_t* Qt_c = CH + (2 + cur) * 64 * PC; bf16_t* Qr_n = CH + nxt * 64 * PC; bf16_t* Qt_n = CH + (2 + nxt) * 64 * PC;
        bf16_t* Pr_c = CH + (4 + cur) * 64 * PC; bf16_t* Pr_p = CH + (4 + nxt) * 64 * PC;
        if (wid < 4) {
            if (s < 5) {
#pragma unroll
                for (int tj = 0; tj < 4; ++tj) { f32x4 acc = {0.f, 0.f, 0.f, 0.f}; acc = mma16(Qr_c + ti * 16 * PC, PC, Qt_c + tj * 16 * PC, PC, 2, acc, lane);
#pragma unroll
                    for (int jj = 0; jj < 4; ++jj) { const int ii = ti * 16 + 4 * q4 + jj, jc = tj * 16 + c16; const bf16_t v = f2bf(acc[jj]); Qr_n[ii * PC + jc] = v; Qt_n[jc * PC + ii] = v; } }
            }
        } else {
#pragma unroll
            for (int tj = 0; tj < 4; ++tj) { if (s >= 1) pacc[tj] = mma16(Pr_p + ti * 16 * PC, PC, Qt_c + tj * 16 * PC, PC, 2, pacc[tj], lane);
#pragma unroll
                for (int jj = 0; jj < 4; ++jj) { const int ii = ti * 16 + 4 * q4 + jj, jc = tj * 16 + c16; Pr_c[ii * PC + jc] = f2bf(pacc[tj][jj]); } }
        }
        LBAR();
    }
    {
        const bf16_t* Tm = CH + 5 * 64 * PC;
#pragma unroll
        for (int t2 = 0; t2 < 2; ++t2) { const int tch = 2 * wid + t2;
#pragma unroll
            for (int tj = 0; tj < 4; ++tj) { f32x4 acc = {0.f, 0.f, 0.f, 0.f}; acc = mma16(RT + tch * 16 * PC, PC, Tm + tj * 16 * PC, PC, 2, acc, lane);
                const int ci = tj * 16 + c16, ch0 = tch * 16 + 4 * q4;
                if (tch < 8) {
#pragma unroll
                    for (int jj = 0; jj < 4; ++jj) { const int dv = ch0 + jj; UHs[((((dv >> 4) * 4 + (ci >> 4)) * 4 + ((ci >> 2) & 3)) * 16 + (dv & 15)) * 4 + (ci & 3)] = f2bf(acc[jj]); }
                } else { u32x2 w; w.x = pk2(acc[0], acc[1]); w.y = pk2(acc[2], acc[3]); *(u32x2*)(Wst + ci * PQ + (ch0 - 128)) = w; }
            } }
        if (tid == 0) G.GL[unit] = __expf(gcs[63]);
    }
    LBAR();
#pragma unroll
    for (int i = 0; i < 2; ++i) { const int idx = tid + 512 * i;
        *(u32x4*)(G.UHT + (size_t)unit * 8192 + idx * 8) = *(const u32x4*)(UHs + idx * 8);
        *(u32x4*)(G.W + (size_t)unit * 8192 + idx * 8) = *(const u32x4*)(Wst + (idx >> 4) * PQ + (idx & 15) * 8); }
    *(u32x4*)(G.AT + (size_t)unit * 4096 + tid * 8) = *(const u32x4*)(ATs + (tid >> 3) * PC + (tid & 7) * 8);
    LBAR();
}

__device__ __forceinline__ void gdn_seq_unit(char* lds, int bh, const Ptrs& P, int tid) {
    const int lane = tid & 63, wid = tid >> 6, c16 = lane & 15, q4 = lane >> 4;
    const int bl = bh >> 3, h = bh & 7;
    bf16_t* ST = (bf16_t*)lds;
    bf16_t* Wl = ST + 128 * PQ;
    bf16_t* QDl = Wl + 64 * PQ;
    bf16_t* ATl = QDl + 64 * PQ;
    bf16_t* KDTl = ATl + 64 * PC;
    bf16_t* UTl = KDTl + 128 * PC;
    bf16_t* GZl = UTl + 128 * PC;
    float* SSl = (float*)(GZl + 64 * PQ);
    const PrepBufs G = prep_bufs(P.ws);
    const bf16_t* gz = (const bf16_t*)(P.ws + WS_PROJ) + 6 * PROJ_STRIDE + (size_t)(bl * SEQ) * 1024 + h * HD;
    bf16_t* yg = (bf16_t*)(P.ws + WS_YGDN) + (size_t)(bl * SEQ) * 1024 + h * HD;
    f32x4 Sacc[8];
#pragma unroll
    for (int t = 0; t < 8; ++t) Sacc[t] = (f32x4){0.f, 0.f, 0.f, 0.f};
    for (int i = lane; i < 16 * PQ / 2; i += 64) ((unsigned*)(ST + wid * 16 * PQ))[i] = 0u;
    const f32x4 gn = *(const f32x4*)(P.gdn_norm + 16 * wid + 4 * q4);
    const int r16 = tid >> 4, ch16 = (tid & 15) * 8;
    const int r8 = tid >> 3, ch8 = (tid & 7) * 8;
    u32x4 sW[2], sQ[2], sA, sK[2], sG[2]; u32x2 uhn[4]; float gln;
    {
        const size_t ub = (size_t)(bh * 32) * 8192;
#pragma unroll
        for (int i = 0; i < 2; ++i) { const int idx = tid + 512 * i; sW[i] = *(const u32x4*)(G.W + ub + idx * 8); sQ[i] = *(const u32x4*)(G.QD + ub + idx * 8); sK[i] = *(const u32x4*)(G.KDT + ub + idx * 8);
            sG[i] = *(const u32x4*)(gz + (size_t)(r16 + 32 * i) * 1024 + ch16); }
        sA = *(const u32x4*)(G.AT + (size_t)(bh * 32) * 4096 + tid * 8);
#pragma unroll
        for (int t = 0; t < 4; ++t) uhn[t] = *(const u32x2*)(G.UHT + ub + ((wid * 4 + t) * 64 + lane) * 4);
        gln = G.GL[bh * 32];
    }
    for (int n = 0; n < 32; ++n) {
        const int unit = bh * 32 + n;
        const size_t ub = (size_t)unit * 8192;
#pragma unroll
        for (int i = 0; i < 2; ++i) { const int idx = tid + 512 * i;
            *(u32x4*)(Wl + (idx >> 4) * PQ + (idx & 15) * 8) = sW[i]; *(u32x4*)(QDl + (idx >> 4) * PQ + (idx & 15) * 8) = sQ[i]; *(u32x4*)(KDTl + (idx >> 3) * PC + (idx & 7) * 8) = sK[i]; }
        *(u32x4*)(ATl + r8 * PC + ch8) = sA;
        const float gl = gln;
        u32x2 uh[4];
#pragma unroll
        for (int t = 0; t < 4; ++t) uh[t] = uhn[t];
        LBAR();
        const int nn = (n + 1 < 32) ? n + 1 : 31;
        { const size_t un = (size_t)(bh * 32 + nn) * 8192;
#pragma unroll
            for (int i = 0; i < 2; ++i) { const int idx = tid + 512 * i; sW[i] = *(const u32x4*)(G.W + un + idx * 8); sQ[i] = *(const u32x4*)(G.QD + un + idx * 8); sK[i] = *(const u32x4*)(G.KDT + un + idx * 8); }
            sA = *(const u32x4*)(G.AT + (size_t)(bh * 32 + nn) * 4096 + tid * 8);
#pragma unroll
            for (int t = 0; t < 4; ++t) uhn[t] = *(const u32x2*)(G.UHT + un + ((wid * 4 + t) * 64 + lane) * 4);
            gln = G.GL[bh * 32 + nn]; }
        { const int np = (n > 0) ? n - 1 : 0;
#pragma unroll
            for (int i = 0; i < 2; ++i) { const u32x4 v = *(const u32x4*)(GZl + (r16 + 32 * i) * PQ + ch16); *(u32x4*)(yg + (size_t)(np * 64 + r16 + 32 * i) * 1024 + ch16) = v; } }
        f32x4 ws[4], os[4];
#pragma unroll
        for (int t = 0; t < 4; ++t) { ws[t] = (f32x4){0.f, 0.f, 0.f, 0.f}; os[t] = (f32x4){0.f, 0.f, 0.f, 0.f}; }
#pragma unroll
        for (int ks = 0; ks < 4; ++ks) { const bf16x8 b = *(const bf16x8*)(ST + (16 * wid + c16) * PQ + ks * 32 + q4 * 8);
#pragma unroll
            for (int t = 0; t < 4; ++t) { const bf16x8 a = *(const bf16x8*)(Wl + (16 * t + c16) * PQ + ks * 32 + q4 * 8); ws[t] = __builtin_amdgcn_mfma_f32_16x16x32_bf16(a, b, ws[t], 0, 0, 0);
                const bf16x8 a2 = *(const bf16x8*)(QDl + (16 * t + c16) * PQ + ks * 32 + q4 * 8); os[t] = __builtin_amdgcn_mfma_f32_16x16x32_bf16(b, a2, os[t], 0, 0, 0); } }
#pragma unroll
        for (int t = 0; t < 4; ++t) { u32x2 w; w.x = pk2(bflo(uh[t].x) - ws[t][0], bfhi(uh[t].x) - ws[t][1]); w.y = pk2(bflo(uh[t].y) - ws[t][2], bfhi(uh[t].y) - ws[t][3]);
            *(u32x2*)(UTl + (16 * wid + c16) * PC + 16 * t + 4 * q4) = w; }
        LBAR();
#pragma unroll
        for (int i = 0; i < 2; ++i) *(u32x4*)(GZl + (r16 + 32 * i) * PQ + ch16) = sG[i];
#pragma unroll
        for (int i = 0; i < 2; ++i) sG[i] = *(const u32x4*)(gz + (size_t)(nn * 64 + r16 + 32 * i) * 1024 + ch16);
#pragma unroll
        for (int ks = 0; ks < 2; ++ks) { const bf16x8 b = *(const bf16x8*)(UTl + (16 * wid + c16) * PC + ks * 32 + q4 * 8);
#pragma unroll
            for (int t = 0; t < 4; ++t) { const bf16x8 a = *(const bf16x8*)(ATl + (16 * t + c16) * PC + ks * 32 + q4 * 8); os[t] = __builtin_amdgcn_mfma_f32_16x16x32_bf16(b, a, os[t], 0, 0, 0); } }
#pragma unroll
        for (int t = 0; t < 8; ++t) Sacc[t] = Sacc[t] * gl;
#pragma unroll
        for (int ks = 0; ks < 2; ++ks) { const bf16x8 a = *(const bf16x8*)(UTl + (16 * wid + c16) * PC + ks * 32 + q4 * 8);
#pragma unroll
            for (int t = 0; t < 8; ++t) { const bf16x8 b = *(const bf16x8*)(KDTl + (16 * t + c16) * PC + ks * 32 + q4 * 8); Sacc[t] = __builtin_amdgcn_mfma_f32_16x16x32_bf16(b, a, Sacc[t], 0, 0, 0); } }
#pragma unroll
        for (int t = 0; t < 8; ++t) { u32x2 w; w.x = pk2(Sacc[t][0], Sacc[t][1]); w.y = pk2(Sacc[t][2], Sacc[t][3]); *(u32x2*)(ST + (16 * wid + c16) * PQ + 16 * t + 4 * q4) = w; }
#pragma unroll
        for (int t = 0; t < 4; ++t) { float s = (os[t][0] * os[t][0] + os[t][1] * os[t][1]) + (os[t][2] * os[t][2] + os[t][3] * os[t][3]); s += __shfl_xor(s, 16); s += __shfl_xor(s, 32);
            if (q4 == 0) SSl[wid * 64 + 16 * t + c16] = s; }
        LBAR();
        float tot = 0.f;
#pragma unroll
        for (int w = 0; w < 8; ++w) tot += SSl[w * 64 + lane];
        const float rstd_l = rsqrtf(tot * (1.0f / 128.0f) + 1e-6f);
#pragma unroll
        for (int t = 0; t < 4; ++t) { const int row = 16 * t + c16; const float rs = __shfl(rstd_l, row);
            u32x2* gp = (u32x2*)(GZl + row * PQ + 16 * wid + 4 * q4); const u32x2 gw = *gp; u32x2 w;
            w.x = pk2(os[t][0] * rs * gn[0] * siluf(bflo(gw.x)), os[t][1] * rs * gn[1] * siluf(bfhi(gw.x)));
            w.y = pk2(os[t][2] * rs * gn[2] * siluf(bflo(gw.y)), os[t][3] * rs * gn[3] * siluf(bfhi(gw.y))); *gp = w; }
    }
    LBAR();
#pragma unroll
    for (int i = 0; i < 2; ++i) { const u32x4 v = *(const u32x4*)(GZl + (r16 + 32 * i) * PQ + ch16); *(u32x4*)(yg + (size_t)(31 * 64 + r16 + 32 * i) * 1024 + ch16) = v; }
    __syncthreads();
}

__device__ __forceinline__ void fox_item(char* lds, int item, const Ptrs& P, int tid) {
    using bf = fox::bf16;
    const int lane = tid & 63, wid = tid >> 6;
    const int bh = item >> 2, xq = item & 3, bl = bh >> 3, h = bh & 7;
    float* cb = (float*)(lds + fox::LDS_BYTES);
    float* tmp = cb + SEQ;
    const float* small = (const float*)(P.ws + WS_SMALL);
    {
        const float fb = P.fox_f_bias[h];
        float lf[4]; float run = 0.f;
#pragma unroll
        for (int e = 0; e < 4; ++e) { const float xv = small[(size_t)(bl * SEQ + 4 * tid + e) * 32 + h] + fb;
            const float l = (xv < -20.f) ? xv : -log1pf(__expf(-xv)); run += l; lf[e] = run; }
        float inc = run;
#pragma unroll
        for (int o = 1; o < 64; o <<= 1) { const float t = __shfl_up(inc, o); if (lane >= o) inc += t; }
        if (lane == 63) tmp[wid] = inc;
        __syncthreads();
        float off = inc - run;
        for (int w = 0; w < wid; ++w) off += tmp[w];
#pragma unroll
        for (int e = 0; e < 4; ++e) cb[4 * tid + e] = -(off + lf[e]) * 11.313708498984761f;
        __syncthreads();
    }
    bf* fq = (bf*)(P.ws + WS_PROJ); const bf* fk = fq + PROJ_STRIDE; const bf* fv = fq + 2 * PROJ_STRIDE;
    const size_t hb = (size_t)(bl * SEQ) * 1024 + h * HD;
    fox::BlockRef<bf, bf> b0, b1;
    bf* yo = (bf*)(P.ws + WS_YFOX);
    b0.Q = fq + hb + (size_t)(xq * 256) * 1024; b0.O = yo + hb + (size_t)(xq * 256) * 1024; b0.K = fk + hb; b0.V = fv + hb; b0.P0 = xq * 256;
    b1.Q = fq + hb + (size_t)((7 - xq) * 256) * 1024; b1.O = yo + hb + (size_t)((7 - xq) * 256) * 1024; b1.K = fk + hb; b1.V = fv + hb; b1.P0 = (7 - xq) * 256;
    fox::Seam<bf> S;
    fox::causal_swa_prime<bf, bf>(b0, 1 << 20, lds, S);
    fox::causal_swa_block<bf, bf>(b0, b1, SEQ, 1 << 20, lds, S, cb);
    fox::causal_swa_block<bf, bf>(b1, b1, SEQ, 1 << 20, lds, S, cb);
    __syncthreads();
}

__device__ __forceinline__ void phase_convgate(const Ptrs& P, int tid, int cid) {
    const bf16_t* up = (const bf16_t*)(P.ws + WS_UP); bf16_t* act = (bf16_t*)(P.ws + WS_ACT);
    constexpr int NFG = DFF / 8;
    constexpr int RPB = GM / 256;
    if (tid < NFG) {
        const int fg = tid, p = fg >> 4, i0 = (fg & 15) * 8, f0 = p * 128 + i0;
        const int cg0 = p * 256 + i0, cv0 = cg0 + 128;
        float wg[3][8], wv[3][8];
#pragma unroll
        for (int i = 0; i < 3; ++i)
#pragma unroll
            for (int j = 0; j < 8; ++j) { wg[i][j] = P.ffn_conv_w[i * NUP + f0 + j]; wv[i][j] = P.ffn_conv_w[i * NUP + DFF + f0 + j]; }
        const int r0 = cid * RPB;
        float g1[8], g2[8], v1[8], v2[8];
#pragma unroll
        for (int j = 0; j < 8; ++j) { g1[j] = 0.f; g2[j] = 0.f; v1[j] = 0.f; v2[j] = 0.f; }
        if ((r0 & (SEQ - 1)) != 0) {
            const u32x4 a1 = *(const u32x4*)(up + (size_t)(r0 - 1) * NUP + cg0), a2 = *(const u32x4*)(up + (size_t)(r0 - 2) * NUP + cg0);
            const u32x4 b1 = *(const u32x4*)(up + (size_t)(r0 - 1) * NUP + cv0), b2 = *(const u32x4*)(up + (size_t)(r0 - 2) * NUP + cv0);
            g1[0] = bflo(a1.x); g1[1] = bfhi(a1.x); g1[2] = bflo(a1.y); g1[3] = bfhi(a1.y); g1[4] = bflo(a1.z); g1[5] = bfhi(a1.z); g1[6] = bflo(a1.w); g1[7] = bfhi(a1.w);
            g2[0] = bflo(a2.x); g2[1] = bfhi(a2.x); g2[2] = bflo(a2.y); g2[3] = bfhi(a2.y); g2[4] = bflo(a2.z); g2[5] = bfhi(a2.z); g2[6] = bflo(a2.w); g2[7] = bfhi(a2.w);
            v1[0] = bflo(b1.x); v1[1] = bfhi(b1.x); v1[2] = bflo(b1.y); v1[3] = bfhi(b1.y); v1[4] = bflo(b1.z); v1[5] = bfhi(b1.z); v1[6] = bflo(b1.w); v1[7] = bfhi(b1.w);
            v2[0] = bflo(b2.x); v2[1] = bfhi(b2.x); v2[2] = bflo(b2.y); v2[3] = bfhi(b2.y); v2[4] = bflo(b2.z); v2[5] = bfhi(b2.z); v2[6] = bflo(b2.w); v2[7] = bfhi(b2.w);
        }
        for (int rb = 0; rb < RPB; rb += 8) {
            u32x4 ga[8], va[8];
#pragma unroll
            for (int r = 0; r < 8; ++r) { ga[r] = *(const u32x4*)(up + (size_t)(r0 + rb + r) * NUP + cg0); va[r] = *(const u32x4*)(up + (size_t)(r0 + rb + r) * NUP + cv0); }
#pragma unroll
            for (int r = 0; r < 8; ++r) {
                const u32x4 a = ga[r], b = va[r];
                float g0[8], v0[8];
                g0[0] = bflo(a.x); g0[1] = bfhi(a.x); g0[2] = bflo(a.y); g0[3] = bfhi(a.y); g0[4] = bflo(a.z); g0[5] = bfhi(a.z); g0[6] = bflo(a.w); g0[7] = bfhi(a.w);
                v0[0] = bflo(b.x); v0[1] = bfhi(b.x); v0[2] = bflo(b.y); v0[3] = bfhi(b.y); v0[4] = bflo(b.z); v0[5] = bfhi(b.z); v0[6] = bflo(b.w); v0[7] = bfhi(b.w);
                const bool s0 = ((r0 + rb + r) & (SEQ - 1)) == 0;
                float o[8];
#pragma unroll
                for (int j = 0; j < 8; ++j) { const float p1 = s0 ? 0.f : g1[j], p2 = s0 ? 0.f : g2[j], q1 = s0 ? 0.f : v1[j], q2 = s0 ? 0.f : v2[j];
                    const float cgv = wg[0][j] * p2 + wg[1][j] * p1 + wg[2][j] * g0[j]; const float cvv = wv[0][j] * q2 + wv[1][j] * q1 + wv[2][j] * v0[j];
                    o[j] = siluf(cgv) * cvv; g2[j] = p1; g1[j] = g0[j]; v2[j] = q1; v1[j] = v0[j]; }
                u32x4 w; w.x = pk2(o[0], o[1]); w.y = pk2(o[2], o[3]); w.z = pk2(o[4], o[5]); w.w = pk2(o[6], o[7]);
                *(u32x4*)(act + (size_t)(r0 + rb + r) * DFF + f0) = w;
            }
        }
    }
}

__device__ __forceinline__ void phase_final(const Ptrs& P, int tid, int cid, float pert) {
    const int lane = tid & 63, wave = tid >> 6;
    const int gw = cid * 8 + wave, NGW = 256 * 8;
    const float* rowss2 = (const float*)(P.ws + WS_CTL) + MTOK;
    f32x4 gv[4];
#pragma unroll
    for (int j = 0; j < 4; ++j) gv[j] = ((const f32x4*)P.norm_final)[lane + 64 * j];
    for (int m0 = gw; m0 < MTOK; m0 += 2 * NGW) {
        const int m1 = m0 + NGW;
        const float rstd0 = rsqrtf(rowss2[m0] * (1.f / DM) + 1e-6f), rstd1 = rsqrtf(rowss2[m1] * (1.f / DM) + 1e-6f);
        f32x4* o0 = (f32x4*)(P.out + (size_t)m0 * DM) + lane; f32x4* o1 = (f32x4*)(P.out + (size_t)m1 * DM) + lane;
        f32x4 a0[4], a1[4];
#pragma unroll
        for (int j = 0; j < 4; ++j) { a0[j] = o0[64 * j]; a1[j] = o1[64 * j]; }
#pragma unroll
        for (int j = 0; j < 4; ++j) { o0[64 * j] = a0[j] * rstd0 * gv[j] + pert; o1[64 * j] = a1[j] * rstd1 * gv[j] + pert; }
    }
}

#define LAS __attribute__((address_space(3)))
#define XB_TMO      128
#define XB_XCNT(j)  (256  + 64 * (j))
#define XB_XSUB(j)  (1280 + 64 * (j))
#define XB_XGEN(j)  (2304 + 64 * (j))
#define XB_TOP      3328
#define XB_TOPGEN   3392
#define XCD_BAR_WORDS 3456
#define XB_SPIN_CAP (1u << 18)

__device__ __forceinline__ unsigned xb_ld(unsigned* p)              { return __hip_atomic_load(p, __ATOMIC_RELAXED, __HIP_MEMORY_SCOPE_AGENT); }
__device__ __forceinline__ unsigned xb_add(unsigned* p, unsigned v) { return __hip_atomic_fetch_add(p, v, __ATOMIC_RELAXED, __HIP_MEMORY_SCOPE_AGENT); }
__device__ __forceinline__ unsigned xb_xcc_id() { return (unsigned)__builtin_amdgcn_s_getreg((3 << 11) | 20) & 0xFu; }
#define XB_SPIN(cond, bar) do { unsigned _sp = 0; while (cond) { __builtin_amdgcn_s_sleep(1); \
    if ((++_sp & 255u) == 0u) { if (xb_ld(&(bar)[XB_TMO])) break; if (_sp > XB_SPIN_CAP) { atomicAdd(&(bar)[XB_TMO], 1u); break; } } } } while (0)

struct XcdBarrier {
    unsigned* bar; unsigned x;
    volatile LAS unsigned* st;
};

__device__ __forceinline__ XcdBarrier xcd_barrier_post(unsigned* bar, volatile LAS unsigned* st) {
    XcdBarrier b; b.bar = bar; b.x = xb_xcc_id(); b.st = st;
    if (threadIdx.x == 0) (void)xb_add(&bar[XB_XCNT(b.x)], 1u);
    return b;
}
__device__ __forceinline__ void xcd_barrier_complete(unsigned* bar, unsigned x, unsigned& nloc, unsigned& nx) {
    const unsigned G = gridDim.x * gridDim.y * gridDim.z;
    unsigned sum, cnt, mine, sp = 0u;
    for (;;) {
        sum = 0u; cnt = 0u; mine = 0u;
#pragma unroll
        for (unsigned j = 0; j < 16; ++j) { const unsigned c = xb_ld(&bar[XB_XCNT(j)]); sum += c; cnt += (c > 0u) ? 1u : 0u; mine = (j == x) ? c : mine; }
        if (sum == G) break;
        __builtin_amdgcn_s_sleep(1);
        if ((++sp & 255u) == 0u) { if (xb_ld(&bar[XB_TMO])) break; if (sp > XB_SPIN_CAP) { atomicAdd(&bar[XB_TMO], 1u); break; } }
    }
    nloc = mine > 0u ? mine : 1u; nx = cnt > 0u ? cnt : 1u;
}

__device__ __forceinline__ void xcd_barrier(const XcdBarrier& b) {
    asm volatile("s_waitcnt vmcnt(0)" ::: "memory");
    __syncthreads();
    if (threadIdx.x == 0) {
        unsigned* bar = b.bar;
        __builtin_amdgcn_s_waitcnt(0);
        unsigned nloc = b.st[0], nx = b.st[1];
        if (nloc == 0u) { xcd_barrier_complete(bar, b.x, nloc, nx); b.st[0] = nloc; b.st[1] = nx; }
        const unsigned old = xb_add(&bar[XB_XSUB(b.x)], 1u);
        const unsigned gen = old / nloc;
        if (old + 1u == (gen + 1u) * nloc) {
            __builtin_amdgcn_fence(__ATOMIC_RELEASE, "agent");
            asm volatile("s_waitcnt vmcnt(0)" ::: "memory");
            const unsigned og = xb_add(&bar[XB_TOP], 1u);
            const unsigned tg = og / nx;
            if (og + 1u == (tg + 1u) * nx) xb_add(&bar[XB_TOPGEN], 1u);
            else XB_SPIN(xb_ld(&bar[XB_TOPGEN]) == tg, bar);
            __builtin_amdgcn_fence(__ATOMIC_ACQUIRE, "agent");
            xb_add(&bar[XB_XGEN(b.x)], 1u);
            asm volatile("s_waitcnt vmcnt(0)" ::: "memory");
        } else {
            XB_SPIN(xb_ld(&bar[XB_XGEN(b.x)]) == gen, bar);
            __builtin_amdgcn_fence(__ATOMIC_ACQUIRE, "agent");
            asm volatile("s_waitcnt vmcnt(0)" ::: "memory");
        }
    }
    __syncthreads();
}

constexpr int N_PHASES = 2 + 8 * NG;
#ifndef PHM
#define PHM 2047
#endif
#ifndef DBL
#define DBL 0
#endif
#define DBLSEL 2
#ifndef TSTAMP
#define TSTAMP 0
#endif
#define TS_MASK 0x200
__global__ void __launch_bounds__(512, 2) mk_fwd(Args args) {
    extern __shared__ __attribute__((aligned(16))) unsigned char lds_raw[];
    char* lds = (char*)lds_raw;
    cg::grid_group grid = cg::this_grid();
    volatile LAS unsigned* xst = (volatile LAS unsigned*)((LAS unsigned char*)lds_raw + (LDS_BYTES - 16));
    if (threadIdx.x < 4) xst[threadIdx.x] = 0u;
    __syncthreads();
    XcdBarrier xbar; xbar.bar = (unsigned*)(args.ws + WS_CTL + 800 * 1024); xbar.x = 0; xbar.st = xst;
    constexpr int G = 256;
    for (int ph = args.ph_lo; ph < args.ph_hi; ++ph) {
      {
        int tid = threadIdx.x; asm volatile("" : "+v"(tid));
        int cid = blockIdx.x; asm volatile("" : "+s"(cid));
        typedef const __attribute__((address_space(4))) Args* KArgsP;
        KArgsP kp = (KArgsP)__builtin_amdgcn_kernarg_segment_ptr(); asm volatile("" : "+s"(kp));
#define GPTR(T, v) ((T*)(__attribute__((address_space(1))) T*)(v))
        Ptrs P;
        P.x = GPTR(const float, kp->in[0]); P.norm_mix = GPTR(const float, kp->in[1]); P.w_in = GPTR(const float, kp->in[2]); P.fox_f_bias = GPTR(const float, kp->in[3]);
        P.gdn_conv_w = GPTR(const float, kp->in[4]); P.gdn_a_log = GPTR(const float, kp->in[5]); P.gdn_dt_bias = GPTR(const float, kp->in[6]); P.gdn_norm = GPTR(const float, kp->in[7]);
        P.w_bf = GPTR(const float, kp->in[8]); P.w_bg = GPTR(const float, kp->in[9]); P.w_out = GPTR(const float, kp->in[10]); P.norm_ffn = GPTR(const float, kp->in[11]);
        P.w_up = GPTR(const float, kp->in[12]); P.ffn_conv_w = GPTR(const float, kp->in[13]); P.w_down = GPTR(const float, kp->in[14]); P.norm_final = GPTR(const float, kp->in[15]);
        P.out = GPTR(float, kp->out); unsigned char* ws = GPTR(unsigned char, kp->ws); P.ws = ws;
        float* rowss1 = (float*)(ws + WS_CTL); float* rowss2 = rowss1 + MTOK;
        if (ph == 0) { if (PHM & 1) phase_prologue(P, lds, tid, cid);
            if (MK_ONE_LAUNCH) {
                unsigned* cz = (unsigned*)(ws + WS_CTL); for (int i = cid * 512 + tid; i < 131072; i += G * 512) cz[i] = 0u;
                if (cid == 0) { unsigned* bz = (unsigned*)(ws + WS_CTL + 800 * 1024); for (int i = tid; i < XCD_BAR_WORDS; i += 512) bz[i] = 0u; } } }
        else if (ph == N_PHASES - 1) {
            const float pert = 0.f;
            if (PHM & 2) phase_final(P, tid, cid, pert); }
        else {
            const int grp = (ph - 1) >> 3, sub = (ph - 1) & 7;
            const size_t r0g = (size_t)grp * GM;
            pg8::bf16_t* proj = (pg8::bf16_t*)(ws + WS_PROJ);
            if (sub == 0 && (PHM & 4)) {
                pg8::Gemm g{(const pg8::bf16_t*)(P.out + r0g * DM), nullptr, (const pg8::bf16_t*)(ws + WS_WIN), nullptr, GM, NIN, DM};
                pg8::StaticOrder S; S.init(GM, NIN, G, cid);
                pg8::EpiIn E{proj, (float*)(ws + WS_SMALL)};
                pg8::gemm_phase<pg8::EpiIn, pg8::StaticOrder, true, true>((PG8_LAS unsigned char*)lds_raw, g, S, E);
            } else if (sub == 1 && (PHM & 8)) {
                { const int hh = (cid >> 5) & 7;
                  float* cwl = (float*)(lds + PL_CW);
                  for (int i = tid; i < 3 * 4 * 128; i += 512) { const int part = i / 512, tap = (i >> 7) & 3, ch = i & 127; cwl[i] = P.gdn_conv_w[tap * 3072 + part * 1024 + hh * HD + ch]; }
                  PrepStage st; prep_fetch(st, cid, P, tid);
                  for (int u = cid; u < NCH; u += G) { const int un = (u + G < NCH) ? u + G : u; gdn_prep_unit(lds, u, un, st, P, tid); } }
            } else if (sub == 2) {
                if ((PHM & 32)) for (int bh = cid; bh < BG * NH; bh += G) gdn_seq_unit(lds, bh, P, tid);
                if ((PHM & 16)) { const bool sq = cid < BG * NH; const int first = sq ? cid * 4 : (cid - BG * NH) * 4 + 1, cnt = sq ? 1 : 3; for (int x = 0; x < cnt; ++x) fox_item(lds, first + x, P, tid); }
            } else if (sub == 3 && (PHM & 64)) {
                pg8::Gemm g{(const pg8::bf16_t*)(ws + WS_YFOX), (const pg8::bf16_t*)(ws + WS_YGDN), (const pg8::bf16_t*)(ws + WS_WBF), (const pg8::bf16_t*)(ws + WS_WBG), GM, DM, DM};
                pg8::PairOrder S; S.init(GM, DM, G, cid);
                pg8::EpiY E{proj + 7 * PROJ_STRIDE, proj + 8 * PROJ_STRIDE, (pg8::bf16_t*)(ws + WS_T1), (pg8::bf16_t*)(ws + WS_Y)};
                pg8::gemm_phase<pg8::EpiY, pg8::PairOrder, true, true>((PG8_LAS unsigned char*)lds_raw, g, S, E);
            } else if (sub == 4 && (PHM & 128)) {
                pg8::Gemm g{(const pg8::bf16_t*)(ws + WS_Y), nullptr, (const pg8::bf16_t*)(ws + WS_WOUT), nullptr, GM, DM, DM};
                pg8::StaticOrder S; S.init(GM, DM, G, cid);
                pg8::EpiOut E{P.x + r0g * DM, P.out + r0g * DM, (pg8::bf16_t*)(ws + WS_H1B), rowss1 + r0g};
                pg8::gemm_phase<pg8::EpiOut, pg8::StaticOrder, true, true>((PG8_LAS unsigned char*)lds_raw, g, S, E);
            } else if (sub == 5 && (PHM & 256)) {
                pg8::Gemm g{(const pg8::bf16_t*)(ws + WS_H1B), nullptr, (const pg8::bf16_t*)(ws + WS_WUP), nullptr, GM, NUP, DM};
                pg8::StaticOrder S; S.init(GM, NUP, G, cid);
                pg8::EpiUp E{(pg8::bf16_t*)(ws + WS_UP), rowss1 + r0g, NUP};
                pg8::gemm_phase<pg8::EpiUp, pg8::StaticOrder, true, true>((PG8_LAS unsigned char*)lds_raw, g, S, E);
            } else if (sub == 6) {
                if (PHM & 512) phase_convgate(P, tid, cid);
            } else if (PHM & 1024) {
                pg8::Gemm g{(const pg8::bf16_t*)(ws + WS_ACT), nullptr, (const pg8::bf16_t*)(ws + WS_WDN), nullptr, GM, DM, DFF};
                pg8::StaticOrder S; S.init(GM, DM, G, cid);
                pg8::EpiDown E{P.out + r0g * DM, rowss2 + r0g};
                pg8::gemm_phase<pg8::EpiDown, pg8::StaticOrder, true, true>((PG8_LAS unsigned char*)lds_raw, g, S, E);
            }
        }
      }
        if (ph + 1 < args.ph_hi) { if (ph == args.ph_lo) { grid.sync(); xbar = xcd_barrier_post((unsigned*)(args.ws + WS_CTL + 800 * 1024), xst); } else xcd_barrier(xbar); }
    }
}

extern "C" void kernel_launch(void* const* d_in, const int* in_sizes, int n_in, void* d_out, int out_size, void* d_ws, size_t ws_size, hipStream_t stream) {
    static int ready = 0;
    if (ready == 0) {
        if (n_in != 16 || in_sizes[0] != MTOK * DM || out_size != MTOK * DM || ws_size < WS_END) {
            fprintf(stderr, "kernel_launch: unexpected shapes (n_in %d, in0 %d, out %d, ws %zu; need ws >= %zu)\n", n_in, n_in > 0 ? in_sizes[0] : -1, out_size, ws_size, (size_t)WS_END); ready = -1; return; }
        if (hipFuncSetAttribute((const void*)mk_fwd, hipFuncAttributeMaxDynamicSharedMemorySize, LDS_BYTES) != hipSuccess) { fprintf(stderr, "kernel_launch: hipFuncSetAttribute failed\n"); ready = -1; return; }
        int per_cu = 0;
        if (hipOccupancyMaxActiveBlocksPerMultiprocessor(&per_cu, (const void*)mk_fwd, 512, LDS_BYTES) != hipSuccess || per_cu < 1) fprintf(stderr, "kernel_launch: occupancy query says %d blocks per CU\n", per_cu);
        (void)hipGetLastError();
        ready = 1;
    }
    if (ready < 0) return;
#if !MK_ONE_LAUNCH
    (void)hipMemsetAsync((char*)d_ws + WS_CTL, 0, 1 * MiB, stream);
#endif
    Args a{};
    for (int i = 0; i < 16; ++i) a.in[i] = (const float*)d_in[i];
    a.out = (float*)d_out; a.ws = (unsigned char*)d_ws;
#if MK_ONE_LAUNCH
    a.ph_lo = 0; a.ph_hi = N_PHASES;
    void* kargs[] = {&a};
    hipError_t e = hipLaunchCooperativeKernel((const void*)mk_fwd, dim3(256), dim3(512), kargs, LDS_BYTES, stream);
    if (e != hipSuccess) fprintf(stderr, "kernel_launch: cooperative launch failed: %s\n", hipGetErrorString(e));
#else
    for (int ph = 0; ph < N_PHASES; ++ph) { a.ph_lo = ph; a.ph_hi = ph + 1; hipLaunchKernelGGL(mk_fwd, dim3(256), dim3(512), LDS_BYTES, stream, a); }
#endif
}
```

```cpp
#include <hip/hip_runtime.h>
#include <hip/hip_bf16.h>
#include <hip/hip_cooperative_groups.h>
#include <cstdio>
#include <cstdint>
namespace cg = cooperative_groups;

#ifndef MK_ONE_LAUNCH
#define MK_ONE_LAUNCH 1
#endif

namespace pg8 {
#define PG8_LAS __attribute__((address_space(3)))
typedef unsigned short bf16_t;
typedef short bf16x8 __attribute__((ext_vector_type(8)));
typedef float f32x4 __attribute__((ext_vector_type(4)));
typedef unsigned u32x4 __attribute__((ext_vector_type(4)));
constexpr int BM = 256, BK = 64, HALF = 128, HTB = HALF * BK * 2  , STAGE_BYTES = 8 * HTB, NXCD = 8, WGM = 8;

__host__ __device__ __forceinline__ int lds_byte(int r, int c) { const int st = (r >> 4) * 2 + (c >> 5), rr = r & 15, cc = c & 31, ob = rr * 64 + cc * 2; return st * 1024 + (ob ^ (((ob >> 9) & 1) << 5)); }
__host__ __device__ __forceinline__ void stage_rc(int b, int& R, int& C) { const int st = b / 1024, sb = b % 1024, swz = sb ^ (((sb >> 9) & 1) << 5); R = (st >> 1) * 16 + swz / 64; C = (st & 1) * 32 + (swz % 64) / 2; }
__host__ __device__ __forceinline__ int perm32(int rho) { const int n = rho >> 4, i = rho & 15; return 8 * (i >> 2) + 4 * n + (i & 3); }

struct Unit { int pm, pn, sel; };
struct Gemm { const bf16_t* A0; const bf16_t* A1; const bf16_t* B0; const bf16_t* B1; int M, N, K; };

struct StaticOrder {
    int nM, nN, nwg, G, c;
    __host__ __device__ __forceinline__ void init(int M, int N, int G_, int c_) { nM = M / BM; nN = N / BM; nwg = nM * nN; G = G_; c = c_; }
    __host__ __device__ __forceinline__ bool next(int i, Unit& u) const {
        const long L = (long)i * G + c; if (L >= nwg) return false;
        int wgid = (int)L; { const int q = nwg / NXCD, r = nwg % NXCD, xcd = wgid % NXCD, off = wgid / NXCD; wgid = (xcd < r ? xcd * (q + 1) : r * (q + 1) + (xcd - r) * q) + off; }
        const int nig = WGM * nN, gid = wgid / nig, fm = gid * WGM, gsz = (nM - fm) < WGM ? (nM - fm) : WGM;
        u.pm = fm + ((wgid % nig) % gsz); u.pn = (wgid % nig) / gsz; u.sel = 0; return true;
    }
    __device__ __forceinline__ void a_ready(const Unit&) const {}
    __device__ __forceinline__ void done(const Unit&) const {}
};

__device__ __forceinline__ unsigned cvt_pk_bf16(float lo, float hi) { unsigned r; asm volatile("v_cvt_pk_bf16_f32 %0, %1, %2" : "=v"(r) : "v"(lo), "v"(hi)); return r; }
typedef unsigned u32x2 __attribute__((ext_vector_type(2)));
__device__ __forceinline__ float bflo(unsigned w) { return __uint_as_float(w << 16); }
__device__ __forceinline__ float bfhi(unsigned w) { return __uint_as_float(w & 0xffff0000u); }
__device__ __forceinline__ float sigm(float x) { return __builtin_amdgcn_rcpf(1.0f + __expf(-x)); }
constexpr int GM = 32768;
constexpr int LDP = 1024;

struct EpiIn {
    static constexpr bool PERM = true, AFTER_DRAIN = false;
    bf16_t* proj; float* small;
    __device__ __forceinline__ void operator()(const f32x4 (&acc)[2][2][4][2], const Unit& u, int wr, int wc, int fr, int fq) const {
        const int row0 = u.pm * BM + wr * 64 + fr;
        if (u.pn < 36) {
            bf16_t* base = proj + (size_t)(u.pn >> 2) * ((size_t)GM * LDP) + (u.pn & 3) * 256 + wc * 32 + 8 * fq;
#pragma unroll
            for (int ai = 0; ai < 2; ++ai)
#pragma unroll
                for (int m = 0; m < 4; ++m) { bf16_t* rowp = base + (size_t)(row0 + ai * HALF + m * 16) * LDP;
#pragma unroll
                    for (int bj = 0; bj < 2; ++bj) { const f32x4 v0 = acc[ai][bj][m][0], v1 = acc[ai][bj][m][1];
                        u32x4 w; w.x = cvt_pk_bf16(v0[0], v0[1]); w.y = cvt_pk_bf16(v0[2], v0[3]); w.z = cvt_pk_bf16(v1[0], v1[1]); w.w = cvt_pk_bf16(v1[2], v1[3]);
                        *(u32x4*)(rowp + bj * HALF) = w; } }
        } else if (wc == 0 && fq < 3) {
#pragma unroll
            for (int ai = 0; ai < 2; ++ai)
#pragma unroll
                for (int m = 0; m < 4; ++m) { float* p = small + (size_t)(row0 + ai * HALF + m * 16) * 32 + 8 * fq;
                    *(f32x4*)p = acc[ai][0][m][0]; *(f32x4*)(p + 4) = acc[ai][0][m][1]; }
        }
    }
};
struct EpiY {
    static constexpr bool PERM = true, AFTER_DRAIN = false;
    const bf16_t* gf; const bf16_t* gg; bf16_t* t1; bf16_t* y;
    __device__ __forceinline__ void operator()(const f32x4 (&acc)[2][2][4][2], const Unit& u, int wr, int wc, int fr, int fq) const {
        const int row0 = u.pm * BM + wr * 64 + fr, col0 = u.pn * BM + wc * 32 + 8 * fq;
        const bf16_t* const gf_ = gf; const bf16_t* const gg_ = gg; bf16_t* const t1_ = t1; bf16_t* const y_ = y;
        const bf16_t* gate = u.sel ? gg_ : gf_; bf16_t* dst = u.sel ? y_ : t1_;
        if (u.sel) asm volatile("s_waitcnt vmcnt(0)" ::: "memory");
#pragma unroll
        for (int ai = 0; ai < 2; ++ai) {
            u32x4 gw[4][2], tw[4][2];
#pragma unroll
            for (int m = 0; m < 4; ++m)
#pragma unroll
                for (int bj = 0; bj < 2; ++bj) { const size_t o = (size_t)(row0 + ai * HALF + m * 16) * LDP + col0 + bj * HALF;
                    gw[m][bj] = *(const u32x4*)(gate + o); tw[m][bj] = u.sel ? *(const u32x4*)(t1_ + o) : (u32x4){0u, 0u, 0u, 0u}; }
#pragma unroll
            for (int m = 0; m < 4; ++m)
#pragma unroll
                for (int bj = 0; bj < 2; ++bj) { const size_t o = (size_t)(row0 + ai * HALF + m * 16) * LDP + col0 + bj * HALF;
                    const u32x4 g = gw[m][bj], t = tw[m][bj]; const f32x4 v0 = acc[ai][bj][m][0], v1 = acc[ai][bj][m][1];
                    const float r0 = sigm(bflo(g.x)) * v0[0] + bflo(t.x), r1 = sigm(bfhi(g.x)) * v0[1] + bfhi(t.x), r2 = sigm(bflo(g.y)) * v0[2] + bflo(t.y), r3 = sigm(bfhi(g.y)) * v0[3] + bfhi(t.y);
                    const float r4 = sigm(bflo(g.z)) * v1[0] + bflo(t.z), r5 = sigm(bfhi(g.z)) * v1[1] + bfhi(t.z), r6 = sigm(bflo(g.w)) * v1[2] + bflo(t.w), r7 = sigm(bfhi(g.w)) * v1[3] + bfhi(t.w);
                    u32x4 w; w.x = cvt_pk_bf16(r0, r1); w.y = cvt_pk_bf16(r2, r3); w.z = cvt_pk_bf16(r4, r5); w.w = cvt_pk_bf16(r6, r7);
                    *(u32x4*)(dst + o) = w; }
        }
    }
};
struct EpiOut {
    static constexpr bool PERM = true, AFTER_DRAIN = false;
    const float* xin; float* hout; bf16_t* h1b; float* rowss;
    __device__ __forceinline__ void operator()(const f32x4 (&acc)[2][2][4][2], const Unit& u, int wr, int wc, int fr, int fq) const {
        const int col0 = u.pn * BM + wc * 32 + 8 * fq;
#pragma unroll
        for (int ai = 0; ai < 2; ++ai) {
            f32x4 pre[4][2][2];
#pragma unroll
            for (int m = 0; m < 4; ++m)
#pragma unroll
                for (int bj = 0; bj < 2; ++bj) { const size_t o = (size_t)(u.pm * BM + ai * HALF + wr * 64 + m * 16 + fr) * LDP + col0 + bj * HALF; pre[m][bj][0] = *(const f32x4*)(xin + o); pre[m][bj][1] = *(const f32x4*)(xin + o + 4); }
#pragma unroll
            for (int m = 0; m < 4; ++m) { const int row = u.pm * BM + ai * HALF + wr * 64 + m * 16 + fr; const size_t ro = (size_t)row * LDP + col0; float ss = 0.f;
#pragma unroll
                for (int bj = 0; bj < 2; ++bj) { const size_t o = ro + bj * HALF;
                    const f32x4 h0 = pre[m][bj][0] + acc[ai][bj][m][0], h1 = pre[m][bj][1] + acc[ai][bj][m][1];
                    *(f32x4*)(hout + o) = h0; *(f32x4*)(hout + o + 4) = h1;
                    u32x4 w; w.x = cvt_pk_bf16(h0[0], h0[1]); w.y = cvt_pk_bf16(h0[2], h0[3]); w.z = cvt_pk_bf16(h1[0], h1[1]); w.w = cvt_pk_bf16(h1[2], h1[3]); *(u32x4*)(h1b + o) = w;
                    ss += (h0[0] * h0[0] + h0[1] * h0[1]) + (h0[2] * h0[2] + h0[3] * h0[3]) + (h1[0] * h1[0] + h1[1] * h1[1]) + (h1[2] * h1[2] + h1[3] * h1[3]); }
                ss += __shfl_xor(ss, 16); ss += __shfl_xor(ss, 32);
                if (fq == 0) atomicAdd(rowss + row, ss); }
        }
    }
};
struct EpiUp {
    static constexpr bool PERM = true, AFTER_DRAIN = false;
    bf16_t* up; const float* rowss; int ldc;
    __device__ __forceinline__ void operator()(const f32x4 (&acc)[2][2][4][2], const Unit& u, int wr, int wc, int fr, int fq) const {
        const int row0 = u.pm * BM + wr * 64 + fr, col0 = u.pn * BM + wc * 32 + 8 * fq;
        float rsv[2][4];
#pragma unroll
        for (int ai = 0; ai < 2; ++ai)
#pragma unroll
            for (int m = 0; m < 4; ++m) rsv[ai][m] = rowss[row0 + ai * HALF + m * 16];
#pragma unroll
        for (int ai = 0; ai < 2; ++ai)
#pragma unroll
            for (int m = 0; m < 4; ++m) { const int row = row0 + ai * HALF + m * 16; const float rs = rsqrtf(rsv[ai][m] * (1.0f / 1024.0f) + 1e-6f); bf16_t* rowp = up + (size_t)row * ldc + col0;
#pragma unroll
                for (int bj = 0; bj < 2; ++bj) { const f32x4 v0 = acc[ai][bj][m][0] * rs, v1 = acc[ai][bj][m][1] * rs;
                    u32x4 w; w.x = cvt_pk_bf16(v0[0], v0[1]); w.y = cvt_pk_bf16(v0[2], v0[3]); w.z = cvt_pk_bf16(v1[0], v1[1]); w.w = cvt_pk_bf16(v1[2], v1[3]);
                    *(u32x4*)(rowp + bj * HALF) = w; } }
    }
};
struct EpiDown {
    static constexpr bool PERM = true, AFTER_DRAIN = false;
    float* hio; float* rowss;
    __device__ __forceinline__ void operator()(const f32x4 (&acc)[2][2][4][2], const Unit& u, int wr, int wc, int fr, int fq) const {
        const int col0 = u.pn * BM + wc * 32 + 8 * fq;
#pragma unroll
        for (int ai = 0; ai < 2; ++ai) {
            f32x4 pre[4][2][2];
#pragma unroll
            for (int m = 0; m < 4; ++m)
#pragma unroll
                for (int bj = 0; bj < 2; ++bj) { const size_t o = (size_t)(u.pm * BM + ai * HALF + wr * 64 + m * 16 + fr) * LDP + col0 + bj * HALF; pre[m][bj][0] = *(const f32x4*)(hio + o); pre[m][bj][1] = *(const f32x4*)(hio + o + 4); }
#pragma unroll
            for (int m = 0; m < 4; ++m) { const int row = u.pm * BM + ai * HALF + wr * 64 + m * 16 + fr; const size_t ro = (size_t)row * LDP + col0; float ss = 0.f;
#pragma unroll
                for (int bj = 0; bj < 2; ++bj) { const size_t o = ro + bj * HALF;
                    const f32x4 h0 = pre[m][bj][0] + acc[ai][bj][m][0], h1 = pre[m][bj][1] + acc[ai][bj][m][1];
                    *(f32x4*)(hio + o) = h0; *(f32x4*)(hio + o + 4) = h1;
                    ss += (h0[0] * h0[0] + h0[1] * h0[1]) + (h0[2] * h0[2] + h0[3] * h0[3]) + (h1[0] * h1[0] + h1[1] * h1[1]) + (h1[2] * h1[2] + h1[3] * h1[3]); }
                ss += __shfl_xor(ss, 16); ss += __shfl_xor(ss, 32);
                if (fq == 0) atomicAdd(rowss + row, ss); }
        }
    }
};
struct PairOrder {
    int nM, nN, nwg, G, c;
    __host__ __device__ __forceinline__ void init(int M, int N, int G_, int c_) { nM = M / BM; nN = N / BM; nwg = nM * nN; G = G_; c = c_; }
    __host__ __device__ __forceinline__ bool next(int i, Unit& u) const {
        const long L = (long)(i >> 1) * G + c; if (L >= nwg) return false;
        int wgid = (int)L; { const int q = nwg / NXCD, r = nwg % NXCD, xcd = wgid % NXCD, off = wgid / NXCD; wgid = (xcd < r ? xcd * (q + 1) : r * (q + 1) + (xcd - r) * q) + off; }
        const int nig = WGM * nN, gid = wgid / nig, fm = gid * WGM, gsz = (nM - fm) < WGM ? (nM - fm) : WGM;
        u.pm = fm + ((wgid % nig) % gsz); u.pn = (wgid % nig) / gsz; u.sel = i & 1; return true;
    }
    __device__ __forceinline__ void a_ready(const Unit&) const {}
    __device__ __forceinline__ void done(const Unit&) const {}
};
template <class Epi, class Sched, bool ALIGN_EPI = false, bool SP2 = false>
__device__ __forceinline__ void gemm_phase(PG8_LAS unsigned char* lds, const Gemm g, const Sched& S, const Epi& E) {
    int tid_l = threadIdx.x; asm volatile("" : "+v"(tid_l));
    const int tid = tid_l, wid = __builtin_amdgcn_readfirstlane(tid >> 6), lane = tid & 63, wr = wid >> 2, wc = wid & 3, fr = lane & 15, fq = lane >> 4;
    const int K = g.K, nt = K / BK;
    unsigned voffA[2], voffB[2];
#pragma unroll
    for (int i = 0; i < 2; ++i) { int R, C; stage_rc(tid * 16 + i * 8192, R, C); const int Rb = Epi::PERM ? ((R & ~31) + perm32(R & 31)) : R;
        voffA[i] = (unsigned)(R * K + C) * 2u; voffB[i] = (unsigned)(Rb * K + C) * 2u; }
    const size_t kstep = (size_t)(BK * 2);
    const size_t hstep = (size_t)HALF * K * 2;
    const size_t tstep = 2 * hstep;
    const unsigned ldsw = (unsigned)wid * 1024u;
    const int aoff = lds_byte(wr * 64 + fr, fq * 8), boff = lds_byte(wc * 32 + fr, fq * 8);
#define PG8_SA(b, h) (((b) * 2 + (h)) * HTB)
#define PG8_SB(b, h) ((4 + (b) * 2 + (h)) * HTB)
#define PG8_STAGE(bufoff, gbase, voff) do { _Pragma("unroll") for (int _i = 0; _i < 2; ++_i) \
        __builtin_amdgcn_global_load_lds((const unsigned*)((const char*)(gbase) + (voff)[_i]), (PG8_LAS unsigned*)(lds + (bufoff) + ldsw + _i * 8192), 16, 0, 0); } while (0)
#define PG8_LDA(dst, b, h) do { _Pragma("unroll") for (int m = 0; m < 4; ++m) _Pragma("unroll") for (int k = 0; k < 2; ++k) dst[m][k] = *(const PG8_LAS bf16x8*)(lds + PG8_SA(b, h) + aoff + m * 2048 + k * 1024); } while (0)
#define PG8_LDB(dst, b, h) do { _Pragma("unroll") for (int n = 0; n < 2; ++n) _Pragma("unroll") for (int k = 0; k < 2; ++k) dst[n][k] = *(const PG8_LAS bf16x8*)(lds + PG8_SB(b, h) + boff + n * 2048 + k * 1024); } while (0)
#define PG8_MMA(ai, bj, At, Bt) do { __builtin_amdgcn_s_setprio(1); _Pragma("unroll") for (int m = 0; m < 4; ++m) _Pragma("unroll") for (int n = 0; n < 2; ++n) _Pragma("unroll") for (int k = 0; k < 2; ++k) \
        acc[ai][bj][m][n] = __builtin_amdgcn_mfma_f32_16x16x32_bf16(Bt[n][k], At[m][k], acc[ai][bj][m][n], 0, 0, 0); __builtin_amdgcn_s_setprio(0); } while (0)
#define PG8_WAIT_V(n) asm volatile("s_waitcnt vmcnt(" #n ")" ::: "memory")
#define PG8_WAIT_L(n) asm volatile("s_waitcnt lgkmcnt(" #n ")" ::: "memory")
#define PG8_BAR __builtin_amdgcn_s_barrier()
#define PG8_SCHED __builtin_amdgcn_sched_barrier(0)
    Unit cur, nxt; int ui = 0;
    if (!S.next(0, cur)) return;
    f32x4 acc[2][2][4][2];
#pragma unroll
    for (int a = 0; a < 2; ++a)
#pragma unroll
        for (int b = 0; b < 2; ++b)
#pragma unroll
            for (int m = 0; m < 4; ++m)
#pragma unroll
                for (int n = 0; n < 2; ++n) acc[a][b][m][n] = (f32x4){0.f, 0.f, 0.f, 0.f};
    bf16x8 At[4][2], B0[2][2], B1[2][2];
    const char* cA = (const char*)(cur.sel ? g.A1 : g.A0) + (size_t)cur.pm * tstep; const char* cB = (const char*)(cur.sel ? g.B1 : g.B0) + (size_t)cur.pn * tstep;
    S.a_ready(cur);
    if constexpr (SP2) {
        PG8_STAGE(PG8_SB(0, 0), cB, voffB); PG8_STAGE(PG8_SB(0, 1), cB + hstep, voffB); PG8_STAGE(PG8_SA(0, 0), cA, voffA); PG8_STAGE(PG8_SA(0, 1), cA + hstep, voffA);
        if (wr == 1) PG8_BAR;
        PG8_WAIT_V(2); PG8_BAR;
        PG8_STAGE(PG8_SB(1, 0), cB + kstep, voffB); PG8_STAGE(PG8_SA(1, 0), cA + kstep, voffA); PG8_STAGE(PG8_SB(1, 1), cB + hstep + kstep, voffB);
        PG8_WAIT_V(6); PG8_BAR;
    } else {
        PG8_STAGE(PG8_SB(0, 0), cB, voffB); PG8_STAGE(PG8_SA(0, 0), cA, voffA); PG8_STAGE(PG8_SB(0, 1), cB + hstep, voffB); PG8_STAGE(PG8_SA(0, 1), cA + hstep, voffA);
        if (wr == 1) PG8_BAR;
        PG8_WAIT_V(4); PG8_BAR;
        PG8_STAGE(PG8_SB(1, 0), cB + kstep, voffB); PG8_STAGE(PG8_SA(1, 0), cA + kstep, voffA); PG8_STAGE(PG8_SB(1, 1), cB + hstep + kstep, voffB);
        PG8_WAIT_V(6); PG8_BAR;
    }
    for (;;) {
        const bool has_next = S.next(ui + 1, nxt);
        const char* nA = has_next ? (const char*)(nxt.sel ? g.A1 : g.A0) + (size_t)nxt.pm * tstep : cA; const char* nB = has_next ? (const char*)(nxt.sel ? g.B1 : g.B0) + (size_t)nxt.pn * tstep : cB;
        for (int t = 0; t < nt; t += 2) {
            const bool last = (t == nt - 2);
            const char* a1 = cA + (size_t)(t + 1) * kstep;
            const char* a2 = last ? nA : cA + (size_t)(t + 2) * kstep; const char* b2 = last ? nB : cB + (size_t)(t + 2) * kstep;
            const char* a3 = a2 + kstep; const char* b3 = b2 + kstep;
            if (last && has_next) S.a_ready(nxt);
            if constexpr (SP2) {
            PG8_LDB(B0, 0, 0); PG8_LDB(B1, 0, 1); PG8_SCHED; PG8_LDA(At, 0, 0); PG8_STAGE(PG8_SA(1, 1), a1 + hstep, voffA);
            PG8_WAIT_V(8); PG8_WAIT_L(0); PG8_BAR; PG8_MMA(0, 0, At, B0); PG8_MMA(0, 1, At, B1); PG8_BAR; PG8_SCHED;
            PG8_LDA(At, 0, 1); PG8_STAGE(PG8_SB(0, 0), b2, voffB); PG8_STAGE(PG8_SB(0, 1), b2 + hstep, voffB); PG8_STAGE(PG8_SA(0, 0), a2, voffA);
            PG8_WAIT_V(8); PG8_WAIT_L(0); PG8_BAR; PG8_MMA(1, 0, At, B0); PG8_MMA(1, 1, At, B1); PG8_BAR; PG8_SCHED;
            PG8_LDB(B0, 1, 0); PG8_LDB(B1, 1, 1); PG8_SCHED; PG8_LDA(At, 1, 0); PG8_STAGE(PG8_SA(0, 1), a2 + hstep, voffA);
            PG8_WAIT_V(8); PG8_WAIT_L(0); PG8_BAR; PG8_MMA(0, 0, At, B0); PG8_MMA(0, 1, At, B1); PG8_BAR; PG8_SCHED;
            PG8_LDA(At, 1, 1); PG8_STAGE(PG8_SB(1, 0), b3, voffB); PG8_STAGE(PG8_SB(1, 1), b3 + hstep, voffB); PG8_STAGE(PG8_SA(1, 0), a3, voffA);
            PG8_WAIT_V(8); PG8_WAIT_L(0); PG8_BAR; PG8_MMA(1, 0, At, B0); PG8_MMA(1, 1, At, B1); PG8_BAR; PG8_SCHED;
            } else {
            PG8_LDB(B0, 0, 0); PG8_SCHED; PG8_LDA(At, 0, 0); PG8_STAGE(PG8_SA(1, 1), a1 + hstep, voffA);
            PG8_WAIT_L(8); PG8_BAR; PG8_WAIT_L(0); PG8_MMA(0, 0, At, B0); PG8_BAR; PG8_SCHED;
            PG8_LDB(B1, 0, 1); PG8_STAGE(PG8_SB(0, 0), b2, voffB);
            PG8_BAR; PG8_WAIT_L(0); PG8_MMA(0, 1, At, B1); PG8_BAR;
            PG8_LDA(At, 0, 1); PG8_STAGE(PG8_SA(0, 0), a2, voffA);
            PG8_BAR; PG8_WAIT_L(0); PG8_MMA(1, 0, At, B0); PG8_BAR; PG8_SCHED;
            PG8_STAGE(PG8_SB(0, 1), b2 + hstep, voffB);
            PG8_WAIT_V(6); PG8_BAR; PG8_MMA(1, 1, At, B1); PG8_BAR;
            PG8_LDB(B0, 1, 0); PG8_SCHED; PG8_LDA(At, 1, 0); PG8_STAGE(PG8_SA(0, 1), a2 + hstep, voffA);
            PG8_WAIT_L(8); PG8_BAR; PG8_WAIT_L(0); PG8_MMA(0, 0, At, B0); PG8_BAR; PG8_SCHED;
            PG8_LDB(B1, 1, 1); PG8_STAGE(PG8_SB(1, 0), b3, voffB);
            PG8_BAR; PG8_WAIT_L(0); PG8_MMA(0, 1, At, B1); PG8_BAR;
            PG8_LDA(At, 1, 1); PG8_STAGE(PG8_SA(1, 0), a3, voffA);
            PG8_BAR; PG8_WAIT_L(0); PG8_MMA(1, 0, At, B0); PG8_BAR; PG8_SCHED;
            PG8_STAGE(PG8_SB(1, 1), b3 + hstep, voffB);
            PG8_WAIT_V(6); PG8_BAR; PG8_MMA(1, 1, At, B1); PG8_BAR;
            }
        }
        if constexpr (ALIGN_EPI) { if (wr == 0) PG8_BAR; }
        if constexpr (!Epi::AFTER_DRAIN) { E(acc, cur, wr, wc, fr, fq); S.done(cur); }
        if (!has_next) break;
#pragma unroll
        for (int a = 0; a < 2; ++a)
#pragma unroll
            for (int b = 0; b < 2; ++b)
#pragma unroll
                for (int m = 0; m < 4; ++m)
#pragma unroll
                    for (int n = 0; n < 2; ++n) acc[a][b][m][n] = (f32x4){0.f, 0.f, 0.f, 0.f};
        cur = nxt; cA = nA; cB = nB; ++ui;
        if constexpr (ALIGN_EPI) { if (wr == 1) PG8_BAR; }
    }
    PG8_WAIT_V(0);
    if constexpr (!ALIGN_EPI) { if (wr == 0) PG8_BAR; }
    PG8_BAR;
    if constexpr (Epi::AFTER_DRAIN) { E.fused(acc, cur, wr, wc, fr, fq, lds, wid, lane); S.done(cur); }
#undef PG8_SA
#undef PG8_SB
#undef PG8_STAGE
#undef PG8_LDA
#undef PG8_LDB
#undef PG8_MMA
#undef PG8_WAIT_V
#undef PG8_WAIT_L
#undef PG8_BAR
#undef PG8_SCHED
}
}

namespace fox {
constexpr int D = 128, PITCH = 1024;
constexpr bool WSKIP = false;
constexpr float THR = 8.f;
constexpr float SCALE = 0.08838834764831845f;
constexpr int NW = 8, QBLK = 32, KVBLK = 64, QB = NW * QBLK;
constexpr int SHM_V = KVBLK * D * 2, SHM_K = KVBLK * D * 2;
constexpr int LDS_BYTES = 2 * SHM_V + 2 * SHM_K + NW * 64 * 4;
using bf16 = __hip_bfloat16;
typedef short bf16x8 __attribute__((ext_vector_type(8)));
typedef short s16x4 __attribute__((ext_vector_type(4)));
typedef float f32x16 __attribute__((ext_vector_type(16)));
typedef float f32x4 __attribute__((ext_vector_type(4)));
typedef unsigned u32x4 __attribute__((ext_vector_type(4)));
template <class A, class Bt> struct same_t { static constexpr bool v = false; };
template <class A> struct same_t<A, A> { static constexpr bool v = true; };
__device__ __forceinline__ void bias_tile(f32x16& p0, f32x16& p1, const float* cbp) {
#pragma unroll
    for (int rr = 0; rr < 4; ++rr) { const f32x4 a = *(const f32x4*)(cbp + 8 * rr), b = *(const f32x4*)(cbp + 32 + 8 * rr);
#pragma unroll
        for (int e = 0; e < 4; ++e) { p0[4 * rr + e] += a[e]; p1[4 * rr + e] += b[e]; } }
}
#define KSWZ(row, colB) ((row) * 256 + ((colB) ^ (((row) & 7) << 4)))
#define SBAR() __builtin_amdgcn_sched_barrier(0)
__device__ __forceinline__ int v_st(int k, int c) { const int kk = (k & ~0xC) | ((k & 4) << 1) | ((k & 8) >> 1); return ((kk >> 3) * 4 + (c >> 5)) * 512 + ((kk & 7) * 32 + (c & 31)) * 2; }
__device__ __forceinline__ int v_rd_base(int lane) { return ((lane & 3) << 3) | (((lane >> 2) & 3) << 6) | (((lane >> 4) & 1) << 5) | (((lane >> 5) & 1) << 8); }
constexpr int v_rd_off(int d0, int ks, int half) { return d0 * 512 + ks * 4096 + half * 2048; }
__device__ __forceinline__ int crow(int r, int hi) { return (r & 3) + 8 * (r >> 2) + 4 * hi; }
__device__ __forceinline__ unsigned cvtpk(float lo, float hi) {
    unsigned r; asm volatile("v_cvt_pk_bf16_f32 %0, %1, %2" : "=v"(r) : "v"(lo), "v"(hi)); return r;
}
__device__ __forceinline__ bf16x8 pack8(f32x4 a, f32x4 b) {
    u32x4 w = {cvtpk(a[0], a[1]), cvtpk(a[2], a[3]), cvtpk(b[0], b[1]), cvtpk(b[2], b[3])};
    return *reinterpret_cast<bf16x8*>(&w);
}
template <class T> __device__ __forceinline__ bf16x8 load8(const T* p) {
    if constexpr (same_t<T, float>::v) { return pack8(*(const f32x4*)p, *(const f32x4*)(p + 4)); }
    else { return *reinterpret_cast<const bf16x8*>(p); }
}
__device__ __forceinline__ void mask_tile(f32x16& p0, f32x16& p1, int dq, unsigned W) {
    const float NEG = -__builtin_inff();
#pragma unroll
    for (int r = 0; r < 16; ++r) {
        const int c = (r & 3) + 8 * (r >> 2);
        if ((unsigned)(dq - c) >= W) p0[r] = NEG;
        if ((unsigned)(dq - c - 32) >= W) p1[r] = NEG;
    }
}
__device__ __forceinline__ void partialSM(f32x16& p0, f32x16& p1, float& m_reg, float& mn, float& alpha) {
    float pmax = p0[0]; for (int r = 1; r < 16; ++r) pmax = fmaxf(pmax, p0[r]); for (int r = 0; r < 16; ++r) pmax = fmaxf(pmax, p1[r]);
    { auto rr = __builtin_amdgcn_permlane32_swap(__float_as_uint(pmax), __float_as_uint(pmax), false, false);
      pmax = fmaxf(__uint_as_float(rr[0]), __uint_as_float(rr[1])); }
    constexpr float C2 = 1.4426950408889634f * SCALE;
    if (__builtin_expect(__all((pmax - m_reg) * SCALE <= THR), 1)) { mn = m_reg; alpha = 1.f; }
    else { mn = fmaxf(m_reg, pmax); alpha = __builtin_amdgcn_exp2f((m_reg - mn) * C2); m_reg = mn; }
    const float mnL = -mn * C2;
    for (int r = 0; r < 16; ++r) p0[r] = fmaf(p0[r], C2, mnL); for (int r = 0; r < 16; ++r) p1[r] = fmaf(p1[r], C2, mnL);
    for (int r = 0; r < 16; ++r) p0[r] = __builtin_amdgcn_exp2f(p0[r]);
}
__device__ __forceinline__ void finishSM(f32x16& p0, f32x16& p1, float alpha, float& l_reg, bf16x8& pa0, bf16x8& pa1, bf16x8& pa2, bf16x8& pa3) {
    for (int r = 0; r < 16; ++r) p1[r] = __builtin_amdgcn_exp2f(p1[r]);
    float ps = 0; for (int r = 0; r < 16; ++r) ps += p0[r]; for (int r = 0; r < 16; ++r) ps += p1[r];
    { auto rr = __builtin_amdgcn_permlane32_swap(__float_as_uint(ps), __float_as_uint(ps), false, false);
      ps = __uint_as_float(rr[0]) + __uint_as_float(rr[1]); }
    l_reg = l_reg * alpha + ps;
#define PK4(P, B_, OUT) do { unsigned a0 = cvtpk(P[B_+0], P[B_+1]), a1 = cvtpk(P[B_+2], P[B_+3]);                          \
        unsigned b0 = cvtpk(P[B_+4], P[B_+5]), b1 = cvtpk(P[B_+6], P[B_+7]);                                             \
        auto r0 = __builtin_amdgcn_permlane32_swap(a0, b0, false, false); auto r1 = __builtin_amdgcn_permlane32_swap(a1, b1, false, false); \
        u32x4 w = {r0[0], r1[0], r0[1], r1[1]}; OUT = *reinterpret_cast<bf16x8*>(&w); } while (0)
    PK4(p0, 0, pa0); PK4(p0, 8, pa1); PK4(p1, 0, pa2); PK4(p1, 8, pa3);
#undef PK4
}
template <int KB, bool SK>
__device__ __forceinline__ void qkt(f32x16& p0, f32x16& p1, const char* K_lds, int r32, int hi, const bf16x8* qr, bool act, const float* cbp) {
    if (SK && !act) { const float NEG = -__builtin_inff();
#pragma unroll
        for (int r = 0; r < 16; ++r) { p0[r] = NEG; p1[r] = NEG; } return; }
    { const f32x4* c4 = (const f32x4*)cbp; const f32x4 a0 = c4[0], a1 = c4[2], a2 = c4[4], a3 = c4[6], b0 = c4[8], b1 = c4[10], b2 = c4[12], b3 = c4[14];
      p0 = (f32x16){a0[0], a0[1], a0[2], a0[3], a1[0], a1[1], a1[2], a1[3], a2[0], a2[1], a2[2], a2[3], a3[0], a3[1], a3[2], a3[3]};
      p1 = (f32x16){b0[0], b0[1], b0[2], b0[3], b1[0], b1[1], b1[2], b1[3], b2[0], b2[1], b2[2], b2[3], b3[0], b3[1], b3[2], b3[3]}; }
    const char* kb[4];
#pragma unroll
    for (int dd = 0; dd < 4; ++dd) kb[dd] = K_lds + KB * SHM_K + KSWZ(r32, (dd * 16 + hi * 8) * 2);
#pragma unroll
    for (int d0 = 0; d0 < 8; ++d0) { const char* a = kb[d0 & 3] + (d0 >> 2) * 128;
        bf16x8 b0 = *reinterpret_cast<const bf16x8*>(a);
        bf16x8 b1 = *reinterpret_cast<const bf16x8*>(a + 32 * 256);
        p0 = __builtin_amdgcn_mfma_f32_32x32x16_bf16(b0, qr[d0], p0, 0, 0, 0);
        p1 = __builtin_amdgcn_mfma_f32_32x32x16_bf16(b1, qr[d0], p1, 0, 0, 0); }
}
template <int VB, bool SK>
__device__ __forceinline__ void pv_tile(f32x16* o, int vb0, bf16x8 pa0, bf16x8 pa1, bf16x8 pa2, bf16x8 pa3, bool act) {
    if (SK && !act) return;
#define TRRD(dst, off) asm volatile("ds_read_b64_tr_b16 %0, %1 offset:%2" : "=&v"(dst) : "v"(vb0), "i"(off) : "memory")
#define PV_D0(d0) do { s16x4 l0, l1, l2, l3, h0, h1, h2, h3; constexpr int b_ = VB * SHM_V + v_rd_off(d0, 0, 0);     \
        TRRD(l0, b_); TRRD(h0, b_ + 2048); TRRD(l1, b_ + 4096); TRRD(h1, b_ + 6144); TRRD(l2, b_ + 8192); TRRD(h2, b_ + 10240); TRRD(l3, b_ + 12288); TRRD(h3, b_ + 14336); \
        asm volatile("s_waitcnt lgkmcnt(0)" ::: "memory"); SBAR();                 \
        o[d0] = __builtin_amdgcn_mfma_f32_32x32x16_bf16(pa0, (bf16x8){l0[0], l0[1], l0[2], l0[3], h0[0], h0[1], h0[2], h0[3]}, o[d0], 0, 0, 0);   \
        o[d0] = __builtin_amdgcn_mfma_f32_32x32x16_bf16(pa1, (bf16x8){l1[0], l1[1], l1[2], l1[3], h1[0], h1[1], h1[2], h1[3]}, o[d0], 0, 0, 0);   \
        o[d0] = __builtin_amdgcn_mfma_f32_32x32x16_bf16(pa2, (bf16x8){l2[0], l2[1], l2[2], l2[3], h2[0], h2[1], h2[2], h2[3]}, o[d0], 0, 0, 0);   \
        o[d0] = __builtin_amdgcn_mfma_f32_32x32x16_bf16(pa3, (bf16x8){l3[0], l3[1], l3[2], l3[3], h3[0], h3[1], h3[2], h3[3]}, o[d0], 0, 0, 0); } while (0)
    PV_D0(0); PV_D0(1); PV_D0(2); PV_D0(3);
#undef PV_D0
#undef TRRD
}

template <class TIn, class TOut> struct BlockRef { const TIn* Q; const TIn* K; const TIn* V; TOut* O; int P0; };
template <class TIn> struct Seam {
    bf16x8 qr[8];
    bf16x8 st_v0, st_v1, st_k0, st_k1; f32x4 sf0, sf1, sf2, sf3;
    f32x4 tq[16];
};
__device__ __forceinline__ int swa_jlo(int P0, int W) { const int lowk = P0 - W + 1; return lowk > 0 ? lowk / KVBLK : 0; }
#define ROW(p, k0, rr) ((p) + (size_t)((k0) + (rr)) * PITCH + sc)
#define VMW() asm volatile("s_waitcnt vmcnt(0)" ::: "memory")
#define VMWN(n) asm volatile("s_waitcnt vmcnt(%0)" :: "i"(n) : "memory")
#define SLOAD_H(Kp, Vp, k0) do { S.st_v0 = load8<TIn>(ROW(Vp, k0, sr)); S.st_v1 = load8<TIn>(ROW(Vp, k0, 32 + sr));              \
                         S.st_k0 = load8<TIn>(ROW(Kp, k0, sr)); S.st_k1 = load8<TIn>(ROW(Kp, k0, 32 + sr)); } while (0)
#define SWRITE_HK(bf) do { *(bf16x8*)(K_lds + (bf) * SHM_K + kws) = S.st_k0; *(bf16x8*)(K_lds + (bf) * SHM_K + kws + 32 * 256) = S.st_k1; } while (0)
#define SWRITE_HV(bf) do { *(bf16x8*)(V_lds + (bf) * SHM_V + vst0) = S.st_v0; *(bf16x8*)(V_lds + (bf) * SHM_V + vst1) = S.st_v1; } while (0)
#define SWRITE_H(bf) do { SWRITE_HV(bf); SWRITE_HK(bf); } while (0)
#define SLOAD_F(p, k0) do { S.sf0 = *(const f32x4*)ROW(p, k0, sr); S.sf1 = *(const f32x4*)(ROW(p, k0, sr) + 4);                \
                            S.sf2 = *(const f32x4*)ROW(p, k0, 32 + sr); S.sf3 = *(const f32x4*)(ROW(p, k0, 32 + sr) + 4); } while (0)
#define SWRITE_KF(bf) do { *(bf16x8*)(K_lds + (bf) * SHM_K + kws) = pack8(S.sf0, S.sf1); *(bf16x8*)(K_lds + (bf) * SHM_K + kws + 32 * 256) = pack8(S.sf2, S.sf3); } while (0)
#define SWRITE_VF(bf) do { *(bf16x8*)(V_lds + (bf) * SHM_V + vst0) = pack8(S.sf0, S.sf1); *(bf16x8*)(V_lds + (bf) * SHM_V + vst1) = pack8(S.sf2, S.sf3); } while (0)
template <class TIn, class TOut>
__device__ __forceinline__ void causal_swa_prime(const BlockRef<TIn, TOut>& cur, int W, char* lds, Seam<TIn>& S) {
    constexpr bool F32 = same_t<TIn, float>::v;
    int tid_l = threadIdx.x; asm volatile("" : "+v"(tid_l));
    const int tid = tid_l, wid = __builtin_amdgcn_readfirstlane(tid >> 6), lane = tid & 63, r32 = lane & 31, hi = lane >> 5;
    const int sr = tid >> 4, sc = (tid & 15) * 8, kws = KSWZ(sr, sc * 2); char* K_lds = lds + 2 * SHM_V;
    const int kb0 = swa_jlo(cur.P0, W) * KVBLK;
    for (int d0 = 0; d0 < 8; ++d0) S.qr[d0] = load8<TIn>(cur.Q + (size_t)(wid * QBLK + r32) * PITCH + d0 * 16 + hi * 8);
    if constexpr (F32) { SLOAD_F((const float*)cur.K, kb0); VMW(); SWRITE_KF(0); SBAR(); SLOAD_F((const float*)cur.V, kb0); }
    else { SLOAD_H(cur.K, cur.V, kb0); VMW(); SWRITE_HK(0); }
    __syncthreads();
}
template <class TIn, class TOut>
__device__ __forceinline__ void causal_swa_block(const BlockRef<TIn, TOut>& cur, const BlockRef<TIn, TOut>& nxt, int skv, int W, char* lds, Seam<TIn>& S, const float* cbias) {
    constexpr bool F32 = same_t<TIn, float>::v;
    int tid_l = threadIdx.x; asm volatile("" : "+v"(tid_l));
    const int tid = tid_l, wid = __builtin_amdgcn_readfirstlane(tid >> 6), lane = tid & 63, r32 = lane & 31, hi = lane >> 5;
    const int j_lo = swa_jlo(cur.P0, W);
    int j_hi = (cur.P0 + QB - 1) / KVBLK + 1; if (j_hi > skv / KVBLK) j_hi = skv / KVBLK;
    const int NT = j_hi - j_lo;
    const int kbn = swa_jlo(nxt.P0, W) * KVBLK;
    const int qlo = cur.P0 + wid * QBLK, qm = qlo + r32 - 4 * hi;
    char* V_lds = lds; char* K_lds = lds + 2 * SHM_V;
    float* ws = (float*)(lds + 2 * SHM_V + 2 * SHM_K) + wid * 64; float* li_l = ws, * al_l = ws + 32;
    float m_reg = -1e30f, l_reg = 0; f32x16 o[4] = {};
    const int sr = tid >> 4, sc = (tid & 15) * 8, vst0 = v_st(sr, sc), vst1 = v_st(32 + sr, sc), kws = KSWZ(sr, sc * 2);
    const int vb0 = (int)(uintptr_t)V_lds + v_rd_base(lane);
    const TIn* Kh = cur.K; const TIn* Vh = cur.V;
#define RESC(a) do { if (__any((a) < 1.f)) { if (hi == 0) al_l[r32] = (a); asm volatile("s_waitcnt lgkmcnt(0)" ::: "memory");              \
                     for (int d_ = 0; d_ < 4; ++d_) for (int r = 0; r < 16; ++r) o[d_][r] *= al_l[crow(r, hi)]; } } while (0)
#define KBASE(t) ((j_lo + (t)) * KVBLK)
#define ACT(t) (KBASE(t) <= qlo + QBLK - 1 && KBASE(t) + KVBLK - 1 >= qlo - W + 1)
#define MASKT(P0_, P1_, t) do { const int kb_ = KBASE(t); if ((!SK || ACT(t)) && (kb_ + KVBLK - 1 > qlo || kb_ <= qlo + QBLK - 1 - W)) mask_tile(P0_, P1_, qm - kb_, (unsigned)W); } while (0)
    constexpr int NQL = F32 ? 16 : 8;
    constexpr bool SK = WSKIP && !F32;
#define SEAM_K0() do { VMWN(NQL); if constexpr (F32) { SWRITE_KF(0); SBAR(); SLOAD_F((const float*)nxt.V, kbn); } else { SWRITE_HK(0); } SBAR(); } while (0)
    f32x16 pA0, pA1, pB0, pB1; float mnA, mnB, alA, alB; bf16x8 pa0, pa1, pa2, pa3;
    if constexpr (F32) { VMW(); SWRITE_VF(0); SBAR(); } else { SWRITE_HV(0); SBAR(); }
    if (NT > 1) { if constexpr (F32) SLOAD_F((const float*)Kh, KBASE(1)); else SLOAD_H(Kh, Vh, KBASE(1)); }
    SBAR(); qkt<0, SK>(pA0, pA1, K_lds, r32, hi, S.qr, ACT(0), cbias + KBASE(0) + 4 * hi);
    if constexpr (F32) { if (NT > 1) { VMW(); SWRITE_KF(1); SBAR(); SLOAD_F((const float*)Vh, KBASE(1)); } }
    MASKT(pA0, pA1, 0); partialSM(pA0, pA1, m_reg, mnA, alA);
    if (NT > 1) { VMW(); if constexpr (F32) { SWRITE_VF(1); SBAR(); if (NT > 2) SLOAD_F((const float*)Kh, KBASE(2)); } else SWRITE_H(1); }
    __syncthreads();
#define HALF_STEP(PX0, PX1, mnX, alX, PY0, PY1, alY, t, KB, VB, SB) do {                                                      \
        SBAR(); qkt<KB, SK>(PX0, PX1, K_lds, r32, hi, S.qr, ACT(t), cbias + KBASE(t) + 4 * hi);                                             \
        finishSM(PY0, PY1, alY, l_reg, pa0, pa1, pa2, pa3); SBAR();                                                           \
        if ((t) + 1 < NT) { if constexpr (F32) { VMW(); SWRITE_KF(SB); SBAR(); SLOAD_F((const float*)Vh, KBASE((t) + 1)); }  \
                            else { SLOAD_H(Kh, Vh, KBASE((t) + 1)); } SBAR(); }                                               \
        pv_tile<VB, SK>(o, vb0, pa0, pa1, pa2, pa3, ACT((t) - 1)); MASKT(PX0, PX1, (t)); partialSM(PX0, PX1, m_reg, mnX, alX);                                        \
        __syncthreads();                                                                                                      \
        if ((t) + 1 < NT) { VMW(); if constexpr (F32) { SWRITE_VF(SB); SBAR(); if ((t) + 2 < NT) SLOAD_F((const float*)Kh, KBASE((t) + 2)); } \
                            else { SWRITE_H(SB); } }                                                                          \
        RESC(alX); __syncthreads(); } while (0)
    for (int t = 1; t + 1 < NT; t += 2) {
        HALF_STEP(pB0, pB1, mnB, alB, pA0, pA1, alA, t, 1, 0, 0);
        HALF_STEP(pA0, pA1, mnA, alA, pB0, pB1, alB, t + 1, 0, 1, 1);
    }
    const bool even = (NT & 1) == 0;
    if (even) { SBAR(); qkt<1, SK>(pB0, pB1, K_lds, r32, hi, S.qr, ACT(NT - 1), cbias + KBASE(NT - 1) + 4 * hi); SBAR(); }
#define QROW(e) (nxt.Q + (size_t)(wid * QBLK + r32) * PITCH + ((e) >> 1) * 16 + hi * 8 + ((e) & 1) * 4)
    if constexpr (F32) { SLOAD_F((const float*)nxt.K, kbn); SBAR();
#pragma unroll
        for (int e = 0; e < 8; ++e) S.tq[e] = *(const f32x4*)QROW(e); }
    else { SLOAD_H(nxt.K, nxt.V, kbn); SBAR();
#pragma unroll
        for (int d0 = 0; d0 < 8; ++d0) S.qr[d0] = load8<TIn>(nxt.Q + (size_t)(wid * QBLK + r32) * PITCH + d0 * 16 + hi * 8); }
    SBAR();
    finishSM(pA0, pA1, alA, l_reg, pa0, pa1, pa2, pa3); SBAR();
    if constexpr (F32) {
#pragma unroll
        for (int e = 8; e < 16; ++e) S.tq[e] = *(const f32x4*)QROW(e); SBAR(); }
#undef QROW
    pv_tile<0, SK>(o, vb0, pa0, pa1, pa2, pa3, ACT(even ? NT - 2 : NT - 1));
    if (even) { MASKT(pB0, pB1, NT - 1); partialSM(pB0, pB1, m_reg, mnB, alB); __syncthreads(); RESC(alB);
        finishSM(pB0, pB1, alB, l_reg, pa0, pa1, pa2, pa3); SBAR(); pv_tile<1, SK>(o, vb0, pa0, pa1, pa2, pa3, ACT(NT - 1)); }
    SBAR(); SEAM_K0();
    if (hi == 0) li_l[r32] = l_reg; asm volatile("s_waitcnt lgkmcnt(0)" ::: "memory");
    float rli[16];
#pragma unroll
    for (int r = 0; r < 16; ++r) rli[r] = __builtin_amdgcn_rcpf(li_l[crow(r, hi)]);
    TOut* Ow = cur.O + (size_t)(wid * QBLK) * PITCH;
#pragma unroll
    for (int r = 0; r < 16; ++r) { const int orow = crow(r, hi);
#pragma unroll
        for (int d0 = 0; d0 < 4; ++d0) { const float v = o[d0][r] * rli[r];
            if constexpr (same_t<TOut, float>::v) { Ow[(size_t)orow * PITCH + d0 * 32 + r32] = v; }
            else { const float vn = __shfl_xor(v, 1);
                   if ((r32 & 1) == 0) *(unsigned*)(Ow + (size_t)orow * PITCH + d0 * 32 + r32) = cvtpk(v, vn); } } }
    if constexpr (F32) {
#pragma unroll
        for (int d0 = 0; d0 < 8; ++d0) S.qr[d0] = pack8(S.tq[2 * d0], S.tq[2 * d0 + 1]); }
    __syncthreads();
#undef RESC
#undef KBASE
#undef ACT
#undef MASKT
#undef SEAM_K0
#undef HALF_STEP
}
#undef ROW
#undef VMW
#undef VMWN
#undef SLOAD_H
#undef SWRITE_HK
#undef SWRITE_HV
#undef SWRITE_H
#undef SLOAD_F
#undef SWRITE_KF
#undef SWRITE_VF
}

typedef unsigned short bf16_t;
typedef short bf16x8 __attribute__((ext_vector_type(8)));
typedef float f32x4 __attribute__((ext_vector_type(4)));
typedef unsigned u32x4 __attribute__((ext_vector_type(4)));
typedef unsigned u32x2 __attribute__((ext_vector_type(2)));
constexpr int DM = 1024, NB = 32, SEQ = 2048, NH = 8, HD = 128, DFF = 2816, NUP = 2 * DFF;
constexpr int MTOK = NB * SEQ;
constexpr int NG = 2, BG = NB / NG, GM = BG * SEQ;
constexpr int NIN = 37 * 256;
constexpr int NCH = BG * NH * 32;
static_assert(GM == pg8::GM, "group rows");
constexpr size_t MiB = 1u << 20;
constexpr size_t WS_CTL = 0;
constexpr size_t WS_WIN = 1 * MiB, WS_WBF = 20 * MiB, WS_WBG = 22 * MiB, WS_WOUT = 24 * MiB, WS_WUP = 26 * MiB, WS_WDN = 37 * MiB;
constexpr size_t WS_PROJ = 44 * MiB;
constexpr size_t WS_SMALL = 620 * MiB;
constexpr size_t WS_PREP = 624 * MiB;
constexpr size_t WS_END = 913 * MiB;
constexpr size_t PBUF = 64 * MiB;
constexpr size_t WS_H1B = WS_PROJ + 0 * PBUF;
constexpr size_t WS_T1 = WS_PROJ + 1 * PBUF;
constexpr size_t WS_Y = WS_PROJ + 2 * PBUF;
constexpr size_t WS_YGDN = WS_PROJ + 3 * PBUF;
constexpr size_t WS_YFOX = WS_PROJ + 5 * PBUF;
constexpr size_t WS_UP = WS_PROJ + 3 * PBUF;
constexpr size_t WS_ACT = WS_PREP;
constexpr size_t PROJ_STRIDE = (size_t)GM * 1024;
constexpr int LDS_BYTES = 163840;

__device__ __forceinline__ float bf2f(bf16_t b) { return __uint_as_float((unsigned)b << 16); }
__device__ __forceinline__ float bflo(unsigned w) { return __uint_as_float(w << 16); }
__device__ __forceinline__ float bfhi(unsigned w) { return __uint_as_float(w & 0xffff0000u); }
typedef float f32x2_t __attribute__((ext_vector_type(2))); typedef __bf16 bf16x2_t __attribute__((ext_vector_type(2)));
__device__ __forceinline__ unsigned pk2(float lo, float hi) { f32x2_t v = {lo, hi}; bf16x2_t b = __builtin_convertvector(v, bf16x2_t); return __builtin_bit_cast(unsigned, b); }
__device__ __forceinline__ bf16_t f2bf(float f) { return (bf16_t)(pk2(f, 0.f) & 0xffffu); }
__device__ __forceinline__ float siluf(float y) { return y * __builtin_amdgcn_rcpf(1.0f + __expf(-y)); }
__device__ __forceinline__ float wave_sum(float v) {
#pragma unroll
    for (int o = 1; o < 64; o <<= 1) v += __shfl_xor(v, o);
    return v;
}

struct Args { const float* in[16]; float* out; unsigned char* ws; int ph_lo, ph_hi; };
struct Ptrs {
    const float *x, *norm_mix, *w_in, *fox_f_bias, *gdn_conv_w, *gdn_a_log, *gdn_dt_bias, *gdn_norm, *w_bf, *w_bg, *w_out, *norm_ffn, *w_up, *ffn_conv_w, *w_down, *norm_final;
    float* out; unsigned char* ws;
};

template <int MODE> __device__ __forceinline__ int srccol(int n) {
    if (MODE == 0) return n;
    if (MODE == 1) {
        if (n < 3072) return n;
        if (n < 6144) return 3080 + (n - 3072);
        if (n < 9216) return 6168 + (n - 6144);
        const int s = n - 9216;
        if (s < 8) return 3072 + s;
        if (s < 16) return 6152 + (s - 8);
        if (s < 24) return 6160 + (s - 16);
        return -1;
    }
    { const int p = n >> 8, s = (n >> 7) & 1, i = n & 127; return s * DFF + 128 * p + i; }
}
template <int MODE> __device__ __forceinline__ void transpose_item(const float* W, int K, int N, const float* ksc, bf16_t* WT, float* scr, int item, int nblk, int lane) {
    const int kb = item / nblk, nb = item % nblk, k0 = 64 * kb, n0 = 32 * nb;
    const int sc = srccol<MODE>(n0 + (lane & 31));
#pragma unroll 8
    for (int i = 0; i < 32; ++i) { const int kk = 2 * i + (lane >> 5); float v = 0.f; if (sc >= 0) { v = W[(size_t)(k0 + kk) * N + sc]; if (ksc) v *= ksc[k0 + kk]; } scr[kk * 33 + (lane & 31)] = v; }
    asm volatile("s_waitcnt lgkmcnt(0)" ::: "memory");
    const int c = lane & 7;
#pragma unroll
    for (int j = 0; j < 4; ++j) { const int n = (lane >> 3) + 8 * j; const float* s = scr + (8 * c) * 33 + n;
        u32x4 o; o.x = pk2(s[0 * 33], s[1 * 33]); o.y = pk2(s[2 * 33], s[3 * 33]); o.z = pk2(s[4 * 33], s[5 * 33]); o.w = pk2(s[6 * 33], s[7 * 33]);
        *(u32x4*)(WT + (size_t)(n0 + n) * K + k0 + 8 * c) = o; }
    asm volatile("s_waitcnt lgkmcnt(0)" ::: "memory");
}
__device__ __forceinline__ void phase_prologue(const Ptrs& P, char* lds, int tid, int cid) {
    const int lane = tid & 63, wave = tid >> 6;
    float* scr = (float*)(lds + wave * 16384);
    const int gw = cid * 8 + wave, NGW = 256 * 8;
    bf16_t* win_t = (bf16_t*)(P.ws + WS_WIN); bf16_t* wbf_t = (bf16_t*)(P.ws + WS_WBF); bf16_t* wbg_t = (bf16_t*)(P.ws + WS_WBG);
    bf16_t* wout_t = (bf16_t*)(P.ws + WS_WOUT); bf16_t* wup_t = (bf16_t*)(P.ws + WS_WUP); bf16_t* wdn_t = (bf16_t*)(P.ws + WS_WDN);
    constexpr int I_IN = 16 * (NIN / 32), I_SQ = 16 * 32, I_UP = 16 * (NUP / 32), I_DN = (DFF / 64) * 32;
    constexpr int NITEMS = I_IN + 3 * I_SQ + I_UP + I_DN;
    for (int it = gw; it < NITEMS; it += NGW) {
        int r = it;
        if (r < I_IN) { transpose_item<1>(P.w_in, DM, 9240, nullptr, win_t, scr, r, NIN / 32, lane); continue; } r -= I_IN;
        if (r < I_SQ) { transpose_item<0>(P.w_bf, DM, DM, nullptr, wbf_t, scr, r, 32, lane); continue; } r -= I_SQ;
        if (r < I_SQ) { transpose_item<0>(P.w_bg, DM, DM, nullptr, wbg_t, scr, r, 32, lane); continue; } r -= I_SQ;
        if (r < I_SQ) { transpose_item<0>(P.w_out, DM, DM, nullptr, wout_t, scr, r, 32, lane); continue; } r -= I_SQ;
        if (r < I_UP) { transpose_item<2>(P.w_up, DM, NUP, P.norm_ffn, wup_t, scr, r, NUP / 32, lane); continue; } r -= I_UP;
        transpose_item<0>(P.w_down, DFF, DM, nullptr, wdn_t, scr, r, 32, lane);
    }
    f32x4 gv[4];
#pragma unroll
    for (int j = 0; j < 4; ++j) gv[j] = ((const f32x4*)P.norm_mix)[lane + 64 * j];
    for (int m0 = gw; m0 < MTOK; m0 += 2 * NGW) {
        const int m1 = m0 + NGW;
        const f32x4* xr0 = (const f32x4*)(P.x + (size_t)m0 * DM) + lane; const f32x4* xr1 = (const f32x4*)(P.x + (size_t)m1 * DM) + lane;
        f32x4 v0[4], v1[4]; float s0 = 0.f, s1 = 0.f;
#pragma unroll
        for (int j = 0; j < 4; ++j) { v0[j] = xr0[64 * j]; v1[j] = xr1[64 * j]; }
#pragma unroll
        for (int j = 0; j < 4; ++j) { s0 += (v0[j][0] * v0[j][0] + v0[j][1] * v0[j][1]) + (v0[j][2] * v0[j][2] + v0[j][3] * v0[j][3]); s1 += (v1[j][0] * v1[j][0] + v1[j][1] * v1[j][1]) + (v1[j][2] * v1[j][2] + v1[j][3] * v1[j][3]); }
        const float rstd0 = rsqrtf(wave_sum(s0) * (1.f / DM) + 1e-6f), rstd1 = rsqrtf(wave_sum(s1) * (1.f / DM) + 1e-6f);
        const int g0 = m0 / GM, g1 = m1 / GM;
        u32x2* o0 = (u32x2*)((bf16_t*)(P.out + (size_t)g0 * GM * DM) + (size_t)(m0 - g0 * GM) * DM) + lane;
        u32x2* o1 = (u32x2*)((bf16_t*)(P.out + (size_t)g1 * GM * DM) + (size_t)(m1 - g1 * GM) * DM) + lane;
#pragma unroll
        for (int j = 0; j < 4; ++j) { const f32x4 t0 = v0[j] * rstd0 * gv[j], t1 = v1[j] * rstd1 * gv[j]; u32x2 w0, w1; w0.x = pk2(t0[0], t0[1]); w0.y = pk2(t0[2], t0[3]); w1.x = pk2(t1[0], t1[1]); w1.y = pk2(t1[2], t1[3]); o0[64 * j] = w0; o1[64 * j] = w1; }
    }
}

__device__ __forceinline__ f32x4 mma16(const bf16_t* A, int lda, const bf16_t* Bt, int ldb, int ksteps, f32x4 acc, int lane) {
    const int r = lane & 15, q = lane >> 4;
    const bf16_t* ap = A + r * lda + q * 8; const bf16_t* bp = Bt + r * ldb + q * 8;
    for (int ks = 0; ks < ksteps; ++ks) { const bf16x8 a = *(const bf16x8*)(ap + ks * 32); const bf16x8 b = *(const bf16x8*)(bp + ks * 32); acc = __builtin_amdgcn_mfma_f32_16x16x32_bf16(a, b, acc, 0, 0, 0); }
    return acc;
}
#define LBAR() do { asm volatile("s_waitcnt lgkmcnt(0)" ::: "memory"); __builtin_amdgcn_s_barrier(); asm volatile("" ::: "memory"); } while (0)
__device__ __forceinline__ f32x4 mma16s(const bf16_t* A, int lda, int sw, const bf16_t* Bt, int ldb, int ksteps, f32x4 acc, int lane) {
    const int r = lane & 15, q = lane >> 4;
    const bf16_t* ap = A + r * lda; const bf16_t* bp = Bt + r * ldb + q * 8;
    for (int ks = 0; ks < ksteps; ++ks) { const bf16x8 a = *(const bf16x8*)(ap + (((ks * 4 + q) ^ sw) << 3)); const bf16x8 b = *(const bf16x8*)(bp + ks * 32); acc = __builtin_amdgcn_mfma_f32_16x16x32_bf16(a, b, acc, 0, 0, 0); }
    return acc;
}
constexpr int PQ = 136, PC = 72;
struct PrepBufs { bf16_t *W, *QD, *KDT, *UHT, *AT; float* GL; };
__device__ __forceinline__ PrepBufs prep_bufs(unsigned char* ws) {
    PrepBufs b; b.W = (bf16_t*)(ws + WS_PREP); b.QD = (bf16_t*)(ws + WS_PREP + 64 * MiB); b.KDT = (bf16_t*)(ws + WS_PREP + 128 * MiB); b.UHT = (bf16_t*)(ws + WS_PREP + 192 * MiB);
    b.AT = (bf16_t*)(ws + WS_PREP + 256 * MiB); b.GL = (float*)(ws + WS_PREP + 288 * MiB); return b;
}
constexpr int PL_QS = 0, PL_KS = 17408, PL_KDT = 34816, PL_RAW = 53248, RAWP = 392  , PL_RT = PL_RAW + 67 * RAWP * 2, PL_GC = PL_RT + 256 * PC * 2, PL_CW = PL_GC + 512, PL_END = PL_CW + 6144;
constexpr int RAW_CHUNKS = 67 * 48;
#ifndef SEGSEL
#define SEGSEL 0
#endif
#define SEG_T0() unsigned long long seg_t0 = 0; if (SEGSEL && blockIdx.x == 0 && threadIdx.x == 0) seg_t0 = __builtin_amdgcn_s_memrealtime()
#define SEG_MARK(k) do { if (SEGSEL && blockIdx.x == 0 && threadIdx.x == 0) { const unsigned long long t_ = __builtin_amdgcn_s_memrealtime(); if (SEGSEL == (k)) atomicAdd((float*)(P.ws + WS_CTL + 768 * 1024), (float)(t_ - seg_t0) * 0.01f); seg_t0 = t_; } } while (0)
struct PrepStage { u32x4 raw[7]; float ga, gb; };
struct ConvW { f32x4 w[3][4]; };
struct PrepHold { u32x4 uh[2], w[2], at; int unit; };
__device__ __forceinline__ void prep_fetch(PrepStage& st, int unit, const Ptrs& P, int tid) {
    const int n = unit & 31, h = (unit >> 5) & 7, bl = unit >> 8;
    const int R0 = bl * SEQ + n * 64;
    const bf16_t* proj = (const bf16_t*)(P.ws + WS_PROJ); const float* small = (const float*)(P.ws + WS_SMALL);
#pragma unroll
    for (int i = 0; i < 7; ++i) { int c = tid + 512 * i; c = c < RAW_CHUNKS ? c : RAW_CHUNKS - 1; const int row = c / 48, c16 = c - row * 48, part = c16 >> 4, ch = (c16 & 15) * 8;
        const bool zero = (n == 0) && (row < 3);
        const int rr = zero ? 3 : row;
        u32x4 v = *(const u32x4*)(proj + (size_t)(3 + part) * PROJ_STRIDE + (size_t)(R0 - 3 + rr) * 1024 + h * HD + ch);
        if (zero) v = (u32x4){0u, 0u, 0u, 0u};
        st.raw[i] = v; }
    { const float* sm = small + (size_t)(R0 + (tid & 63)) * 32; st.ga = sm[8 + h]; st.gb = sm[16 + h]; }
}
__device__ __forceinline__ void prep_flush(const PrepHold& hd, const Ptrs& P, int tid) {
    const PrepBufs G = prep_bufs(P.ws);
#pragma unroll
    for (int i = 0; i < 2; ++i) { const int idx = tid + 512 * i; *(u32x4*)(G.UHT + (size_t)hd.unit * 8192 + idx * 8) = hd.uh[i]; *(u32x4*)(G.W + (size_t)hd.unit * 8192 + idx * 8) = hd.w[i]; }
    *(u32x4*)(G.AT + (size_t)hd.unit * 4096 + tid * 8) = hd.at;
}
__device__ __forceinline__ void gdn_prep_unit(char* lds, int unit, int unit_next, PrepStage& st, PrepHold& hd, const ConvW& cwr, const Ptrs& P, int tid_in, float neg_a, float dtb) {
    int tid = tid_in; asm volatile("" : "+v"(tid));
    const int lane = tid & 63, wid = tid >> 6, c16 = lane & 15, q4 = lane >> 4;
    const int h = (unit >> 5) & 7;
    bf16_t* Qs = (bf16_t*)(lds + PL_QS); bf16_t* Ks = (bf16_t*)(lds + PL_KS); bf16_t* KDTs = (bf16_t*)(lds + PL_KDT);
    bf16_t* RAW = (bf16_t*)(lds + PL_RAW);
    bf16_t* RT = (bf16_t*)(lds + PL_RT);
    float* gcs = (float*)(lds + PL_GC); float* bts = gcs + 64;
    bf16_t* UHs = (bf16_t*)(lds + PL_RAW + 4096); bf16_t* Wst = UHs + 8192; bf16_t* ATs = Wst + 64 * PQ;
    bf16_t* CH = (bf16_t*)lds;
    const PrepBufs G = prep_bufs(P.ws);
    SEG_T0();
#pragma unroll
    for (int i = 0; i < 7; ++i) { const int c = tid + 512 * i; const int row = c / 48, cc = c - row * 48; if (c < RAW_CHUNKS) *(u32x4*)(RAW + row * RAWP + cc * 8) = st.raw[i]; }
    if (wid == 0) {
        const float xx = st.ga + dtb;
        const float sp = xx > 20.f ? xx : log1pf(__expf(xx));
        float cum = neg_a * sp;
        const float beta = __builtin_amdgcn_rcpf(1.0f + __expf(-st.gb));
#pragma unroll
        for (int o = 1; o < 64; o <<= 1) { const float t = __shfl_up(cum, o); if (lane >= o) cum += t; }
        gcs[lane] = cum; bts[lane] = beta;
    }
    prep_flush(hd, P, tid);
    LBAR();
    SEG_MARK(1);
    prep_fetch(st, unit_next, P, tid);
    {
        const int cg = tid & 31, rg = tid >> 5, r0 = 4 * rg, c0 = 4 * cg;
        const f32x4 gc4 = *(const f32x4*)(gcs + r0), bt4 = *(const f32x4*)(bts + r0); const float glast = gcs[63];
        float eg[4], egl[4];
#pragma unroll
        for (int rr = 0; rr < 4; ++rr) { eg[rr] = __expf(gc4[rr]); egl[rr] = __expf(glast - gc4[rr]); }
        const int key = (cg >> 1) & 7;
        const int csw = ((((rg >> 1) ^ key) << 3) | ((rg & 1) << 2));
#pragma unroll
        for (int part = 0; part < 3; ++part) {
            float x[7][4];
#pragma unroll
            for (int i = 0; i < 7; ++i) { const u32x2 a = *(const u32x2*)(RAW + (r0 + i) * RAWP + part * 128 + c0); x[i][0] = bflo(a.x); x[i][1] = bfhi(a.x); x[i][2] = bflo(a.y); x[i][3] = bfhi(a.y); }
            float y[4][4]; float ss[4];
#pragma unroll
            for (int rr = 0; rr < 4; ++rr) { ss[rr] = 0.f;
#pragma unroll
                for (int e = 0; e < 4; ++e) { float v = cwr.w[part][0][e] * x[rr][e] + cwr.w[part][1][e] * x[rr + 1][e] + cwr.w[part][2][e] * x[rr + 2][e] + cwr.w[part][3][e] * x[rr + 3][e];
                    v = siluf(v); y[rr][e] = v; ss[rr] += v * v; } }
            if (part < 2) {
#pragma unroll
                for (int rr = 0; rr < 4; ++rr) { float t = ss[rr]; t += __shfl_xor(t, 1); t += __shfl_xor(t, 2); t += __shfl_xor(t, 4); t += __shfl_xor(t, 8); t += __shfl_xor(t, 16); ss[rr] = rsqrtf(t + 1e-6f); }
            }
            if (part == 0) {
#pragma unroll
                for (int rr = 0; rr < 4; ++rr) { const float sc = ss[rr] * 0.08838834764831845f; const float a0 = y[rr][0] * sc, a1 = y[rr][1] * sc, a2 = y[rr][2] * sc, a3 = y[rr][3] * sc;
                    u32x2 w; w.x = pk2(a0, a1); w.y = pk2(a2, a3); *(u32x2*)(Qs + (r0 + rr) * PQ + c0) = w;
                    u32x2 d; d.x = pk2(a0 * eg[rr], a1 * eg[rr]); d.y = pk2(a2 * eg[rr], a3 * eg[rr]); *(u32x2*)(G.QD + (size_t)unit * 8192 + (r0 + rr) * 128 + c0) = d; }
            } else if (part == 1) {
#pragma unroll
                for (int rr = 0; rr < 4; ++rr) {
#pragma unroll
                    for (int e = 0; e < 4; ++e) y[rr][e] *= ss[rr];
                    u32x2 w; w.x = pk2(y[rr][0], y[rr][1]); w.y = pk2(y[rr][2], y[rr][3]); *(u32x2*)(Ks + (r0 + rr) * PQ + c0) = w; }
#pragma unroll
                for (int e = 0; e < 4; ++e) { u32x2 w1, w2;
                    w1.x = pk2(y[0][e] * bt4[0] * eg[0], y[1][e] * bt4[1] * eg[1]); w1.y = pk2(y[2][e] * bt4[2] * eg[2], y[3][e] * bt4[3] * eg[3]);
                    w2.x = pk2(y[0][e] * egl[0], y[1][e] * egl[1]); w2.y = pk2(y[2][e] * egl[2], y[3][e] * egl[3]);
                    *(u32x2*)(RT + (128 + c0 + e) * PC + csw) = w1; *(u32x2*)(KDTs + (c0 + e) * PC + csw) = w2; }
            } else {
#pragma unroll
                for (int e = 0; e < 4; ++e) { u32x2 w1; w1.x = pk2(y[0][e] * bt4[0], y[1][e] * bt4[1]); w1.y = pk2(y[2][e] * bt4[2], y[3][e] * bt4[3]); *(u32x2*)(RT + (c0 + e) * PC + csw) = w1; }
            }
        }
    }
    LBAR();
    SEG_MARK(2);
    {
#pragma unroll
        for (int i = 0; i < 2; ++i) { const int idx = tid + 512 * i, row = idx >> 3, ch = idx & 7; *(u32x4*)(G.KDT + (size_t)unit * 8192 + row * 64 + ch * 8) = *(const u32x4*)(KDTs + row * PC + ((ch ^ ((row >> 3) & 7)) << 3)); }
    }
    const int mat = wid >> 2, ti = wid & 3;
    f32x4 res[4], res2[4];
#pragma unroll
    for (int tj = 0; tj < 4; ++tj) { f32x4 acc = {0.f, 0.f, 0.f, 0.f}, acc2 = {0.f, 0.f, 0.f, 0.f};
        if (tj <= ti) { if (mat == 0) acc = mma16(Ks + ti * 16 * PQ, PQ, Ks + tj * 16 * PQ, PQ, 4, acc, lane);
                        acc2 = mma16(Ks + tj * 16 * PQ, PQ, (mat ? Qs : Ks) + ti * 16 * PQ, PQ, 4, acc2, lane); }
        res[tj] = acc; res2[tj] = acc2; }
    LBAR();
    {
        const int iiL = ti * 16 + c16; const float gciL = gcs[iiL], btL = bts[iiL];
#pragma unroll
        for (int tj = 0; tj < 4; ++tj) {
            const int jc0 = tj * 16 + 4 * q4;
            const f32x4 gcj = *(const f32x4*)(gcs + jc0);
            float v[4];
#pragma unroll
            for (int jj = 0; jj < 4; ++jj) { const int jc = jc0 + jj; const float dec = (iiL >= jc) ? __expf(gciL - gcj[jj]) : 0.f;
                v[jj] = (mat == 0) ? ((iiL > jc) ? -res2[tj][jj] * dec * btL : 0.f) : ((iiL >= jc) ? res2[tj][jj] * dec : 0.f); }
            u32x2 w; w.x = pk2(v[0], v[1]); w.y = pk2(v[2], v[3]);
            if (mat == 0) *(u32x2*)(CH + iiL * PC + jc0) = w;
            else *(u32x2*)(ATs + iiL * PC + jc0) = w;
            if (mat == 0) {
                const int jcL = tj * 16 + c16, ii0 = ti * 16 + 4 * q4; const float gcjL = gcs[jcL];
                const f32x4 gci = *(const f32x4*)(gcs + ii0), bti = *(const f32x4*)(bts + ii0);
                float t[4];
#pragma unroll
                for (int jj = 0; jj < 4; ++jj) { const int ii = ii0 + jj; t[jj] = (ii > jcL) ? -res[tj][jj] * __expf(gci[jj] - gcjL) * bti[jj] : 0.f; }
                u32x2 w2; w2.x = pk2(t[0], t[1]); w2.y = pk2(t[2], t[3]);
                *(u32x2*)(CH + 2 * 64 * PC + jcL * PC + ii0) = w2; }
        }
    }
    LBAR();
    SEG_MARK(3);
    f32x4 pacc[4];
    if (wid >= 4) {
#pragma unroll
        for (int tj = 0; tj < 4; ++tj) { const u32x2 nw = *(const u32x2*)(CH + (ti * 16 + c16) * PC + tj * 16 + 4 * q4); const int ii = ti * 16 + c16, jc0 = tj * 16 + 4 * q4;
            pacc[tj][0] = bflo(nw.x) + (ii == jc0 ? 1.f : 0.f); pacc[tj][1] = bfhi(nw.x) + (ii == jc0 + 1 ? 1.f : 0.f); pacc[tj][2] = bflo(nw.y) + (ii == jc0 + 2 ? 1.f : 0.f); pacc[tj][3] = bfhi(nw.y) + (ii == jc0 + 3 ? 1.f : 0.f); }
    }
    for (int s = 0; s < 6; ++s) {
        const int cur = s & 1, nxt = cur ^ 1;
        bf16_t* Qr_c = CH + cur * 64 * PC; bf16_t* Qt_c = CH + (2 + cur) * 64 * PC; bf16_t* Qr_n = CH + nxt * 64 * PC; bf16_t* Qt_n = CH + (2 + nxt) * 64 * PC;
        bf16_t* Pr_c = CH + (4 + cur) * 64 * PC; bf16_t* Pr_p = CH + (4 + nxt) * 64 * PC;
        if (wid < 4) {
            if (s < 5) {
#pragma unroll
                for (int tj = 0; tj < 4; ++tj) { f32x4 a1 = {0.f, 0.f, 0.f, 0.f}, a2 = {0.f, 0.f, 0.f, 0.f};
                    const bf16_t* ap = Qr_c + (ti * 16 + c16) * PC + q4 * 8; const bf16_t* bp = Qt_c + (tj * 16 + c16) * PC + q4 * 8;
#pragma unroll
                    for (int ks = 0; ks < 2; ++ks) { const bf16x8 fa = *(const bf16x8*)(ap + ks * 32), fb = *(const bf16x8*)(bp + ks * 32);
                        a1 = __builtin_amdgcn_mfma_f32_16x16x32_bf16(fa, fb, a1, 0, 0, 0);
                        a2 = __builtin_amdgcn_mfma_f32_16x16x32_bf16(fb, fa, a2, 0, 0, 0); }
                    u32x2 w1, w2; w1.x = pk2(a1[0], a1[1]); w1.y = pk2(a1[2], a1[3]); w2.x = pk2(a2[0], a2[1]); w2.y = pk2(a2[2], a2[3]);
                    *(u32x2*)(Qt_n + (tj * 16 + c16) * PC + ti * 16 + 4 * q4) = w1;
                    *(u32x2*)(Qr_n + (ti * 16 + c16) * PC + tj * 16 + 4 * q4) = w2; }
            }
        } else {
#pragma unroll
            for (int tj = 0; tj < 4; ++tj) {
                if (s >= 1) { const bf16_t* ap = Qt_c + (tj * 16 + c16) * PC + q4 * 8; const bf16_t* bp = Pr_p + (ti * 16 + c16) * PC + q4 * 8;
#pragma unroll
                    for (int ks = 0; ks < 2; ++ks) { const bf16x8 fa = *(const bf16x8*)(ap + ks * 32), fb = *(const bf16x8*)(bp + ks * 32); pacc[tj] = __builtin_amdgcn_mfma_f32_16x16x32_bf16(fa, fb, pacc[tj], 0, 0, 0); } }
                u32x2 w; w.x = pk2(pacc[tj][0], pacc[tj][1]); w.y = pk2(pacc[tj][2], pacc[tj][3]);
                *(u32x2*)(Pr_c + (ti * 16 + c16) * PC + tj * 16 + 4 * q4) = w; }
        }
        LBAR();
    }
    SEG_MARK(4);
    {
        const bf16_t* Tm = CH + 5 * 64 * PC;
#pragma unroll
        for (int t2 = 0; t2 < 2; ++t2) { const int tch = 2 * wid + t2; const int swl = (2 * tch + (c16 >> 3)) & 7;
#pragma unroll
            for (int tj = 0; tj < 4; ++tj) { f32x4 acc = {0.f, 0.f, 0.f, 0.f};
#pragma unroll
                for (int ks = 0; ks < 2; ++ks) { const bf16x8 fr = *(const bf16x8*)(RT + (tch * 16 + c16) * PC + (((ks * 4 + q4) ^ swl) << 3)); const bf16x8 ft = *(const bf16x8*)(Tm + (tj * 16 + c16) * PC + ks * 32 + q4 * 8);
                    acc = (tch < 8) ? __builtin_amdgcn_mfma_f32_16x16x32_bf16(ft, fr, acc, 0, 0, 0) : __builtin_amdgcn_mfma_f32_16x16x32_bf16(fr, ft, acc, 0, 0, 0); }
                u32x2 w; w.x = pk2(acc[0], acc[1]); w.y = pk2(acc[2], acc[3]);
                if (tch < 8) *(u32x2*)(UHs + ((((tch * 4 + tj) * 4 + q4) * 16 + c16) * 4)) = w;
                else *(u32x2*)(Wst + (tj * 16 + c16) * PQ + (tch - 8) * 16 + 4 * q4) = w;
            } }
        G.GL[unit] = __expf(gcs[63]);
    }
    LBAR();
#pragma unroll
    for (int i = 0; i < 2; ++i) { const int idx = tid + 512 * i; hd.uh[i] = *(const u32x4*)(UHs + idx * 8); hd.w[i] = *(const u32x4*)(Wst + (idx >> 4) * PQ + (idx & 15) * 8); }
    hd.at = *(const u32x4*)(ATs + (tid >> 3) * PC + (tid & 7) * 8); hd.unit = unit;
    LBAR();
    SEG_MARK(5);
}

__device__ __forceinline__ void gdn_seq_unit(char* lds, int bh, const Ptrs& P, int tid) {
    const int lane = tid & 63, wid = tid >> 6, c16 = lane & 15, q4 = lane >> 4;
    const int bl = bh >> 3, h = bh & 7;
    bf16_t* ST = (bf16_t*)lds;
    bf16_t* Wl = ST + 128 * PQ;
    bf16_t* QDl = Wl + 64 * PQ;
    bf16_t* ATl = QDl + 64 * PQ;
    bf16_t* KDTl = ATl + 64 * PC;
    bf16_t* UTl = KDTl + 128 * PC;
    bf16_t* GZl = UTl + 128 * PC;
    float* SSl = (float*)(GZl + 64 * PQ);
    const PrepBufs G = prep_bufs(P.ws);
    const bf16_t* gz = (const bf16_t*)(P.ws + WS_PROJ) + 6 * PROJ_STRIDE + (size_t)(bl * SEQ) * 1024 + h * HD;
    bf16_t* yg = (bf16_t*)(P.ws + WS_YGDN) + (size_t)(bl * SEQ) * 1024 + h * HD;
    f32x4 Sacc[8];
#pragma unroll
    for (int t = 0; t < 8; ++t) Sacc[t] = (f32x4){0.f, 0.f, 0.f, 0.f};
    for (int i = lane; i < 16 * PQ / 2; i += 64) ((unsigned*)(ST + wid * 16 * PQ))[i] = 0u;
    const f32x4 gn = *(const f32x4*)(P.gdn_norm + 16 * wid + 4 * q4);
    const int r16 = tid >> 4, ch16 = (tid & 15) * 8;
    const int r8 = tid >> 3, ch8 = (tid & 7) * 8;
    u32x4 sW[2], sQ[2], sA, sK[2], sG[2]; u32x2 uhn[4]; float gln;
    {
        const size_t ub = (size_t)(bh * 32) * 8192;
#pragma unroll
        for (int i = 0; i < 2; ++i) { const int idx = tid + 512 * i; sW[i] = *(const u32x4*)(G.W + ub + idx * 8); sQ[i] = *(const u32x4*)(G.QD + ub + idx * 8); sK[i] = *(const u32x4*)(G.KDT + ub + idx * 8);
            sG[i] = *(const u32x4*)(gz + (size_t)(r16 + 32 * i) * 1024 + ch16); }
        sA = *(const u32x4*)(G.AT + (size_t)(bh * 32) * 4096 + tid * 8);
#pragma unroll
        for (int t = 0; t < 4; ++t) uhn[t] = *(const u32x2*)(G.UHT + ub + ((wid * 4 + t) * 64 + lane) * 4);
        gln = G.GL[bh * 32];
    }
    for (int n = 0; n < 32; ++n) {
        const int unit = bh * 32 + n;
        const size_t ub = (size_t)unit * 8192;
#pragma unroll
        for (int i = 0; i < 2; ++i) { const int idx = tid + 512 * i;
            *(u32x4*)(Wl + (idx >> 4) * PQ + (idx & 15) * 8) = sW[i]; *(u32x4*)(QDl + (idx >> 4) * PQ + (idx & 15) * 8) = sQ[i]; *(u32x4*)(KDTl + (idx >> 3) * PC + (idx & 7) * 8) = sK[i]; }
        *(u32x4*)(ATl + r8 * PC + ch8) = sA;
        const float gl = gln;
        u32x2 uh[4];
#pragma unroll
        for (int t = 0; t < 4; ++t) uh[t] = uhn[t];
        LBAR();
        const int nn = (n + 1 < 32) ? n + 1 : 31;
        { const size_t un = (size_t)(bh * 32 + nn) * 8192;
#pragma unroll
            for (int i = 0; i < 2; ++i) { const int idx = tid + 512 * i; sW[i] = *(const u32x4*)(G.W + un + idx * 8); sQ[i] = *(const u32x4*)(G.QD + un + idx * 8); sK[i] = *(const u32x4*)(G.KDT + un + idx * 8); }
            sA = *(const u32x4*)(G.AT + (size_t)(bh * 32 + nn) * 4096 + tid * 8);
#pragma unroll
            for (int t = 0; t < 4; ++t) uhn[t] = *(const u32x2*)(G.UHT + un + ((wid * 4 + t) * 64 + lane) * 4);
            gln = G.GL[bh * 32 + nn]; }
        { const int np = (n > 0) ? n - 1 : 0;
#pragma unroll
            for (int i = 0; i < 2; ++i) { const u32x4 v = *(const u32x4*)(GZl + (r16 + 32 * i) * PQ + ch16); *(u32x4*)(yg + (size_t)(np * 64 + r16 + 32 * i) * 1024 + ch16) = v; } }
        f32x4 ws[4], os[4];
#pragma unroll
        for (int t = 0; t < 4; ++t) { ws[t] = (f32x4){0.f, 0.f, 0.f, 0.f}; os[t] = (f32x4){0.f, 0.f, 0.f, 0.f}; }
#pragma unroll
        for (int ks = 0; ks < 4; ++ks) { const bf16x8 b = *(const bf16x8*)(ST + (16 * wid + c16) * PQ + ks * 32 + q4 * 8);
#pragma unroll
            for (int t = 0; t < 4; ++t) { const bf16x8 a = *(const bf16x8*)(Wl + (16 * t + c16) * PQ + ks * 32 + q4 * 8); ws[t] = __builtin_amdgcn_mfma_f32_16x16x32_bf16(a, b, ws[t], 0, 0, 0);
                const bf16x8 a2 = *(const bf16x8*)(QDl + (16 * t + c16) * PQ + ks * 32 + q4 * 8); os[t] = __builtin_amdgcn_mfma_f32_16x16x32_bf16(b, a2, os[t], 0, 0, 0); } }
#pragma unroll
        for (int t = 0; t < 4; ++t) { u32x2 w; w.x = pk2(bflo(uh[t].x) - ws[t][0], bfhi(uh[t].x) - ws[t][1]); w.y = pk2(bflo(uh[t].y) - ws[t][2], bfhi(uh[t].y) - ws[t][3]);
            *(u32x2*)(UTl + (16 * wid + c16) * PC + 16 * t + 4 * q4) = w; }
        LBAR();
#pragma unroll
        for (int i = 0; i < 2; ++i) *(u32x4*)(GZl + (r16 + 32 * i) * PQ + ch16) = sG[i];
#pragma unroll
        for (int i = 0; i < 2; ++i) sG[i] = *(const u32x4*)(gz + (size_t)(nn * 64 + r16 + 32 * i) * 1024 + ch16);
#pragma unroll
        for (int ks = 0; ks < 2; ++ks) { const bf16x8 b = *(const bf16x8*)(UTl + (16 * wid + c16) * PC + ks * 32 + q4 * 8);
#pragma unroll
            for (int t = 0; t < 4; ++t) { const bf16x8 a = *(const bf16x8*)(ATl + (16 * t + c16) * PC + ks * 32 + q4 * 8); os[t] = __builtin_amdgcn_mfma_f32_16x16x32_bf16(b, a, os[t], 0, 0, 0); } }
#pragma unroll
        for (int t = 0; t < 8; ++t) Sacc[t] = Sacc[t] * gl;
#pragma unroll
        for (int ks = 0; ks < 2; ++ks) { const bf16x8 a = *(const bf16x8*)(UTl + (16 * wid + c16) * PC + ks * 32 + q4 * 8);
#pragma unroll
            for (int t = 0; t < 8; ++t) { const bf16x8 b = *(const bf16x8*)(KDTl + (16 * t + c16) * PC + ks * 32 + q4 * 8); Sacc[t] = __builtin_amdgcn_mfma_f32_16x16x32_bf16(b, a, Sacc[t], 0, 0, 0); } }
#pragma unroll
        for (int t = 0; t < 8; ++t) { u32x2 w; w.x = pk2(Sacc[t][0], Sacc[t][1]); w.y = pk2(Sacc[t][2], Sacc[t][3]); *(u32x2*)(ST + (16 * wid + c16) * PQ + 16 * t + 4 * q4) = w; }
#pragma unroll
        for (int t = 0; t < 4; ++t) { float s = (os[t][0] * os[t][0] + os[t][1] * os[t][1]) + (os[t][2] * os[t][2] + os[t][3] * os[t][3]); s += __shfl_xor(s, 16); s += __shfl_xor(s, 32);
            if (q4 == 0) SSl[wid * 64 + 16 * t + c16] = s; }
        LBAR();
        float tot = 0.f;
#pragma unroll
        for (int w = 0; w < 8; ++w) tot += SSl[w * 64 + lane];
        const float rstd_l = rsqrtf(tot * (1.0f / 128.0f) + 1e-6f);
#pragma unroll
        for (int t = 0; t < 4; ++t) { const int row = 16 * t + c16; const float rs = __shfl(rstd_l, row);
            u32x2* gp = (u32x2*)(GZl + row * PQ + 16 * wid + 4 * q4); const u32x2 gw = *gp; u32x2 w;
            w.x = pk2(os[t][0] * rs * gn[0] * siluf(bflo(gw.x)), os[t][1] * rs * gn[1] * siluf(bfhi(gw.x)));
            w.y = pk2(os[t][2] * rs * gn[2] * siluf(bflo(gw.y)), os[t][3] * rs * gn[3] * siluf(bfhi(gw.y))); *gp = w; }
    }
    LBAR();
#pragma unroll
    for (int i = 0; i < 2; ++i) { const u32x4 v = *(const u32x4*)(GZl + (r16 + 32 * i) * PQ + ch16); *(u32x4*)(yg + (size_t)(31 * 64 + r16 + 32 * i) * 1024 + ch16) = v; }
    __syncthreads();
}

__device__ __forceinline__ void fox_item(char* lds, int item, const Ptrs& P, int tid) {
    using bf = fox::bf16;
    const int lane = tid & 63, wid = tid >> 6;
    const int bh = item >> 2, xq = item & 3, bl = bh >> 3, h = bh & 7;
    float* cb = (float*)(lds + fox::LDS_BYTES);
    float* tmp = cb + SEQ;
    const float* small = (const float*)(P.ws + WS_SMALL);
    {
        const float fb = P.fox_f_bias[h];
        float lf[4]; float run = 0.f;
#pragma unroll
        for (int e = 0; e < 4; ++e) { const float xv = small[(size_t)(bl * SEQ + 4 * tid + e) * 32 + h] + fb;
            const float l = (xv < -20.f) ? xv : -log1pf(__expf(-xv)); run += l; lf[e] = run; }
        float inc = run;
#pragma unroll
        for (int o = 1; o < 64; o <<= 1) { const float t = __shfl_up(inc, o); if (lane >= o) inc += t; }
        if (lane == 63) tmp[wid] = inc;
        __syncthreads();
        float off = inc - run;
        for (int w = 0; w < wid; ++w) off += tmp[w];
#pragma unroll
        for (int e = 0; e < 4; ++e) cb[4 * tid + e] = -(off + lf[e]) * 11.313708498984761f;
        __syncthreads();
    }
    bf* fq = (bf*)(P.ws + WS_PROJ); const bf* fk = fq + PROJ_STRIDE; const bf* fv = fq + 2 * PROJ_STRIDE;
    const size_t hb = (size_t)(bl * SEQ) * 1024 + h * HD;
    fox::BlockRef<bf, bf> b0, b1;
    bf* yo = (bf*)(P.ws + WS_YFOX);
    b0.Q = fq + hb + (size_t)(xq * 256) * 1024; b0.O = yo + hb + (size_t)(xq * 256) * 1024; b0.K = fk + hb; b0.V = fv + hb; b0.P0 = xq * 256;
    b1.Q = fq + hb + (size_t)((7 - xq) * 256) * 1024; b1.O = yo + hb + (size_t)((7 - xq) * 256) * 1024; b1.K = fk + hb; b1.V = fv + hb; b1.P0 = (7 - xq) * 256;
    fox::Seam<bf> S;
    fox::causal_swa_prime<bf, bf>(b0, 1 << 20, lds, S);
    fox::causal_swa_block<bf, bf>(b0, b1, SEQ, 1 << 20, lds, S, cb);
    fox::causal_swa_block<bf, bf>(b1, b1, SEQ, 1 << 20, lds, S, cb);
    __syncthreads();
}

__device__ __forceinline__ void phase_convgate(const Ptrs& P, int tid, int cid) {
    const bf16_t* up = (const bf16_t*)(P.ws + WS_UP); bf16_t* act = (bf16_t*)(P.ws + WS_ACT);
    constexpr int NFG = DFF / 8;
    constexpr int RPB = GM / 256; static_assert(SEQ % RPB == 0, "a slab never straddles a sequence start");
    if (tid < NFG) {
        const int fg = tid, p = fg >> 4, i0 = (fg & 15) * 8, f0 = p * 128 + i0;
        const int cg0 = p * 256 + i0, cv0 = cg0 + 128;
        float wg[3][8], wv[3][8];
#pragma unroll
        for (int i = 0; i < 3; ++i)
#pragma unroll
            for (int j = 0; j < 8; ++j) { wg[i][j] = P.ffn_conv_w[i * NUP + f0 + j]; wv[i][j] = P.ffn_conv_w[i * NUP + DFF + f0 + j]; }
        const int r0 = cid * RPB;
        float g1[8], g2[8], v1[8], v2[8];
#pragma unroll
        for (int j = 0; j < 8; ++j) { g1[j] = 0.f; g2[j] = 0.f; v1[j] = 0.f; v2[j] = 0.f; }
        if ((r0 & (SEQ - 1)) != 0) {
            const u32x4 a1 = *(const u32x4*)(up + (size_t)(r0 - 1) * NUP + cg0), a2 = *(const u32x4*)(up + (size_t)(r0 - 2) * NUP + cg0);
            const u32x4 b1 = *(const u32x4*)(up + (size_t)(r0 - 1) * NUP + cv0), b2 = *(const u32x4*)(up + (size_t)(r0 - 2) * NUP + cv0);
            g1[0] = bflo(a1.x); g1[1] = bfhi(a1.x); g1[2] = bflo(a1.y); g1[3] = bfhi(a1.y); g1[4] = bflo(a1.z); g1[5] = bfhi(a1.z); g1[6] = bflo(a1.w); g1[7] = bfhi(a1.w);
            g2[0] = bflo(a2.x); g2[1] = bfhi(a2.x); g2[2] = bflo(a2.y); g2[3] = bfhi(a2.y); g2[4] = bflo(a2.z); g2[5] = bfhi(a2.z); g2[6] = bflo(a2.w); g2[7] = bfhi(a2.w);
            v1[0] = bflo(b1.x); v1[1] = bfhi(b1.x); v1[2] = bflo(b1.y); v1[3] = bfhi(b1.y); v1[4] = bflo(b1.z); v1[5] = bfhi(b1.z); v1[6] = bflo(b1.w); v1[7] = bfhi(b1.w);
            v2[0] = bflo(b2.x); v2[1] = bfhi(b2.x); v2[2] = bflo(b2.y); v2[3] = bfhi(b2.y); v2[4] = bflo(b2.z); v2[5] = bfhi(b2.z); v2[6] = bflo(b2.w); v2[7] = bfhi(b2.w);
        }
        for (int rb = 0; rb < RPB; rb += 8) {
            u32x4 ga[8], va[8];
#pragma unroll
            for (int r = 0; r < 8; ++r) { ga[r] = *(const u32x4*)(up + (size_t)(r0 + rb + r) * NUP + cg0); va[r] = *(const u32x4*)(up + (size_t)(r0 + rb + r) * NUP + cv0); }
#pragma unroll
            for (int r = 0; r < 8; ++r) {
                const u32x4 a = ga[r], b = va[r];
                float g0[8], v0[8];
                g0[0] = bflo(a.x); g0[1] = bfhi(a.x); g0[2] = bflo(a.y); g0[3] = bfhi(a.y); g0[4] = bflo(a.z); g0[5] = bfhi(a.z); g0[6] = bflo(a.w); g0[7] = bfhi(a.w);
                v0[0] = bflo(b.x); v0[1] = bfhi(b.x); v0[2] = bflo(b.y); v0[3] = bfhi(b.y); v0[4] = bflo(b.z); v0[5] = bfhi(b.z); v0[6] = bflo(b.w); v0[7] = bfhi(b.w);
                float o[8];
#pragma unroll
                for (int j = 0; j < 8; ++j) { const float cgv = wg[0][j] * g2[j] + wg[1][j] * g1[j] + wg[2][j] * g0[j]; const float cvv = wv[0][j] * v2[j] + wv[1][j] * v1[j] + wv[2][j] * v0[j];
                    o[j] = siluf(cgv) * cvv; g2[j] = g1[j]; g1[j] = g0[j]; v2[j] = v1[j]; v1[j] = v0[j]; }
                u32x4 w; w.x = pk2(o[0], o[1]); w.y = pk2(o[2], o[3]); w.z = pk2(o[4], o[5]); w.w = pk2(o[6], o[7]);
                *(u32x4*)(act + (size_t)(r0 + rb + r) * DFF + f0) = w;
            }
        }
    }
}

__device__ __forceinline__ void phase_final(const Ptrs& P, int tid, int cid, float pert) {
    const int lane = tid & 63, wave = tid >> 6;
    const int gw = cid * 8 + wave, NGW = 256 * 8;
    const float* rowss2 = (const float*)(P.ws + WS_CTL) + MTOK;
    f32x4 gv[4];
#pragma unroll
    for (int j = 0; j < 4; ++j) gv[j] = ((const f32x4*)P.norm_final)[lane + 64 * j];
    for (int m0 = gw; m0 < MTOK; m0 += 2 * NGW) {
        const int m1 = m0 + NGW;
        const float rstd0 = rsqrtf(rowss2[m0] * (1.f / DM) + 1e-6f), rstd1 = rsqrtf(rowss2[m1] * (1.f / DM) + 1e-6f);
        f32x4* o0 = (f32x4*)(P.out + (size_t)m0 * DM) + lane; f32x4* o1 = (f32x4*)(P.out + (size_t)m1 * DM) + lane;
        f32x4 a0[4], a1[4];
#pragma unroll
        for (int j = 0; j < 4; ++j) { a0[j] = o0[64 * j]; a1[j] = o1[64 * j]; }
#pragma unroll
        for (int j = 0; j < 4; ++j) { o0[64 * j] = a0[j] * rstd0 * gv[j] + pert; o1[64 * j] = a1[j] * rstd1 * gv[j] + pert; }
    }
}

#define LAS __attribute__((address_space(3)))
#define XB_TMO      128
#define XB_XCNT(j)  (256  + 64 * (j))
#define XB_XSUB(j)  (1280 + 64 * (j))
#define XB_XGEN(j)  (2304 + 64 * (j))
#define XB_TOP      3328
#define XB_TOPGEN   3392
#define XCD_BAR_WORDS 3456
#define XB_SPIN_CAP (1u << 18)

__device__ __forceinline__ unsigned xb_ld(unsigned* p)              { return __hip_atomic_load(p, __ATOMIC_RELAXED, __HIP_MEMORY_SCOPE_AGENT); }
__device__ __forceinline__ unsigned xb_add(unsigned* p, unsigned v) { return __hip_atomic_fetch_add(p, v, __ATOMIC_RELAXED, __HIP_MEMORY_SCOPE_AGENT); }
__device__ __forceinline__ unsigned xb_xcc_id() { return (unsigned)__builtin_amdgcn_s_getreg((3 << 11) | 20) & 0xFu; }
#define XB_SPIN(cond, bar) do { unsigned _sp = 0; while (cond) { __builtin_amdgcn_s_sleep(1); \
    if ((++_sp & 255u) == 0u) { if (xb_ld(&(bar)[XB_TMO])) break; if (_sp > XB_SPIN_CAP) { atomicAdd(&(bar)[XB_TMO], 1u); break; } } } } while (0)

struct XcdBarrier {
    unsigned* bar; unsigned x;
    volatile LAS unsigned* st;
};

__device__ __forceinline__ XcdBarrier xcd_barrier_post(unsigned* bar, volatile LAS unsigned* st) {
    XcdBarrier b; b.bar = bar; b.x = xb_xcc_id(); b.st = st;
    if (threadIdx.x == 0) (void)xb_add(&bar[XB_XCNT(b.x)], 1u);
    return b;
}
__device__ __forceinline__ void xcd_barrier_complete(unsigned* bar, unsigned x, unsigned& nloc, unsigned& nx) {
    const unsigned G = gridDim.x * gridDim.y * gridDim.z;
    unsigned sum, cnt, mine, sp = 0u;
    for (;;) {
        sum = 0u; cnt = 0u; mine = 0u;
#pragma unroll
        for (unsigned j = 0; j < 16; ++j) { const unsigned c = xb_ld(&bar[XB_XCNT(j)]); sum += c; cnt += (c > 0u) ? 1u : 0u; mine = (j == x) ? c : mine; }
        if (sum == G) break;
        __builtin_amdgcn_s_sleep(1);
        if ((++sp & 255u) == 0u) { if (xb_ld(&bar[XB_TMO])) break; if (sp > XB_SPIN_CAP) { atomicAdd(&bar[XB_TMO], 1u); break; } }
    }
    nloc = mine > 0u ? mine : 1u; nx = cnt > 0u ? cnt : 1u;
}

__device__ __forceinline__ void xcd_barrier(const XcdBarrier& b) {
    asm volatile("s_waitcnt vmcnt(0)" ::: "memory");
    __syncthreads();
    if (threadIdx.x == 0) {
        unsigned* bar = b.bar;
        __builtin_amdgcn_s_waitcnt(0);
        unsigned nloc = b.st[0], nx = b.st[1];
        if (nloc == 0u) { xcd_barrier_complete(bar, b.x, nloc, nx); b.st[0] = nloc; b.st[1] = nx; }
        const unsigned old = xb_add(&bar[XB_XSUB(b.x)], 1u);
        const unsigned gen = old / nloc;
        if (old + 1u == (gen + 1u) * nloc) {
            __builtin_amdgcn_fence(__ATOMIC_RELEASE, "agent");
            asm volatile("s_waitcnt vmcnt(0)" ::: "memory");
            const unsigned og = xb_add(&bar[XB_TOP], 1u);
            const unsigned tg = og / nx;
            if (og + 1u == (tg + 1u) * nx) xb_add(&bar[XB_TOPGEN], 1u);
            else XB_SPIN(xb_ld(&bar[XB_TOPGEN]) == tg, bar);
            __builtin_amdgcn_fence(__ATOMIC_ACQUIRE, "agent");
            xb_add(&bar[XB_XGEN(b.x)], 1u);
            asm volatile("s_waitcnt vmcnt(0)" ::: "memory");
        } else {
            XB_SPIN(xb_ld(&bar[XB_XGEN(b.x)]) == gen, bar);
            __builtin_amdgcn_fence(__ATOMIC_ACQUIRE, "agent");
            asm volatile("s_waitcnt vmcnt(0)" ::: "memory");
        }
    }
    __syncthreads();
}

constexpr int N_PHASES = 2 + 8 * NG;
#ifndef PHM
#define PHM 2047
#endif
#ifndef DBL
#define DBL 0
#endif
#define DBLSEL 2
#ifndef TSTAMP
#define TSTAMP 0
#endif
#define TS_MASK 0x200
__global__ void __launch_bounds__(512, 2) mk_fwd(Args args) {
    extern __shared__ __attribute__((aligned(16))) unsigned char lds_raw[];
    char* lds = (char*)lds_raw;
    cg::grid_group grid = cg::this_grid();
    volatile LAS unsigned* xst = (volatile LAS unsigned*)((LAS unsigned char*)lds_raw + (LDS_BYTES - 16));
    if (threadIdx.x < 4) xst[threadIdx.x] = 0u;
    __syncthreads();
    XcdBarrier xbar; xbar.bar = (unsigned*)(args.ws + WS_CTL + 800 * 1024); xbar.x = 0; xbar.st = xst;
    constexpr int G = 256;
    for (int ph = args.ph_lo; ph < args.ph_hi; ++ph) {
      {
        int tid = threadIdx.x; asm volatile("" : "+v"(tid));
        int cid = blockIdx.x; asm volatile("" : "+s"(cid));
        typedef const __attribute__((address_space(4))) Args* KArgsP;
        KArgsP kp = (KArgsP)__builtin_amdgcn_kernarg_segment_ptr(); asm volatile("" : "+s"(kp));
#define GPTR(T, v) ((T*)(__attribute__((address_space(1))) T*)(v))
        Ptrs P;
        P.x = GPTR(const float, kp->in[0]); P.norm_mix = GPTR(const float, kp->in[1]); P.w_in = GPTR(const float, kp->in[2]); P.fox_f_bias = GPTR(const float, kp->in[3]);
        P.gdn_conv_w = GPTR(const float, kp->in[4]); P.gdn_a_log = GPTR(const float, kp->in[5]); P.gdn_dt_bias = GPTR(const float, kp->in[6]); P.gdn_norm = GPTR(const float, kp->in[7]);
        P.w_bf = GPTR(const float, kp->in[8]); P.w_bg = GPTR(const float, kp->in[9]); P.w_out = GPTR(const float, kp->in[10]); P.norm_ffn = GPTR(const float, kp->in[11]);
        P.w_up = GPTR(const float, kp->in[12]); P.ffn_conv_w = GPTR(const float, kp->in[13]); P.w_down = GPTR(const float, kp->in[14]); P.norm_final = GPTR(const float, kp->in[15]);
        P.out = GPTR(float, kp->out); unsigned char* ws = GPTR(unsigned char, kp->ws); P.ws = ws;
        float* rowss1 = (float*)(ws + WS_CTL); float* rowss2 = rowss1 + MTOK;
        if (ph == 0) { if (PHM & 1) phase_prologue(P, lds, tid, cid);
            if (MK_ONE_LAUNCH) {
                unsigned* cz = (unsigned*)(ws + WS_CTL); for (int i = cid * 512 + tid; i < 131072; i += G * 512) cz[i] = 0u;
                if (cid == 0) { unsigned* bz = (unsigned*)(ws + WS_CTL + 800 * 1024); for (int i = tid; i < XCD_BAR_WORDS; i += 512) bz[i] = 0u; if (tid < 64) ((unsigned*)(ws + WS_CTL + 768 * 1024))[tid] = 0u; } } }
        else if (ph == N_PHASES - 1) {
            float pert = 0.f;
            if (SEGSEL && blockIdx.x == 0) pert = fminf(__hip_atomic_load((float*)(ws + WS_CTL + 768 * 1024), __ATOMIC_RELAXED, __HIP_MEMORY_SCOPE_AGENT) * 5e-5f, 0.12f);
            if (PHM & 2) phase_final(P, tid, cid, pert); }
        else {
            const int grp = (ph - 1) >> 3, sub = (ph - 1) & 7;
            const size_t r0g = (size_t)grp * GM;
            pg8::bf16_t* proj = (pg8::bf16_t*)(ws + WS_PROJ);
            if (sub == 0 && (PHM & 4)) {
                pg8::Gemm g{(const pg8::bf16_t*)(P.out + r0g * DM), nullptr, (const pg8::bf16_t*)(ws + WS_WIN), nullptr, GM, NIN, DM};
                pg8::StaticOrder S; S.init(GM, NIN, G, cid);
                pg8::EpiIn E{proj, (float*)(ws + WS_SMALL)};
                pg8::gemm_phase<pg8::EpiIn, pg8::StaticOrder, true, true>((PG8_LAS unsigned char*)lds_raw, g, S, E);
            } else if (sub == 1 && (PHM & 8)) {
                { const int hh = (cid >> 5) & 7;
                  ConvW cwr;
#pragma unroll
                  for (int part = 0; part < 3; ++part)
#pragma unroll
                      for (int tap = 0; tap < 4; ++tap) cwr.w[part][tap] = *(const f32x4*)(P.gdn_conv_w + tap * 3072 + part * 1024 + hh * HD + 4 * (tid & 31));
                  const float neg_a = -__expf(P.gdn_a_log[hh]), dtb = P.gdn_dt_bias[hh];
                  PrepStage st; prep_fetch(st, cid, P, tid);
                  PrepHold hd; hd.unit = cid; hd.at = (u32x4){0u, 0u, 0u, 0u}; hd.uh[0] = hd.at; hd.uh[1] = hd.at; hd.w[0] = hd.at; hd.w[1] = hd.at;
                  for (int u = cid; u < NCH; u += G) { const int un = (u + G < NCH) ? u + G : u; gdn_prep_unit(lds, u, un, st, hd, cwr, P, tid, neg_a, dtb); }
                  prep_flush(hd, P, tid); }
            } else if (sub == 2) {
                if ((PHM & 32)) for (int bh = cid; bh < BG * NH; bh += G) gdn_seq_unit(lds, bh, P, tid);
                if ((PHM & 16)) { const bool sq = cid < BG * NH; const int first = sq ? cid * 4 : (cid - BG * NH) * 4 + 1, cnt = sq ? 1 : 3; for (int x = 0; x < cnt; ++x) fox_item(lds, first + x, P, tid); }
            } else if (sub == 3 && (PHM & 64)) {
                pg8::Gemm g{(const pg8::bf16_t*)(ws + WS_YFOX), (const pg8::bf16_t*)(ws + WS_YGDN), (const pg8::bf16_t*)(ws + WS_WBF), (const pg8::bf16_t*)(ws + WS_WBG), GM, DM, DM};
                pg8::PairOrder S; S.init(GM, DM, G, cid);
                pg8::EpiY E{proj + 7 * PROJ_STRIDE, proj + 8 * PROJ_STRIDE, (pg8::bf16_t*)(ws + WS_T1), (pg8::bf16_t*)(ws + WS_Y)};
                pg8::gemm_phase<pg8::EpiY, pg8::PairOrder, true, true>((PG8_LAS unsigned char*)lds_raw, g, S, E);
            } else if (sub == 4 && (PHM & 128)) {
                pg8::Gemm g{(const pg8::bf16_t*)(ws + WS_Y), nullptr, (const pg8::bf16_t*)(ws + WS_WOUT), nullptr, GM, DM, DM};
                pg8::StaticOrder S; S.init(GM, DM, G, cid);
                pg8::EpiOut E{P.x + r0g * DM, P.out + r0g * DM, (pg8::bf16_t*)(ws + WS_H1B), rowss1 + r0g};
                pg8::gemm_phase<pg8::EpiOut, pg8::StaticOrder, true, true>((PG8_LAS unsigned char*)lds_raw, g, S, E);
            } else if (sub == 5 && (PHM & 256)) {
                pg8::Gemm g{(const pg8::bf16_t*)(ws + WS_H1B), nullptr, (const pg8::bf16_t*)(ws + WS_WUP), nullptr, GM, NUP, DM};
                pg8::StaticOrder S; S.init(GM, NUP, G, cid);
                pg8::EpiUp E{(pg8::bf16_t*)(ws + WS_UP), rowss1 + r0g, NUP};
                pg8::gemm_phase<pg8::EpiUp, pg8::StaticOrder, true, true>((PG8_LAS unsigned char*)lds_raw, g, S, E);
            } else if (sub == 6) {
                if (PHM & 512) phase_convgate(P, tid, cid);
            } else if (PHM & 1024) {
                pg8::Gemm g{(const pg8::bf16_t*)(ws + WS_ACT), nullptr, (const pg8::bf16_t*)(ws + WS_WDN), nullptr, GM, DM, DFF};
                pg8::StaticOrder S; S.init(GM, DM, G, cid);
                pg8::EpiDown E{P.out + r0g * DM, rowss2 + r0g};
                pg8::gemm_phase<pg8::EpiDown, pg8::StaticOrder, true, true>((PG8_LAS unsigned char*)lds_raw, g, S, E);
            }
        }
      }
        if (ph + 1 < args.ph_hi) { if (ph == args.ph_lo) { grid.sync(); xbar = xcd_barrier_post((unsigned*)(args.ws + WS_CTL + 800 * 1024), xst); } else xcd_barrier(xbar); }
    }
}

extern "C" void kernel_launch(void* const* d_in, const int* in_sizes, int n_in, void* d_out, int out_size, void* d_ws, size_t ws_size, hipStream_t stream) {
    static int ready = 0;
    if (ready == 0) {
        if (n_in != 16 || in_sizes[0] != MTOK * DM || out_size != MTOK * DM || ws_size < WS_END) {
            fprintf(stderr, "kernel_launch: unexpected shapes (n_in %d, in0 %d, out %d, ws %zu; need ws >= %zu)\n", n_in, n_in > 0 ? in_sizes[0] : -1, out_size, ws_size, (size_t)WS_END); ready = -1; return; }
        if (hipFuncSetAttribute((const void*)mk_fwd, hipFuncAttributeMaxDynamicSharedMemorySize, LDS_BYTES) != hipSuccess) { fprintf(stderr, "kernel_launch: hipFuncSetAttribute failed\n"); ready = -1; return; }
        int per_cu = 0;
        if (hipOccupancyMaxActiveBlocksPerMultiprocessor(&per_cu, (const void*)mk_fwd, 512, LDS_BYTES) != hipSuccess || per_cu < 1) fprintf(stderr, "kernel_launch: occupancy query says %d blocks per CU\n", per_cu);
        (void)hipGetLastError();
        ready = 1;
    }
    if (ready < 0) return;
#if !MK_ONE_LAUNCH
    (void)hipMemsetAsync((char*)d_ws + WS_CTL, 0, 1 * MiB, stream);
#endif
    Args a{};
    for (int i = 0; i < 16; ++i) a.in[i] = (const float*)d_in[i];
    a.out = (float*)d_out; a.ws = (unsigned char*)d_ws;
#if MK_ONE_LAUNCH
    a.ph_lo = 0; a.ph_hi = N_PHASES;
    void* kargs[] = {&a};
    hipError_t e = hipLaunchCooperativeKernel((const void*)mk_fwd, dim3(256), dim3(512), kargs, LDS_BYTES, stream);
    if (e != hipSuccess) fprintf(stderr, "kernel_launch: cooperative launch failed: %s\n", hipGetErrorString(e));
#else
    for (int ph = 0; ph < N_PHASES; ++ph) { a.ph_lo = ph; a.ph_hi = ph + 1; hipLaunchKernelGGL(mk_fwd, dim3(256), dim3(512), LDS_BYTES, stream, a); }
#endif
}
```

```cpp
#include <hip/hip_runtime.h>
#include <hip/hip_bf16.h>
#include <hip/hip_cooperative_groups.h>
#include <cstdio>
#include <cstdint>
namespace cg = cooperative_groups;

#ifndef MK_ONE_LAUNCH
#define MK_ONE_LAUNCH 1
#endif

namespace pg8 {
#define PG8_LAS __attribute__((address_space(3)))
typedef unsigned short bf16_t;
typedef short bf16x8 __attribute__((ext_vector_type(8)));
typedef float f32x4 __attribute__((ext_vector_type(4)));
typedef unsigned u32x4 __attribute__((ext_vector_type(4)));
constexpr int BM = 256, BK = 64, HALF = 128, HTB = HALF * BK * 2  , STAGE_BYTES = 8 * HTB, NXCD = 8, WGM = 8;

__host__ __device__ __forceinline__ int lds_byte(int r, int c) { const int st = (r >> 4) * 2 + (c >> 5), rr = r & 15, cc = c & 31, ob = rr * 64 + cc * 2; return st * 1024 + (ob ^ (((ob >> 9) & 1) << 5)); }
__host__ __device__ __forceinline__ void stage_rc(int b, int& R, int& C) { const int st = b / 1024, sb = b % 1024, swz = sb ^ (((sb >> 9) & 1) << 5); R = (st >> 1) * 16 + swz / 64; C = (st & 1) * 32 + (swz % 64) / 2; }
__host__ __device__ __forceinline__ int perm32(int rho) { const int n = rho >> 4, i = rho & 15; return 8 * (i >> 2) + 4 * n + (i & 3); }

struct Unit { int pm, pn, sel; };
struct Gemm { const bf16_t* A0; const bf16_t* A1; const bf16_t* B0; const bf16_t* B1; int M, N, K; };

struct StaticOrder {
    int nM, nN, nwg, G, c;
    __host__ __device__ __forceinline__ void init(int M, int N, int G_, int c_) { nM = M / BM; nN = N / BM; nwg = nM * nN; G = G_; c = c_; }
    __host__ __device__ __forceinline__ bool next(int i, Unit& u) const {
        const long L = (long)i * G + c; if (L >= nwg) return false;
        int wgid = (int)L; { const int q = nwg / NXCD, r = nwg % NXCD, xcd = wgid % NXCD, off = wgid / NXCD; wgid = (xcd < r ? xcd * (q + 1) : r * (q + 1) + (xcd - r) * q) + off; }
        const int nig = WGM * nN, gid = wgid / nig, fm = gid * WGM, gsz = (nM - fm) < WGM ? (nM - fm) : WGM;
        u.pm = fm + ((wgid % nig) % gsz); u.pn = (wgid % nig) / gsz; u.sel = 0; return true;
    }
    __device__ __forceinline__ void a_ready(const Unit&) const {}
    __device__ __forceinline__ void done(const Unit&) const {}
};

__device__ __forceinline__ unsigned cvt_pk_bf16(float lo, float hi) { unsigned r; asm volatile("v_cvt_pk_bf16_f32 %0, %1, %2" : "=v"(r) : "v"(lo), "v"(hi)); return r; }
typedef unsigned u32x2 __attribute__((ext_vector_type(2)));
__device__ __forceinline__ float bflo(unsigned w) { return __uint_as_float(w << 16); }
__device__ __forceinline__ float bfhi(unsigned w) { return __uint_as_float(w & 0xffff0000u); }
__device__ __forceinline__ float sigm(float x) { return __builtin_amdgcn_rcpf(1.0f + __expf(-x)); }
constexpr int GM = 32768;
constexpr int LDP = 1024;

struct EpiIn {
    static constexpr bool PERM = true, AFTER_DRAIN = false;
    bf16_t* proj; float* small;
    __device__ __forceinline__ void operator()(const f32x4 (&acc)[2][2][4][2], const Unit& u, int wr, int wc, int fr, int fq) const {
        const int row0 = u.pm * BM + wr * 64 + fr;
        if (u.pn < 36) {
            bf16_t* base = proj + (size_t)(u.pn >> 2) * ((size_t)GM * LDP) + (u.pn & 3) * 256 + wc * 32 + 8 * fq;
#pragma unroll
            for (int ai = 0; ai < 2; ++ai)
#pragma unroll
                for (int m = 0; m < 4; ++m) { bf16_t* rowp = base + (size_t)(row0 + ai * HALF + m * 16) * LDP;
#pragma unroll
                    for (int bj = 0; bj < 2; ++bj) { const f32x4 v0 = acc[ai][bj][m][0], v1 = acc[ai][bj][m][1];
                        u32x4 w; w.x = cvt_pk_bf16(v0[0], v0[1]); w.y = cvt_pk_bf16(v0[2], v0[3]); w.z = cvt_pk_bf16(v1[0], v1[1]); w.w = cvt_pk_bf16(v1[2], v1[3]);
                        *(u32x4*)(rowp + bj * HALF) = w; } }
        } else if (wc == 0 && fq < 3) {
#pragma unroll
            for (int ai = 0; ai < 2; ++ai)
#pragma unroll
                for (int m = 0; m < 4; ++m) { float* p = small + (size_t)(row0 + ai * HALF + m * 16) * 32 + 8 * fq;
                    *(f32x4*)p = acc[ai][0][m][0]; *(f32x4*)(p + 4) = acc[ai][0][m][1]; }
        }
    }
};
struct EpiY {
    static constexpr bool PERM = true, AFTER_DRAIN = false;
    const bf16_t* gf; const bf16_t* gg; bf16_t* t1; bf16_t* y;
    __device__ __forceinline__ void operator()(const f32x4 (&acc)[2][2][4][2], const Unit& u, int wr, int wc, int fr, int fq) const {
        const int row0 = u.pm * BM + wr * 64 + fr, col0 = u.pn * BM + wc * 32 + 8 * fq;
        const bf16_t* const gf_ = gf; const bf16_t* const gg_ = gg; bf16_t* const t1_ = t1; bf16_t* const y_ = y;
        const bf16_t* gate = u.sel ? gg_ : gf_; bf16_t* dst = u.sel ? y_ : t1_;
        if (u.sel) asm volatile("s_waitcnt vmcnt(0)" ::: "memory");
#pragma unroll
        for (int ai = 0; ai < 2; ++ai) {
            u32x4 gw[4][2], tw[4][2];
#pragma unroll
            for (int m = 0; m < 4; ++m)
#pragma unroll
                for (int bj = 0; bj < 2; ++bj) { const size_t o = (size_t)(row0 + ai * HALF + m * 16) * LDP + col0 + bj * HALF;
                    gw[m][bj] = *(const u32x4*)(gate + o); tw[m][bj] = u.sel ? *(const u32x4*)(t1_ + o) : (u32x4){0u, 0u, 0u, 0u}; }
#pragma unroll
            for (int m = 0; m < 4; ++m)
#pragma unroll
                for (int bj = 0; bj < 2; ++bj) { const size_t o = (size_t)(row0 + ai * HALF + m * 16) * LDP + col0 + bj * HALF;
                    const u32x4 g = gw[m][bj], t = tw[m][bj]; const f32x4 v0 = acc[ai][bj][m][0], v1 = acc[ai][bj][m][1];
                    const float r0 = sigm(bflo(g.x)) * v0[0] + bflo(t.x), r1 = sigm(bfhi(g.x)) * v0[1] + bfhi(t.x), r2 = sigm(bflo(g.y)) * v0[2] + bflo(t.y), r3 = sigm(bfhi(g.y)) * v0[3] + bfhi(t.y);
                    const float r4 = sigm(bflo(g.z)) * v1[0] + bflo(t.z), r5 = sigm(bfhi(g.z)) * v1[1] + bfhi(t.z), r6 = sigm(bflo(g.w)) * v1[2] + bflo(t.w), r7 = sigm(bfhi(g.w)) * v1[3] + bfhi(t.w);
                    u32x4 w; w.x = cvt_pk_bf16(r0, r1); w.y = cvt_pk_bf16(r2, r3); w.z = cvt_pk_bf16(r4, r5); w.w = cvt_pk_bf16(r6, r7);
                    *(u32x4*)(dst + o) = w; }
        }
    }
};
struct EpiOut {
    static constexpr bool PERM = true, AFTER_DRAIN = false;
    const float* xin; float* hout; bf16_t* h1b; float* rowss;
    __device__ __forceinline__ void operator()(const f32x4 (&acc)[2][2][4][2], const Unit& u, int wr, int wc, int fr, int fq) const {
        const int col0 = u.pn * BM + wc * 32 + 8 * fq;
#pragma unroll
        for (int ai = 0; ai < 2; ++ai) {
            f32x4 pre[4][2][2];
#pragma unroll
            for (int m = 0; m < 4; ++m)
#pragma unroll
                for (int bj = 0; bj < 2; ++bj) { const size_t o = (size_t)(u.pm * BM + ai * HALF + wr * 64 + m * 16 + fr) * LDP + col0 + bj * HALF; pre[m][bj][0] = *(const f32x4*)(xin + o); pre[m][bj][1] = *(const f32x4*)(xin + o + 4); }
#pragma unroll
            for (int m = 0; m < 4; ++m) { const int row = u.pm * BM + ai * HALF + wr * 64 + m * 16 + fr; const size_t ro = (size_t)row * LDP + col0; float ss = 0.f;
#pragma unroll
                for (int bj = 0; bj < 2; ++bj) { const size_t o = ro + bj * HALF;
                    const f32x4 h0 = pre[m][bj][0] + acc[ai][bj][m][0], h1 = pre[m][bj][1] + acc[ai][bj][m][1];
                    u32x4 w; w.x = cvt_pk_bf16(h0[0], h0[1]); w.y = cvt_pk_bf16(h0[2], h0[3]); w.z = cvt_pk_bf16(h1[0], h1[1]); w.w = cvt_pk_bf16(h1[2], h1[3]); *(u32x4*)(h1b + o) = w;
                    ss += (h0[0] * h0[0] + h0[1] * h0[1]) + (h0[2] * h0[2] + h0[3] * h0[3]) + (h1[0] * h1[0] + h1[1] * h1[1]) + (h1[2] * h1[2] + h1[3] * h1[3]); }
                ss += __shfl_xor(ss, 16); ss += __shfl_xor(ss, 32);
                if (fq == 0) atomicAdd(rowss + row, ss); }
        }
    }
};
struct EpiUp {
    static constexpr bool PERM = true, AFTER_DRAIN = false;
    bf16_t* up; const float* rowss; int ldc;
    __device__ __forceinline__ void operator()(const f32x4 (&acc)[2][2][4][2], const Unit& u, int wr, int wc, int fr, int fq) const {
        const int row0 = u.pm * BM + wr * 64 + fr, col0 = u.pn * BM + wc * 32 + 8 * fq;
        float rsv[2][4];
#pragma unroll
        for (int ai = 0; ai < 2; ++ai)
#pragma unroll
            for (int m = 0; m < 4; ++m) rsv[ai][m] = rowss[row0 + ai * HALF + m * 16];
#pragma unroll
        for (int ai = 0; ai < 2; ++ai)
#pragma unroll
            for (int m = 0; m < 4; ++m) { const int row = row0 + ai * HALF + m * 16; const float rs = rsqrtf(rsv[ai][m] * (1.0f / 1024.0f) + 1e-6f); bf16_t* rowp = up + (size_t)row * ldc + col0;
#pragma unroll
                for (int bj = 0; bj < 2; ++bj) { const f32x4 v0 = acc[ai][bj][m][0] * rs, v1 = acc[ai][bj][m][1] * rs;
                    u32x4 w; w.x = cvt_pk_bf16(v0[0], v0[1]); w.y = cvt_pk_bf16(v0[2], v0[3]); w.z = cvt_pk_bf16(v1[0], v1[1]); w.w = cvt_pk_bf16(v1[2], v1[3]);
                    *(u32x4*)(rowp + bj * HALF) = w; } }
    }
};
struct EpiDown {
    static constexpr bool PERM = true, AFTER_DRAIN = false;
    const bf16_t* h1b; float* hout; float* rowss;
    __device__ __forceinline__ void operator()(const f32x4 (&acc)[2][2][4][2], const Unit& u, int wr, int wc, int fr, int fq) const {
        const int col0 = u.pn * BM + wc * 32 + 8 * fq;
#pragma unroll
        for (int ai = 0; ai < 2; ++ai) {
            u32x4 pre[4][2];
#pragma unroll
            for (int m = 0; m < 4; ++m)
#pragma unroll
                for (int bj = 0; bj < 2; ++bj) pre[m][bj] = *(const u32x4*)(h1b + (size_t)(u.pm * BM + ai * HALF + wr * 64 + m * 16 + fr) * LDP + col0 + bj * HALF);
#pragma unroll
            for (int m = 0; m < 4; ++m) { const int row = u.pm * BM + ai * HALF + wr * 64 + m * 16 + fr; const size_t ro = (size_t)row * LDP + col0; float ss = 0.f;
#pragma unroll
                for (int bj = 0; bj < 2; ++bj) { const size_t o = ro + bj * HALF; const u32x4 p = pre[m][bj];
                    const f32x4 h0 = (f32x4){bflo(p.x), bfhi(p.x), bflo(p.y), bfhi(p.y)} + acc[ai][bj][m][0], h1 = (f32x4){bflo(p.z), bfhi(p.z), bflo(p.w), bfhi(p.w)} + acc[ai][bj][m][1];
                    *(f32x4*)(hout + o) = h0; *(f32x4*)(hout + o + 4) = h1;
                    ss += (h0[0] * h0[0] + h0[1] * h0[1]) + (h0[2] * h0[2] + h0[3] * h0[3]) + (h1[0] * h1[0] + h1[1] * h1[1]) + (h1[2] * h1[2] + h1[3] * h1[3]); }
                ss += __shfl_xor(ss, 16); ss += __shfl_xor(ss, 32);
                if (fq == 0) atomicAdd(rowss + row, ss); }
        }
    }
};
struct PairOrder {
    int nM, nN, nwg, G, c;
    __host__ __device__ __forceinline__ void init(int M, int N, int G_, int c_) { nM = M / BM; nN = N / BM; nwg = nM * nN; G = G_; c = c_; }
    __host__ __device__ __forceinline__ bool next(int i, Unit& u) const {
        const long L = (long)(i >> 1) * G + c; if (L >= nwg) return false;
        int wgid = (int)L; { const int q = nwg / NXCD, r = nwg % NXCD, xcd = wgid % NXCD, off = wgid / NXCD; wgid = (xcd < r ? xcd * (q + 1) : r * (q + 1) + (xcd - r) * q) + off; }
        const int nig = WGM * nN, gid = wgid / nig, fm = gid * WGM, gsz = (nM - fm) < WGM ? (nM - fm) : WGM;
        u.pm = fm + ((wgid % nig) % gsz); u.pn = (wgid % nig) / gsz; u.sel = i & 1; return true;
    }
    __device__ __forceinline__ void a_ready(const Unit&) const {}
    __device__ __forceinline__ void done(const Unit&) const {}
};
template <class Epi, class Sched, bool ALIGN_EPI = false, bool SP2 = false>
__device__ __forceinline__ void gemm_phase(PG8_LAS unsigned char* lds, const Gemm g, const Sched& S, const Epi& E) {
    int tid_l = threadIdx.x; asm volatile("" : "+v"(tid_l));
    const int tid = tid_l, wid = __builtin_amdgcn_readfirstlane(tid >> 6), lane = tid & 63, wr = wid >> 2, wc = wid & 3, fr = lane & 15, fq = lane >> 4;
    const int K = g.K, nt = K / BK;
    unsigned voffA[2], voffB[2];
#pragma unroll
    for (int i = 0; i < 2; ++i) { int R, C; stage_rc(tid * 16 + i * 8192, R, C); const int Rb = Epi::PERM ? ((R & ~31) + perm32(R & 31)) : R;
        voffA[i] = (unsigned)(R * K + C) * 2u; voffB[i] = (unsigned)(Rb * K + C) * 2u; }
    const size_t kstep = (size_t)(BK * 2);
    const size_t hstep = (size_t)HALF * K * 2;
    const size_t tstep = 2 * hstep;
    const unsigned ldsw = (unsigned)wid * 1024u;
    const int aoff = lds_byte(wr * 64 + fr, fq * 8), boff = lds_byte(wc * 32 + fr, fq * 8);
#define PG8_SA(b, h) (((b) * 2 + (h)) * HTB)
#define PG8_SB(b, h) ((4 + (b) * 2 + (h)) * HTB)
#define PG8_STAGE(bufoff, gbase, voff) do { _Pragma("unroll") for (int _i = 0; _i < 2; ++_i) \
        __builtin_amdgcn_global_load_lds((const unsigned*)((const char*)(gbase) + (voff)[_i]), (PG8_LAS unsigned*)(lds + (bufoff) + ldsw + _i * 8192), 16, 0, 0); } while (0)
#define PG8_LDA(dst, b, h) do { _Pragma("unroll") for (int m = 0; m < 4; ++m) _Pragma("unroll") for (int k = 0; k < 2; ++k) dst[m][k] = *(const PG8_LAS bf16x8*)(lds + PG8_SA(b, h) + aoff + m * 2048 + k * 1024); } while (0)
#define PG8_LDB(dst, b, h) do { _Pragma("unroll") for (int n = 0; n < 2; ++n) _Pragma("unroll") for (int k = 0; k < 2; ++k) dst[n][k] = *(const PG8_LAS bf16x8*)(lds + PG8_SB(b, h) + boff + n * 2048 + k * 1024); } while (0)
#define PG8_MMA(ai, bj, At, Bt) do { __builtin_amdgcn_s_setprio(1); _Pragma("unroll") for (int m = 0; m < 4; ++m) _Pragma("unroll") for (int n = 0; n < 2; ++n) _Pragma("unroll") for (int k = 0; k < 2; ++k) \
        acc[ai][bj][m][n] = __builtin_amdgcn_mfma_f32_16x16x32_bf16(Bt[n][k], At[m][k], acc[ai][bj][m][n], 0, 0, 0); __builtin_amdgcn_s_setprio(0); } while (0)
#define PG8_WAIT_V(n) asm volatile("s_waitcnt vmcnt(" #n ")" ::: "memory")
#define PG8_WAIT_L(n) asm volatile("s_waitcnt lgkmcnt(" #n ")" ::: "memory")
#define PG8_BAR __builtin_amdgcn_s_barrier()
#define PG8_SCHED __builtin_amdgcn_sched_barrier(0)
    Unit cur, nxt; int ui = 0;
    if (!S.next(0, cur)) return;
    f32x4 acc[2][2][4][2];
#pragma unroll
    for (int a = 0; a < 2; ++a)
#pragma unroll
        for (int b = 0; b < 2; ++b)
#pragma unroll
            for (int m = 0; m < 4; ++m)
#pragma unroll
                for (int n = 0; n < 2; ++n) acc[a][b][m][n] = (f32x4){0.f, 0.f, 0.f, 0.f};
    bf16x8 At[4][2], B0[2][2], B1[2][2];
    const char* cA = (const char*)(cur.sel ? g.A1 : g.A0) + (size_t)cur.pm * tstep; const char* cB = (const char*)(cur.sel ? g.B1 : g.B0) + (size_t)cur.pn * tstep;
    S.a_ready(cur);
    if constexpr (SP2) {
        PG8_STAGE(PG8_SB(0, 0), cB, voffB); PG8_STAGE(PG8_SB(0, 1), cB + hstep, voffB); PG8_STAGE(PG8_SA(0, 0), cA, voffA); PG8_STAGE(PG8_SA(0, 1), cA + hstep, voffA);
        if (wr == 1) PG8_BAR;
        PG8_WAIT_V(2); PG8_BAR;
        PG8_STAGE(PG8_SB(1, 0), cB + kstep, voffB); PG8_STAGE(PG8_SA(1, 0), cA + kstep, voffA); PG8_STAGE(PG8_SB(1, 1), cB + hstep + kstep, voffB);
        PG8_WAIT_V(6); PG8_BAR;
    } else {
        PG8_STAGE(PG8_SB(0, 0), cB, voffB); PG8_STAGE(PG8_SA(0, 0), cA, voffA); PG8_STAGE(PG8_SB(0, 1), cB + hstep, voffB); PG8_STAGE(PG8_SA(0, 1), cA + hstep, voffA);
        if (wr == 1) PG8_BAR;
        PG8_WAIT_V(4); PG8_BAR;
        PG8_STAGE(PG8_SB(1, 0), cB + kstep, voffB); PG8_STAGE(PG8_SA(1, 0), cA + kstep, voffA); PG8_STAGE(PG8_SB(1, 1), cB + hstep + kstep, voffB);
        PG8_WAIT_V(6); PG8_BAR;
    }
    for (;;) {
        const bool has_next = S.next(ui + 1, nxt);
        const char* nA = has_next ? (const char*)(nxt.sel ? g.A1 : g.A0) + (size_t)nxt.pm * tstep : cA; const char* nB = has_next ? (const char*)(nxt.sel ? g.B1 : g.B0) + (size_t)nxt.pn * tstep : cB;
        for (int t = 0; t < nt; t += 2) {
            const bool last = (t == nt - 2);
            const char* a1 = cA + (size_t)(t + 1) * kstep;
            const char* a2 = last ? nA : cA + (size_t)(t + 2) * kstep; const char* b2 = last ? nB : cB + (size_t)(t + 2) * kstep;
            const char* a3 = a2 + kstep; const char* b3 = b2 + kstep;
            if (last && has_next) S.a_ready(nxt);
            if constexpr (SP2) {
            PG8_LDB(B0, 0, 0); PG8_LDB(B1, 0, 1); PG8_SCHED; PG8_LDA(At, 0, 0); PG8_STAGE(PG8_SA(1, 1), a1 + hstep, voffA);
            PG8_WAIT_V(8); PG8_WAIT_L(0); PG8_BAR; PG8_MMA(0, 0, At, B0); PG8_MMA(0, 1, At, B1); PG8_BAR; PG8_SCHED;
            PG8_LDA(At, 0, 1); PG8_STAGE(PG8_SB(0, 0), b2, voffB); PG8_STAGE(PG8_SB(0, 1), b2 + hstep, voffB); PG8_STAGE(PG8_SA(0, 0), a2, voffA);
            PG8_WAIT_V(8); PG8_WAIT_L(0); PG8_BAR; PG8_MMA(1, 0, At, B0); PG8_MMA(1, 1, At, B1); PG8_BAR; PG8_SCHED;
            PG8_LDB(B0, 1, 0); PG8_LDB(B1, 1, 1); PG8_SCHED; PG8_LDA(At, 1, 0); PG8_STAGE(PG8_SA(0, 1), a2 + hstep, voffA);
            PG8_WAIT_V(8); PG8_WAIT_L(0); PG8_BAR; PG8_MMA(0, 0, At, B0); PG8_MMA(0, 1, At, B1); PG8_BAR; PG8_SCHED;
            PG8_LDA(At, 1, 1); PG8_STAGE(PG8_SB(1, 0), b3, voffB); PG8_STAGE(PG8_SB(1, 1), b3 + hstep, voffB); PG8_STAGE(PG8_SA(1, 0), a3, voffA);
            PG8_WAIT_V(8); PG8_WAIT_L(0); PG8_BAR; PG8_MMA(1, 0, At, B0); PG8_MMA(1, 1, At, B1); PG8_BAR; PG8_SCHED;
            } else {
            PG8_LDB(B0, 0, 0); PG8_SCHED; PG8_LDA(At, 0, 0); PG8_STAGE(PG8_SA(1, 1), a1 + hstep, voffA);
            PG8_WAIT_L(8); PG8_BAR; PG8_WAIT_L(0); PG8_MMA(0, 0, At, B0); PG8_BAR; PG8_SCHED;
            PG8_LDB(B1, 0, 1); PG8_STAGE(PG8_SB(0, 0), b2, voffB);
            PG8_BAR; PG8_WAIT_L(0); PG8_MMA(0, 1, At, B1); PG8_BAR;
            PG8_LDA(At, 0, 1); PG8_STAGE(PG8_SA(0, 0), a2, voffA);
            PG8_BAR; PG8_WAIT_L(0); PG8_MMA(1, 0, At, B0); PG8_BAR; PG8_SCHED;
            PG8_STAGE(PG8_SB(0, 1), b2 + hstep, voffB);
            PG8_WAIT_V(6); PG8_BAR; PG8_MMA(1, 1, At, B1); PG8_BAR;
            PG8_LDB(B0, 1, 0); PG8_SCHED; PG8_LDA(At, 1, 0); PG8_STAGE(PG8_SA(0, 1), a2 + hstep, voffA);
            PG8_WAIT_L(8); PG8_BAR; PG8_WAIT_L(0); PG8_MMA(0, 0, At, B0); PG8_BAR; PG8_SCHED;
            PG8_LDB(B1, 1, 1); PG8_STAGE(PG8_SB(1, 0), b3, voffB);
            PG8_BAR; PG8_WAIT_L(0); PG8_MMA(0, 1, At, B1); PG8_BAR;
            PG8_LDA(At, 1, 1); PG8_STAGE(PG8_SA(1, 0), a3, voffA);
            PG8_BAR; PG8_WAIT_L(0); PG8_MMA(1, 0, At, B0); PG8_BAR; PG8_SCHED;
            PG8_STAGE(PG8_SB(1, 1), b3 + hstep, voffB);
            PG8_WAIT_V(6); PG8_BAR; PG8_MMA(1, 1, At, B1); PG8_BAR;
            }
        }
        if constexpr (ALIGN_EPI) { if (wr == 0) PG8_BAR; }
        if constexpr (!Epi::AFTER_DRAIN) { E(acc, cur, wr, wc, fr, fq); S.done(cur); }
        if (!has_next) break;
#pragma unroll
        for (int a = 0; a < 2; ++a)
#pragma unroll
            for (int b = 0; b < 2; ++b)
#pragma unroll
                for (int m = 0; m < 4; ++m)
#pragma unroll
                    for (int n = 0; n < 2; ++n) acc[a][b][m][n] = (f32x4){0.f, 0.f, 0.f, 0.f};
        cur = nxt; cA = nA; cB = nB; ++ui;
        if constexpr (ALIGN_EPI) { if (wr == 1) PG8_BAR; }
    }
    PG8_WAIT_V(0);
    if constexpr (!ALIGN_EPI) { if (wr == 0) PG8_BAR; }
    PG8_BAR;
    if constexpr (Epi::AFTER_DRAIN) { E.fused(acc, cur, wr, wc, fr, fq, lds, wid, lane); S.done(cur); }
#undef PG8_SA
#undef PG8_SB
#undef PG8_STAGE
#undef PG8_LDA
#undef PG8_LDB
#undef PG8_MMA
#undef PG8_WAIT_V
#undef PG8_WAIT_L
#undef PG8_BAR
#undef PG8_SCHED
}
}

namespace fox {
constexpr int D = 128, PITCH = 1024;
constexpr bool WSKIP = false;
constexpr float THR = 8.f;
constexpr float SCALE = 0.08838834764831845f;
constexpr int NW = 8, QBLK = 32, KVBLK = 64, QB = NW * QBLK;
constexpr int SHM_V = KVBLK * D * 2, SHM_K = KVBLK * D * 2;
constexpr int LDS_BYTES = 2 * SHM_V + 2 * SHM_K + NW * 64 * 4;
using bf16 = __hip_bfloat16;
typedef short bf16x8 __attribute__((ext_vector_type(8)));
typedef short s16x4 __attribute__((ext_vector_type(4)));
typedef float f32x16 __attribute__((ext_vector_type(16)));
typedef float f32x4 __attribute__((ext_vector_type(4)));
typedef unsigned u32x4 __attribute__((ext_vector_type(4)));
template <class A, class Bt> struct same_t { static constexpr bool v = false; };
template <class A> struct same_t<A, A> { static constexpr bool v = true; };
__device__ __forceinline__ void bias_tile(f32x16& p0, f32x16& p1, const float* cbp) {
#pragma unroll
    for (int rr = 0; rr < 4; ++rr) { const f32x4 a = *(const f32x4*)(cbp + 8 * rr), b = *(const f32x4*)(cbp + 32 + 8 * rr);
#pragma unroll
        for (int e = 0; e < 4; ++e) { p0[4 * rr + e] += a[e]; p1[4 * rr + e] += b[e]; } }
}
#define KSWZ(row, colB) ((row) * 256 + ((colB) ^ (((row) & 7) << 4)))
#define SBAR() __builtin_amdgcn_sched_barrier(0)
__device__ __forceinline__ int v_st(int k, int c) { const int kk = (k & ~0xC) | ((k & 4) << 1) | ((k & 8) >> 1); return ((kk >> 3) * 4 + (c >> 5)) * 512 + ((kk & 7) * 32 + (c & 31)) * 2; }
__device__ __forceinline__ int v_rd_base(int lane) { return ((lane & 3) << 3) | (((lane >> 2) & 3) << 6) | (((lane >> 4) & 1) << 5) | (((lane >> 5) & 1) << 8); }
constexpr int v_rd_off(int d0, int ks, int half) { return d0 * 512 + ks * 4096 + half * 2048; }
__device__ __forceinline__ int crow(int r, int hi) { return (r & 3) + 8 * (r >> 2) + 4 * hi; }
__device__ __forceinline__ unsigned cvtpk(float lo, float hi) {
    unsigned r; asm volatile("v_cvt_pk_bf16_f32 %0, %1, %2" : "=v"(r) : "v"(lo), "v"(hi)); return r;
}
__device__ __forceinline__ bf16x8 pack8(f32x4 a, f32x4 b) {
    u32x4 w = {cvtpk(a[0], a[1]), cvtpk(a[2], a[3]), cvtpk(b[0], b[1]), cvtpk(b[2], b[3])};
    return *reinterpret_cast<bf16x8*>(&w);
}
template <class T> __device__ __forceinline__ bf16x8 load8(const T* p) {
    if constexpr (same_t<T, float>::v) { return pack8(*(const f32x4*)p, *(const f32x4*)(p + 4)); }
    else { return *reinterpret_cast<const bf16x8*>(p); }
}
__device__ __forceinline__ void mask_tile(f32x16& p0, f32x16& p1, int dq, unsigned W) {
    const float NEG = -__builtin_inff();
#pragma unroll
    for (int r = 0; r < 16; ++r) {
        const int c = (r & 3) + 8 * (r >> 2);
        if ((unsigned)(dq - c) >= W) p0[r] = NEG;
        if ((unsigned)(dq - c - 32) >= W) p1[r] = NEG;
    }
}
__device__ __forceinline__ void partialSM(f32x16& p0, f32x16& p1, float& m_reg, float& mn, float& alpha) {
    float pmax = p0[0]; for (int r = 1; r < 16; ++r) pmax = fmaxf(pmax, p0[r]); for (int r = 0; r < 16; ++r) pmax = fmaxf(pmax, p1[r]);
    { auto rr = __builtin_amdgcn_permlane32_swap(__float_as_uint(pmax), __float_as_uint(pmax), false, false);
      pmax = fmaxf(__uint_as_float(rr[0]), __uint_as_float(rr[1])); }
    constexpr float C2 = 1.4426950408889634f * SCALE;
    if (__builtin_expect(__all((pmax - m_reg) * SCALE <= THR), 1)) { mn = m_reg; alpha = 1.f; }
    else { mn = fmaxf(m_reg, pmax); alpha = __builtin_amdgcn_exp2f((m_reg - mn) * C2); m_reg = mn; }
    const float mnL = -mn * C2;
    for (int r = 0; r < 16; ++r) p0[r] = fmaf(p0[r], C2, mnL); for (int r = 0; r < 16; ++r) p1[r] = fmaf(p1[r], C2, mnL);
    for (int r = 0; r < 16; ++r) p0[r] = __builtin_amdgcn_exp2f(p0[r]);
}
__device__ __forceinline__ void finishSM(f32x16& p0, f32x16& p1, float alpha, float& l_reg, bf16x8& pa0, bf16x8& pa1, bf16x8& pa2, bf16x8& pa3) {
    for (int r = 0; r < 16; ++r) p1[r] = __builtin_amdgcn_exp2f(p1[r]);
    float ps = 0; for (int r = 0; r < 16; ++r) ps += p0[r]; for (int r = 0; r < 16; ++r) ps += p1[r];
    { auto rr = __builtin_amdgcn_permlane32_swap(__float_as_uint(ps), __float_as_uint(ps), false, false);
      ps = __uint_as_float(rr[0]) + __uint_as_float(rr[1]); }
    l_reg = l_reg * alpha + ps;
#define PK4(P, B_, OUT) do { unsigned a0 = cvtpk(P[B_+0], P[B_+1]), a1 = cvtpk(P[B_+2], P[B_+3]);                          \
        unsigned b0 = cvtpk(P[B_+4], P[B_+5]), b1 = cvtpk(P[B_+6], P[B_+7]);                                             \
        auto r0 = __builtin_amdgcn_permlane32_swap(a0, b0, false, false); auto r1 = __builtin_amdgcn_permlane32_swap(a1, b1, false, false); \
        u32x4 w = {r0[0], r1[0], r0[1], r1[1]}; OUT = *reinterpret_cast<bf16x8*>(&w); } while (0)
    PK4(p0, 0, pa0); PK4(p0, 8, pa1); PK4(p1, 0, pa2); PK4(p1, 8, pa3);
#undef PK4
}
template <int KB, bool SK>
__device__ __forceinline__ void qkt(f32x16& p0, f32x16& p1, const char* K_lds, int r32, int hi, const bf16x8* qr, bool act, const float* cbp) {
    if (SK && !act) { const float NEG = -__builtin_inff();
#pragma unroll
        for (int r = 0; r < 16; ++r) { p0[r] = NEG; p1[r] = NEG; } return; }
    { const f32x4* c4 = (const f32x4*)cbp; const f32x4 a0 = c4[0], a1 = c4[2], a2 = c4[4], a3 = c4[6], b0 = c4[8], b1 = c4[10], b2 = c4[12], b3 = c4[14];
      p0 = (f32x16){a0[0], a0[1], a0[2], a0[3], a1[0], a1[1], a1[2], a1[3], a2[0], a2[1], a2[2], a2[3], a3[0], a3[1], a3[2], a3[3]};
      p1 = (f32x16){b0[0], b0[1], b0[2], b0[3], b1[0], b1[1], b1[2], b1[3], b2[0], b2[1], b2[2], b2[3], b3[0], b3[1], b3[2], b3[3]}; }
    const char* kb[4];
#pragma unroll
    for (int dd = 0; dd < 4; ++dd) kb[dd] = K_lds + KB * SHM_K + KSWZ(r32, (dd * 16 + hi * 8) * 2);
#pragma unroll
    for (int d0 = 0; d0 < 8; ++d0) { const char* a = kb[d0 & 3] + (d0 >> 2) * 128;
        bf16x8 b0 = *reinterpret_cast<const bf16x8*>(a);
        bf16x8 b1 = *reinterpret_cast<const bf16x8*>(a + 32 * 256);
        p0 = __builtin_amdgcn_mfma_f32_32x32x16_bf16(b0, qr[d0], p0, 0, 0, 0);
        p1 = __builtin_amdgcn_mfma_f32_32x32x16_bf16(b1, qr[d0], p1, 0, 0, 0); }
}
template <int VB, bool SK>
__device__ __forceinline__ void pv_tile(f32x16* o, int vb0, bf16x8 pa0, bf16x8 pa1, bf16x8 pa2, bf16x8 pa3, bool act) {
    if (SK && !act) return;
#define TRRD(dst, off) asm volatile("ds_read_b64_tr_b16 %0, %1 offset:%2" : "=&v"(dst) : "v"(vb0), "i"(off) : "memory")
#define PV_D0(d0) do { s16x4 l0, l1, l2, l3, h0, h1, h2, h3; constexpr int b_ = VB * SHM_V + v_rd_off(d0, 0, 0);     \
        TRRD(l0, b_); TRRD(h0, b_ + 2048); TRRD(l1, b_ + 4096); TRRD(h1, b_ + 6144); TRRD(l2, b_ + 8192); TRRD(h2, b_ + 10240); TRRD(l3, b_ + 12288); TRRD(h3, b_ + 14336); \
        asm volatile("s_waitcnt lgkmcnt(0)" ::: "memory"); SBAR();                 \
        o[d0] = __builtin_amdgcn_mfma_f32_32x32x16_bf16(pa0, (bf16x8){l0[0], l0[1], l0[2], l0[3], h0[0], h0[1], h0[2], h0[3]}, o[d0], 0, 0, 0);   \
        o[d0] = __builtin_amdgcn_mfma_f32_32x32x16_bf16(pa1, (bf16x8){l1[0], l1[1], l1[2], l1[3], h1[0], h1[1], h1[2], h1[3]}, o[d0], 0, 0, 0);   \
        o[d0] = __builtin_amdgcn_mfma_f32_32x32x16_bf16(pa2, (bf16x8){l2[0], l2[1], l2[2], l2[3], h2[0], h2[1], h2[2], h2[3]}, o[d0], 0, 0, 0);   \
        o[d0] = __builtin_amdgcn_mfma_f32_32x32x16_bf16(pa3, (bf16x8){l3[0], l3[1], l3[2], l3[3], h3[0], h3[1], h3[2], h3[3]}, o[d0], 0, 0, 0); } while (0)
    PV_D0(0); PV_D0(1); PV_D0(2); PV_D0(3);
#undef PV_D0
#undef TRRD
}

template <class TIn, class TOut> struct BlockRef { const TIn* Q; const TIn* K; const TIn* V; TOut* O; int P0; };
template <class TIn> struct Seam {
    bf16x8 qr[8];
    bf16x8 st_v0, st_v1, st_k0, st_k1; f32x4 sf0, sf1, sf2, sf3;
    f32x4 tq[16];
};
__device__ __forceinline__ int swa_jlo(int P0, int W) { const int lowk = P0 - W + 1; return lowk > 0 ? lowk / KVBLK : 0; }
#define ROW(p, k0, rr) ((p) + (size_t)((k0) + (rr)) * PITCH + sc)
#define VMW() asm volatile("s_waitcnt vmcnt(0)" ::: "memory")
#define VMWN(n) asm volatile("s_waitcnt vmcnt(%0)" :: "i"(n) : "memory")
#define SLOAD_H(Kp, Vp, k0) do { S.st_v0 = load8<TIn>(ROW(Vp, k0, sr)); S.st_v1 = load8<TIn>(ROW(Vp, k0, 32 + sr));              \
                         S.st_k0 = load8<TIn>(ROW(Kp, k0, sr)); S.st_k1 = load8<TIn>(ROW(Kp, k0, 32 + sr)); } while (0)
#define SWRITE_HK(bf) do { *(bf16x8*)(K_lds + (bf) * SHM_K + kws) = S.st_k0; *(bf16x8*)(K_lds + (bf) * SHM_K + kws + 32 * 256) = S.st_k1; } while (0)
#define SWRITE_HV(bf) do { *(bf16x8*)(V_lds + (bf) * SHM_V + vst0) = S.st_v0; *(bf16x8*)(V_lds + (bf) * SHM_V + vst1) = S.st_v1; } while (0)
#define SWRITE_H(bf) do { SWRITE_HV(bf); SWRITE_HK(bf); } while (0)
#define SLOAD_F(p, k0) do { S.sf0 = *(const f32x4*)ROW(p, k0, sr); S.sf1 = *(const f32x4*)(ROW(p, k0, sr) + 4);                \
                            S.sf2 = *(const f32x4*)ROW(p, k0, 32 + sr); S.sf3 = *(const f32x4*)(ROW(p, k0, 32 + sr) + 4); } while (0)
#define SWRITE_KF(bf) do { *(bf16x8*)(K_lds + (bf) * SHM_K + kws) = pack8(S.sf0, S.sf1); *(bf16x8*)(K_lds + (bf) * SHM_K + kws + 32 * 256) = pack8(S.sf2, S.sf3); } while (0)
#define SWRITE_VF(bf) do { *(bf16x8*)(V_lds + (bf) * SHM_V + vst0) = pack8(S.sf0, S.sf1); *(bf16x8*)(V_lds + (bf) * SHM_V + vst1) = pack8(S.sf2, S.sf3); } while (0)
template <class TIn, class TOut>
__device__ __forceinline__ void causal_swa_prime(const BlockRef<TIn, TOut>& cur, int W, char* lds, Seam<TIn>& S) {
    constexpr bool F32 = same_t<TIn, float>::v;
    int tid_l = threadIdx.x; asm volatile("" : "+v"(tid_l));
    const int tid = tid_l, wid = __builtin_amdgcn_readfirstlane(tid >> 6), lane = tid & 63, r32 = lane & 31, hi = lane >> 5;
    const int sr = tid >> 4, sc = (tid & 15) * 8, kws = KSWZ(sr, sc * 2); char* K_lds = lds + 2 * SHM_V;
    const int kb0 = swa_jlo(cur.P0, W) * KVBLK;
    for (int d0 = 0; d0 < 8; ++d0) S.qr[d0] = load8<TIn>(cur.Q + (size_t)(wid * QBLK + r32) * PITCH + d0 * 16 + hi * 8);
    if constexpr (F32) { SLOAD_F((const float*)cur.K, kb0); VMW(); SWRITE_KF(0); SBAR(); SLOAD_F((const float*)cur.V, kb0); }
    else { SLOAD_H(cur.K, cur.V, kb0); VMW(); SWRITE_HK(0); }
    __syncthreads();
}
template <class TIn, class TOut>
__device__ __forceinline__ void causal_swa_block(const BlockRef<TIn, TOut>& cur, const BlockRef<TIn, TOut>& nxt, int skv, int W, char* lds, Seam<TIn>& S, const float* cbias) {
    constexpr bool F32 = same_t<TIn, float>::v;
    int tid_l = threadIdx.x; asm volatile("" : "+v"(tid_l));
    const int tid = tid_l, wid = __builtin_amdgcn_readfirstlane(tid >> 6), lane = tid & 63, r32 = lane & 31, hi = lane >> 5;
    const int j_lo = swa_jlo(cur.P0, W);
    int j_hi = (cur.P0 + QB - 1) / KVBLK + 1; if (j_hi > skv / KVBLK) j_hi = skv / KVBLK;
    const int NT = j_hi - j_lo;
    const int kbn = swa_jlo(nxt.P0, W) * KVBLK;
    const int qlo = cur.P0 + wid * QBLK, qm = qlo + r32 - 4 * hi;
    char* V_lds = lds; char* K_lds = lds + 2 * SHM_V;
    float* ws = (float*)(lds + 2 * SHM_V + 2 * SHM_K) + wid * 64; float* li_l = ws, * al_l = ws + 32;
    float m_reg = -1e30f, l_reg = 0; f32x16 o[4] = {};
    const int sr = tid >> 4, sc = (tid & 15) * 8, vst0 = v_st(sr, sc), vst1 = v_st(32 + sr, sc), kws = KSWZ(sr, sc * 2);
    const int vb0 = (int)(uintptr_t)V_lds + v_rd_base(lane);
    const TIn* Kh = cur.K; const TIn* Vh = cur.V;
#define RESC(a) do { if (__any((a) < 1.f)) { if (hi == 0) al_l[r32] = (a); asm volatile("s_waitcnt lgkmcnt(0)" ::: "memory");              \
                     for (int d_ = 0; d_ < 4; ++d_) for (int r = 0; r < 16; ++r) o[d_][r] *= al_l[crow(r, hi)]; } } while (0)
#define KBASE(t) ((j_lo + (t)) * KVBLK)
#define ACT(t) (KBASE(t) <= qlo + QBLK - 1 && KBASE(t) + KVBLK - 1 >= qlo - W + 1)
#define MASKT(P0_, P1_, t) do { const int kb_ = KBASE(t); if ((!SK || ACT(t)) && (kb_ + KVBLK - 1 > qlo || kb_ <= qlo + QBLK - 1 - W)) mask_tile(P0_, P1_, qm - kb_, (unsigned)W); } while (0)
    constexpr int NQL = F32 ? 16 : 8;
    constexpr bool SK = WSKIP && !F32;
#define SEAM_K0() do { VMWN(NQL); if constexpr (F32) { SWRITE_KF(0); SBAR(); SLOAD_F((const float*)nxt.V, kbn); } else { SWRITE_HK(0); } SBAR(); } while (0)
    f32x16 pA0, pA1, pB0, pB1; float mnA, mnB, alA, alB; bf16x8 pa0, pa1, pa2, pa3;
    if constexpr (F32) { VMW(); SWRITE_VF(0); SBAR(); } else { SWRITE_HV(0); SBAR(); }
    if (NT > 1) { if constexpr (F32) SLOAD_F((const float*)Kh, KBASE(1)); else SLOAD_H(Kh, Vh, KBASE(1)); }
    SBAR(); qkt<0, SK>(pA0, pA1, K_lds, r32, hi, S.qr, ACT(0), cbias + KBASE(0) + 4 * hi);
    if constexpr (F32) { if (NT > 1) { VMW(); SWRITE_KF(1); SBAR(); SLOAD_F((const float*)Vh, KBASE(1)); } }
    MASKT(pA0, pA1, 0); partialSM(pA0, pA1, m_reg, mnA, alA);
    if (NT > 1) { VMW(); if constexpr (F32) { SWRITE_VF(1); SBAR(); if (NT > 2) SLOAD_F((const float*)Kh, KBASE(2)); } else SWRITE_H(1); }
    __syncthreads();
#define HALF_STEP(PX0, PX1, mnX, alX, PY0, PY1, alY, t, KB, VB, SB) do {                                                      \
        SBAR(); qkt<KB, SK>(PX0, PX1, K_lds, r32, hi, S.qr, ACT(t), cbias + KBASE(t) + 4 * hi);                                             \
        finishSM(PY0, PY1, alY, l_reg, pa0, pa1, pa2, pa3); SBAR();                                                           \
        if ((t) + 1 < NT) { if constexpr (F32) { VMW(); SWRITE_KF(SB); SBAR(); SLOAD_F((const float*)Vh, KBASE((t) + 1)); }  \
                            else { SLOAD_H(Kh, Vh, KBASE((t) + 1)); } SBAR(); }                                               \
        pv_tile<VB, SK>(o, vb0, pa0, pa1, pa2, pa3, ACT((t) - 1)); MASKT(PX0, PX1, (t)); partialSM(PX0, PX1, m_reg, mnX, alX);                                        \
        __syncthreads();                                                                                                      \
        if ((t) + 1 < NT) { VMW(); if constexpr (F32) { SWRITE_VF(SB); SBAR(); if ((t) + 2 < NT) SLOAD_F((const float*)Kh, KBASE((t) + 2)); } \
                            else { SWRITE_H(SB); } }                                                                          \
        RESC(alX); __syncthreads(); } while (0)
    for (int t = 1; t + 1 < NT; t += 2) {
        HALF_STEP(pB0, pB1, mnB, alB, pA0, pA1, alA, t, 1, 0, 0);
        HALF_STEP(pA0, pA1, mnA, alA, pB0, pB1, alB, t + 1, 0, 1, 1);
    }
    const bool even = (NT & 1) == 0;
    if (even) { SBAR(); qkt<1, SK>(pB0, pB1, K_lds, r32, hi, S.qr, ACT(NT - 1), cbias + KBASE(NT - 1) + 4 * hi); SBAR(); }
#define QROW(e) (nxt.Q + (size_t)(wid * QBLK + r32) * PITCH + ((e) >> 1) * 16 + hi * 8 + ((e) & 1) * 4)
    if constexpr (F32) { SLOAD_F((const float*)nxt.K, kbn); SBAR();
#pragma unroll
        for (int e = 0; e < 8; ++e) S.tq[e] = *(const f32x4*)QROW(e); }
    else { SLOAD_H(nxt.K, nxt.V, kbn); SBAR();
#pragma unroll
        for (int d0 = 0; d0 < 8; ++d0) S.qr[d0] = load8<TIn>(nxt.Q + (size_t)(wid * QBLK + r32) * PITCH + d0 * 16 + hi * 8); }
    SBAR();
    finishSM(pA0, pA1, alA, l_reg, pa0, pa1, pa2, pa3); SBAR();
    if constexpr (F32) {
#pragma unroll
        for (int e = 8; e < 16; ++e) S.tq[e] = *(const f32x4*)QROW(e); SBAR(); }
#undef QROW
    pv_tile<0, SK>(o, vb0, pa0, pa1, pa2, pa3, ACT(even ? NT - 2 : NT - 1));
    if (even) { MASKT(pB0, pB1, NT - 1); partialSM(pB0, pB1, m_reg, mnB, alB); __syncthreads(); RESC(alB);
        finishSM(pB0, pB1, alB, l_reg, pa0, pa1, pa2, pa3); SBAR(); pv_tile<1, SK>(o, vb0, pa0, pa1, pa2, pa3, ACT(NT - 1)); }
    SBAR(); SEAM_K0();
    if (hi == 0) li_l[r32] = l_reg; asm volatile("s_waitcnt lgkmcnt(0)" ::: "memory");
    float rli[16];
#pragma unroll
    for (int r = 0; r < 16; ++r) rli[r] = __builtin_amdgcn_rcpf(li_l[crow(r, hi)]);
    TOut* Ow = cur.O + (size_t)(wid * QBLK) * PITCH;
#pragma unroll
    for (int r = 0; r < 16; ++r) { const int orow = crow(r, hi);
#pragma unroll
        for (int d0 = 0; d0 < 4; ++d0) { const float v = o[d0][r] * rli[r];
            if constexpr (same_t<TOut, float>::v) { Ow[(size_t)orow * PITCH + d0 * 32 + r32] = v; }
            else { const float vn = __shfl_xor(v, 1);
                   if ((r32 & 1) == 0) *(unsigned*)(Ow + (size_t)orow * PITCH + d0 * 32 + r32) = cvtpk(v, vn); } } }
    if constexpr (F32) {
#pragma unroll
        for (int d0 = 0; d0 < 8; ++d0) S.qr[d0] = pack8(S.tq[2 * d0], S.tq[2 * d0 + 1]); }
    __syncthreads();
#undef RESC
#undef KBASE
#undef ACT
#undef MASKT
#undef SEAM_K0
#undef HALF_STEP
}
#undef ROW
#undef VMW
#undef VMWN
#undef SLOAD_H
#undef SWRITE_HK
#undef SWRITE_HV
#undef SWRITE_H
#undef SLOAD_F
#undef SWRITE_KF
#undef SWRITE_VF
}

typedef unsigned short bf16_t;
typedef short bf16x8 __attribute__((ext_vector_type(8)));
typedef float f32x4 __attribute__((ext_vector_type(4)));
typedef unsigned u32x4 __attribute__((ext_vector_type(4)));
typedef unsigned u32x2 __attribute__((ext_vector_type(2)));
constexpr int DM = 1024, NB = 32, SEQ = 2048, NH = 8, HD = 128, DFF = 2816, NUP = 2 * DFF;
constexpr int MTOK = NB * SEQ;
constexpr int NG = 2, BG = NB / NG, GM = BG * SEQ;
constexpr int NIN = 37 * 256;
constexpr int NCH = BG * NH * 32;
static_assert(GM == pg8::GM, "group rows");
constexpr size_t MiB = 1u << 20;
constexpr size_t WS_CTL = 0;
constexpr size_t WS_WIN = 1 * MiB, WS_WBF = 20 * MiB, WS_WBG = 22 * MiB, WS_WOUT = 24 * MiB, WS_WUP = 26 * MiB, WS_WDN = 37 * MiB;
constexpr size_t WS_PROJ = 44 * MiB;
constexpr size_t WS_SMALL = 620 * MiB;
constexpr size_t WS_PREP = 624 * MiB;
constexpr size_t WS_END = 913 * MiB;
constexpr size_t PBUF = 64 * MiB;
constexpr size_t WS_H1B = WS_PROJ + 0 * PBUF;
constexpr size_t WS_T1 = WS_PROJ + 1 * PBUF;
constexpr size_t WS_Y = WS_PROJ + 2 * PBUF;
constexpr size_t WS_YGDN = WS_PROJ + 3 * PBUF;
constexpr size_t WS_YFOX = WS_PROJ + 5 * PBUF;
constexpr size_t WS_UP = WS_PROJ + 3 * PBUF;
constexpr size_t WS_ACT = WS_PREP;
constexpr size_t PROJ_STRIDE = (size_t)GM * 1024;
constexpr int LDS_BYTES = 163840;

__device__ __forceinline__ float bf2f(bf16_t b) { return __uint_as_float((unsigned)b << 16); }
__device__ __forceinline__ float bflo(unsigned w) { return __uint_as_float(w << 16); }
__device__ __forceinline__ float bfhi(unsigned w) { return __uint_as_float(w & 0xffff0000u); }
typedef float f32x2_t __attribute__((ext_vector_type(2))); typedef __bf16 bf16x2_t __attribute__((ext_vector_type(2)));
__device__ __forceinline__ unsigned pk2(float lo, float hi) { f32x2_t v = {lo, hi}; bf16x2_t b = __builtin_convertvector(v, bf16x2_t); return __builtin_bit_cast(unsigned, b); }
__device__ __forceinline__ bf16_t f2bf(float f) { return (bf16_t)(pk2(f, 0.f) & 0xffffu); }
__device__ __forceinline__ float siluf(float y) { return y * __builtin_amdgcn_rcpf(1.0f + __expf(-y)); }
__device__ __forceinline__ float wave_sum(float v) {
#pragma unroll
    for (int o = 1; o < 64; o <<= 1) v += __shfl_xor(v, o);
    return v;
}

struct Args { const float* in[16]; float* out; unsigned char* ws; int ph_lo, ph_hi; };
struct Ptrs {
    const float *x, *norm_mix, *w_in, *fox_f_bias, *gdn_conv_w, *gdn_a_log, *gdn_dt_bias, *gdn_norm, *w_bf, *w_bg, *w_out, *norm_ffn, *w_up, *ffn_conv_w, *w_down, *norm_final;
    float* out; unsigned char* ws;
};

template <int MODE> __device__ __forceinline__ int srccol(int n) {
    if (MODE == 0) return n;
    if (MODE == 1) {
        if (n < 3072) return n;
        if (n < 6144) return 3080 + (n - 3072);
        if (n < 9216) return 6168 + (n - 6144);
        const int s = n - 9216;
        if (s < 8) return 3072 + s;
        if (s < 16) return 6152 + (s - 8);
        if (s < 24) return 6160 + (s - 16);
        return -1;
    }
    { const int p = n >> 8, s = (n >> 7) & 1, i = n & 127; return s * DFF + 128 * p + i; }
}
template <int MODE> __device__ __forceinline__ void transpose_item(const float* W, int K, int N, const float* ksc, bf16_t* WT, float* scr, int item, int nblk, int lane) {
    const int kb = item / nblk, nb = item % nblk, k0 = 64 * kb, n0 = 32 * nb;
    const int sc = srccol<MODE>(n0 + (lane & 31));
    float tv[32];
    const int scc = sc >= 0 ? sc : 0;
#pragma unroll
    for (int i = 0; i < 32; ++i) tv[i] = W[(size_t)(k0 + 2 * i + (lane >> 5)) * N + scc];
    if (ksc) {
#pragma unroll
        for (int i = 0; i < 32; ++i) tv[i] *= ksc[k0 + 2 * i + (lane >> 5)]; }
#pragma unroll
    for (int i = 0; i < 32; ++i) scr[(2 * i + (lane >> 5)) * 33 + (lane & 31)] = (sc >= 0) ? tv[i] : 0.f;
    asm volatile("s_waitcnt lgkmcnt(0)" ::: "memory");
    const int c = lane & 7;
#pragma unroll
    for (int j = 0; j < 4; ++j) { const int n = (lane >> 3) + 8 * j; const float* s = scr + (8 * c) * 33 + n;
        u32x4 o; o.x = pk2(s[0 * 33], s[1 * 33]); o.y = pk2(s[2 * 33], s[3 * 33]); o.z = pk2(s[4 * 33], s[5 * 33]); o.w = pk2(s[6 * 33], s[7 * 33]);
        *(u32x4*)(WT + (size_t)(n0 + n) * K + k0 + 8 * c) = o; }
    asm volatile("s_waitcnt lgkmcnt(0)" ::: "memory");
}
__device__ __forceinline__ void phase_prologue(const Ptrs& P, char* lds, int tid, int cid) {
    const int lane = tid & 63, wave = tid >> 6;
    float* scr = (float*)(lds + wave * 16384);
    const int gw = cid * 8 + wave, NGW = 256 * 8;
    bf16_t* win_t = (bf16_t*)(P.ws + WS_WIN); bf16_t* wbf_t = (bf16_t*)(P.ws + WS_WBF); bf16_t* wbg_t = (bf16_t*)(P.ws + WS_WBG);
    bf16_t* wout_t = (bf16_t*)(P.ws + WS_WOUT); bf16_t* wup_t = (bf16_t*)(P.ws + WS_WUP); bf16_t* wdn_t = (bf16_t*)(P.ws + WS_WDN);
    constexpr int I_IN = 16 * (NIN / 32), I_SQ = 16 * 32, I_UP = 16 * (NUP / 32), I_DN = (DFF / 64) * 32;
    constexpr int NITEMS = I_IN + 3 * I_SQ + I_UP + I_DN;
    for (int it = gw; it < NITEMS; it += NGW) {
        int r = it;
        if (r < I_IN) { transpose_item<1>(P.w_in, DM, 9240, nullptr, win_t, scr, r, NIN / 32, lane); continue; } r -= I_IN;
        if (r < I_SQ) { transpose_item<0>(P.w_bf, DM, DM, nullptr, wbf_t, scr, r, 32, lane); continue; } r -= I_SQ;
        if (r < I_SQ) { transpose_item<0>(P.w_bg, DM, DM, nullptr, wbg_t, scr, r, 32, lane); continue; } r -= I_SQ;
        if (r < I_SQ) { transpose_item<0>(P.w_out, DM, DM, nullptr, wout_t, scr, r, 32, lane); continue; } r -= I_SQ;
        if (r < I_UP) { transpose_item<2>(P.w_up, DM, NUP, P.norm_ffn, wup_t, scr, r, NUP / 32, lane); continue; } r -= I_UP;
        transpose_item<0>(P.w_down, DFF, DM, nullptr, wdn_t, scr, r, 32, lane);
    }
    f32x4 gv[4];
#pragma unroll
    for (int j = 0; j < 4; ++j) gv[j] = ((const f32x4*)P.norm_mix)[lane + 64 * j];
    for (int m0 = gw; m0 < MTOK; m0 += 2 * NGW) {
        const int m1 = m0 + NGW;
        const f32x4* xr0 = (const f32x4*)(P.x + (size_t)m0 * DM) + lane; const f32x4* xr1 = (const f32x4*)(P.x + (size_t)m1 * DM) + lane;
        f32x4 v0[4], v1[4]; float s0 = 0.f, s1 = 0.f;
#pragma unroll
        for (int j = 0; j < 4; ++j) { v0[j] = xr0[64 * j]; v1[j] = xr1[64 * j]; }
#pragma unroll
        for (int j = 0; j < 4; ++j) { s0 += (v0[j][0] * v0[j][0] + v0[j][1] * v0[j][1]) + (v0[j][2] * v0[j][2] + v0[j][3] * v0[j][3]); s1 += (v1[j][0] * v1[j][0] + v1[j][1] * v1[j][1]) + (v1[j][2] * v1[j][2] + v1[j][3] * v1[j][3]); }
        const float rstd0 = rsqrtf(wave_sum(s0) * (1.f / DM) + 1e-6f), rstd1 = rsqrtf(wave_sum(s1) * (1.f / DM) + 1e-6f);
        const int g0 = m0 / GM, g1 = m1 / GM;
        u32x2* o0 = (u32x2*)((bf16_t*)(P.out + (size_t)g0 * GM * DM) + (size_t)(m0 - g0 * GM) * DM) + lane;
        u32x2* o1 = (u32x2*)((bf16_t*)(P.out + (size_t)g1 * GM * DM) + (size_t)(m1 - g1 * GM) * DM) + lane;
#pragma unroll
        for (int j = 0; j < 4; ++j) { const f32x4 t0 = v0[j] * rstd0 * gv[j], t1 = v1[j] * rstd1 * gv[j]; u32x2 w0, w1; w0.x = pk2(t0[0], t0[1]); w0.y = pk2(t0[2], t0[3]); w1.x = pk2(t1[0], t1[1]); w1.y = pk2(t1[2], t1[3]); o0[64 * j] = w0; o1[64 * j] = w1; }
    }
}

__device__ __forceinline__ f32x4 mma16(const bf16_t* A, int lda, const bf16_t* Bt, int ldb, int ksteps, f32x4 acc, int lane) {
    const int r = lane & 15, q = lane >> 4;
    const bf16_t* ap = A + r * lda + q * 8; const bf16_t* bp = Bt + r * ldb + q * 8;
    for (int ks = 0; ks < ksteps; ++ks) { const bf16x8 a = *(const bf16x8*)(ap + ks * 32); const bf16x8 b = *(const bf16x8*)(bp + ks * 32); acc = __builtin_amdgcn_mfma_f32_16x16x32_bf16(a, b, acc, 0, 0, 0); }
    return acc;
}
#define LBAR() do { asm volatile("s_waitcnt lgkmcnt(0)" ::: "memory"); __builtin_amdgcn_s_barrier(); asm volatile("" ::: "memory"); } while (0)
__device__ __forceinline__ f32x4 mma16s(const bf16_t* A, int lda, int sw, const bf16_t* Bt, int ldb, int ksteps, f32x4 acc, int lane) {
    const int r = lane & 15, q = lane >> 4;
    const bf16_t* ap = A + r * lda; const bf16_t* bp = Bt + r * ldb + q * 8;
    for (int ks = 0; ks < ksteps; ++ks) { const bf16x8 a = *(const bf16x8*)(ap + (((ks * 4 + q) ^ sw) << 3)); const bf16x8 b = *(const bf16x8*)(bp + ks * 32); acc = __builtin_amdgcn_mfma_f32_16x16x32_bf16(a, b, acc, 0, 0, 0); }
    return acc;
}
constexpr int PQ = 136, PC = 72;
struct PrepBufs { bf16_t *W, *QD, *KDT, *UHT, *AT; float* GL; };
__device__ __forceinline__ PrepBufs prep_bufs(unsigned char* ws) {
    PrepBufs b; b.W = (bf16_t*)(ws + WS_PREP); b.QD = (bf16_t*)(ws + WS_PREP + 64 * MiB); b.KDT = (bf16_t*)(ws + WS_PREP + 128 * MiB); b.UHT = (bf16_t*)(ws + WS_PREP + 192 * MiB);
    b.AT = (bf16_t*)(ws + WS_PREP + 256 * MiB); b.GL = (float*)(ws + WS_PREP + 288 * MiB); return b;
}
constexpr int PL_QS = 0, PL_KS = 17408, PL_KDT = 34816, PL_RAW = 53248, RAWP = 392  , PL_RT = PL_RAW + 67 * RAWP * 2, PL_GC = PL_RT + 256 * PC * 2, PL_CW = PL_GC + 512, PL_END = PL_CW + 6144;
constexpr int RAW_CHUNKS = 67 * 48;
#ifndef SEGSEL
#define SEGSEL 0
#endif
#define SEG_T0() unsigned long long seg_t0 = 0; if (SEGSEL && blockIdx.x == 0 && threadIdx.x == 0) seg_t0 = __builtin_amdgcn_s_memrealtime()
#define SEG_MARK(k) do { if (SEGSEL && blockIdx.x == 0 && threadIdx.x == 0) { const unsigned long long t_ = __builtin_amdgcn_s_memrealtime(); if (SEGSEL == (k)) atomicAdd((float*)(P.ws + WS_CTL + 768 * 1024), (float)(t_ - seg_t0) * 0.01f); seg_t0 = t_; } } while (0)
struct PrepStage { u32x4 raw[7]; float ga, gb; };
struct ConvW { f32x4 w[3][4]; };
struct PrepHold { u32x4 uh[2], w[2], at; int unit; };
__device__ __forceinline__ void prep_fetch(PrepStage& st, int unit, const Ptrs& P, int tid) {
    const int n = unit & 31, h = (unit >> 5) & 7, bl = unit >> 8;
    const int R0 = bl * SEQ + n * 64;
    const bf16_t* proj = (const bf16_t*)(P.ws + WS_PROJ); const float* small = (const float*)(P.ws + WS_SMALL);
#pragma unroll
    for (int i = 0; i < 7; ++i) { int c = tid + 512 * i; c = c < RAW_CHUNKS ? c : RAW_CHUNKS - 1; const int row = c / 48, c16 = c - row * 48, part = c16 >> 4, ch = (c16 & 15) * 8;
        const bool zero = (n == 0) && (row < 3);
        const int rr = zero ? 3 : row;
        u32x4 v = *(const u32x4*)(proj + (size_t)(3 + part) * PROJ_STRIDE + (size_t)(R0 - 3 + rr) * 1024 + h * HD + ch);
        if (zero) v = (u32x4){0u, 0u, 0u, 0u};
        st.raw[i] = v; }
    { const float* sm = small + (size_t)(R0 + (tid & 63)) * 32; st.ga = sm[8 + h]; st.gb = sm[16 + h]; }
}
__device__ __forceinline__ void prep_flush(const PrepHold& hd, const Ptrs& P, int tid) {
    const PrepBufs G = prep_bufs(P.ws);
#pragma unroll
    for (int i = 0; i < 2; ++i) { const int idx = tid + 512 * i; *(u32x4*)(G.UHT + (size_t)hd.unit * 8192 + idx * 8) = hd.uh[i]; *(u32x4*)(G.W + (size_t)hd.unit * 8192 + idx * 8) = hd.w[i]; }
    *(u32x4*)(G.AT + (size_t)hd.unit * 4096 + tid * 8) = hd.at;
}
__device__ __forceinline__ void gdn_prep_unit(char* lds, int unit, int unit_next, PrepStage& st, PrepHold& hd, const ConvW& cwr, const Ptrs& P, int tid_in, float neg_a, float dtb) {
    int tid = tid_in; asm volatile("" : "+v"(tid));
    const int lane = tid & 63, wid = tid >> 6, c16 = lane & 15, q4 = lane >> 4;
    const int h = (unit >> 5) & 7;
    bf16_t* Qs = (bf16_t*)(lds + PL_QS); bf16_t* Ks = (bf16_t*)(lds + PL_KS); bf16_t* KDTs = (bf16_t*)(lds + PL_KDT);
    bf16_t* RAW = (bf16_t*)(lds + PL_RAW);
    bf16_t* RT = (bf16_t*)(lds + PL_RT);
    float* gcs = (float*)(lds + PL_GC); float* bts = gcs + 64;
    bf16_t* UHs = (bf16_t*)(lds + PL_RAW + 4096); bf16_t* Wst = UHs + 8192; bf16_t* ATs = Wst + 64 * PQ;
    bf16_t* CH = (bf16_t*)lds;
    const PrepBufs G = prep_bufs(P.ws);
    SEG_T0();
#pragma unroll
    for (int i = 0; i < 7; ++i) { const int c = tid + 512 * i; const int row = c / 48, cc = c - row * 48; if (c < RAW_CHUNKS) *(u32x4*)(RAW + row * RAWP + cc * 8) = st.raw[i]; }
    if (wid == 0) {
        const float xx = st.ga + dtb;
        const float sp = xx > 20.f ? xx : log1pf(__expf(xx));
        float cum = neg_a * sp;
        const float beta = __builtin_amdgcn_rcpf(1.0f + __expf(-st.gb));
#pragma unroll
        for (int o = 1; o < 64; o <<= 1) { const float t = __shfl_up(cum, o); if (lane >= o) cum += t; }
        gcs[lane] = cum; bts[lane] = beta;
    }
    prep_flush(hd, P, tid);
    LBAR();
    SEG_MARK(1);
    prep_fetch(st, unit_next, P, tid);
    {
        const int cg = tid & 31, rg = tid >> 5, r0 = 4 * rg, c0 = 4 * cg;
        const f32x4 gc4 = *(const f32x4*)(gcs + r0), bt4 = *(const f32x4*)(bts + r0); const float glast = gcs[63];
        float eg[4], egl[4];
#pragma unroll
        for (int rr = 0; rr < 4; ++rr) { eg[rr] = __expf(gc4[rr]); egl[rr] = __expf(glast - gc4[rr]); }
        const int key = (cg >> 1) & 7;
        const int csw = ((((rg >> 1) ^ key) << 3) | ((rg & 1) << 2));
#pragma unroll
        for (int part = 0; part < 3; ++part) {
            float x[7][4];
#pragma unroll
            for (int i = 0; i < 7; ++i) { const u32x2 a = *(const u32x2*)(RAW + (r0 + i) * RAWP + part * 128 + c0); x[i][0] = bflo(a.x); x[i][1] = bfhi(a.x); x[i][2] = bflo(a.y); x[i][3] = bfhi(a.y); }
            float y[4][4]; float ss[4];
#pragma unroll
            for (int rr = 0; rr < 4; ++rr) { ss[rr] = 0.f;
#pragma unroll
                for (int e = 0; e < 4; ++e) { float v = cwr.w[part][0][e] * x[rr][e] + cwr.w[part][1][e] * x[rr + 1][e] + cwr.w[part][2][e] * x[rr + 2][e] + cwr.w[part][3][e] * x[rr + 3][e];
                    v = siluf(v); y[rr][e] = v; ss[rr] += v * v; } }
            if (part < 2) {
#pragma unroll
                for (int rr = 0; rr < 4; ++rr) { float t = ss[rr]; t += __shfl_xor(t, 1); t += __shfl_xor(t, 2); t += __shfl_xor(t, 4); t += __shfl_xor(t, 8); t += __shfl_xor(t, 16); ss[rr] = rsqrtf(t + 1e-6f); }
            }
            if (part == 0) {
#pragma unroll
                for (int rr = 0; rr < 4; ++rr) { const float sc = ss[rr] * 0.08838834764831845f; const float a0 = y[rr][0] * sc, a1 = y[rr][1] * sc, a2 = y[rr][2] * sc, a3 = y[rr][3] * sc;
                    u32x2 w; w.x = pk2(a0, a1); w.y = pk2(a2, a3); *(u32x2*)(Qs + (r0 + rr) * PQ + c0) = w;
                    u32x2 d; d.x = pk2(a0 * eg[rr], a1 * eg[rr]); d.y = pk2(a2 * eg[rr], a3 * eg[rr]); *(u32x2*)(G.QD + (size_t)unit * 8192 + (r0 + rr) * 128 + c0) = d; }
            } else if (part == 1) {
#pragma unroll
                for (int rr = 0; rr < 4; ++rr) {
#pragma unroll
                    for (int e = 0; e < 4; ++e) y[rr][e] *= ss[rr];
                    u32x2 w; w.x = pk2(y[rr][0], y[rr][1]); w.y = pk2(y[rr][2], y[rr][3]); *(u32x2*)(Ks + (r0 + rr) * PQ + c0) = w; }
#pragma unroll
                for (int e = 0; e < 4; ++e) { u32x2 w1, w2;
                    w1.x = pk2(y[0][e] * bt4[0] * eg[0], y[1][e] * bt4[1] * eg[1]); w1.y = pk2(y[2][e] * bt4[2] * eg[2], y[3][e] * bt4[3] * eg[3]);
                    w2.x = pk2(y[0][e] * egl[0], y[1][e] * egl[1]); w2.y = pk2(y[2][e] * egl[2], y[3][e] * egl[3]);
                    *(u32x2*)(RT + (128 + c0 + e) * PC + csw) = w1; *(u32x2*)(KDTs + (c0 + e) * PC + csw) = w2; }
            } else {
#pragma unroll
                for (int e = 0; e < 4; ++e) { u32x2 w1; w1.x = pk2(y[0][e] * bt4[0], y[1][e] * bt4[1]); w1.y = pk2(y[2][e] * bt4[2], y[3][e] * bt4[3]); *(u32x2*)(RT + (c0 + e) * PC + csw) = w1; }
            }
        }
    }
    LBAR();
    SEG_MARK(2);
    {
#pragma unroll
        for (int i = 0; i < 2; ++i) { const int idx = tid + 512 * i, row = idx >> 3, ch = idx & 7; *(u32x4*)(G.KDT + (size_t)unit * 8192 + row * 64 + ch * 8) = *(const u32x4*)(KDTs + row * PC + ((ch ^ ((row >> 3) & 7)) << 3)); }
    }
    const int mat = wid >> 2, ti = wid & 3;
    f32x4 res[4], res2[4];
#pragma unroll
    for (int tj = 0; tj < 4; ++tj) { f32x4 acc = {0.f, 0.f, 0.f, 0.f}, acc2 = {0.f, 0.f, 0.f, 0.f};
        if (tj <= ti) { if (mat == 0) acc = mma16(Ks + ti * 16 * PQ, PQ, Ks + tj * 16 * PQ, PQ, 4, acc, lane);
                        acc2 = mma16(Ks + tj * 16 * PQ, PQ, (mat ? Qs : Ks) + ti * 16 * PQ, PQ, 4, acc2, lane); }
        res[tj] = acc; res2[tj] = acc2; }
    LBAR();
    {
        const int iiL = ti * 16 + c16; const float gciL = gcs[iiL], btL = bts[iiL];
#pragma unroll
        for (int tj = 0; tj < 4; ++tj) {
            const int jc0 = tj * 16 + 4 * q4;
            const f32x4 gcj = *(const f32x4*)(gcs + jc0);
            float v[4];
#pragma unroll
            for (int jj = 0; jj < 4; ++jj) { const int jc = jc0 + jj; const float dec = (iiL >= jc) ? __expf(gciL - gcj[jj]) : 0.f;
                v[jj] = (mat == 0) ? ((iiL > jc) ? -res2[tj][jj] * dec * btL : 0.f) : ((iiL >= jc) ? res2[tj][jj] * dec : 0.f); }
            u32x2 w; w.x = pk2(v[0], v[1]); w.y = pk2(v[2], v[3]);
            if (mat == 0) *(u32x2*)(CH + iiL * PC + jc0) = w;
            else *(u32x2*)(ATs + iiL * PC + jc0) = w;
            if (mat == 0) {
                const int jcL = tj * 16 + c16, ii0 = ti * 16 + 4 * q4; const float gcjL = gcs[jcL];
                const f32x4 gci = *(const f32x4*)(gcs + ii0), bti = *(const f32x4*)(bts + ii0);
                float t[4];
#pragma unroll
                for (int jj = 0; jj < 4; ++jj) { const int ii = ii0 + jj; t[jj] = (ii > jcL) ? -res[tj][jj] * __expf(gci[jj] - gcjL) * bti[jj] : 0.f; }
                u32x2 w2; w2.x = pk2(t[0], t[1]); w2.y = pk2(t[2], t[3]);
                *(u32x2*)(CH + 2 * 64 * PC + jcL * PC + ii0) = w2; }
        }
    }
    LBAR();
    SEG_MARK(3);
    f32x4 pacc[4];
    if (wid >= 4) {
#pragma unroll
        for (int tj = 0; tj < 4; ++tj) { const u32x2 nw = *(const u32x2*)(CH + (ti * 16 + c16) * PC + tj * 16 + 4 * q4); const int ii = ti * 16 + c16, jc0 = tj * 16 + 4 * q4;
            pacc[tj][0] = bflo(nw.x) + (ii == jc0 ? 1.f : 0.f); pacc[tj][1] = bfhi(nw.x) + (ii == jc0 + 1 ? 1.f : 0.f); pacc[tj][2] = bflo(nw.y) + (ii == jc0 + 2 ? 1.f : 0.f); pacc[tj][3] = bfhi(nw.y) + (ii == jc0 + 3 ? 1.f : 0.f); }
    }
    for (int s = 0; s < 6; ++s) {
        const int cur = s & 1, nxt = cur ^ 1;
        bf16_t* Qr_c = CH + cur * 64 * PC; bf16_t* Qt_c = CH + (2 + cur) * 64 * PC; bf16_t* Qr_n = CH + nxt * 64 * PC; bf16_t* Qt_n = CH + (2 + nxt) * 64 * PC;
        bf16_t* Pr_c = CH + (4 + cur) * 64 * PC; bf16_t* Pr_p = CH + (4 + nxt) * 64 * PC;
        if (wid < 4) {
            if (s < 5) {
#pragma unroll
                for (int tj = 0; tj < 4; ++tj) { f32x4 a1 = {0.f, 0.f, 0.f, 0.f}, a2 = {0.f, 0.f, 0.f, 0.f};
                    const bf16_t* ap = Qr_c + (ti * 16 + c16) * PC + q4 * 8; const bf16_t* bp = Qt_c + (tj * 16 + c16) * PC + q4 * 8;
#pragma unroll
                    for (int ks = 0; ks < 2; ++ks) { const bf16x8 fa = *(const bf16x8*)(ap + ks * 32), fb = *(const bf16x8*)(bp + ks * 32);
                        a1 = __builtin_amdgcn_mfma_f32_16x16x32_bf16(fa, fb, a1, 0, 0, 0);
                        a2 = __builtin_amdgcn_mfma_f32_16x16x32_bf16(fb, fa, a2, 0, 0, 0); }
                    u32x2 w1, w2; w1.x = pk2(a1[0], a1[1]); w1.y = pk2(a1[2], a1[3]); w2.x = pk2(a2[0], a2[1]); w2.y = pk2(a2[2], a2[3]);
                    *(u32x2*)(Qt_n + (tj * 16 + c16) * PC + ti * 16 + 4 * q4) = w1;
                    *(u32x2*)(Qr_n + (ti * 16 + c16) * PC + tj * 16 + 4 * q4) = w2; }
            }
        } else {
#pragma unroll
            for (int tj = 0; tj < 4; ++tj) {
                if (s >= 1) { const bf16_t* ap = Qt_c + (tj * 16 + c16) * PC + q4 * 8; const bf16_t* bp = Pr_p + (ti * 16 + c16) * PC + q4 * 8;
#pragma unroll
                    for (int ks = 0; ks < 2; ++ks) { const bf16x8 fa = *(const bf16x8*)(ap + ks * 32), fb = *(const bf16x8*)(bp + ks * 32); pacc[tj] = __builtin_amdgcn_mfma_f32_16x16x32_bf16(fa, fb, pacc[tj], 0, 0, 0); } }
                u32x2 w; w.x = pk2(pacc[tj][0], pacc[tj][1]); w.y = pk2(pacc[tj][2], pacc[tj][3]);
                *(u32x2*)(Pr_c + (ti * 16 + c16) * PC + tj * 16 + 4 * q4) = w; }
        }
        LBAR();
    }
    SEG_MARK(4);
    {
        const bf16_t* Tm = CH + 5 * 64 * PC;
#pragma unroll
        for (int t2 = 0; t2 < 2; ++t2) { const int tch = 2 * wid + t2; const int swl = (2 * tch + (c16 >> 3)) & 7;
#pragma unroll
            for (int tj = 0; tj < 4; ++tj) { f32x4 acc = {0.f, 0.f, 0.f, 0.f};
#pragma unroll
                for (int ks = 0; ks < 2; ++ks) { const bf16x8 fr = *(const bf16x8*)(RT + (tch * 16 + c16) * PC + (((ks * 4 + q4) ^ swl) << 3)); const bf16x8 ft = *(const bf16x8*)(Tm + (tj * 16 + c16) * PC + ks * 32 + q4 * 8);
                    acc = (tch < 8) ? __builtin_amdgcn_mfma_f32_16x16x32_bf16(ft, fr, acc, 0, 0, 0) : __builtin_amdgcn_mfma_f32_16x16x32_bf16(fr, ft, acc, 0, 0, 0); }
                u32x2 w; w.x = pk2(acc[0], acc[1]); w.y = pk2(acc[2], acc[3]);
                if (tch < 8) *(u32x2*)(UHs + ((((tch * 4 + tj) * 4 + q4) * 16 + c16) * 4)) = w;
                else *(u32x2*)(Wst + (tj * 16 + c16) * PQ + (tch - 8) * 16 + 4 * q4) = w;
            } }
        G.GL[unit] = __expf(gcs[63]);
    }
    LBAR();
#pragma unroll
    for (int i = 0; i < 2; ++i) { const int idx = tid + 512 * i; hd.uh[i] = *(const u32x4*)(UHs + idx * 8); hd.w[i] = *(const u32x4*)(Wst + (idx >> 4) * PQ + (idx & 15) * 8); }
    hd.at = *(const u32x4*)(ATs + (tid >> 3) * PC + (tid & 7) * 8); hd.unit = unit;
    LBAR();
    SEG_MARK(5);
}

__device__ __forceinline__ void gdn_seq_unit(char* lds, int bh, const Ptrs& P, int tid) {
    const int lane = tid & 63, wid = tid >> 6, c16 = lane & 15, q4 = lane >> 4;
    const int bl = bh >> 3, h = bh & 7;
    bf16_t* ST = (bf16_t*)lds;
    bf16_t* Wl = ST + 128 * PQ;
    bf16_t* QDl = Wl + 64 * PQ;
    bf16_t* ATl = QDl + 64 * PQ;
    bf16_t* KDTl = ATl + 64 * PC;
    bf16_t* UTl = KDTl + 128 * PC;
    bf16_t* GZl = UTl + 128 * PC;
    float* SSl = (float*)(GZl + 64 * PQ);
    const PrepBufs G = prep_bufs(P.ws);
    const bf16_t* gz = (const bf16_t*)(P.ws + WS_PROJ) + 6 * PROJ_STRIDE + (size_t)(bl * SEQ) * 1024 + h * HD;
    bf16_t* yg = (bf16_t*)(P.ws + WS_YGDN) + (size_t)(bl * SEQ) * 1024 + h * HD;
    f32x4 Sacc[8];
#pragma unroll
    for (int t = 0; t < 8; ++t) Sacc[t] = (f32x4){0.f, 0.f, 0.f, 0.f};
    for (int i = lane; i < 16 * PQ / 2; i += 64) ((unsigned*)(ST + wid * 16 * PQ))[i] = 0u;
    const f32x4 gn = *(const f32x4*)(P.gdn_norm + 16 * wid + 4 * q4);
    const int r16 = tid >> 4, ch16 = (tid & 15) * 8;
    const int r8 = tid >> 3, ch8 = (tid & 7) * 8;
    u32x4 sW[2], sQ[2], sA, sK[2], sG[2]; u32x2 uhn[4]; float gln;
    {
        const size_t ub = (size_t)(bh * 32) * 8192;
#pragma unroll
        for (int i = 0; i < 2; ++i) { const int idx = tid + 512 * i; sW[i] = *(const u32x4*)(G.W + ub + idx * 8); sQ[i] = *(const u32x4*)(G.QD + ub + idx * 8); sK[i] = *(const u32x4*)(G.KDT + ub + idx * 8);
            sG[i] = *(const u32x4*)(gz + (size_t)(r16 + 32 * i) * 1024 + ch16); }
        sA = *(const u32x4*)(G.AT + (size_t)(bh * 32) * 4096 + tid * 8);
#pragma unroll
        for (int t = 0; t < 4; ++t) uhn[t] = *(const u32x2*)(G.UHT + ub + ((wid * 4 + t) * 64 + lane) * 4);
        gln = G.GL[bh * 32];
    }
    for (int n = 0; n < 32; ++n) {
        const int unit = bh * 32 + n;
        const size_t ub = (size_t)unit * 8192;
#pragma unroll
        for (int i = 0; i < 2; ++i) { const int idx = tid + 512 * i;
            *(u32x4*)(Wl + (idx >> 4) * PQ + (idx & 15) * 8) = sW[i]; *(u32x4*)(QDl + (idx >> 4) * PQ + (idx & 15) * 8) = sQ[i]; *(u32x4*)(KDTl + (idx >> 3) * PC + (idx & 7) * 8) = sK[i]; }
        *(u32x4*)(ATl + r8 * PC + ch8) = sA;
        const float gl = gln;
        u32x2 uh[4];
#pragma unroll
        for (int t = 0; t < 4; ++t) uh[t] = uhn[t];
        LBAR();
        const int nn = (n + 1 < 32) ? n + 1 : 31;
        { const size_t un = (size_t)(bh * 32 + nn) * 8192;
#pragma unroll
            for (int i = 0; i < 2; ++i) { const int idx = tid + 512 * i; sW[i] = *(const u32x4*)(G.W + un + idx * 8); sQ[i] = *(const u32x4*)(G.QD + un + idx * 8); sK[i] = *(const u32x4*)(G.KDT + un + idx * 8); }
            sA = *(const u32x4*)(G.AT + (size_t)(bh * 32 + nn) * 4096 + tid * 8);
#pragma unroll
            for (int t = 0; t < 4; ++t) uhn[t] = *(const u32x2*)(G.UHT + un + ((wid * 4 + t) * 64 + lane) * 4);
            gln = G.GL[bh * 32 + nn]; }
        { const int np = (n > 0) ? n - 1 : 0;
#pragma unroll
            for (int i = 0; i < 2; ++i) { const u32x4 v = *(const u32x4*)(GZl + (r16 + 32 * i) * PQ + ch16); *(u32x4*)(yg + (size_t)(np * 64 + r16 + 32 * i) * 1024 + ch16) = v; } }
        f32x4 ws[4], os[4];
#pragma unroll
        for (int t = 0; t < 4; ++t) { ws[t] = (f32x4){0.f, 0.f, 0.f, 0.f}; os[t] = (f32x4){0.f, 0.f, 0.f, 0.f}; }
#pragma unroll
        for (int ks = 0; ks < 4; ++ks) { const bf16x8 b = *(const bf16x8*)(ST + (16 * wid + c16) * PQ + ks * 32 + q4 * 8);
#pragma unroll
            for (int t = 0; t < 4; ++t) { const bf16x8 a = *(const bf16x8*)(Wl + (16 * t + c16) * PQ + ks * 32 + q4 * 8); ws[t] = __builtin_amdgcn_mfma_f32_16x16x32_bf16(a, b, ws[t], 0, 0, 0);
                const bf16x8 a2 = *(const bf16x8*)(QDl + (16 * t + c16) * PQ + ks * 32 + q4 * 8); os[t] = __builtin_amdgcn_mfma_f32_16x16x32_bf16(b, a2, os[t], 0, 0, 0); } }
#pragma unroll
        for (int t = 0; t < 4; ++t) { u32x2 w; w.x = pk2(bflo(uh[t].x) - ws[t][0], bfhi(uh[t].x) - ws[t][1]); w.y = pk2(bflo(uh[t].y) - ws[t][2], bfhi(uh[t].y) - ws[t][3]);
            *(u32x2*)(UTl + (16 * wid + c16) * PC + 16 * t + 4 * q4) = w; }
        LBAR();
#pragma unroll
        for (int i = 0; i < 2; ++i) *(u32x4*)(GZl + (r16 + 32 * i) * PQ + ch16) = sG[i];
#pragma unroll
        for (int i = 0; i < 2; ++i) sG[i] = *(const u32x4*)(gz + (size_t)(nn * 64 + r16 + 32 * i) * 1024 + ch16);
#pragma unroll
        for (int ks = 0; ks < 2; ++ks) { const bf16x8 b = *(const bf16x8*)(UTl + (16 * wid + c16) * PC + ks * 32 + q4 * 8);
#pragma unroll
            for (int t = 0; t < 4; ++t) { const bf16x8 a = *(const bf16x8*)(ATl + (16 * t + c16) * PC + ks * 32 + q4 * 8); os[t] = __builtin_amdgcn_mfma_f32_16x16x32_bf16(b, a, os[t], 0, 0, 0); } }
#pragma unroll
        for (int t = 0; t < 8; ++t) Sacc[t] = Sacc[t] * gl;
#pragma unroll
        for (int ks = 0; ks < 2; ++ks) { const bf16x8 a = *(const bf16x8*)(UTl + (16 * wid + c16) * PC + ks * 32 + q4 * 8);
#pragma unroll
            for (int t = 0; t < 8; ++t) { const bf16x8 b = *(const bf16x8*)(KDTl + (16 * t + c16) * PC + ks * 32 + q4 * 8); Sacc[t] = __builtin_amdgcn_mfma_f32_16x16x32_bf16(b, a, Sacc[t], 0, 0, 0); } }
#pragma unroll
        for (int t = 0; t < 8; ++t) { u32x2 w; w.x = pk2(Sacc[t][0], Sacc[t][1]); w.y = pk2(Sacc[t][2], Sacc[t][3]); *(u32x2*)(ST + (16 * wid + c16) * PQ + 16 * t + 4 * q4) = w; }
#pragma unroll
        for (int t = 0; t < 4; ++t) { float s = (os[t][0] * os[t][0] + os[t][1] * os[t][1]) + (os[t][2] * os[t][2] + os[t][3] * os[t][3]); s += __shfl_xor(s, 16); s += __shfl_xor(s, 32);
            if (q4 == 0) SSl[wid * 64 + 16 * t + c16] = s; }
        LBAR();
        float tot = 0.f;
#pragma unroll
        for (int w = 0; w < 8; ++w) tot += SSl[w * 64 + lane];
        const float rstd_l = rsqrtf(tot * (1.0f / 128.0f) + 1e-6f);
#pragma unroll
        for (int t = 0; t < 4; ++t) { const int row = 16 * t + c16; const float rs = __shfl(rstd_l, row);
            u32x2* gp = (u32x2*)(GZl + row * PQ + 16 * wid + 4 * q4); const u32x2 gw = *gp; u32x2 w;
            w.x = pk2(os[t][0] * rs * gn[0] * siluf(bflo(gw.x)), os[t][1] * rs * gn[1] * siluf(bfhi(gw.x)));
            w.y = pk2(os[t][2] * rs * gn[2] * siluf(bflo(gw.y)), os[t][3] * rs * gn[3] * siluf(bfhi(gw.y))); *gp = w; }
    }
    LBAR();
#pragma unroll
    for (int i = 0; i < 2; ++i) { const u32x4 v = *(const u32x4*)(GZl + (r16 + 32 * i) * PQ + ch16); *(u32x4*)(yg + (size_t)(31 * 64 + r16 + 32 * i) * 1024 + ch16) = v; }
    __syncthreads();
}

__device__ __forceinline__ void fox_item(char* lds, int item, const Ptrs& P, int tid) {
    using bf = fox::bf16;
    const int lane = tid & 63, wid = tid >> 6;
    const int bh = item >> 2, xq = item & 3, bl = bh >> 3, h = bh & 7;
    float* cb = (float*)(lds + fox::LDS_BYTES);
    float* tmp = cb + SEQ;
    const float* small = (const float*)(P.ws + WS_SMALL);
    {
        const float fb = P.fox_f_bias[h];
        float lf[4]; float run = 0.f;
#pragma unroll
        for (int e = 0; e < 4; ++e) { const float xv = small[(size_t)(bl * SEQ + 4 * tid + e) * 32 + h] + fb;
            const float l = (xv < -20.f) ? xv : -log1pf(__expf(-xv)); run += l; lf[e] = run; }
        float inc = run;
#pragma unroll
        for (int o = 1; o < 64; o <<= 1) { const float t = __shfl_up(inc, o); if (lane >= o) inc += t; }
        if (lane == 63) tmp[wid] = inc;
        __syncthreads();
        float off = inc - run;
        for (int w = 0; w < wid; ++w) off += tmp[w];
#pragma unroll
        for (int e = 0; e < 4; ++e) cb[4 * tid + e] = -(off + lf[e]) * 11.313708498984761f;
        __syncthreads();
    }
    bf* fq = (bf*)(P.ws + WS_PROJ); const bf* fk = fq + PROJ_STRIDE; const bf* fv = fq + 2 * PROJ_STRIDE;
    const size_t hb = (size_t)(bl * SEQ) * 1024 + h * HD;
    fox::BlockRef<bf, bf> b0, b1;
    bf* yo = (bf*)(P.ws + WS_YFOX);
    b0.Q = fq + hb + (size_t)(xq * 256) * 1024; b0.O = yo + hb + (size_t)(xq * 256) * 1024; b0.K = fk + hb; b0.V = fv + hb; b0.P0 = xq * 256;
    b1.Q = fq + hb + (size_t)((7 - xq) * 256) * 1024; b1.O = yo + hb + (size_t)((7 - xq) * 256) * 1024; b1.K = fk + hb; b1.V = fv + hb; b1.P0 = (7 - xq) * 256;
    fox::Seam<bf> S;
    fox::causal_swa_prime<bf, bf>(b0, 1 << 20, lds, S);
    fox::causal_swa_block<bf, bf>(b0, b1, SEQ, 1 << 20, lds, S, cb);
    fox::causal_swa_block<bf, bf>(b1, b1, SEQ, 1 << 20, lds, S, cb);
    __syncthreads();
}

__device__ __forceinline__ void phase_convgate(const Ptrs& P, int tid, int cid) {
    const bf16_t* up = (const bf16_t*)(P.ws + WS_UP); bf16_t* act = (bf16_t*)(P.ws + WS_ACT);
    constexpr int NFG = DFF / 8;
    constexpr int RPB = GM / 256; static_assert(SEQ % RPB == 0, "a slab never straddles a sequence start");
    if (tid < NFG) {
        const int fg = tid, p = fg >> 4, i0 = (fg & 15) * 8, f0 = p * 128 + i0;
        const int cg0 = p * 256 + i0, cv0 = cg0 + 128;
        float wg[3][8], wv[3][8];
#pragma unroll
        for (int i = 0; i < 3; ++i)
#pragma unroll
            for (int j = 0; j < 8; ++j) { wg[i][j] = P.ffn_conv_w[i * NUP + f0 + j]; wv[i][j] = P.ffn_conv_w[i * NUP + DFF + f0 + j]; }
        const int r0 = cid * RPB;
        float g1[8], g2[8], v1[8], v2[8];
#pragma unroll
        for (int j = 0; j < 8; ++j) { g1[j] = 0.f; g2[j] = 0.f; v1[j] = 0.f; v2[j] = 0.f; }
        if ((r0 & (SEQ - 1)) != 0) {
            const u32x4 a1 = *(const u32x4*)(up + (size_t)(r0 - 1) * NUP + cg0), a2 = *(const u32x4*)(up + (size_t)(r0 - 2) * NUP + cg0);
            const u32x4 b1 = *(const u32x4*)(up + (size_t)(r0 - 1) * NUP + cv0), b2 = *(const u32x4*)(up + (size_t)(r0 - 2) * NUP + cv0);
            g1[0] = bflo(a1.x); g1[1] = bfhi(a1.x); g1[2] = bflo(a1.y); g1[3] = bfhi(a1.y); g1[4] = bflo(a1.z); g1[5] = bfhi(a1.z); g1[6] = bflo(a1.w); g1[7] = bfhi(a1.w);
            g2[0] = bflo(a2.x); g2[1] = bfhi(a2.x); g2[2] = bflo(a2.y); g2[3] = bfhi(a2.y); g2[4] = bflo(a2.z); g2[5] = bfhi(a2.z); g2[6] = bflo(a2.w); g2[7] = bfhi(a2.w);
            v1[0] = bflo(b1.x); v1[1] = bfhi(b1.x); v1[2] = bflo(b1.y); v1[3] = bfhi(b1.y); v1[4] = bflo(b1.z); v1[5] = bfhi(b1.z); v1[6] = bflo(b1.w); v1[7] = bfhi(b1.w);
            v2[0] = bflo(b2.x); v2[1] = bfhi(b2.x); v2[2] = bflo(b2.y); v2[3] = bfhi(b2.y); v2[4] = bflo(b2.z); v2[5] = bfhi(b2.z); v2[6] = bflo(b2.w); v2[7] = bfhi(b2.w);
        }
        for (int rb = 0; rb < RPB; rb += 8) {
            u32x4 ga[8], va[8];
#pragma unroll
            for (int r = 0; r < 8; ++r) { ga[r] = *(const u32x4*)(up + (size_t)(r0 + rb + r) * NUP + cg0); va[r] = *(const u32x4*)(up + (size_t)(r0 + rb + r) * NUP + cv0); }
#pragma unroll
            for (int r = 0; r < 8; ++r) {
                const u32x4 a = ga[r], b = va[r];
                float g0[8], v0[8];
                g0[0] = bflo(a.x); g0[1] = bfhi(a.x); g0[2] = bflo(a.y); g0[3] = bfhi(a.y); g0[4] = bflo(a.z); g0[5] = bfhi(a.z); g0[6] = bflo(a.w); g0[7] = bfhi(a.w);
                v0[0] = bflo(b.x); v0[1] = bfhi(b.x); v0[2] = bflo(b.y); v0[3] = bfhi(b.y); v0[4] = bflo(b.z); v0[5] = bfhi(b.z); v0[6] = bflo(b.w); v0[7] = bfhi(b.w);
                float o[8];
#pragma unroll
                for (int j = 0; j < 8; ++j) { const float cgv = wg[0][j] * g2[j] + wg[1][j] * g1[j] + wg[2][j] * g0[j]; const float cvv = wv[0][j] * v2[j] + wv[1][j] * v1[j] + wv[2][j] * v0[j];
                    o[j] = siluf(cgv) * cvv; g2[j] = g1[j]; g1[j] = g0[j]; v2[j] = v1[j]; v1[j] = v0[j]; }
                u32x4 w; w.x = pk2(o[0], o[1]); w.y = pk2(o[2], o[3]); w.z = pk2(o[4], o[5]); w.w = pk2(o[6], o[7]);
                *(u32x4*)(act + (size_t)(r0 + rb + r) * DFF + f0) = w;
            }
        }
    }
}

__device__ __forceinline__ void phase_final(const Ptrs& P, int tid, int cid, float pert) {
    const int lane = tid & 63, wave = tid >> 6;
    const int gw = cid * 8 + wave, NGW = 256 * 8;
    const float* rowss2 = (const float*)(P.ws + WS_CTL) + MTOK;
    f32x4 gv[4];
#pragma unroll
    for (int j = 0; j < 4; ++j) gv[j] = ((const f32x4*)P.norm_final)[lane + 64 * j];
    for (int m0 = gw; m0 < MTOK; m0 += 2 * NGW) {
        const int m1 = m0 + NGW;
        const float rstd0 = rsqrtf(rowss2[m0] * (1.f / DM) + 1e-6f), rstd1 = rsqrtf(rowss2[m1] * (1.f / DM) + 1e-6f);
        f32x4* o0 = (f32x4*)(P.out + (size_t)m0 * DM) + lane; f32x4* o1 = (f32x4*)(P.out + (size_t)m1 * DM) + lane;
        f32x4 a0[4], a1[4];
#pragma unroll
        for (int j = 0; j < 4; ++j) { a0[j] = o0[64 * j]; a1[j] = o1[64 * j]; }
#pragma unroll
        for (int j = 0; j < 4; ++j) { o0[64 * j] = a0[j] * rstd0 * gv[j] + pert; o1[64 * j] = a1[j] * rstd1 * gv[j] + pert; }
    }
}

#define LAS __attribute__((address_space(3)))
#define XB_TMO      128
#define XB_XCNT(j)  (256  + 64 * (j))
#define XB_XSUB(j)  (1280 + 64 * (j))
#define XB_XGEN(j)  (2304 + 64 * (j))
#define XB_TOP      3328
#define XB_TOPGEN   3392
#define XCD_BAR_WORDS 3456
#define XB_SPIN_CAP (1u << 18)

__device__ __forceinline__ unsigned xb_ld(unsigned* p)              { return __hip_atomic_load(p, __ATOMIC_RELAXED, __HIP_MEMORY_SCOPE_AGENT); }
__device__ __forceinline__ unsigned xb_add(unsigned* p, unsigned v) { return __hip_atomic_fetch_add(p, v, __ATOMIC_RELAXED, __HIP_MEMORY_SCOPE_AGENT); }
__device__ __forceinline__ unsigned xb_xcc_id() { return (unsigned)__builtin_amdgcn_s_getreg((3 << 11) | 20) & 0xFu; }
#define XB_SPIN(cond, bar) do { unsigned _sp = 0; while (cond) { __builtin_amdgcn_s_sleep(1); \
    if ((++_sp & 255u) == 0u) { if (xb_ld(&(bar)[XB_TMO])) break; if (_sp > XB_SPIN_CAP) { atomicAdd(&(bar)[XB_TMO], 1u); break; } } } } while (0)

struct XcdBarrier {
    unsigned* bar; unsigned x;
    volatile LAS unsigned* st;
};

__device__ __forceinline__ XcdBarrier xcd_barrier_post(unsigned* bar, volatile LAS unsigned* st) {
    XcdBarrier b; b.bar = bar; b.x = xb_xcc_id(); b.st = st;
    if (threadIdx.x == 0) (void)xb_add(&bar[XB_XCNT(b.x)], 1u);
    return b;
}
__device__ __forceinline__ void xcd_barrier_complete(unsigned* bar, unsigned x, unsigned& nloc, unsigned& nx) {
    const unsigned G = gridDim.x * gridDim.y * gridDim.z;
    unsigned sum, cnt, mine, sp = 0u;
    for (;;) {
        sum = 0u; cnt = 0u; mine = 0u;
#pragma unroll
        for (unsigned j = 0; j < 16; ++j) { const unsigned c = xb_ld(&bar[XB_XCNT(j)]); sum += c; cnt += (c > 0u) ? 1u : 0u; mine = (j == x) ? c : mine; }
        if (sum == G) break;
        __builtin_amdgcn_s_sleep(1);
        if ((++sp & 255u) == 0u) { if (xb_ld(&bar[XB_TMO])) break; if (sp > XB_SPIN_CAP) { atomicAdd(&bar[XB_TMO], 1u); break; } }
    }
    nloc = mine > 0u ? mine : 1u; nx = cnt > 0u ? cnt : 1u;
}

__device__ __forceinline__ void xcd_barrier(const XcdBarrier& b) {
    asm volatile("s_waitcnt vmcnt(0)" ::: "memory");
    __syncthreads();
    if (threadIdx.x == 0) {
        unsigned* bar = b.bar;
        __builtin_amdgcn_s_waitcnt(0);
        unsigned nloc = b.st[0], nx = b.st[1];
        if (nloc == 0u) { xcd_barrier_complete(bar, b.x, nloc, nx); b.st[0] = nloc; b.st[1] = nx; }
        const unsigned old = xb_add(&bar[XB_XSUB(b.x)], 1u);
        const unsigned gen = old / nloc;
        if (old + 1u == (gen + 1u) * nloc) {
            __builtin_amdgcn_fence(__ATOMIC_RELEASE, "agent");
            asm volatile("s_waitcnt vmcnt(0)" ::: "memory");
            const unsigned og = xb_add(&bar[XB_TOP], 1u);
            const unsigned tg = og / nx;
            if (og + 1u == (tg + 1u) * nx) xb_add(&bar[XB_TOPGEN], 1u);
            else XB_SPIN(xb_ld(&bar[XB_TOPGEN]) == tg, bar);
            __builtin_amdgcn_fence(__ATOMIC_ACQUIRE, "agent");
            xb_add(&bar[XB_XGEN(b.x)], 1u);
            asm volatile("s_waitcnt vmcnt(0)" ::: "memory");
        } else {
            XB_SPIN(xb_ld(&bar[XB_XGEN(b.x)]) == gen, bar);
            __builtin_amdgcn_fence(__ATOMIC_ACQUIRE, "agent");
            asm volatile("s_waitcnt vmcnt(0)" ::: "memory");
        }
    }
    __syncthreads();
}

constexpr int N_PHASES = 2 + 8 * NG;
#ifndef PHM
#define PHM 2047
#endif
#ifndef DBL
#define DBL 0
#endif
#define DBLSEL 2
#ifndef TSTAMP
#define TSTAMP 0
#endif
#define TS_MASK 0x200
__global__ void __launch_bounds__(512, 2) mk_fwd(Args args) {
    extern __shared__ __attribute__((aligned(16))) unsigned char lds_raw[];
    char* lds = (char*)lds_raw;
    cg::grid_group grid = cg::this_grid();
    volatile LAS unsigned* xst = (volatile LAS unsigned*)((LAS unsigned char*)lds_raw + (LDS_BYTES - 16));
    if (threadIdx.x < 4) xst[threadIdx.x] = 0u;
    __syncthreads();
    XcdBarrier xbar; xbar.bar = (unsigned*)(args.ws + WS_CTL + 800 * 1024); xbar.x = 0; xbar.st = xst;
    constexpr int G = 256;
    for (int ph = args.ph_lo; ph < args.ph_hi; ++ph) {
      {
        int tid = threadIdx.x; asm volatile("" : "+v"(tid));
        int cid = blockIdx.x; asm volatile("" : "+s"(cid));
        typedef const __attribute__((address_space(4))) Args* KArgsP;
        KArgsP kp = (KArgsP)__builtin_amdgcn_kernarg_segment_ptr(); asm volatile("" : "+s"(kp));
#define GPTR(T, v) ((T*)(__attribute__((address_space(1))) T*)(v))
        Ptrs P;
        P.x = GPTR(const float, kp->in[0]); P.norm_mix = GPTR(const float, kp->in[1]); P.w_in = GPTR(const float, kp->in[2]); P.fox_f_bias = GPTR(const float, kp->in[3]);
        P.gdn_conv_w = GPTR(const float, kp->in[4]); P.gdn_a_log = GPTR(const float, kp->in[5]); P.gdn_dt_bias = GPTR(const float, kp->in[6]); P.gdn_norm = GPTR(const float, kp->in[7]);
        P.w_bf = GPTR(const float, kp->in[8]); P.w_bg = GPTR(const float, kp->in[9]); P.w_out = GPTR(const float, kp->in[10]); P.norm_ffn = GPTR(const float, kp->in[11]);
        P.w_up = GPTR(const float, kp->in[12]); P.ffn_conv_w = GPTR(const float, kp->in[13]); P.w_down = GPTR(const float, kp->in[14]); P.norm_final = GPTR(const float, kp->in[15]);
        P.out = GPTR(float, kp->out); unsigned char* ws = GPTR(unsigned char, kp->ws); P.ws = ws;
        float* rowss1 = (float*)(ws + WS_CTL); float* rowss2 = rowss1 + MTOK;
        if (ph == 0) { if (PHM & 1) phase_prologue(P, lds, tid, cid);
            if (MK_ONE_LAUNCH) {
                unsigned* cz = (unsigned*)(ws + WS_CTL); for (int i = cid * 512 + tid; i < 131072; i += G * 512) cz[i] = 0u;
                if (cid == 0) { unsigned* bz = (unsigned*)(ws + WS_CTL + 800 * 1024); for (int i = tid; i < XCD_BAR_WORDS; i += 512) bz[i] = 0u; if (tid < 64) ((unsigned*)(ws + WS_CTL + 768 * 1024))[tid] = 0u; } } }
        else if (ph == N_PHASES - 1) {
            float pert = 0.f;
            if (SEGSEL && blockIdx.x == 0) pert = fminf(__hip_atomic_load((float*)(ws + WS_CTL + 768 * 1024), __ATOMIC_RELAXED, __HIP_MEMORY_SCOPE_AGENT) * 5e-5f, 0.12f);
            if (PHM & 2) phase_final(P, tid, cid, pert); }
        else {
            const int grp = (ph - 1) >> 3, sub = (ph - 1) & 7;
            const size_t r0g = (size_t)grp * GM;
            pg8::bf16_t* proj = (pg8::bf16_t*)(ws + WS_PROJ);
            if (sub == 0 && (PHM & 4)) {
                pg8::Gemm g{(const pg8::bf16_t*)(P.out + r0g * DM), nullptr, (const pg8::bf16_t*)(ws + WS_WIN), nullptr, GM, NIN, DM};
                pg8::StaticOrder S; S.init(GM, NIN, G, cid);
                pg8::EpiIn E{proj, (float*)(ws + WS_SMALL)};
                pg8::gemm_phase<pg8::EpiIn, pg8::StaticOrder, true, true>((PG8_LAS unsigned char*)lds_raw, g, S, E);
            } else if (sub == 1 && (PHM & 8)) {
                { const int hh = (cid >> 5) & 7;
                  ConvW cwr;
#pragma unroll
                  for (int part = 0; part < 3; ++part)
#pragma unroll
                      for (int tap = 0; tap < 4; ++tap) cwr.w[part][tap] = *(const f32x4*)(P.gdn_conv_w + tap * 3072 + part * 1024 + hh * HD + 4 * (tid & 31));
                  const float neg_a = -__expf(P.gdn_a_log[hh]), dtb = P.gdn_dt_bias[hh];
                  PrepStage st; prep_fetch(st, cid, P, tid);
                  PrepHold hd; hd.unit = cid; hd.at = (u32x4){0u, 0u, 0u, 0u}; hd.uh[0] = hd.at; hd.uh[1] = hd.at; hd.w[0] = hd.at; hd.w[1] = hd.at;
                  for (int u = cid; u < NCH; u += G) { const int un = (u + G < NCH) ? u + G : u; gdn_prep_unit(lds, u, un, st, hd, cwr, P, tid, neg_a, dtb); }
                  prep_flush(hd, P, tid); }
            } else if (sub == 2) {
                if ((PHM & 32)) for (int bh = cid; bh < BG * NH; bh += G) gdn_seq_unit(lds, bh, P, tid);
                if ((PHM & 16)) { const bool sq = cid < BG * NH; const int first = sq ? cid * 4 : (cid - BG * NH) * 4 + 1, cnt = sq ? 1 : 3; for (int x = 0; x < cnt; ++x) fox_item(lds, first + x, P, tid); }
            } else if (sub == 3 && (PHM & 64)) {
                pg8::Gemm g{(const pg8::bf16_t*)(ws + WS_YFOX), (const pg8::bf16_t*)(ws + WS_YGDN), (const pg8::bf16_t*)(ws + WS_WBF), (const pg8::bf16_t*)(ws + WS_WBG), GM, DM, DM};
                pg8::PairOrder S; S.init(GM, DM, G, cid);
                pg8::EpiY E{proj + 7 * PROJ_STRIDE, proj + 8 * PROJ_STRIDE, (pg8::bf16_t*)(ws + WS_T1), (pg8::bf16_t*)(ws + WS_Y)};
                pg8::gemm_phase<pg8::EpiY, pg8::PairOrder, true, true>((PG8_LAS unsigned char*)lds_raw, g, S, E);
            } else if (sub == 4 && (PHM & 128)) {
                pg8::Gemm g{(const pg8::bf16_t*)(ws + WS_Y), nullptr, (const pg8::bf16_t*)(ws + WS_WOUT), nullptr, GM, DM, DM};
                pg8::StaticOrder S; S.init(GM, DM, G, cid);
                pg8::EpiOut E{P.x + r0g * DM, P.out + r0g * DM, (pg8::bf16_t*)(ws + WS_H1B), rowss1 + r0g};
                pg8::gemm_phase<pg8::EpiOut, pg8::StaticOrder, true, true>((PG8_LAS unsigned char*)lds_raw, g, S, E);
            } else if (sub == 5 && (PHM & 256)) {
                pg8::Gemm g{(const pg8::bf16_t*)(ws + WS_H1B), nullptr, (const pg8::bf16_t*)(ws + WS_WUP), nullptr, GM, NUP, DM};
                pg8::StaticOrder S; S.init(GM, NUP, G, cid);
                pg8::EpiUp E{(pg8::bf16_t*)(ws + WS_UP), rowss1 + r0g, NUP};
                pg8::gemm_phase<pg8::EpiUp, pg8::StaticOrder, true, true>((PG8_LAS unsigned char*)lds_raw, g, S, E);
            } else if (sub == 6) {
                if (PHM & 512) phase_convgate(P, tid, cid);
            } else if (PHM & 1024) {
                pg8::Gemm g{(const pg8::bf16_t*)(ws + WS_ACT), nullptr, (const pg8::bf16_t*)(ws + WS_WDN), nullptr, GM, DM, DFF};
                pg8::StaticOrder S; S.init(GM, DM, G, cid);
                pg8::EpiDown E{(const pg8::bf16_t*)(ws + WS_H1B), P.out + r0g * DM, rowss2 + r0g};
                pg8::gemm_phase<pg8::EpiDown, pg8::StaticOrder, true, true>((PG8_LAS unsigned char*)lds_raw, g, S, E);
            }
        }
      }
        if (ph + 1 < args.ph_hi) { if (ph == args.ph_lo) { grid.sync(); xbar = xcd_barrier_post((unsigned*)(args.ws + WS_CTL + 800 * 1024), xst); } else xcd_barrier(xbar); }
    }
}

extern "C" void kernel_launch(void* const* d_in, const int* in_sizes, int n_in, void* d_out, int out_size, void* d_ws, size_t ws_size, hipStream_t stream) {
    static int ready = 0;
    if (ready == 0) {
        if (n_in != 16 || in_sizes[0] != MTOK * DM || out_size != MTOK * DM || ws_size < WS_END) {
            fprintf(stderr, "kernel_launch: unexpected shapes (n_in %d, in0 %d, out %d, ws %zu; need ws >= %zu)\n", n_in, n_in > 0 ? in_sizes[0] : -1, out_size, ws_size, (size_t)WS_END); ready = -1; return; }
        if (hipFuncSetAttribute((const void*)mk_fwd, hipFuncAttributeMaxDynamicSharedMemorySize, LDS_BYTES) != hipSuccess) { fprintf(stderr, "kernel_launch: hipFuncSetAttribute failed\n"); ready = -1; return; }
        int per_cu = 0;
        if (hipOccupancyMaxActiveBlocksPerMultiprocessor(&per_cu, (const void*)mk_fwd, 512, LDS_BYTES) != hipSuccess || per_cu < 1) fprintf(stderr, "kernel_launch: occupancy query says %d blocks per CU\n", per_cu);
        (void)hipGetLastError();
        ready = 1;
    }
    if (ready < 0) return;
#if !MK_ONE_LAUNCH
    (void)hipMemsetAsync((char*)d_ws + WS_CTL, 0, 1 * MiB, stream);
#endif
    Args a{};
    for (int i = 0; i < 16; ++i) a.in[i] = (const float*)d_in[i];
    a.out = (float*)d_out; a.ws = (unsigned char*)d_ws;
#if MK_ONE_LAUNCH
    a.ph_lo = 0; a.ph_hi = N_PHASES;
    void* kargs[] = {&a};
    hipError_t e = hipLaunchCooperativeKernel((const void*)mk_fwd, dim3(256), dim3(512), kargs, LDS_BYTES, stream);
    if (e != hipSuccess) fprintf(stderr, "kernel_launch: cooperative launch failed: %s\n", hipGetErrorString(e));
#else
    for (int ph = 0; ph < N_PHASES; ++ph) { a.ph_lo = ph; a.ph_hi = ph + 1; hipLaunchKernelGGL(mk_fwd, dim3(256), dim3(512), LDS_BYTES, stream, a); }
#endif
}
```

```cpp
#include <hip/hip_runtime.h>
#include <hip/hip_bf16.h>
#include <hip/hip_cooperative_groups.h>
#include <cstdio>
#include <cstdint>
namespace cg = cooperative_groups;

#ifndef MK_ONE_LAUNCH
#define MK_ONE_LAUNCH 1
#endif

namespace pg8 {
#define PG8_LAS __attribute__((address_space(3)))
typedef unsigned short bf16_t;
typedef short bf16x8 __attribute__((ext_vector_type(8)));
typedef float f32x4 __attribute__((ext_vector_type(4)));
typedef unsigned u32x4 __attribute__((ext_vector_type(4)));
constexpr int BM = 256, BK = 64, HALF = 128, HTB = HALF * BK * 2  , STAGE_BYTES = 8 * HTB, NXCD = 8, WGM = 8;

__host__ __device__ __forceinline__ int lds_byte(int r, int c) { const int st = (r >> 4) * 2 + (c >> 5), rr = r & 15, cc = c & 31, ob = rr * 64 + cc * 2; return st * 1024 + (ob ^ (((ob >> 9) & 1) << 5)); }
__host__ __device__ __forceinline__ void stage_rc(int b, int& R, int& C) { const int st = b / 1024, sb = b % 1024, swz = sb ^ (((sb >> 9) & 1) << 5); R = (st >> 1) * 16 + swz / 64; C = (st & 1) * 32 + (swz % 64) / 2; }
__host__ __device__ __forceinline__ int perm32(int rho) { const int n = rho >> 4, i = rho & 15; return 8 * (i >> 2) + 4 * n + (i & 3); }

struct Unit { int pm, pn, sel; };
struct Gemm { const bf16_t* A0; const bf16_t* A1; const bf16_t* B0; const bf16_t* B1; int M, N, K; };

struct StaticOrder {
    int nM, nN, nwg, G, c;
    __host__ __device__ __forceinline__ void init(int M, int N, int G_, int c_) { nM = M / BM; nN = N / BM; nwg = nM * nN; G = G_; c = c_; }
    __host__ __device__ __forceinline__ bool next(int i, Unit& u) const {
        const long L = (long)i * G + c; if (L >= nwg) return false;
        int wgid = (int)L; { const int q = nwg / NXCD, r = nwg % NXCD, xcd = wgid % NXCD, off = wgid / NXCD; wgid = (xcd < r ? xcd * (q + 1) : r * (q + 1) + (xcd - r) * q) + off; }
        const int nig = WGM * nN, gid = wgid / nig, fm = gid * WGM, gsz = (nM - fm) < WGM ? (nM - fm) : WGM;
        u.pm = fm + ((wgid % nig) % gsz); u.pn = (wgid % nig) / gsz; u.sel = 0; return true;
    }
    __device__ __forceinline__ void a_ready(const Unit&) const {}
    __device__ __forceinline__ void done(const Unit&) const {}
};

__device__ __forceinline__ unsigned cvt_pk_bf16(float lo, float hi) { unsigned r; asm volatile("v_cvt_pk_bf16_f32 %0, %1, %2" : "=v"(r) : "v"(lo), "v"(hi)); return r; }
typedef unsigned u32x2 __attribute__((ext_vector_type(2)));
__device__ __forceinline__ float bflo(unsigned w) { return __uint_as_float(w << 16); }
__device__ __forceinline__ float bfhi(unsigned w) { return __uint_as_float(w & 0xffff0000u); }
__device__ __forceinline__ float sigm(float x) { return __builtin_amdgcn_rcpf(1.0f + __expf(-x)); }
constexpr int GM = 32768;
constexpr int LDP = 1024;

struct EpiIn {
    static constexpr bool PERM = true, AFTER_DRAIN = false;
    bf16_t* proj; float* small;
    __device__ __forceinline__ void operator()(const f32x4 (&acc)[2][2][4][2], const Unit& u, int wr, int wc, int fr, int fq) const {
        const int row0 = u.pm * BM + wr * 64 + fr;
        if (u.pn < 36) {
            bf16_t* base = proj + (size_t)(u.pn >> 2) * ((size_t)GM * LDP) + (u.pn & 3) * 256 + wc * 32 + 8 * fq;
#pragma unroll
            for (int ai = 0; ai < 2; ++ai)
#pragma unroll
                for (int m = 0; m < 4; ++m) { bf16_t* rowp = base + (size_t)(row0 + ai * HALF + m * 16) * LDP;
#pragma unroll
                    for (int bj = 0; bj < 2; ++bj) { const f32x4 v0 = acc[ai][bj][m][0], v1 = acc[ai][bj][m][1];
                        u32x4 w; w.x = cvt_pk_bf16(v0[0], v0[1]); w.y = cvt_pk_bf16(v0[2], v0[3]); w.z = cvt_pk_bf16(v1[0], v1[1]); w.w = cvt_pk_bf16(v1[2], v1[3]);
                        *(u32x4*)(rowp + bj * HALF) = w; } }
        } else if (wc == 0 && fq < 3) {
#pragma unroll
            for (int ai = 0; ai < 2; ++ai)
#pragma unroll
                for (int m = 0; m < 4; ++m) { float* p = small + (size_t)(row0 + ai * HALF + m * 16) * 32 + 8 * fq;
                    *(f32x4*)p = acc[ai][0][m][0]; *(f32x4*)(p + 4) = acc[ai][0][m][1]; }
        }
    }
};
struct EpiY {
    static constexpr bool PERM = true, AFTER_DRAIN = false;
    const bf16_t* gf; const bf16_t* gg; bf16_t* t1; bf16_t* y;
    __device__ __forceinline__ void operator()(const f32x4 (&acc)[2][2][4][2], const Unit& u, int wr, int wc, int fr, int fq) const {
        const int row0 = u.pm * BM + wr * 64 + fr, col0 = u.pn * BM + wc * 32 + 8 * fq;
        const bf16_t* const gf_ = gf; const bf16_t* const gg_ = gg; bf16_t* const t1_ = t1; bf16_t* const y_ = y;
        const bf16_t* gate = u.sel ? gg_ : gf_; bf16_t* dst = u.sel ? y_ : t1_;
        if (u.sel) asm volatile("s_waitcnt vmcnt(0)" ::: "memory");
#pragma unroll
        for (int ai = 0; ai < 2; ++ai) {
            u32x4 gw[4][2], tw[4][2];
#pragma unroll
            for (int m = 0; m < 4; ++m)
#pragma unroll
                for (int bj = 0; bj < 2; ++bj) { const size_t o = (size_t)(row0 + ai * HALF + m * 16) * LDP + col0 + bj * HALF;
                    gw[m][bj] = *(const u32x4*)(gate + o); tw[m][bj] = u.sel ? *(const u32x4*)(t1_ + o) : (u32x4){0u, 0u, 0u, 0u}; }
#pragma unroll
            for (int m = 0; m < 4; ++m)
#pragma unroll
                for (int bj = 0; bj < 2; ++bj) { const size_t o = (size_t)(row0 + ai * HALF + m * 16) * LDP + col0 + bj * HALF;
                    const u32x4 g = gw[m][bj], t = tw[m][bj]; const f32x4 v0 = acc[ai][bj][m][0], v1 = acc[ai][bj][m][1];
                    const float r0 = sigm(bflo(g.x)) * v0[0] + bflo(t.x), r1 = sigm(bfhi(g.x)) * v0[1] + bfhi(t.x), r2 = sigm(bflo(g.y)) * v0[2] + bflo(t.y), r3 = sigm(bfhi(g.y)) * v0[3] + bfhi(t.y);
                    const float r4 = sigm(bflo(g.z)) * v1[0] + bflo(t.z), r5 = sigm(bfhi(g.z)) * v1[1] + bfhi(t.z), r6 = sigm(bflo(g.w)) * v1[2] + bflo(t.w), r7 = sigm(bfhi(g.w)) * v1[3] + bfhi(t.w);
                    u32x4 w; w.x = cvt_pk_bf16(r0, r1); w.y = cvt_pk_bf16(r2, r3); w.z = cvt_pk_bf16(r4, r5); w.w = cvt_pk_bf16(r6, r7);
                    *(u32x4*)(dst + o) = w; }
        }
    }
};
struct EpiOut {
    static constexpr bool PERM = true, AFTER_DRAIN = false;
    const bf16_t* xn; const float* irx; const float* gmix; bf16_t* h1b; float* rowss;
    __device__ __forceinline__ void operator()(const f32x4 (&acc)[2][2][4][2], const Unit& u, int wr, int wc, int fr, int fq) const {
        const int col0 = u.pn * BM + wc * 32 + 8 * fq;
        f32x4 ig[2][2];
#pragma unroll
        for (int bj = 0; bj < 2; ++bj)
#pragma unroll
            for (int n = 0; n < 2; ++n) { const f32x4 g = *(const f32x4*)(gmix + col0 + bj * HALF + 4 * n); ig[bj][n] = (f32x4){__builtin_amdgcn_rcpf(g[0]), __builtin_amdgcn_rcpf(g[1]), __builtin_amdgcn_rcpf(g[2]), __builtin_amdgcn_rcpf(g[3])}; }
#pragma unroll
        for (int ai = 0; ai < 2; ++ai) {
            u32x4 pre[4][2]; float ir[4];
#pragma unroll
            for (int m = 0; m < 4; ++m) { const int row = u.pm * BM + ai * HALF + wr * 64 + m * 16 + fr; ir[m] = irx[row];
#pragma unroll
                for (int bj = 0; bj < 2; ++bj) pre[m][bj] = *(const u32x4*)(xn + (size_t)row * LDP + col0 + bj * HALF); }
#pragma unroll
            for (int m = 0; m < 4; ++m) { const int row = u.pm * BM + ai * HALF + wr * 64 + m * 16 + fr; const size_t ro = (size_t)row * LDP + col0; float ss = 0.f;
#pragma unroll
                for (int bj = 0; bj < 2; ++bj) { const size_t o = ro + bj * HALF; const u32x4 p = pre[m][bj];
                    const f32x4 h0 = (f32x4){bflo(p.x), bfhi(p.x), bflo(p.y), bfhi(p.y)} * ir[m] * ig[bj][0] + acc[ai][bj][m][0], h1 = (f32x4){bflo(p.z), bfhi(p.z), bflo(p.w), bfhi(p.w)} * ir[m] * ig[bj][1] + acc[ai][bj][m][1];
                    u32x4 w; w.x = cvt_pk_bf16(h0[0], h0[1]); w.y = cvt_pk_bf16(h0[2], h0[3]); w.z = cvt_pk_bf16(h1[0], h1[1]); w.w = cvt_pk_bf16(h1[2], h1[3]); *(u32x4*)(h1b + o) = w;
                    ss += (h0[0] * h0[0] + h0[1] * h0[1]) + (h0[2] * h0[2] + h0[3] * h0[3]) + (h1[0] * h1[0] + h1[1] * h1[1]) + (h1[2] * h1[2] + h1[3] * h1[3]); }
                ss += __shfl_xor(ss, 16); ss += __shfl_xor(ss, 32);
                if (fq == 0) atomicAdd(rowss + row, ss); }
        }
    }
};
struct EpiUp {
    static constexpr bool PERM = true, AFTER_DRAIN = false;
    bf16_t* up; const float* rowss; int ldc;
    __device__ __forceinline__ void operator()(const f32x4 (&acc)[2][2][4][2], const Unit& u, int wr, int wc, int fr, int fq) const {
        const int row0 = u.pm * BM + wr * 64 + fr, col0 = u.pn * BM + wc * 32 + 8 * fq;
        float rsv[2][4];
#pragma unroll
        for (int ai = 0; ai < 2; ++ai)
#pragma unroll
            for (int m = 0; m < 4; ++m) rsv[ai][m] = rowss[row0 + ai * HALF + m * 16];
#pragma unroll
        for (int ai = 0; ai < 2; ++ai)
#pragma unroll
            for (int m = 0; m < 4; ++m) { const int row = row0 + ai * HALF + m * 16; const float rs = rsqrtf(rsv[ai][m] * (1.0f / 1024.0f) + 1e-6f); bf16_t* rowp = up + (size_t)row * ldc + col0;
#pragma unroll
                for (int bj = 0; bj < 2; ++bj) { const f32x4 v0 = acc[ai][bj][m][0] * rs, v1 = acc[ai][bj][m][1] * rs;
                    u32x4 w; w.x = cvt_pk_bf16(v0[0], v0[1]); w.y = cvt_pk_bf16(v0[2], v0[3]); w.z = cvt_pk_bf16(v1[0], v1[1]); w.w = cvt_pk_bf16(v1[2], v1[3]);
                    *(u32x4*)(rowp + bj * HALF) = w; } }
    }
};
struct EpiDown {
    static constexpr bool PERM = true, AFTER_DRAIN = false;
    const bf16_t* h1b; float* hout; float* rowss;
    __device__ __forceinline__ void operator()(const f32x4 (&acc)[2][2][4][2], const Unit& u, int wr, int wc, int fr, int fq) const {
        const int col0 = u.pn * BM + wc * 32 + 8 * fq;
#pragma unroll
        for (int ai = 0; ai < 2; ++ai) {
            u32x4 pre[4][2];
#pragma unroll
            for (int m = 0; m < 4; ++m)
#pragma unroll
                for (int bj = 0; bj < 2; ++bj) pre[m][bj] = *(const u32x4*)(h1b + (size_t)(u.pm * BM + ai * HALF + wr * 64 + m * 16 + fr) * LDP + col0 + bj * HALF);
#pragma unroll
            for (int m = 0; m < 4; ++m) { const int row = u.pm * BM + ai * HALF + wr * 64 + m * 16 + fr; const size_t ro = (size_t)row * LDP + col0; float ss = 0.f;
#pragma unroll
                for (int bj = 0; bj < 2; ++bj) { const size_t o = ro + bj * HALF; const u32x4 p = pre[m][bj];
                    const f32x4 h0 = (f32x4){bflo(p.x), bfhi(p.x), bflo(p.y), bfhi(p.y)} + acc[ai][bj][m][0], h1 = (f32x4){bflo(p.z), bfhi(p.z), bflo(p.w), bfhi(p.w)} + acc[ai][bj][m][1];
                    *(f32x4*)(hout + o) = h0; *(f32x4*)(hout + o + 4) = h1;
                    ss += (h0[0] * h0[0] + h0[1] * h0[1]) + (h0[2] * h0[2] + h0[3] * h0[3]) + (h1[0] * h1[0] + h1[1] * h1[1]) + (h1[2] * h1[2] + h1[3] * h1[3]); }
                ss += __shfl_xor(ss, 16); ss += __shfl_xor(ss, 32);
                if (fq == 0) atomicAdd(rowss + row, ss); }
        }
    }
};
struct PairOrder {
    int nM, nN, nwg, G, c;
    __host__ __device__ __forceinline__ void init(int M, int N, int G_, int c_) { nM = M / BM; nN = N / BM; nwg = nM * nN; G = G_; c = c_; }
    __host__ __device__ __forceinline__ bool next(int i, Unit& u) const {
        const long L = (long)(i >> 1) * G + c; if (L >= nwg) return false;
        int wgid = (int)L; { const int q = nwg / NXCD, r = nwg % NXCD, xcd = wgid % NXCD, off = wgid / NXCD; wgid = (xcd < r ? xcd * (q + 1) : r * (q + 1) + (xcd - r) * q) + off; }
        const int nig = WGM * nN, gid = wgid / nig, fm = gid * WGM, gsz = (nM - fm) < WGM ? (nM - fm) : WGM;
        u.pm = fm + ((wgid % nig) % gsz); u.pn = (wgid % nig) / gsz; u.sel = i & 1; return true;
    }
    __device__ __forceinline__ void a_ready(const Unit&) const {}
    __device__ __forceinline__ void done(const Unit&) const {}
};
template <class Epi, class Sched, bool ALIGN_EPI = false, bool SP2 = false>
__device__ __forceinline__ void gemm_phase(PG8_LAS unsigned char* lds, const Gemm g, const Sched& S, const Epi& E) {
    int tid_l = threadIdx.x; asm volatile("" : "+v"(tid_l));
    const int tid = tid_l, wid = __builtin_amdgcn_readfirstlane(tid >> 6), lane = tid & 63, wr = wid >> 2, wc = wid & 3, fr = lane & 15, fq = lane >> 4;
    const int K = g.K, nt = K / BK;
    unsigned voffA[2], voffB[2];
#pragma unroll
    for (int i = 0; i < 2; ++i) { int R, C; stage_rc(tid * 16 + i * 8192, R, C); const int Rb = Epi::PERM ? ((R & ~31) + perm32(R & 31)) : R;
        voffA[i] = (unsigned)(R * K + C) * 2u; voffB[i] = (unsigned)(Rb * K + C) * 2u; }
    const size_t kstep = (size_t)(BK * 2);
    const size_t hstep = (size_t)HALF * K * 2;
    const size_t tstep = 2 * hstep;
    const unsigned ldsw = (unsigned)wid * 1024u;
    const int aoff = lds_byte(wr * 64 + fr, fq * 8), boff = lds_byte(wc * 32 + fr, fq * 8);
#define PG8_SA(b, h) (((b) * 2 + (h)) * HTB)
#define PG8_SB(b, h) ((4 + (b) * 2 + (h)) * HTB)
#define PG8_STAGE(bufoff, gbase, voff) do { _Pragma("unroll") for (int _i = 0; _i < 2; ++_i) \
        __builtin_amdgcn_global_load_lds((const unsigned*)((const char*)(gbase) + (voff)[_i]), (PG8_LAS unsigned*)(lds + (bufoff) + ldsw + _i * 8192), 16, 0, 0); } while (0)
#define PG8_LDA(dst, b, h) do { _Pragma("unroll") for (int m = 0; m < 4; ++m) _Pragma("unroll") for (int k = 0; k < 2; ++k) dst[m][k] = *(const PG8_LAS bf16x8*)(lds + PG8_SA(b, h) + aoff + m * 2048 + k * 1024); } while (0)
#define PG8_LDB(dst, b, h) do { _Pragma("unroll") for (int n = 0; n < 2; ++n) _Pragma("unroll") for (int k = 0; k < 2; ++k) dst[n][k] = *(const PG8_LAS bf16x8*)(lds + PG8_SB(b, h) + boff + n * 2048 + k * 1024); } while (0)
#define PG8_MMA(ai, bj, At, Bt) do { __builtin_amdgcn_s_setprio(1); _Pragma("unroll") for (int m = 0; m < 4; ++m) _Pragma("unroll") for (int n = 0; n < 2; ++n) _Pragma("unroll") for (int k = 0; k < 2; ++k) \
        acc[ai][bj][m][n] = __builtin_amdgcn_mfma_f32_16x16x32_bf16(Bt[n][k], At[m][k], acc[ai][bj][m][n], 0, 0, 0); __builtin_amdgcn_s_setprio(0); } while (0)
#define PG8_WAIT_V(n) asm volatile("s_waitcnt vmcnt(" #n ")" ::: "memory")
#define PG8_WAIT_L(n) asm volatile("s_waitcnt lgkmcnt(" #n ")" ::: "memory")
#define PG8_BAR __builtin_amdgcn_s_barrier()
#define PG8_SCHED __builtin_amdgcn_sched_barrier(0)
    Unit cur, nxt; int ui = 0;
    if (!S.next(0, cur)) return;
    f32x4 acc[2][2][4][2];
#pragma unroll
    for (int a = 0; a < 2; ++a)
#pragma unroll
        for (int b = 0; b < 2; ++b)
#pragma unroll
            for (int m = 0; m < 4; ++m)
#pragma unroll
                for (int n = 0; n < 2; ++n) acc[a][b][m][n] = (f32x4){0.f, 0.f, 0.f, 0.f};
    bf16x8 At[4][2], B0[2][2], B1[2][2];
    const char* cA = (const char*)(cur.sel ? g.A1 : g.A0) + (size_t)cur.pm * tstep; const char* cB = (const char*)(cur.sel ? g.B1 : g.B0) + (size_t)cur.pn * tstep;
    S.a_ready(cur);
    if constexpr (SP2) {
        PG8_STAGE(PG8_SB(0, 0), cB, voffB); PG8_STAGE(PG8_SB(0, 1), cB + hstep, voffB); PG8_STAGE(PG8_SA(0, 0), cA, voffA); PG8_STAGE(PG8_SA(0, 1), cA + hstep, voffA);
        if (wr == 1) PG8_BAR;
        PG8_WAIT_V(2); PG8_BAR;
        PG8_STAGE(PG8_SB(1, 0), cB + kstep, voffB); PG8_STAGE(PG8_SA(1, 0), cA + kstep, voffA); PG8_STAGE(PG8_SB(1, 1), cB + hstep + kstep, voffB);
        PG8_WAIT_V(6); PG8_BAR;
    } else {
        PG8_STAGE(PG8_SB(0, 0), cB, voffB); PG8_STAGE(PG8_SA(0, 0), cA, voffA); PG8_STAGE(PG8_SB(0, 1), cB + hstep, voffB); PG8_STAGE(PG8_SA(0, 1), cA + hstep, voffA);
        if (wr == 1) PG8_BAR;
        PG8_WAIT_V(4); PG8_BAR;
        PG8_STAGE(PG8_SB(1, 0), cB + kstep, voffB); PG8_STAGE(PG8_SA(1, 0), cA + kstep, voffA); PG8_STAGE(PG8_SB(1, 1), cB + hstep + kstep, voffB);
        PG8_WAIT_V(6); PG8_BAR;
    }
    for (;;) {
        const bool has_next = S.next(ui + 1, nxt);
        const char* nA = has_next ? (const char*)(nxt.sel ? g.A1 : g.A0) + (size_t)nxt.pm * tstep : cA; const char* nB = has_next ? (const char*)(nxt.sel ? g.B1 : g.B0) + (size_t)nxt.pn * tstep : cB;
        for (int t = 0; t < nt; t += 2) {
            const bool last = (t == nt - 2);
            const char* a1 = cA + (size_t)(t + 1) * kstep;
            const char* a2 = last ? nA : cA + (size_t)(t + 2) * kstep; const char* b2 = last ? nB : cB + (size_t)(t + 2) * kstep;
            const char* a3 = a2 + kstep; const char* b3 = b2 + kstep;
            if (last && has_next) S.a_ready(nxt);
            if constexpr (SP2) {
            PG8_LDB(B0, 0, 0); PG8_LDB(B1, 0, 1); PG8_SCHED; PG8_LDA(At, 0, 0); PG8_STAGE(PG8_SA(1, 1), a1 + hstep, voffA);
            PG8_WAIT_V(8); PG8_WAIT_L(0); PG8_BAR; PG8_MMA(0, 0, At, B0); PG8_MMA(0, 1, At, B1); PG8_BAR; PG8_SCHED;
            PG8_LDA(At, 0, 1); PG8_STAGE(PG8_SB(0, 0), b2, voffB); PG8_STAGE(PG8_SB(0, 1), b2 + hstep, voffB); PG8_STAGE(PG8_SA(0, 0), a2, voffA);
            PG8_WAIT_V(8); PG8_WAIT_L(0); PG8_BAR; PG8_MMA(1, 0, At, B0); PG8_MMA(1, 1, At, B1); PG8_BAR; PG8_SCHED;
            PG8_LDB(B0, 1, 0); PG8_LDB(B1, 1, 1); PG8_SCHED; PG8_LDA(At, 1, 0); PG8_STAGE(PG8_SA(0, 1), a2 + hstep, voffA);
            PG8_WAIT_V(8); PG8_WAIT_L(0); PG8_BAR; PG8_MMA(0, 0, At, B0); PG8_MMA(0, 1, At, B1); PG8_BAR; PG8_SCHED;
            PG8_LDA(At, 1, 1); PG8_STAGE(PG8_SB(1, 0), b3, voffB); PG8_STAGE(PG8_SB(1, 1), b3 + hstep, voffB); PG8_STAGE(PG8_SA(1, 0), a3, voffA);
            PG8_WAIT_V(8); PG8_WAIT_L(0); PG8_BAR; PG8_MMA(1, 0, At, B0); PG8_MMA(1, 1, At, B1); PG8_BAR; PG8_SCHED;
            } else {
            PG8_LDB(B0, 0, 0); PG8_SCHED; PG8_LDA(At, 0, 0); PG8_STAGE(PG8_SA(1, 1), a1 + hstep, voffA);
            PG8_WAIT_L(8); PG8_BAR; PG8_WAIT_L(0); PG8_MMA(0, 0, At, B0); PG8_BAR; PG8_SCHED;
            PG8_LDB(B1, 0, 1); PG8_STAGE(PG8_SB(0, 0), b2, voffB);
            PG8_BAR; PG8_WAIT_L(0); PG8_MMA(0, 1, At, B1); PG8_BAR;
            PG8_LDA(At, 0, 1); PG8_STAGE(PG8_SA(0, 0), a2, voffA);
            PG8_BAR; PG8_WAIT_L(0); PG8_MMA(1, 0, At, B0); PG8_BAR; PG8_SCHED;
            PG8_STAGE(PG8_SB(0, 1), b2 + hstep, voffB);
            PG8_WAIT_V(6); PG8_BAR; PG8_MMA(1, 1, At, B1); PG8_BAR;
            PG8_LDB(B0, 1, 0); PG8_SCHED; PG8_LDA(At, 1, 0); PG8_STAGE(PG8_SA(0, 1), a2 + hstep, voffA);
            PG8_WAIT_L(8); PG8_BAR; PG8_WAIT_L(0); PG8_MMA(0, 0, At, B0); PG8_BAR; PG8_SCHED;
            PG8_LDB(B1, 1, 1); PG8_STAGE(PG8_SB(1, 0), b3, voffB);
            PG8_BAR; PG8_WAIT_L(0); PG8_MMA(0, 1, At, B1); PG8_BAR;
            PG8_LDA(At, 1, 1); PG8_STAGE(PG8_SA(1, 0), a3, voffA);
            PG8_BAR; PG8_WAIT_L(0); PG8_MMA(1, 0, At, B0); PG8_BAR; PG8_SCHED;
            PG8_STAGE(PG8_SB(1, 1), b3 + hstep, voffB);
            PG8_WAIT_V(6); PG8_BAR; PG8_MMA(1, 1, At, B1); PG8_BAR;
            }
        }
        if constexpr (ALIGN_EPI) { if (wr == 0) PG8_BAR; }
        if constexpr (!Epi::AFTER_DRAIN) { E(acc, cur, wr, wc, fr, fq); S.done(cur); }
        if (!has_next) break;
#pragma unroll
        for (int a = 0; a < 2; ++a)
#pragma unroll
            for (int b = 0; b < 2; ++b)
#pragma unroll
                for (int m = 0; m < 4; ++m)
#pragma unroll
                    for (int n = 0; n < 2; ++n) acc[a][b][m][n] = (f32x4){0.f, 0.f, 0.f, 0.f};
        cur = nxt; cA = nA; cB = nB; ++ui;
        if constexpr (ALIGN_EPI) { if (wr == 1) PG8_BAR; }
    }
    PG8_WAIT_V(0);
    if constexpr (!ALIGN_EPI) { if (wr == 0) PG8_BAR; }
    PG8_BAR;
    if constexpr (Epi::AFTER_DRAIN) { E.fused(acc, cur, wr, wc, fr, fq, lds, wid, lane); S.done(cur); }
#undef PG8_SA
#undef PG8_SB
#undef PG8_STAGE
#undef PG8_LDA
#undef PG8_LDB
#undef PG8_MMA
#undef PG8_WAIT_V
#undef PG8_WAIT_L
#undef PG8_BAR
#undef PG8_SCHED
}
}

namespace fox {
constexpr int D = 128, PITCH = 1024;
constexpr bool WSKIP = false;
constexpr float THR = 8.f;
constexpr float SCALE = 0.08838834764831845f;
constexpr int NW = 8, QBLK = 32, KVBLK = 64, QB = NW * QBLK;
constexpr int SHM_V = KVBLK * D * 2, SHM_K = KVBLK * D * 2;
constexpr int LDS_BYTES = 2 * SHM_V + 2 * SHM_K + NW * 64 * 4;
using bf16 = __hip_bfloat16;
typedef short bf16x8 __attribute__((ext_vector_type(8)));
typedef short s16x4 __attribute__((ext_vector_type(4)));
typedef float f32x16 __attribute__((ext_vector_type(16)));
typedef float f32x4 __attribute__((ext_vector_type(4)));
typedef unsigned u32x4 __attribute__((ext_vector_type(4)));
template <class A, class Bt> struct same_t { static constexpr bool v = false; };
template <class A> struct same_t<A, A> { static constexpr bool v = true; };
__device__ __forceinline__ void bias_tile(f32x16& p0, f32x16& p1, const float* cbp) {
#pragma unroll
    for (int rr = 0; rr < 4; ++rr) { const f32x4 a = *(const f32x4*)(cbp + 8 * rr), b = *(const f32x4*)(cbp + 32 + 8 * rr);
#pragma unroll
        for (int e = 0; e < 4; ++e) { p0[4 * rr + e] += a[e]; p1[4 * rr + e] += b[e]; } }
}
#define KSWZ(row, colB) ((row) * 256 + ((colB) ^ (((row) & 7) << 4)))
#define SBAR() __builtin_amdgcn_sched_barrier(0)
__device__ __forceinline__ int v_st(int k, int c) { const int kk = (k & ~0xC) | ((k & 4) << 1) | ((k & 8) >> 1); return ((kk >> 3) * 4 + (c >> 5)) * 512 + ((kk & 7) * 32 + (c & 31)) * 2; }
__device__ __forceinline__ int v_rd_base(int lane) { return ((lane & 3) << 3) | (((lane >> 2) & 3) << 6) | (((lane >> 4) & 1) << 5) | (((lane >> 5) & 1) << 8); }
constexpr int v_rd_off(int d0, int ks, int half) { return d0 * 512 + ks * 4096 + half * 2048; }
__device__ __forceinline__ int crow(int r, int hi) { return (r & 3) + 8 * (r >> 2) + 4 * hi; }
__device__ __forceinline__ unsigned cvtpk(float lo, float hi) {
    unsigned r; asm volatile("v_cvt_pk_bf16_f32 %0, %1, %2" : "=v"(r) : "v"(lo), "v"(hi)); return r;
}
__device__ __forceinline__ bf16x8 pack8(f32x4 a, f32x4 b) {
    u32x4 w = {cvtpk(a[0], a[1]), cvtpk(a[2], a[3]), cvtpk(b[0], b[1]), cvtpk(b[2], b[3])};
    return *reinterpret_cast<bf16x8*>(&w);
}
template <class T> __device__ __forceinline__ bf16x8 load8(const T* p) {
    if constexpr (same_t<T, float>::v) { return pack8(*(const f32x4*)p, *(const f32x4*)(p + 4)); }
    else { return *reinterpret_cast<const bf16x8*>(p); }
}
__device__ __forceinline__ void mask_tile(f32x16& p0, f32x16& p1, int dq, unsigned W) {
    const float NEG = -__builtin_inff();
#pragma unroll
    for (int r = 0; r < 16; ++r) {
        const int c = (r & 3) + 8 * (r >> 2);
        if ((unsigned)(dq - c) >= W) p0[r] = NEG;
        if ((unsigned)(dq - c - 32) >= W) p1[r] = NEG;
    }
}
__device__ __forceinline__ void partialSM(f32x16& p0, f32x16& p1, float& m_reg, float& mn, float& alpha) {
    float pmax = p0[0]; for (int r = 1; r < 16; ++r) pmax = fmaxf(pmax, p0[r]); for (int r = 0; r < 16; ++r) pmax = fmaxf(pmax, p1[r]);
    { auto rr = __builtin_amdgcn_permlane32_swap(__float_as_uint(pmax), __float_as_uint(pmax), false, false);
      pmax = fmaxf(__uint_as_float(rr[0]), __uint_as_float(rr[1])); }
    constexpr float C2 = 1.4426950408889634f * SCALE;
    if (__builtin_expect(__all((pmax - m_reg) * SCALE <= THR), 1)) { mn = m_reg; alpha = 1.f; }
    else { mn = fmaxf(m_reg, pmax); alpha = __builtin_amdgcn_exp2f((m_reg - mn) * C2); m_reg = mn; }
    const float mnL = -mn * C2;
    for (int r = 0; r < 16; ++r) p0[r] = fmaf(p0[r], C2, mnL); for (int r = 0; r < 16; ++r) p1[r] = fmaf(p1[r], C2, mnL);
    for (int r = 0; r < 16; ++r) p0[r] = __builtin_amdgcn_exp2f(p0[r]);
}
__device__ __forceinline__ void finishSM(f32x16& p0, f32x16& p1, float alpha, float& l_reg, bf16x8& pa0, bf16x8& pa1, bf16x8& pa2, bf16x8& pa3) {
    for (int r = 0; r < 16; ++r) p1[r] = __builtin_amdgcn_exp2f(p1[r]);
    float ps = 0; for (int r = 0; r < 16; ++r) ps += p0[r]; for (int r = 0; r < 16; ++r) ps += p1[r];
    { auto rr = __builtin_amdgcn_permlane32_swap(__float_as_uint(ps), __float_as_uint(ps), false, false);
      ps = __uint_as_float(rr[0]) + __uint_as_float(rr[1]); }
    l_reg = l_reg * alpha + ps;
#define PK4(P, B_, OUT) do { unsigned a0 = cvtpk(P[B_+0], P[B_+1]), a1 = cvtpk(P[B_+2], P[B_+3]);                          \
        unsigned b0 = cvtpk(P[B_+4], P[B_+5]), b1 = cvtpk(P[B_+6], P[B_+7]);                                             \
        auto r0 = __builtin_amdgcn_permlane32_swap(a0, b0, false, false); auto r1 = __builtin_amdgcn_permlane32_swap(a1, b1, false, false); \
        u32x4 w = {r0[0], r1[0], r0[1], r1[1]}; OUT = *reinterpret_cast<bf16x8*>(&w); } while (0)
    PK4(p0, 0, pa0); PK4(p0, 8, pa1); PK4(p1, 0, pa2); PK4(p1, 8, pa3);
#undef PK4
}
template <int KB, bool SK>
__device__ __forceinline__ void qkt(f32x16& p0, f32x16& p1, const char* K_lds, int r32, int hi, const bf16x8* qr, bool act, const float* cbp) {
    if (SK && !act) { const float NEG = -__builtin_inff();
#pragma unroll
        for (int r = 0; r < 16; ++r) { p0[r] = NEG; p1[r] = NEG; } return; }
    { const f32x4* c4 = (const f32x4*)cbp; const f32x4 a0 = c4[0], a1 = c4[2], a2 = c4[4], a3 = c4[6], b0 = c4[8], b1 = c4[10], b2 = c4[12], b3 = c4[14];
      p0 = (f32x16){a0[0], a0[1], a0[2], a0[3], a1[0], a1[1], a1[2], a1[3], a2[0], a2[1], a2[2], a2[3], a3[0], a3[1], a3[2], a3[3]};
      p1 = (f32x16){b0[0], b0[1], b0[2], b0[3], b1[0], b1[1], b1[2], b1[3], b2[0], b2[1], b2[2], b2[3], b3[0], b3[1], b3[2], b3[3]}; }
    const char* kb[4];
#pragma unroll
    for (int dd = 0; dd < 4; ++dd) kb[dd] = K_lds + KB * SHM_K + KSWZ(r32, (dd * 16 + hi * 8) * 2);
#pragma unroll
    for (int d0 = 0; d0 < 8; ++d0) { const char* a = kb[d0 & 3] + (d0 >> 2) * 128;
        bf16x8 b0 = *reinterpret_cast<const bf16x8*>(a);
        bf16x8 b1 = *reinterpret_cast<const bf16x8*>(a + 32 * 256);
        p0 = __builtin_amdgcn_mfma_f32_32x32x16_bf16(b0, qr[d0], p0, 0, 0, 0);
        p1 = __builtin_amdgcn_mfma_f32_32x32x16_bf16(b1, qr[d0], p1, 0, 0, 0); }
}
template <int VB, bool SK>
__device__ __forceinline__ void pv_tile(f32x16* o, int vb0, bf16x8 pa0, bf16x8 pa1, bf16x8 pa2, bf16x8 pa3, bool act) {
    if (SK && !act) return;
#define TRRD(dst, off) asm volatile("ds_read_b64_tr_b16 %0, %1 offset:%2" : "=&v"(dst) : "v"(vb0), "i"(off) : "memory")
#define PV_D0(d0) do { s16x4 l0, l1, l2, l3, h0, h1, h2, h3; constexpr int b_ = VB * SHM_V + v_rd_off(d0, 0, 0);     \
        TRRD(l0, b_); TRRD(h0, b_ + 2048); TRRD(l1, b_ + 4096); TRRD(h1, b_ + 6144); TRRD(l2, b_ + 8192); TRRD(h2, b_ + 10240); TRRD(l3, b_ + 12288); TRRD(h3, b_ + 14336); \
        asm volatile("s_waitcnt lgkmcnt(0)" ::: "memory"); SBAR();                 \
        o[d0] = __builtin_amdgcn_mfma_f32_32x32x16_bf16(pa0, (bf16x8){l0[0], l0[1], l0[2], l0[3], h0[0], h0[1], h0[2], h0[3]}, o[d0], 0, 0, 0);   \
        o[d0] = __builtin_amdgcn_mfma_f32_32x32x16_bf16(pa1, (bf16x8){l1[0], l1[1], l1[2], l1[3], h1[0], h1[1], h1[2], h1[3]}, o[d0], 0, 0, 0);   \
        o[d0] = __builtin_amdgcn_mfma_f32_32x32x16_bf16(pa2, (bf16x8){l2[0], l2[1], l2[2], l2[3], h2[0], h2[1], h2[2], h2[3]}, o[d0], 0, 0, 0);   \
        o[d0] = __builtin_amdgcn_mfma_f32_32x32x16_bf16(pa3, (bf16x8){l3[0], l3[1], l3[2], l3[3], h3[0], h3[1], h3[2], h3[3]}, o[d0], 0, 0, 0); } while (0)
    PV_D0(0); PV_D0(1); PV_D0(2); PV_D0(3);
#undef PV_D0
#undef TRRD
}

template <class TIn, class TOut> struct BlockRef { const TIn* Q; const TIn* K; const TIn* V; TOut* O; int P0; };
template <class TIn> struct Seam {
    bf16x8 qr[8];
    bf16x8 st_v0, st_v1, st_k0, st_k1; f32x4 sf0, sf1, sf2, sf3;
    f32x4 tq[16];
};
__device__ __forceinline__ int swa_jlo(int P0, int W) { const int lowk = P0 - W + 1; return lowk > 0 ? lowk / KVBLK : 0; }
#define ROW(p, k0, rr) ((p) + (size_t)((k0) + (rr)) * PITCH + sc)
#define VMW() asm volatile("s_waitcnt vmcnt(0)" ::: "memory")
#define VMWN(n) asm volatile("s_waitcnt vmcnt(%0)" :: "i"(n) : "memory")
#define SLOAD_H(Kp, Vp, k0) do { S.st_v0 = load8<TIn>(ROW(Vp, k0, sr)); S.st_v1 = load8<TIn>(ROW(Vp, k0, 32 + sr));              \
                         S.st_k0 = load8<TIn>(ROW(Kp, k0, sr)); S.st_k1 = load8<TIn>(ROW(Kp, k0, 32 + sr)); } while (0)
#define SWRITE_HK(bf) do { *(bf16x8*)(K_lds + (bf) * SHM_K + kws) = S.st_k0; *(bf16x8*)(K_lds + (bf) * SHM_K + kws + 32 * 256) = S.st_k1; } while (0)
#define SWRITE_HV(bf) do { *(bf16x8*)(V_lds + (bf) * SHM_V + vst0) = S.st_v0; *(bf16x8*)(V_lds + (bf) * SHM_V + vst1) = S.st_v1; } while (0)
#define SWRITE_H(bf) do { SWRITE_HV(bf); SWRITE_HK(bf); } while (0)
#define SLOAD_F(p, k0) do { S.sf0 = *(const f32x4*)ROW(p, k0, sr); S.sf1 = *(const f32x4*)(ROW(p, k0, sr) + 4);                \
                            S.sf2 = *(const f32x4*)ROW(p, k0, 32 + sr); S.sf3 = *(const f32x4*)(ROW(p, k0, 32 + sr) + 4); } while (0)
#define SWRITE_KF(bf) do { *(bf16x8*)(K_lds + (bf) * SHM_K + kws) = pack8(S.sf0, S.sf1); *(bf16x8*)(K_lds + (bf) * SHM_K + kws + 32 * 256) = pack8(S.sf2, S.sf3); } while (0)
#define SWRITE_VF(bf) do { *(bf16x8*)(V_lds + (bf) * SHM_V + vst0) = pack8(S.sf0, S.sf1); *(bf16x8*)(V_lds + (bf) * SHM_V + vst1) = pack8(S.sf2, S.sf3); } while (0)
template <class TIn, class TOut>
__device__ __forceinline__ void causal_swa_prime(const BlockRef<TIn, TOut>& cur, int W, char* lds, Seam<TIn>& S) {
    constexpr bool F32 = same_t<TIn, float>::v;
    int tid_l = threadIdx.x; asm volatile("" : "+v"(tid_l));
    const int tid = tid_l, wid = __builtin_amdgcn_readfirstlane(tid >> 6), lane = tid & 63, r32 = lane & 31, hi = lane >> 5;
    const int sr = tid >> 4, sc = (tid & 15) * 8, kws = KSWZ(sr, sc * 2); char* K_lds = lds + 2 * SHM_V;
    const int kb0 = swa_jlo(cur.P0, W) * KVBLK;
    for (int d0 = 0; d0 < 8; ++d0) S.qr[d0] = load8<TIn>(cur.Q + (size_t)(wid * QBLK + r32) * PITCH + d0 * 16 + hi * 8);
    if constexpr (F32) { SLOAD_F((const float*)cur.K, kb0); VMW(); SWRITE_KF(0); SBAR(); SLOAD_F((const float*)cur.V, kb0); }
    else { SLOAD_H(cur.K, cur.V, kb0); VMW(); SWRITE_HK(0); }
    __syncthreads();
}
template <class TIn, class TOut>
__device__ __forceinline__ void causal_swa_block(const BlockRef<TIn, TOut>& cur, const BlockRef<TIn, TOut>& nxt, int skv, int W, char* lds, Seam<TIn>& S, const float* cbias) {
    constexpr bool F32 = same_t<TIn, float>::v;
    int tid_l = threadIdx.x; asm volatile("" : "+v"(tid_l));
    const int tid = tid_l, wid = __builtin_amdgcn_readfirstlane(tid >> 6), lane = tid & 63, r32 = lane & 31, hi = lane >> 5;
    const int j_lo = swa_jlo(cur.P0, W);
    int j_hi = (cur.P0 + QB - 1) / KVBLK + 1; if (j_hi > skv / KVBLK) j_hi = skv / KVBLK;
    const int NT = j_hi - j_lo;
    const int kbn = swa_jlo(nxt.P0, W) * KVBLK;
    const int qlo = cur.P0 + wid * QBLK, qm = qlo + r32 - 4 * hi;
    char* V_lds = lds; char* K_lds = lds + 2 * SHM_V;
    float* ws = (float*)(lds + 2 * SHM_V + 2 * SHM_K) + wid * 64; float* li_l = ws, * al_l = ws + 32;
    float m_reg = -1e30f, l_reg = 0; f32x16 o[4] = {};
    const int sr = tid >> 4, sc = (tid & 15) * 8, vst0 = v_st(sr, sc), vst1 = v_st(32 + sr, sc), kws = KSWZ(sr, sc * 2);
    const int vb0 = (int)(uintptr_t)V_lds + v_rd_base(lane);
    const TIn* Kh = cur.K; const TIn* Vh = cur.V;
#define RESC(a) do { if (__any((a) < 1.f)) { if (hi == 0) al_l[r32] = (a); asm volatile("s_waitcnt lgkmcnt(0)" ::: "memory");              \
                     for (int d_ = 0; d_ < 4; ++d_) for (int r = 0; r < 16; ++r) o[d_][r] *= al_l[crow(r, hi)]; } } while (0)
#define KBASE(t) ((j_lo + (t)) * KVBLK)
#define ACT(t) (KBASE(t) <= qlo + QBLK - 1 && KBASE(t) + KVBLK - 1 >= qlo - W + 1)
#define MASKT(P0_, P1_, t) do { const int kb_ = KBASE(t); if ((!SK || ACT(t)) && (kb_ + KVBLK - 1 > qlo || kb_ <= qlo + QBLK - 1 - W)) mask_tile(P0_, P1_, qm - kb_, (unsigned)W); } while (0)
    constexpr int NQL = F32 ? 16 : 8;
    constexpr bool SK = WSKIP && !F32;
#define SEAM_K0() do { VMWN(NQL); if constexpr (F32) { SWRITE_KF(0); SBAR(); SLOAD_F((const float*)nxt.V, kbn); } else { SWRITE_HK(0); } SBAR(); } while (0)
    f32x16 pA0, pA1, pB0, pB1; float mnA, mnB, alA, alB; bf16x8 pa0, pa1, pa2, pa3;
    if constexpr (F32) { VMW(); SWRITE_VF(0); SBAR(); } else { SWRITE_HV(0); SBAR(); }
    if (NT > 1) { if constexpr (F32) SLOAD_F((const float*)Kh, KBASE(1)); else SLOAD_H(Kh, Vh, KBASE(1)); }
    SBAR(); qkt<0, SK>(pA0, pA1, K_lds, r32, hi, S.qr, ACT(0), cbias + KBASE(0) + 4 * hi);
    if constexpr (F32) { if (NT > 1) { VMW(); SWRITE_KF(1); SBAR(); SLOAD_F((const float*)Vh, KBASE(1)); } }
    MASKT(pA0, pA1, 0); partialSM(pA0, pA1, m_reg, mnA, alA);
    if (NT > 1) { VMW(); if constexpr (F32) { SWRITE_VF(1); SBAR(); if (NT > 2) SLOAD_F((const float*)Kh, KBASE(2)); } else SWRITE_H(1); }
    __syncthreads();
#define HALF_STEP(PX0, PX1, mnX, alX, PY0, PY1, alY, t, KB, VB, SB) do {                                                      \
        SBAR(); qkt<KB, SK>(PX0, PX1, K_lds, r32, hi, S.qr, ACT(t), cbias + KBASE(t) + 4 * hi);                                             \
        finishSM(PY0, PY1, alY, l_reg, pa0, pa1, pa2, pa3); SBAR();                                                           \
        if ((t) + 1 < NT) { if constexpr (F32) { VMW(); SWRITE_KF(SB); SBAR(); SLOAD_F((const float*)Vh, KBASE((t) + 1)); }  \
                            else { SLOAD_H(Kh, Vh, KBASE((t) + 1)); } SBAR(); }                                               \
        pv_tile<VB, SK>(o, vb0, pa0, pa1, pa2, pa3, ACT((t) - 1)); MASKT(PX0, PX1, (t)); partialSM(PX0, PX1, m_reg, mnX, alX);                                        \
        __syncthreads();                                                                                                      \
        if ((t) + 1 < NT) { VMW(); if constexpr (F32) { SWRITE_VF(SB); SBAR(); if ((t) + 2 < NT) SLOAD_F((const float*)Kh, KBASE((t) + 2)); } \
                            else { SWRITE_H(SB); } }                                                                          \
        RESC(alX); __syncthreads(); } while (0)
    for (int t = 1; t + 1 < NT; t += 2) {
        HALF_STEP(pB0, pB1, mnB, alB, pA0, pA1, alA, t, 1, 0, 0);
        HALF_STEP(pA0, pA1, mnA, alA, pB0, pB1, alB, t + 1, 0, 1, 1);
    }
    const bool even = (NT & 1) == 0;
    if (even) { SBAR(); qkt<1, SK>(pB0, pB1, K_lds, r32, hi, S.qr, ACT(NT - 1), cbias + KBASE(NT - 1) + 4 * hi); SBAR(); }
#define QROW(e) (nxt.Q + (size_t)(wid * QBLK + r32) * PITCH + ((e) >> 1) * 16 + hi * 8 + ((e) & 1) * 4)
    if constexpr (F32) { SLOAD_F((const float*)nxt.K, kbn); SBAR();
#pragma unroll
        for (int e = 0; e < 8; ++e) S.tq[e] = *(const f32x4*)QROW(e); }
    else { SLOAD_H(nxt.K, nxt.V, kbn); SBAR();
#pragma unroll
        for (int d0 = 0; d0 < 8; ++d0) S.qr[d0] = load8<TIn>(nxt.Q + (size_t)(wid * QBLK + r32) * PITCH + d0 * 16 + hi * 8); }
    SBAR();
    finishSM(pA0, pA1, alA, l_reg, pa0, pa1, pa2, pa3); SBAR();
    if constexpr (F32) {
#pragma unroll
        for (int e = 8; e < 16; ++e) S.tq[e] = *(const f32x4*)QROW(e); SBAR(); }
#undef QROW
    pv_tile<0, SK>(o, vb0, pa0, pa1, pa2, pa3, ACT(even ? NT - 2 : NT - 1));
    if (even) { MASKT(pB0, pB1, NT - 1); partialSM(pB0, pB1, m_reg, mnB, alB); __syncthreads(); RESC(alB);
        finishSM(pB0, pB1, alB, l_reg, pa0, pa1, pa2, pa3); SBAR(); pv_tile<1, SK>(o, vb0, pa0, pa1, pa2, pa3, ACT(NT - 1)); }
    SBAR(); SEAM_K0();
    if (hi == 0) li_l[r32] = l_reg; asm volatile("s_waitcnt lgkmcnt(0)" ::: "memory");
    float rli[16];
#pragma unroll
    for (int r = 0; r < 16; ++r) rli[r] = __builtin_amdgcn_rcpf(li_l[crow(r, hi)]);
    TOut* Ow = cur.O + (size_t)(wid * QBLK) * PITCH;
#pragma unroll
    for (int r = 0; r < 16; ++r) { const int orow = crow(r, hi);
#pragma unroll
        for (int d0 = 0; d0 < 4; ++d0) { const float v = o[d0][r] * rli[r];
            if constexpr (same_t<TOut, float>::v) { Ow[(size_t)orow * PITCH + d0 * 32 + r32] = v; }
            else { const float vn = __shfl_xor(v, 1);
                   if ((r32 & 1) == 0) *(unsigned*)(Ow + (size_t)orow * PITCH + d0 * 32 + r32) = cvtpk(v, vn); } } }
    if constexpr (F32) {
#pragma unroll
        for (int d0 = 0; d0 < 8; ++d0) S.qr[d0] = pack8(S.tq[2 * d0], S.tq[2 * d0 + 1]); }
    __syncthreads();
#undef RESC
#undef KBASE
#undef ACT
#undef MASKT
#undef SEAM_K0
#undef HALF_STEP
}
#undef ROW
#undef VMW
#undef VMWN
#undef SLOAD_H
#undef SWRITE_HK
#undef SWRITE_HV
#undef SWRITE_H
#undef SLOAD_F
#undef SWRITE_KF
#undef SWRITE_VF
}

typedef unsigned short bf16_t;
typedef short bf16x8 __attribute__((ext_vector_type(8)));
typedef float f32x4 __attribute__((ext_vector_type(4)));
typedef unsigned u32x4 __attribute__((ext_vector_type(4)));
typedef unsigned u32x2 __attribute__((ext_vector_type(2)));
constexpr int DM = 1024, NB = 32, SEQ = 2048, NH = 8, HD = 128, DFF = 2816, NUP = 2 * DFF;
constexpr int MTOK = NB * SEQ;
constexpr int NG = 2, BG = NB / NG, GM = BG * SEQ;
constexpr int NIN = 37 * 256;
constexpr int NCH = BG * NH * 32;
static_assert(GM == pg8::GM, "group rows");
constexpr size_t MiB = 1u << 20;
constexpr size_t WS_CTL = 0;
constexpr size_t WS_WIN = 1 * MiB, WS_WBF = 20 * MiB, WS_WBG = 22 * MiB, WS_WOUT = 24 * MiB, WS_WUP = 26 * MiB, WS_WDN = 37 * MiB;
constexpr size_t WS_PROJ = 44 * MiB;
constexpr size_t WS_SMALL = 620 * MiB;
constexpr size_t WS_PREP = 624 * MiB;
constexpr size_t WS_END = 913 * MiB;
constexpr size_t PBUF = 64 * MiB;
constexpr size_t WS_H1B = WS_PROJ + 0 * PBUF;
constexpr size_t WS_T1 = WS_PROJ + 1 * PBUF;
constexpr size_t WS_Y = WS_PROJ + 2 * PBUF;
constexpr size_t WS_YGDN = WS_PROJ + 3 * PBUF;
constexpr size_t WS_YFOX = WS_PROJ + 5 * PBUF;
constexpr size_t WS_UP = WS_PROJ + 3 * PBUF;
constexpr size_t WS_ACT = WS_PREP;
constexpr size_t PROJ_STRIDE = (size_t)GM * 1024;
constexpr int LDS_BYTES = 163840;

__device__ __forceinline__ float bf2f(bf16_t b) { return __uint_as_float((unsigned)b << 16); }
__device__ __forceinline__ float bflo(unsigned w) { return __uint_as_float(w << 16); }
__device__ __forceinline__ float bfhi(unsigned w) { return __uint_as_float(w & 0xffff0000u); }
typedef float f32x2_t __attribute__((ext_vector_type(2))); typedef __bf16 bf16x2_t __attribute__((ext_vector_type(2)));
__device__ __forceinline__ unsigned pk2(float lo, float hi) { f32x2_t v = {lo, hi}; bf16x2_t b = __builtin_convertvector(v, bf16x2_t); return __builtin_bit_cast(unsigned, b); }
__device__ __forceinline__ bf16_t f2bf(float f) { return (bf16_t)(pk2(f, 0.f) & 0xffffu); }
__device__ __forceinline__ float siluf(float y) { return y * __builtin_amdgcn_rcpf(1.0f + __expf(-y)); }
__device__ __forceinline__ float wave_sum(float v) {
#pragma unroll
    for (int o = 1; o < 64; o <<= 1) v += __shfl_xor(v, o);
    return v;
}

struct Args { const float* in[16]; float* out; unsigned char* ws; int ph_lo, ph_hi; };
struct Ptrs {
    const float *x, *norm_mix, *w_in, *fox_f_bias, *gdn_conv_w, *gdn_a_log, *gdn_dt_bias, *gdn_norm, *w_bf, *w_bg, *w_out, *norm_ffn, *w_up, *ffn_conv_w, *w_down, *norm_final;
    float* out; unsigned char* ws;
};

template <int MODE> __device__ __forceinline__ int srccol(int n) {
    if (MODE == 0) return n;
    if (MODE == 1) {
        if (n < 3072) return n;
        if (n < 6144) return 3080 + (n - 3072);
        if (n < 9216) return 6168 + (n - 6144);
        const int s = n - 9216;
        if (s < 8) return 3072 + s;
        if (s < 16) return 6152 + (s - 8);
        if (s < 24) return 6160 + (s - 16);
        return -1;
    }
    { const int p = n >> 8, s = (n >> 7) & 1, i = n & 127; return s * DFF + 128 * p + i; }
}
template <int MODE> __device__ __forceinline__ void transpose_item(const float* W, int K, int N, const float* ksc, bf16_t* WT, float* scr, int item, int nblk, int lane) {
    const int kb = item / nblk, nb = item % nblk, k0 = 64 * kb, n0 = 32 * nb;
    const int sc = srccol<MODE>(n0 + (lane & 31));
    float tv[32];
    const int scc = sc >= 0 ? sc : 0;
#pragma unroll
    for (int i = 0; i < 32; ++i) tv[i] = W[(size_t)(k0 + 2 * i + (lane >> 5)) * N + scc];
    if (ksc) {
#pragma unroll
        for (int i = 0; i < 32; ++i) tv[i] *= ksc[k0 + 2 * i + (lane >> 5)]; }
#pragma unroll
    for (int i = 0; i < 32; ++i) scr[(2 * i + (lane >> 5)) * 33 + (lane & 31)] = (sc >= 0) ? tv[i] : 0.f;
    asm volatile("s_waitcnt lgkmcnt(0)" ::: "memory");
    const int c = lane & 7;
#pragma unroll
    for (int j = 0; j < 4; ++j) { const int n = (lane >> 3) + 8 * j; const float* s = scr + (8 * c) * 33 + n;
        u32x4 o; o.x = pk2(s[0 * 33], s[1 * 33]); o.y = pk2(s[2 * 33], s[3 * 33]); o.z = pk2(s[4 * 33], s[5 * 33]); o.w = pk2(s[6 * 33], s[7 * 33]);
        *(u32x4*)(WT + (size_t)(n0 + n) * K + k0 + 8 * c) = o; }
    asm volatile("s_waitcnt lgkmcnt(0)" ::: "memory");
}
__device__ __forceinline__ void phase_prologue(const Ptrs& P, char* lds, int tid, int cid) {
    const int lane = tid & 63, wave = tid >> 6;
    float* scr = (float*)(lds + wave * 16384);
    const int gw = cid * 8 + wave, NGW = 256 * 8;
    bf16_t* win_t = (bf16_t*)(P.ws + WS_WIN); bf16_t* wbf_t = (bf16_t*)(P.ws + WS_WBF); bf16_t* wbg_t = (bf16_t*)(P.ws + WS_WBG);
    bf16_t* wout_t = (bf16_t*)(P.ws + WS_WOUT); bf16_t* wup_t = (bf16_t*)(P.ws + WS_WUP); bf16_t* wdn_t = (bf16_t*)(P.ws + WS_WDN);
    constexpr int I_IN = 16 * (NIN / 32), I_SQ = 16 * 32, I_UP = 16 * (NUP / 32), I_DN = (DFF / 64) * 32;
    constexpr int NITEMS = I_IN + 3 * I_SQ + I_UP + I_DN;
    for (int it = gw; it < NITEMS; it += NGW) {
        int r = it;
        if (r < I_IN) { transpose_item<1>(P.w_in, DM, 9240, nullptr, win_t, scr, r, NIN / 32, lane); continue; } r -= I_IN;
        if (r < I_SQ) { transpose_item<0>(P.w_bf, DM, DM, nullptr, wbf_t, scr, r, 32, lane); continue; } r -= I_SQ;
        if (r < I_SQ) { transpose_item<0>(P.w_bg, DM, DM, nullptr, wbg_t, scr, r, 32, lane); continue; } r -= I_SQ;
        if (r < I_SQ) { transpose_item<0>(P.w_out, DM, DM, nullptr, wout_t, scr, r, 32, lane); continue; } r -= I_SQ;
        if (r < I_UP) { transpose_item<2>(P.w_up, DM, NUP, P.norm_ffn, wup_t, scr, r, NUP / 32, lane); continue; } r -= I_UP;
        transpose_item<0>(P.w_down, DFF, DM, nullptr, wdn_t, scr, r, 32, lane);
    }
    f32x4 gv[4];
#pragma unroll
    for (int j = 0; j < 4; ++j) gv[j] = ((const f32x4*)P.norm_mix)[lane + 64 * j];
    for (int m0 = gw; m0 < MTOK; m0 += 2 * NGW) {
        const int m1 = m0 + NGW;
        const f32x4* xr0 = (const f32x4*)(P.x + (size_t)m0 * DM) + lane; const f32x4* xr1 = (const f32x4*)(P.x + (size_t)m1 * DM) + lane;
        f32x4 v0[4], v1[4]; float s0 = 0.f, s1 = 0.f;
#pragma unroll
        for (int j = 0; j < 4; ++j) { v0[j] = xr0[64 * j]; v1[j] = xr1[64 * j]; }
#pragma unroll
        for (int j = 0; j < 4; ++j) { s0 += (v0[j][0] * v0[j][0] + v0[j][1] * v0[j][1]) + (v0[j][2] * v0[j][2] + v0[j][3] * v0[j][3]); s1 += (v1[j][0] * v1[j][0] + v1[j][1] * v1[j][1]) + (v1[j][2] * v1[j][2] + v1[j][3] * v1[j][3]); }
        const float rstd0 = rsqrtf(wave_sum(s0) * (1.f / DM) + 1e-6f), rstd1 = rsqrtf(wave_sum(s1) * (1.f / DM) + 1e-6f);
        if (lane == 0) { float* irx = (float*)(P.ws + WS_CTL + 512 * 1024); irx[m0] = __builtin_amdgcn_rcpf(rstd0); irx[m1] = __builtin_amdgcn_rcpf(rstd1); }
        const int g0 = m0 / GM, g1 = m1 / GM;
        u32x2* o0 = (u32x2*)((bf16_t*)(P.out + (size_t)g0 * GM * DM) + (size_t)(m0 - g0 * GM) * DM) + lane;
        u32x2* o1 = (u32x2*)((bf16_t*)(P.out + (size_t)g1 * GM * DM) + (size_t)(m1 - g1 * GM) * DM) + lane;
#pragma unroll
        for (int j = 0; j < 4; ++j) { const f32x4 t0 = v0[j] * rstd0 * gv[j], t1 = v1[j] * rstd1 * gv[j]; u32x2 w0, w1; w0.x = pk2(t0[0], t0[1]); w0.y = pk2(t0[2], t0[3]); w1.x = pk2(t1[0], t1[1]); w1.y = pk2(t1[2], t1[3]); o0[64 * j] = w0; o1[64 * j] = w1; }
    }
}

__device__ __forceinline__ f32x4 mma16(const bf16_t* A, int lda, const bf16_t* Bt, int ldb, int ksteps, f32x4 acc, int lane) {
    const int r = lane & 15, q = lane >> 4;
    const bf16_t* ap = A + r * lda + q * 8; const bf16_t* bp = Bt + r * ldb + q * 8;
    for (int ks = 0; ks < ksteps; ++ks) { const bf16x8 a = *(const bf16x8*)(ap + ks * 32); const bf16x8 b = *(const bf16x8*)(bp + ks * 32); acc = __builtin_amdgcn_mfma_f32_16x16x32_bf16(a, b, acc, 0, 0, 0); }
    return acc;
}
#define LBAR() do { asm volatile("s_waitcnt lgkmcnt(0)" ::: "memory"); __builtin_amdgcn_s_barrier(); asm volatile("" ::: "memory"); } while (0)
__device__ __forceinline__ f32x4 mma16s(const bf16_t* A, int lda, int sw, const bf16_t* Bt, int ldb, int ksteps, f32x4 acc, int lane) {
    const int r = lane & 15, q = lane >> 4;
    const bf16_t* ap = A + r * lda; const bf16_t* bp = Bt + r * ldb + q * 8;
    for (int ks = 0; ks < ksteps; ++ks) { const bf16x8 a = *(const bf16x8*)(ap + (((ks * 4 + q) ^ sw) << 3)); const bf16x8 b = *(const bf16x8*)(bp + ks * 32); acc = __builtin_amdgcn_mfma_f32_16x16x32_bf16(a, b, acc, 0, 0, 0); }
    return acc;
}
constexpr int PQ = 136, PC = 72;
struct PrepBufs { bf16_t *W, *QD, *KDT, *UHT, *AT; float* GL; };
__device__ __forceinline__ PrepBufs prep_bufs(unsigned char* ws) {
    PrepBufs b; b.W = (bf16_t*)(ws + WS_PREP); b.QD = (bf16_t*)(ws + WS_PREP + 64 * MiB); b.KDT = (bf16_t*)(ws + WS_PREP + 128 * MiB); b.UHT = (bf16_t*)(ws + WS_PREP + 192 * MiB);
    b.AT = (bf16_t*)(ws + WS_PREP + 256 * MiB); b.GL = (float*)(ws + WS_PREP + 288 * MiB); return b;
}
constexpr int PL_QS = 0, PL_KS = 17408, PL_KDT = 34816, PL_RAW = 53248, RAWP = 392  , PL_RT = PL_RAW + 67 * RAWP * 2, PL_GC = PL_RT + 256 * PC * 2, PL_CW = PL_GC + 512, PL_END = PL_CW + 6144;
constexpr int RAW_CHUNKS = 67 * 48;
#ifndef SEGSEL
#define SEGSEL 0
#endif
#define SEG_T0() unsigned long long seg_t0 = 0; if (SEGSEL && blockIdx.x == 0 && threadIdx.x == 0) seg_t0 = __builtin_amdgcn_s_memrealtime()
#define SEG_MARK(k) do { if (SEGSEL && blockIdx.x == 0 && threadIdx.x == 0) { const unsigned long long t_ = __builtin_amdgcn_s_memrealtime(); if (SEGSEL == (k)) atomicAdd((float*)(P.ws + WS_CTL + 768 * 1024), (float)(t_ - seg_t0) * 0.01f); seg_t0 = t_; } } while (0)
struct PrepStage { u32x4 raw[7]; float ga, gb; };
struct ConvW { f32x4 w[3][4]; };
struct PrepHold { u32x4 uh[2], w[2], at; int unit; };
__device__ __forceinline__ void prep_fetch(PrepStage& st, int unit, const Ptrs& P, int tid) {
    const int n = unit & 31, h = (unit >> 5) & 7, bl = unit >> 8;
    const int R0 = bl * SEQ + n * 64;
    const bf16_t* proj = (const bf16_t*)(P.ws + WS_PROJ); const float* small = (const float*)(P.ws + WS_SMALL);
#pragma unroll
    for (int i = 0; i < 7; ++i) { int c = tid + 512 * i; c = c < RAW_CHUNKS ? c : RAW_CHUNKS - 1; const int row = c / 48, c16 = c - row * 48, part = c16 >> 4, ch = (c16 & 15) * 8;
        const bool zero = (n == 0) && (row < 3);
        const int rr = zero ? 3 : row;
        u32x4 v = *(const u32x4*)(proj + (size_t)(3 + part) * PROJ_STRIDE + (size_t)(R0 - 3 + rr) * 1024 + h * HD + ch);
        if (zero) v = (u32x4){0u, 0u, 0u, 0u};
        st.raw[i] = v; }
    { const float* sm = small + (size_t)(R0 + (tid & 63)) * 32; st.ga = sm[8 + h]; st.gb = sm[16 + h]; }
}
__device__ __forceinline__ void prep_flush(const PrepHold& hd, const Ptrs& P, int tid) {
    const PrepBufs G = prep_bufs(P.ws);
#pragma unroll
    for (int i = 0; i < 2; ++i) { const int idx = tid + 512 * i; *(u32x4*)(G.UHT + (size_t)hd.unit * 8192 + idx * 8) = hd.uh[i]; *(u32x4*)(G.W + (size_t)hd.unit * 8192 + idx * 8) = hd.w[i]; }
    *(u32x4*)(G.AT + (size_t)hd.unit * 4096 + tid * 8) = hd.at;
}
__device__ __forceinline__ void gdn_prep_unit(char* lds, int unit, int unit_next, PrepStage& st, PrepHold& hd, const ConvW& cwr, const Ptrs& P, int tid_in, float neg_a, float dtb) {
    int tid = tid_in; asm volatile("" : "+v"(tid));
    const int lane = tid & 63, wid = tid >> 6, c16 = lane & 15, q4 = lane >> 4;
    const int h = (unit >> 5) & 7;
    bf16_t* Qs = (bf16_t*)(lds + PL_QS); bf16_t* Ks = (bf16_t*)(lds + PL_KS); bf16_t* KDTs = (bf16_t*)(lds + PL_KDT);
    bf16_t* RAW = (bf16_t*)(lds + PL_RAW);
    bf16_t* RT = (bf16_t*)(lds + PL_RT);
    float* gcs = (float*)(lds + PL_GC); float* bts = gcs + 64;
    bf16_t* UHs = (bf16_t*)(lds + PL_RAW + 4096); bf16_t* Wst = UHs + 8192; bf16_t* ATs = Wst + 64 * PQ;
    bf16_t* CH = (bf16_t*)lds;
    const PrepBufs G = prep_bufs(P.ws);
    SEG_T0();
#pragma unroll
    for (int i = 0; i < 7; ++i) { const int c = tid + 512 * i; const int row = c / 48, cc = c - row * 48; if (c < RAW_CHUNKS) *(u32x4*)(RAW + row * RAWP + cc * 8) = st.raw[i]; }
    if (wid == 0) {
        const float xx = st.ga + dtb;
        const float sp = xx > 20.f ? xx : log1pf(__expf(xx));
        float cum = neg_a * sp;
        const float beta = __builtin_amdgcn_rcpf(1.0f + __expf(-st.gb));
#pragma unroll
        for (int o = 1; o < 64; o <<= 1) { const float t = __shfl_up(cum, o); if (lane >= o) cum += t; }
        gcs[lane] = cum; bts[lane] = beta;
    }
    prep_flush(hd, P, tid);
    LBAR();
    SEG_MARK(1);
    prep_fetch(st, unit_next, P, tid);
    {
        const int cg = tid & 31, rg = tid >> 5, r0 = 4 * rg, c0 = 4 * cg;
        const f32x4 gc4 = *(const f32x4*)(gcs + r0), bt4 = *(const f32x4*)(bts + r0); const float glast = gcs[63];
        float eg[4], egl[4];
#pragma unroll
        for (int rr = 0; rr < 4; ++rr) { eg[rr] = __expf(gc4[rr]); egl[rr] = __expf(glast - gc4[rr]); }
        const int key = (cg >> 1) & 7;
        const int csw = ((((rg >> 1) ^ key) << 3) | ((rg & 1) << 2));
#pragma unroll
        for (int part = 0; part < 3; ++part) {
            float x[7][4];
#pragma unroll
            for (int i = 0; i < 7; ++i) { const u32x2 a = *(const u32x2*)(RAW + (r0 + i) * RAWP + part * 128 + c0); x[i][0] = bflo(a.x); x[i][1] = bfhi(a.x); x[i][2] = bflo(a.y); x[i][3] = bfhi(a.y); }
            float y[4][4]; float ss[4];
#pragma unroll
            for (int rr = 0; rr < 4; ++rr) { ss[rr] = 0.f;
#pragma unroll
                for (int e = 0; e < 4; ++e) { float v = cwr.w[part][0][e] * x[rr][e] + cwr.w[part][1][e] * x[rr + 1][e] + cwr.w[part][2][e] * x[rr + 2][e] + cwr.w[part][3][e] * x[rr + 3][e];
                    v = siluf(v); y[rr][e] = v; ss[rr] += v * v; } }
            if (part < 2) {
#pragma unroll
                for (int rr = 0; rr < 4; ++rr) { float t = ss[rr]; t += __shfl_xor(t, 1); t += __shfl_xor(t, 2); t += __shfl_xor(t, 4); t += __shfl_xor(t, 8); t += __shfl_xor(t, 16); ss[rr] = rsqrtf(t + 1e-6f); }
            }
            if (part == 0) {
#pragma unroll
                for (int rr = 0; rr < 4; ++rr) { const float sc = ss[rr] * 0.08838834764831845f; const float a0 = y[rr][0] * sc, a1 = y[rr][1] * sc, a2 = y[rr][2] * sc, a3 = y[rr][3] * sc;
                    u32x2 w; w.x = pk2(a0, a1); w.y = pk2(a2, a3); *(u32x2*)(Qs + (r0 + rr) * PQ + c0) = w;
                    u32x2 d; d.x = pk2(a0 * eg[rr], a1 * eg[rr]); d.y = pk2(a2 * eg[rr], a3 * eg[rr]); *(u32x2*)(G.QD + (size_t)unit * 8192 + (r0 + rr) * 128 + c0) = d; }
            } else if (part == 1) {
#pragma unroll
                for (int rr = 0; rr < 4; ++rr) {
#pragma unroll
                    for (int e = 0; e < 4; ++e) y[rr][e] *= ss[rr];
                    u32x2 w; w.x = pk2(y[rr][0], y[rr][1]); w.y = pk2(y[rr][2], y[rr][3]); *(u32x2*)(Ks + (r0 + rr) * PQ + c0) = w; }
#pragma unroll
                for (int e = 0; e < 4; ++e) { u32x2 w1, w2;
                    w1.x = pk2(y[0][e] * bt4[0] * eg[0], y[1][e] * bt4[1] * eg[1]); w1.y = pk2(y[2][e] * bt4[2] * eg[2], y[3][e] * bt4[3] * eg[3]);
                    w2.x = pk2(y[0][e] * egl[0], y[1][e] * egl[1]); w2.y = pk2(y[2][e] * egl[2], y[3][e] * egl[3]);
                    *(u32x2*)(RT + (128 + c0 + e) * PC + csw) = w1; *(u32x2*)(KDTs + (c0 + e) * PC + csw) = w2; }
            } else {
#pragma unroll
                for (int e = 0; e < 4; ++e) { u32x2 w1; w1.x = pk2(y[0][e] * bt4[0], y[1][e] * bt4[1]); w1.y = pk2(y[2][e] * bt4[2], y[3][e] * bt4[3]); *(u32x2*)(RT + (c0 + e) * PC + csw) = w1; }
            }
        }
    }
    LBAR();
    SEG_MARK(2);
    {
#pragma unroll
        for (int i = 0; i < 2; ++i) { const int idx = tid + 512 * i, row = idx >> 3, ch = idx & 7; *(u32x4*)(G.KDT + (size_t)unit * 8192 + row * 64 + ch * 8) = *(const u32x4*)(KDTs + row * PC + ((ch ^ ((row >> 3) & 7)) << 3)); }
    }
    const int mat = wid >> 2, ti = wid & 3;
    f32x4 res[4], res2[4];
#pragma unroll
    for (int tj = 0; tj < 4; ++tj) { f32x4 acc = {0.f, 0.f, 0.f, 0.f}, acc2 = {0.f, 0.f, 0.f, 0.f};
        if (tj <= ti) { if (mat == 0) acc = mma16(Ks + ti * 16 * PQ, PQ, Ks + tj * 16 * PQ, PQ, 4, acc, lane);
                        acc2 = mma16(Ks + tj * 16 * PQ, PQ, (mat ? Qs : Ks) + ti * 16 * PQ, PQ, 4, acc2, lane); }
        res[tj] = acc; res2[tj] = acc2; }
    LBAR();
    {
        const int iiL = ti * 16 + c16; const float gciL = gcs[iiL], btL = bts[iiL];
#pragma unroll
        for (int tj = 0; tj < 4; ++tj) {
            const int jc0 = tj * 16 + 4 * q4;
            const f32x4 gcj = *(const f32x4*)(gcs + jc0);
            float v[4];
#pragma unroll
            for (int jj = 0; jj < 4; ++jj) { const int jc = jc0 + jj; const float dec = (iiL >= jc) ? __expf(gciL - gcj[jj]) : 0.f;
                v[jj] = (mat == 0) ? ((iiL > jc) ? -res2[tj][jj] * dec * btL : 0.f) : ((iiL >= jc) ? res2[tj][jj] * dec : 0.f); }
            u32x2 w; w.x = pk2(v[0], v[1]); w.y = pk2(v[2], v[3]);
            if (mat == 0) *(u32x2*)(CH + iiL * PC + jc0) = w;
            else *(u32x2*)(ATs + iiL * PC + jc0) = w;
            if (mat == 0) {
                const int jcL = tj * 16 + c16, ii0 = ti * 16 + 4 * q4; const float gcjL = gcs[jcL];
                const f32x4 gci = *(const f32x4*)(gcs + ii0), bti = *(const f32x4*)(bts + ii0);
                float t[4];
#pragma unroll
                for (int jj = 0; jj < 4; ++jj) { const int ii = ii0 + jj; t[jj] = (ii > jcL) ? -res[tj][jj] * __expf(gci[jj] - gcjL) * bti[jj] : 0.f; }
                u32x2 w2; w2.x = pk2(t[0], t[1]); w2.y = pk2(t[2], t[3]);
                *(u32x2*)(CH + 2 * 64 * PC + jcL * PC + ii0) = w2; }
        }
    }
    LBAR();
    SEG_MARK(3);
    f32x4 pacc[4];
    if (wid >= 4) {
#pragma unroll
        for (int tj = 0; tj < 4; ++tj) { const u32x2 nw = *(const u32x2*)(CH + (ti * 16 + c16) * PC + tj * 16 + 4 * q4); const int ii = ti * 16 + c16, jc0 = tj * 16 + 4 * q4;
            pacc[tj][0] = bflo(nw.x) + (ii == jc0 ? 1.f : 0.f); pacc[tj][1] = bfhi(nw.x) + (ii == jc0 + 1 ? 1.f : 0.f); pacc[tj][2] = bflo(nw.y) + (ii == jc0 + 2 ? 1.f : 0.f); pacc[tj][3] = bfhi(nw.y) + (ii == jc0 + 3 ? 1.f : 0.f); }
    }
    for (int s = 0; s < 6; ++s) {
        const int cur = s & 1, nxt = cur ^ 1;
        bf16_t* Qr_c = CH + cur * 64 * PC; bf16_t* Qt_c = CH + (2 + cur) * 64 * PC; bf16_t* Qr_n = CH + nxt * 64 * PC; bf16_t* Qt_n = CH + (2 + nxt) * 64 * PC;
        bf16_t* Pr_c = CH + (4 + cur) * 64 * PC; bf16_t* Pr_p = CH + (4 + nxt) * 64 * PC;
        if (wid < 4) {
            if (s < 5) {
#pragma unroll
                for (int tj = 0; tj < 4; ++tj) { f32x4 a1 = {0.f, 0.f, 0.f, 0.f}, a2 = {0.f, 0.f, 0.f, 0.f};
                    const bf16_t* ap = Qr_c + (ti * 16 + c16) * PC + q4 * 8; const bf16_t* bp = Qt_c + (tj * 16 + c16) * PC + q4 * 8;
#pragma unroll
                    for (int ks = 0; ks < 2; ++ks) { const bf16x8 fa = *(const bf16x8*)(ap + ks * 32), fb = *(const bf16x8*)(bp + ks * 32);
                        a1 = __builtin_amdgcn_mfma_f32_16x16x32_bf16(fa, fb, a1, 0, 0, 0);
                        a2 = __builtin_amdgcn_mfma_f32_16x16x32_bf16(fb, fa, a2, 0, 0, 0); }
                    u32x2 w1, w2; w1.x = pk2(a1[0], a1[1]); w1.y = pk2(a1[2], a1[3]); w2.x = pk2(a2[0], a2[1]); w2.y = pk2(a2[2], a2[3]);
                    *(u32x2*)(Qt_n + (tj * 16 + c16) * PC + ti * 16 + 4 * q4) = w1;
                    *(u32x2*)(Qr_n + (ti * 16 + c16) * PC + tj * 16 + 4 * q4) = w2; }
            }
        } else {
#pragma unroll
            for (int tj = 0; tj < 4; ++tj) {
                if (s >= 1) { const bf16_t* ap = Qt_c + (tj * 16 + c16) * PC + q4 * 8; const bf16_t* bp = Pr_p + (ti * 16 + c16) * PC + q4 * 8;
#pragma unroll
                    for (int ks = 0; ks < 2; ++ks) { const bf16x8 fa = *(const bf16x8*)(ap + ks * 32), fb = *(const bf16x8*)(bp + ks * 32); pacc[tj] = __builtin_amdgcn_mfma_f32_16x16x32_bf16(fa, fb, pacc[tj], 0, 0, 0); } }
                u32x2 w; w.x = pk2(pacc[tj][0], pacc[tj][1]); w.y = pk2(pacc[tj][2], pacc[tj][3]);
                *(u32x2*)(Pr_c + (ti * 16 + c16) * PC + tj * 16 + 4 * q4) = w; }
        }
        LBAR();
    }
    SEG_MARK(4);
    {
        const bf16_t* Tm = CH + 5 * 64 * PC;
#pragma unroll
        for (int t2 = 0; t2 < 2; ++t2) { const int tch = 2 * wid + t2; const int swl = (2 * tch + (c16 >> 3)) & 7;
#pragma unroll
            for (int tj = 0; tj < 4; ++tj) { f32x4 acc = {0.f, 0.f, 0.f, 0.f};
#pragma unroll
                for (int ks = 0; ks < 2; ++ks) { const bf16x8 fr = *(const bf16x8*)(RT + (tch * 16 + c16) * PC + (((ks * 4 + q4) ^ swl) << 3)); const bf16x8 ft = *(const bf16x8*)(Tm + (tj * 16 + c16) * PC + ks * 32 + q4 * 8);
                    acc = (tch < 8) ? __builtin_amdgcn_mfma_f32_16x16x32_bf16(ft, fr, acc, 0, 0, 0) : __builtin_amdgcn_mfma_f32_16x16x32_bf16(fr, ft, acc, 0, 0, 0); }
                u32x2 w; w.x = pk2(acc[0], acc[1]); w.y = pk2(acc[2], acc[3]);
                if (tch < 8) *(u32x2*)(UHs + ((((tch * 4 + tj) * 4 + q4) * 16 + c16) * 4)) = w;
                else *(u32x2*)(Wst + (tj * 16 + c16) * PQ + (tch - 8) * 16 + 4 * q4) = w;
            } }
        G.GL[unit] = __expf(gcs[63]);
    }
    LBAR();
#pragma unroll
    for (int i = 0; i < 2; ++i) { const int idx = tid + 512 * i; hd.uh[i] = *(const u32x4*)(UHs + idx * 8); hd.w[i] = *(const u32x4*)(Wst + (idx >> 4) * PQ + (idx & 15) * 8); }
    hd.at = *(const u32x4*)(ATs + (tid >> 3) * PC + (tid & 7) * 8); hd.unit = unit;
    LBAR();
    SEG_MARK(5);
}

__device__ __forceinline__ void gdn_seq_unit(char* lds, int bh, const Ptrs& P, int tid) {
    const int lane = tid & 63, wid = tid >> 6, c16 = lane & 15, q4 = lane >> 4;
    const int bl = bh >> 3, h = bh & 7;
    bf16_t* ST = (bf16_t*)lds;
    bf16_t* Wl = ST + 128 * PQ;
    bf16_t* QDl = Wl + 64 * PQ;
    bf16_t* ATl = QDl + 64 * PQ;
    bf16_t* KDTl = ATl + 64 * PC;
    bf16_t* UTl = KDTl + 128 * PC;
    bf16_t* GZl = UTl + 128 * PC;
    float* SSl = (float*)(GZl + 64 * PQ);
    const PrepBufs G = prep_bufs(P.ws);
    const bf16_t* gz = (const bf16_t*)(P.ws + WS_PROJ) + 6 * PROJ_STRIDE + (size_t)(bl * SEQ) * 1024 + h * HD;
    bf16_t* yg = (bf16_t*)(P.ws + WS_YGDN) + (size_t)(bl * SEQ) * 1024 + h * HD;
    f32x4 Sacc[8];
#pragma unroll
    for (int t = 0; t < 8; ++t) Sacc[t] = (f32x4){0.f, 0.f, 0.f, 0.f};
    for (int i = lane; i < 16 * PQ / 2; i += 64) ((unsigned*)(ST + wid * 16 * PQ))[i] = 0u;
    const f32x4 gn = *(const f32x4*)(P.gdn_norm + 16 * wid + 4 * q4);
    const int r16 = tid >> 4, ch16 = (tid & 15) * 8;
    const int r8 = tid >> 3, ch8 = (tid & 7) * 8;
    u32x4 sW[2], sQ[2], sA, sK[2], sG[2]; u32x2 uhn[4]; float gln;
    {
        const size_t ub = (size_t)(bh * 32) * 8192;
#pragma unroll
        for (int i = 0; i < 2; ++i) { const int idx = tid + 512 * i; sW[i] = *(const u32x4*)(G.W + ub + idx * 8); sQ[i] = *(const u32x4*)(G.QD + ub + idx * 8); sK[i] = *(const u32x4*)(G.KDT + ub + idx * 8);
            sG[i] = *(const u32x4*)(gz + (size_t)(r16 + 32 * i) * 1024 + ch16); }
        sA = *(const u32x4*)(G.AT + (size_t)(bh * 32) * 4096 + tid * 8);
#pragma unroll
        for (int t = 0; t < 4; ++t) uhn[t] = *(const u32x2*)(G.UHT + ub + ((wid * 4 + t) * 64 + lane) * 4);
        gln = G.GL[bh * 32];
    }
    for (int n = 0; n < 32; ++n) {
        const int unit = bh * 32 + n;
        const size_t ub = (size_t)unit * 8192;
#pragma unroll
        for (int i = 0; i < 2; ++i) { const int idx = tid + 512 * i;
            *(u32x4*)(Wl + (idx >> 4) * PQ + (idx & 15) * 8) = sW[i]; *(u32x4*)(QDl + (idx >> 4) * PQ + (idx & 15) * 8) = sQ[i]; *(u32x4*)(KDTl + (idx >> 3) * PC + (idx & 7) * 8) = sK[i]; }
        *(u32x4*)(ATl + r8 * PC + ch8) = sA;
        const float gl = gln;
        u32x2 uh[4];
#pragma unroll
        for (int t = 0; t < 4; ++t) uh[t] = uhn[t];
        LBAR();
        const int nn = (n + 1 < 32) ? n + 1 : 31;
        { const size_t un = (size_t)(bh * 32 + nn) * 8192;
#pragma unroll
            for (int i = 0; i < 2; ++i) { const int idx = tid + 512 * i; sW[i] = *(const u32x4*)(G.W + un + idx * 8); sQ[i] = *(const u32x4*)(G.QD + un + idx * 8); sK[i] = *(const u32x4*)(G.KDT + un + idx * 8); }
            sA = *(const u32x4*)(G.AT + (size_t)(bh * 32 + nn) * 4096 + tid * 8);
#pragma unroll
            for (int t = 0; t < 4; ++t) uhn[t] = *(const u32x2*)(G.UHT + un + ((wid * 4 + t) * 64 + lane) * 4);
            gln = G.GL[bh * 32 + nn]; }
        { const int np = (n > 0) ? n - 1 : 0;
#pragma unroll
            for (int i = 0; i < 2; ++i) { const u32x4 v = *(const u32x4*)(GZl + (r16 + 32 * i) * PQ + ch16); *(u32x4*)(yg + (size_t)(np * 64 + r16 + 32 * i) * 1024 + ch16) = v; } }
        f32x4 ws[4], os[4];
#pragma unroll
        for (int t = 0; t < 4; ++t) { ws[t] = (f32x4){0.f, 0.f, 0.f, 0.f}; os[t] = (f32x4){0.f, 0.f, 0.f, 0.f}; }
#pragma unroll
        for (int ks = 0; ks < 4; ++ks) { const bf16x8 b = *(const bf16x8*)(ST + (16 * wid + c16) * PQ + ks * 32 + q4 * 8);
#pragma unroll
            for (int t = 0; t < 4; ++t) { const bf16x8 a = *(const bf16x8*)(Wl + (16 * t + c16) * PQ + ks * 32 + q4 * 8); ws[t] = __builtin_amdgcn_mfma_f32_16x16x32_bf16(a, b, ws[t], 0, 0, 0);
                const bf16x8 a2 = *(const bf16x8*)(QDl + (16 * t + c16) * PQ + ks * 32 + q4 * 8); os[t] = __builtin_amdgcn_mfma_f32_16x16x32_bf16(b, a2, os[t], 0, 0, 0); } }
#pragma unroll
        for (int t = 0; t < 4; ++t) { u32x2 w; w.x = pk2(bflo(uh[t].x) - ws[t][0], bfhi(uh[t].x) - ws[t][1]); w.y = pk2(bflo(uh[t].y) - ws[t][2], bfhi(uh[t].y) - ws[t][3]);
            *(u32x2*)(UTl + (16 * wid + c16) * PC + 16 * t + 4 * q4) = w; }
        LBAR();
#pragma unroll
        for (int i = 0; i < 2; ++i) *(u32x4*)(GZl + (r16 + 32 * i) * PQ + ch16) = sG[i];
#pragma unroll
        for (int i = 0; i < 2; ++i) sG[i] = *(const u32x4*)(gz + (size_t)(nn * 64 + r16 + 32 * i) * 1024 + ch16);
#pragma unroll
        for (int ks = 0; ks < 2; ++ks) { const bf16x8 b = *(const bf16x8*)(UTl + (16 * wid + c16) * PC + ks * 32 + q4 * 8);
#pragma unroll
            for (int t = 0; t < 4; ++t) { const bf16x8 a = *(const bf16x8*)(ATl + (16 * t + c16) * PC + ks * 32 + q4 * 8); os[t] = __builtin_amdgcn_mfma_f32_16x16x32_bf16(b, a, os[t], 0, 0, 0); } }
#pragma unroll
        for (int t = 0; t < 8; ++t) Sacc[t] = Sacc[t] * gl;
#pragma unroll
        for (int ks = 0; ks < 2; ++ks) { const bf16x8 a = *(const bf16x8*)(UTl + (16 * wid + c16) * PC + ks * 32 + q4 * 8);
#pragma unroll
            for (int t = 0; t < 8; ++t) { const bf16x8 b = *(const bf16x8*)(KDTl + (16 * t + c16) * PC + ks * 32 + q4 * 8); Sacc[t] = __builtin_amdgcn_mfma_f32_16x16x32_bf16(b, a, Sacc[t], 0, 0, 0); } }
#pragma unroll
        for (int t = 0; t < 8; ++t) { u32x2 w; w.x = pk2(Sacc[t][0], Sacc[t][1]); w.y = pk2(Sacc[t][2], Sacc[t][3]); *(u32x2*)(ST + (16 * wid + c16) * PQ + 16 * t + 4 * q4) = w; }
#pragma unroll
        for (int t = 0; t < 4; ++t) { float s = (os[t][0] * os[t][0] + os[t][1] * os[t][1]) + (os[t][2] * os[t][2] + os[t][3] * os[t][3]); s += __shfl_xor(s, 16); s += __shfl_xor(s, 32);
            if (q4 == 0) SSl[wid * 64 + 16 * t + c16] = s; }
        LBAR();
        float tot = 0.f;
#pragma unroll
        for (int w = 0; w < 8; ++w) tot += SSl[w * 64 + lane];
        const float rstd_l = rsqrtf(tot * (1.0f / 128.0f) + 1e-6f);
#pragma unroll
        for (int t = 0; t < 4; ++t) { const int row = 16 * t + c16; const float rs = __shfl(rstd_l, row);
            u32x2* gp = (u32x2*)(GZl + row * PQ + 16 * wid + 4 * q4); const u32x2 gw = *gp; u32x2 w;
            w.x = pk2(os[t][0] * rs * gn[0] * siluf(bflo(gw.x)), os[t][1] * rs * gn[1] * siluf(bfhi(gw.x)));
            w.y = pk2(os[t][2] * rs * gn[2] * siluf(bflo(gw.y)), os[t][3] * rs * gn[3] * siluf(bfhi(gw.y))); *gp = w; }
    }
    LBAR();
#pragma unroll
    for (int i = 0; i < 2; ++i) { const u32x4 v = *(const u32x4*)(GZl + (r16 + 32 * i) * PQ + ch16); *(u32x4*)(yg + (size_t)(31 * 64 + r16 + 32 * i) * 1024 + ch16) = v; }
    __syncthreads();
}

__device__ __forceinline__ void fox_item(char* lds, int item, const Ptrs& P, int tid) {
    using bf = fox::bf16;
    const int lane = tid & 63, wid = tid >> 6;
    const int bh = item >> 2, xq = item & 3, bl = bh >> 3, h = bh & 7;
    float* cb = (float*)(lds + fox::LDS_BYTES);
    float* tmp = cb + SEQ;
    const float* small = (const float*)(P.ws + WS_SMALL);
    {
        const float fb = P.fox_f_bias[h];
        float lf[4]; float run = 0.f;
#pragma unroll
        for (int e = 0; e < 4; ++e) { const float xv = small[(size_t)(bl * SEQ + 4 * tid + e) * 32 + h] + fb;
            const float l = (xv < -20.f) ? xv : -log1pf(__expf(-xv)); run += l; lf[e] = run; }
        float inc = run;
#pragma unroll
        for (int o = 1; o < 64; o <<= 1) { const float t = __shfl_up(inc, o); if (lane >= o) inc += t; }
        if (lane == 63) tmp[wid] = inc;
        __syncthreads();
        float off = inc - run;
        for (int w = 0; w < wid; ++w) off += tmp[w];
#pragma unroll
        for (int e = 0; e < 4; ++e) cb[4 * tid + e] = -(off + lf[e]) * 11.313708498984761f;
        __syncthreads();
    }
    bf* fq = (bf*)(P.ws + WS_PROJ); const bf* fk = fq + PROJ_STRIDE; const bf* fv = fq + 2 * PROJ_STRIDE;
    const size_t hb = (size_t)(bl * SEQ) * 1024 + h * HD;
    fox::BlockRef<bf, bf> b0, b1;
    bf* yo = (bf*)(P.ws + WS_YFOX);
    b0.Q = fq + hb + (size_t)(xq * 256) * 1024; b0.O = yo + hb + (size_t)(xq * 256) * 1024; b0.K = fk + hb; b0.V = fv + hb; b0.P0 = xq * 256;
    b1.Q = fq + hb + (size_t)((7 - xq) * 256) * 1024; b1.O = yo + hb + (size_t)((7 - xq) * 256) * 1024; b1.K = fk + hb; b1.V = fv + hb; b1.P0 = (7 - xq) * 256;
    fox::Seam<bf> S;
    fox::causal_swa_prime<bf, bf>(b0, 1 << 20, lds, S);
    fox::causal_swa_block<bf, bf>(b0, b1, SEQ, 1 << 20, lds, S, cb);
    fox::causal_swa_block<bf, bf>(b1, b1, SEQ, 1 << 20, lds, S, cb);
    __syncthreads();
}

__device__ __forceinline__ void phase_convgate(const Ptrs& P, int tid, int cid) {
    const bf16_t* up = (const bf16_t*)(P.ws + WS_UP); bf16_t* act = (bf16_t*)(P.ws + WS_ACT);
    constexpr int NFG = DFF / 8;
    constexpr int RPB = GM / 256; static_assert(SEQ % RPB == 0, "a slab never straddles a sequence start");
    if (tid < NFG) {
        const int fg = tid, p = fg >> 4, i0 = (fg & 15) * 8, f0 = p * 128 + i0;
        const int cg0 = p * 256 + i0, cv0 = cg0 + 128;
        float wg[3][8], wv[3][8];
#pragma unroll
        for (int i = 0; i < 3; ++i)
#pragma unroll
            for (int j = 0; j < 8; ++j) { wg[i][j] = P.ffn_conv_w[i * NUP + f0 + j]; wv[i][j] = P.ffn_conv_w[i * NUP + DFF + f0 + j]; }
        const int r0 = cid * RPB;
        float g1[8], g2[8], v1[8], v2[8];
#pragma unroll
        for (int j = 0; j < 8; ++j) { g1[j] = 0.f; g2[j] = 0.f; v1[j] = 0.f; v2[j] = 0.f; }
        if ((r0 & (SEQ - 1)) != 0) {
            const u32x4 a1 = *(const u32x4*)(up + (size_t)(r0 - 1) * NUP + cg0), a2 = *(const u32x4*)(up + (size_t)(r0 - 2) * NUP + cg0);
            const u32x4 b1 = *(const u32x4*)(up + (size_t)(r0 - 1) * NUP + cv0), b2 = *(const u32x4*)(up + (size_t)(r0 - 2) * NUP + cv0);
            g1[0] = bflo(a1.x); g1[1] = bfhi(a1.x); g1[2] = bflo(a1.y); g1[3] = bfhi(a1.y); g1[4] = bflo(a1.z); g1[5] = bfhi(a1.z); g1[6] = bflo(a1.w); g1[7] = bfhi(a1.w);
            g2[0] = bflo(a2.x); g2[1] = bfhi(a2.x); g2[2] = bflo(a2.y); g2[3] = bfhi(a2.y); g2[4] = bflo(a2.z); g2[5] = bfhi(a2.z); g2[6] = bflo(a2.w); g2[7] = bfhi(a2.w);
            v1[0] = bflo(b1.x); v1[1] = bfhi(b1.x); v1[2] = bflo(b1.y); v1[3] = bfhi(b1.y); v1[4] = bflo(b1.z); v1[5] = bfhi(b1.z); v1[6] = bflo(b1.w); v1[7] = bfhi(b1.w);
            v2[0] = bflo(b2.x); v2[1] = bfhi(b2.x); v2[2] = bflo(b2.y); v2[3] = bfhi(b2.y); v2[4] = bflo(b2.z); v2[5] = bfhi(b2.z); v2[6] = bflo(b2.w); v2[7] = bfhi(b2.w);
        }
        for (int rb = 0; rb < RPB; rb += 8) {
            u32x4 ga[8], va[8];
#pragma unroll
            for (int r = 0; r < 8; ++r) { ga[r] = *(const u32x4*)(up + (size_t)(r0 + rb + r) * NUP + cg0); va[r] = *(const u32x4*)(up + (size_t)(r0 + rb + r) * NUP + cv0); }
#pragma unroll
            for (int r = 0; r < 8; ++r) {
                const u32x4 a = ga[r], b = va[r];
                float g0[8], v0[8];
                g0[0] = bflo(a.x); g0[1] = bfhi(a.x); g0[2] = bflo(a.y); g0[3] = bfhi(a.y); g0[4] = bflo(a.z); g0[5] = bfhi(a.z); g0[6] = bflo(a.w); g0[7] = bfhi(a.w);
                v0[0] = bflo(b.x); v0[1] = bfhi(b.x); v0[2] = bflo(b.y); v0[3] = bfhi(b.y); v0[4] = bflo(b.z); v0[5] = bfhi(b.z); v0[6] = bflo(b.w); v0[7] = bfhi(b.w);
                float o[8];
#pragma unroll
                for (int j = 0; j < 8; ++j) { const float cgv = wg[0][j] * g2[j] + wg[1][j] * g1[j] + wg[2][j] * g0[j]; const float cvv = wv[0][j] * v2[j] + wv[1][j] * v1[j] + wv[2][j] * v0[j];
                    o[j] = siluf(cgv) * cvv; g2[j] = g1[j]; g1[j] = g0[j]; v2[j] = v1[j]; v1[j] = v0[j]; }
                u32x4 w; w.x = pk2(o[0], o[1]); w.y = pk2(o[2], o[3]); w.z = pk2(o[4], o[5]); w.w = pk2(o[6], o[7]);
                *(u32x4*)(act + (size_t)(r0 + rb + r) * DFF + f0) = w;
            }
        }
    }
}

__device__ __forceinline__ void phase_final(const Ptrs& P, int tid, int cid, float pert) {
    const int lane = tid & 63, wave = tid >> 6;
    const int gw = cid * 8 + wave, NGW = 256 * 8;
    const float* rowss2 = (const float*)(P.ws + WS_CTL) + MTOK;
    f32x4 gv[4];
#pragma unroll
    for (int j = 0; j < 4; ++j) gv[j] = ((const f32x4*)P.norm_final)[lane + 64 * j];
    for (int m0 = gw; m0 < MTOK; m0 += 2 * NGW) {
        const int m1 = m0 + NGW;
        const float rstd0 = rsqrtf(rowss2[m0] * (1.f / DM) + 1e-6f), rstd1 = rsqrtf(rowss2[m1] * (1.f / DM) + 1e-6f);
        f32x4* o0 = (f32x4*)(P.out + (size_t)m0 * DM) + lane; f32x4* o1 = (f32x4*)(P.out + (size_t)m1 * DM) + lane;
        f32x4 a0[4], a1[4];
#pragma unroll
        for (int j = 0; j < 4; ++j) { a0[j] = o0[64 * j]; a1[j] = o1[64 * j]; }
#pragma unroll
        for (int j = 0; j < 4; ++j) { o0[64 * j] = a0[j] * rstd0 * gv[j] + pert; o1[64 * j] = a1[j] * rstd1 * gv[j] + pert; }
    }
}

#define LAS __attribute__((address_space(3)))
#define XB_TMO      128
#define XB_XCNT(j)  (256  + 64 * (j))
#define XB_XSUB(j)  (1280 + 64 * (j))
#define XB_XGEN(j)  (2304 + 64 * (j))
#define XB_TOP      3328
#define XB_TOPGEN   3392
#define XCD_BAR_WORDS 3456
#define XB_SPIN_CAP (1u << 18)

__device__ __forceinline__ unsigned xb_ld(unsigned* p)              { return __hip_atomic_load(p, __ATOMIC_RELAXED, __HIP_MEMORY_SCOPE_AGENT); }
__device__ __forceinline__ unsigned xb_add(unsigned* p, unsigned v) { return __hip_atomic_fetch_add(p, v, __ATOMIC_RELAXED, __HIP_MEMORY_SCOPE_AGENT); }
__device__ __forceinline__ unsigned xb_xcc_id() { return (unsigned)__builtin_amdgcn_s_getreg((3 << 11) | 20) & 0xFu; }
#define XB_SPIN(cond, bar) do { unsigned _sp = 0; while (cond) { __builtin_amdgcn_s_sleep(1); \
    if ((++_sp & 255u) == 0u) { if (xb_ld(&(bar)[XB_TMO])) break; if (_sp > XB_SPIN_CAP) { atomicAdd(&(bar)[XB_TMO], 1u); break; } } } } while (0)

struct XcdBarrier {
    unsigned* bar; unsigned x;
    volatile LAS unsigned* st;
};

__device__ __forceinline__ XcdBarrier xcd_barrier_post(unsigned* bar, volatile LAS unsigned* st) {
    XcdBarrier b; b.bar = bar; b.x = xb_xcc_id(); b.st = st;
    if (threadIdx.x == 0) (void)xb_add(&bar[XB_XCNT(b.x)], 1u);
    return b;
}
__device__ __forceinline__ void xcd_barrier_complete(unsigned* bar, unsigned x, unsigned& nloc, unsigned& nx) {
    const unsigned G = gridDim.x * gridDim.y * gridDim.z;
    unsigned sum, cnt, mine, sp = 0u;
    for (;;) {
        sum = 0u; cnt = 0u; mine = 0u;
#pragma unroll
        for (unsigned j = 0; j < 16; ++j) { const unsigned c = xb_ld(&bar[XB_XCNT(j)]); sum += c; cnt += (c > 0u) ? 1u : 0u; mine = (j == x) ? c : mine; }
        if (sum == G) break;
        __builtin_amdgcn_s_sleep(1);
        if ((++sp & 255u) == 0u) { if (xb_ld(&bar[XB_TMO])) break; if (sp > XB_SPIN_CAP) { atomicAdd(&bar[XB_TMO], 1u); break; } }
    }
    nloc = mine > 0u ? mine : 1u; nx = cnt > 0u ? cnt : 1u;
}

__device__ __forceinline__ void xcd_barrier(const XcdBarrier& b) {
    asm volatile("s_waitcnt vmcnt(0)" ::: "memory");
    __syncthreads();
    if (threadIdx.x == 0) {
        unsigned* bar = b.bar;
        __builtin_amdgcn_s_waitcnt(0);
        unsigned nloc = b.st[0], nx = b.st[1];
        if (nloc == 0u) { xcd_barrier_complete(bar, b.x, nloc, nx); b.st[0] = nloc; b.st[1] = nx; }
        const unsigned old = xb_add(&bar[XB_XSUB(b.x)], 1u);
        const unsigned gen = old / nloc;
        if (old + 1u == (gen + 1u) * nloc) {
            __builtin_amdgcn_fence(__ATOMIC_RELEASE, "agent");
            asm volatile("s_waitcnt vmcnt(0)" ::: "memory");
            const unsigned og = xb_add(&bar[XB_TOP], 1u);
            const unsigned tg = og / nx;
            if (og + 1u == (tg + 1u) * nx) xb_add(&bar[XB_TOPGEN], 1u);
            else XB_SPIN(xb_ld(&bar[XB_TOPGEN]) == tg, bar);
            __builtin_amdgcn_fence(__ATOMIC_ACQUIRE, "agent");
            xb_add(&bar[XB_XGEN(b.x)], 1u);
            asm volatile("s_waitcnt vmcnt(0)" ::: "memory");
        } else {
            XB_SPIN(xb_ld(&bar[XB_XGEN(b.x)]) == gen, bar);
            __builtin_amdgcn_fence(__ATOMIC_ACQUIRE, "agent");
            asm volatile("s_waitcnt vmcnt(0)" ::: "memory");
        }
    }
    __syncthreads();
}

constexpr int N_PHASES = 2 + 8 * NG;
#ifndef PHM
#define PHM 2047
#endif
#ifndef DBL
#define DBL 0
#endif
#define DBLSEL 2
#ifndef TSTAMP
#define TSTAMP 0
#endif
#define TS_MASK 0x200
__global__ void __launch_bounds__(512, 2) mk_fwd(Args args) {
    extern __shared__ __attribute__((aligned(16))) unsigned char lds_raw[];
    char* lds = (char*)lds_raw;
    cg::grid_group grid = cg::this_grid();
    volatile LAS unsigned* xst = (volatile LAS unsigned*)((LAS unsigned char*)lds_raw + (LDS_BYTES - 16));
    if (threadIdx.x < 4) xst[threadIdx.x] = 0u;
    __syncthreads();
    XcdBarrier xbar; xbar.bar = (unsigned*)(args.ws + WS_CTL + 800 * 1024); xbar.x = 0; xbar.st = xst;
    constexpr int G = 256;
    for (int ph = args.ph_lo; ph < args.ph_hi; ++ph) {
      {
        int tid = threadIdx.x; asm volatile("" : "+v"(tid));
        int cid = blockIdx.x; asm volatile("" : "+s"(cid));
        typedef const __attribute__((address_space(4))) Args* KArgsP;
        KArgsP kp = (KArgsP)__builtin_amdgcn_kernarg_segment_ptr(); asm volatile("" : "+s"(kp));
#define GPTR(T, v) ((T*)(__attribute__((address_space(1))) T*)(v))
        Ptrs P;
        P.x = GPTR(const float, kp->in[0]); P.norm_mix = GPTR(const float, kp->in[1]); P.w_in = GPTR(const float, kp->in[2]); P.fox_f_bias = GPTR(const float, kp->in[3]);
        P.gdn_conv_w = GPTR(const float, kp->in[4]); P.gdn_a_log = GPTR(const float, kp->in[5]); P.gdn_dt_bias = GPTR(const float, kp->in[6]); P.gdn_norm = GPTR(const float, kp->in[7]);
        P.w_bf = GPTR(const float, kp->in[8]); P.w_bg = GPTR(const float, kp->in[9]); P.w_out = GPTR(const float, kp->in[10]); P.norm_ffn = GPTR(const float, kp->in[11]);
        P.w_up = GPTR(const float, kp->in[12]); P.ffn_conv_w = GPTR(const float, kp->in[13]); P.w_down = GPTR(const float, kp->in[14]); P.norm_final = GPTR(const float, kp->in[15]);
        P.out = GPTR(float, kp->out); unsigned char* ws = GPTR(unsigned char, kp->ws); P.ws = ws;
        float* rowss1 = (float*)(ws + WS_CTL); float* rowss2 = rowss1 + MTOK;
        if (ph == 0) { if (PHM & 1) phase_prologue(P, lds, tid, cid);
            if (MK_ONE_LAUNCH) {
                unsigned* cz = (unsigned*)(ws + WS_CTL); for (int i = cid * 512 + tid; i < 131072; i += G * 512) cz[i] = 0u;
                if (cid == 0) { unsigned* bz = (unsigned*)(ws + WS_CTL + 800 * 1024); for (int i = tid; i < XCD_BAR_WORDS; i += 512) bz[i] = 0u; if (tid < 64) ((unsigned*)(ws + WS_CTL + 768 * 1024))[tid] = 0u; } } }
        else if (ph == N_PHASES - 1) {
            float pert = 0.f;
            if (SEGSEL && blockIdx.x == 0) pert = fminf(__hip_atomic_load((float*)(ws + WS_CTL + 768 * 1024), __ATOMIC_RELAXED, __HIP_MEMORY_SCOPE_AGENT) * 5e-5f, 0.12f);
            if (PHM & 2) phase_final(P, tid, cid, pert); }
        else {
            const int grp = (ph - 1) >> 3, sub = (ph - 1) & 7;
            const size_t r0g = (size_t)grp * GM;
            pg8::bf16_t* proj = (pg8::bf16_t*)(ws + WS_PROJ);
            if (sub == 0 && (PHM & 4)) {
                pg8::Gemm g{(const pg8::bf16_t*)(P.out + r0g * DM), nullptr, (const pg8::bf16_t*)(ws + WS_WIN), nullptr, GM, NIN, DM};
                pg8::StaticOrder S; S.init(GM, NIN, G, cid);
                pg8::EpiIn E{proj, (float*)(ws + WS_SMALL)};
                pg8::gemm_phase<pg8::EpiIn, pg8::StaticOrder, true, true>((PG8_LAS unsigned char*)lds_raw, g, S, E);
            } else if (sub == 1 && (PHM & 8)) {
                { const int hh = (cid >> 5) & 7;
                  ConvW cwr;
#pragma unroll
                  for (int part = 0; part < 3; ++part)
#pragma unroll
                      for (int tap = 0; tap < 4; ++tap) cwr.w[part][tap] = *(const f32x4*)(P.gdn_conv_w + tap * 3072 + part * 1024 + hh * HD + 4 * (tid & 31));
                  const float neg_a = -__expf(P.gdn_a_log[hh]), dtb = P.gdn_dt_bias[hh];
                  PrepStage st; prep_fetch(st, cid, P, tid);
                  PrepHold hd; hd.unit = cid; hd.at = (u32x4){0u, 0u, 0u, 0u}; hd.uh[0] = hd.at; hd.uh[1] = hd.at; hd.w[0] = hd.at; hd.w[1] = hd.at;
                  for (int u = cid; u < NCH; u += G) { const int un = (u + G < NCH) ? u + G : u; gdn_prep_unit(lds, u, un, st, hd, cwr, P, tid, neg_a, dtb); }
                  prep_flush(hd, P, tid); }
            } else if (sub == 2) {
                if ((PHM & 32)) for (int bh = cid; bh < BG * NH; bh += G) gdn_seq_unit(lds, bh, P, tid);
                if ((PHM & 16)) { const bool sq = cid < BG * NH; const int first = sq ? cid * 4 : (cid - BG * NH) * 4 + 1, cnt = sq ? 1 : 3; for (int x = 0; x < cnt; ++x) fox_item(lds, first + x, P, tid); }
            } else if (sub == 3 && (PHM & 64)) {
                pg8::Gemm g{(const pg8::bf16_t*)(ws + WS_YFOX), (const pg8::bf16_t*)(ws + WS_YGDN), (const pg8::bf16_t*)(ws + WS_WBF), (const pg8::bf16_t*)(ws + WS_WBG), GM, DM, DM};
                pg8::PairOrder S; S.init(GM, DM, G, cid);
                pg8::EpiY E{proj + 7 * PROJ_STRIDE, proj + 8 * PROJ_STRIDE, (pg8::bf16_t*)(ws + WS_T1), (pg8::bf16_t*)(ws + WS_Y)};
                pg8::gemm_phase<pg8::EpiY, pg8::PairOrder, true, true>((PG8_LAS unsigned char*)lds_raw, g, S, E);
            } else if (sub == 4 && (PHM & 128)) {
                pg8::Gemm g{(const pg8::bf16_t*)(ws + WS_Y), nullptr, (const pg8::bf16_t*)(ws + WS_WOUT), nullptr, GM, DM, DM};
                pg8::StaticOrder S; S.init(GM, DM, G, cid);
                pg8::EpiOut E{(const pg8::bf16_t*)(P.out + r0g * DM), (const float*)(ws + WS_CTL + 512 * 1024) + r0g, P.norm_mix, (pg8::bf16_t*)(ws + WS_H1B), rowss1 + r0g};
                pg8::gemm_phase<pg8::EpiOut, pg8::StaticOrder, true, true>((PG8_LAS unsigned char*)lds_raw, g, S, E);
            } else if (sub == 5 && (PHM & 256)) {
                pg8::Gemm g{(const pg8::bf16_t*)(ws + WS_H1B), nullptr, (const pg8::bf16_t*)(ws + WS_WUP), nullptr, GM, NUP, DM};
                pg8::StaticOrder S; S.init(GM, NUP, G, cid);
                pg8::EpiUp E{(pg8::bf16_t*)(ws + WS_UP), rowss1 + r0g, NUP};
                pg8::gemm_phase<pg8::EpiUp, pg8::StaticOrder, true, true>((PG8_LAS unsigned char*)lds_raw, g, S, E);
            } else if (sub == 6) {
                if (PHM & 512) phase_convgate(P, tid, cid);
            } else if (PHM & 1024) {
                pg8::Gemm g{(const pg8::bf16_t*)(ws + WS_ACT), nullptr, (const pg8::bf16_t*)(ws + WS_WDN), nullptr, GM, DM, DFF};
                pg8::StaticOrder S; S.init(GM, DM, G, cid);
                pg8::EpiDown E{(const pg8::bf16_t*)(ws + WS_H1B), P.out + r0g * DM, rowss2 + r0g};
                pg8::gemm_phase<pg8::EpiDown, pg8::StaticOrder, true, true>((PG8_LAS unsigned char*)lds_raw, g, S, E);
            }
        }
      }
        if (ph + 1 < args.ph_hi) { if (ph == args.ph_lo) { grid.sync(); xbar = xcd_barrier_post((unsigned*)(args.ws + WS_CTL + 800 * 1024), xst); } else xcd_barrier(xbar); }
    }
}

extern "C" void kernel_launch(void* const* d_in, const int* in_sizes, int n_in, void* d_out, int out_size, void* d_ws, size_t ws_size, hipStream_t stream) {
    static int ready = 0;
    if (ready == 0) {
        if (n_in != 16 || in_sizes[0] != MTOK * DM || out_size != MTOK * DM || ws_size < WS_END) {
            fprintf(stderr, "kernel_launch: unexpected shapes (n_in %d, in0 %d, out %d, ws %zu; need ws >= %zu)\n", n_in, n_in > 0 ? in_sizes[0] : -1, out_size, ws_size, (size_t)WS_END); ready = -1; return; }
        if (hipFuncSetAttribute((const void*)mk_fwd, hipFuncAttributeMaxDynamicSharedMemorySize, LDS_BYTES) != hipSuccess) { fprintf(stderr, "kernel_launch: hipFuncSetAttribute failed\n"); ready = -1; return; }
        int per_cu = 0;
        if (hipOccupancyMaxActiveBlocksPerMultiprocessor(&per_cu, (const void*)mk_fwd, 512, LDS_BYTES) != hipSuccess || per_cu < 1) fprintf(stderr, "kernel_launch: occupancy query says %d blocks per CU\n", per_cu);
        (void)hipGetLastError();
        ready = 1;
    }
    if (ready < 0) return;
#if !MK_ONE_LAUNCH
    (void)hipMemsetAsync((char*)d_ws + WS_CTL, 0, 1 * MiB, stream);
#endif
    Args a{};
    for (int i = 0; i < 16; ++i) a.in[i] = (const float*)d_in[i];
    a.out = (float*)d_out; a.ws = (unsigned char*)d_ws;
#if MK_ONE_LAUNCH
    a.ph_lo = 0; a.ph_hi = N_PHASES;
    void* kargs[] = {&a};
    hipError_t e = hipLaunchCooperativeKernel((const void*)mk_fwd, dim3(256), dim3(512), kargs, LDS_BYTES, stream);
    if (e != hipSuccess) fprintf(stderr, "kernel_launch: cooperative launch failed: %s\n", hipGetErrorString(e));
#else
    for (int ph = 0; ph < N_PHASES; ++ph) { a.ph_lo = ph; a.ph_hi = ph + 1; hipLaunchKernelGGL(mk_fwd, dim3(256), dim3(512), LDS_BYTES, stream, a); }
#endif
}
```

```cpp
#include <hip/hip_runtime.h>
#include <hip/hip_bf16.h>
#include <hip/hip_cooperative_groups.h>
#include <cstdio>
#include <cstdint>
namespace cg = cooperative_groups;

#ifndef MK_ONE_LAUNCH
#define MK_ONE_LAUNCH 1
#endif

namespace pg8 {
#define PG8_LAS __attribute__((address_space(3)))
typedef unsigned short bf16_t;
typedef short bf16x8 __attribute__((ext_vector_type(8)));
typedef float f32x4 __attribute__((ext_vector_type(4)));
typedef unsigned u32x4 __attribute__((ext_vector_type(4)));
constexpr int BM = 256, BK = 64, HALF = 128, HTB = HALF * BK * 2  , STAGE_BYTES = 8 * HTB, NXCD = 8, WGM = 8;

__host__ __device__ __forceinline__ int lds_byte(int r, int c) { const int st = (r >> 4) * 2 + (c >> 5), rr = r & 15, cc = c & 31, ob = rr * 64 + cc * 2; return st * 1024 + (ob ^ (((ob >> 9) & 1) << 5)); }
__host__ __device__ __forceinline__ void stage_rc(int b, int& R, int& C) { const int st = b / 1024, sb = b % 1024, swz = sb ^ (((sb >> 9) & 1) << 5); R = (st >> 1) * 16 + swz / 64; C = (st & 1) * 32 + (swz % 64) / 2; }
__host__ __device__ __forceinline__ int perm32(int rho) { const int n = rho >> 4, i = rho & 15; return 8 * (i >> 2) + 4 * n + (i & 3); }

struct Unit { int pm, pn, sel; };
struct Gemm { const bf16_t* A0; const bf16_t* A1; const bf16_t* B0; const bf16_t* B1; int M, N, K; };

struct StaticOrder {
    int nM, nN, nwg, G, c;
    __host__ __device__ __forceinline__ void init(int M, int N, int G_, int c_) { nM = M / BM; nN = N / BM; nwg = nM * nN; G = G_; c = c_; }
    __host__ __device__ __forceinline__ bool next(int i, Unit& u) const {
        const long L = (long)i * G + c; if (L >= nwg) return false;
        int wgid = (int)L; { const int q = nwg / NXCD, r = nwg % NXCD, xcd = wgid % NXCD, off = wgid / NXCD; wgid = (xcd < r ? xcd * (q + 1) : r * (q + 1) + (xcd - r) * q) + off; }
        const int nig = WGM * nN, gid = wgid / nig, fm = gid * WGM, gsz = (nM - fm) < WGM ? (nM - fm) : WGM;
        u.pm = fm + ((wgid % nig) % gsz); u.pn = (wgid % nig) / gsz; u.sel = 0; return true;
    }
    __device__ __forceinline__ void a_ready(const Unit&) const {}
    __device__ __forceinline__ void done(const Unit&) const {}
};

__device__ __forceinline__ unsigned cvt_pk_bf16(float lo, float hi) { unsigned r; asm volatile("v_cvt_pk_bf16_f32 %0, %1, %2" : "=v"(r) : "v"(lo), "v"(hi)); return r; }
typedef unsigned u32x2 __attribute__((ext_vector_type(2)));
__device__ __forceinline__ float bflo(unsigned w) { return __uint_as_float(w << 16); }
__device__ __forceinline__ float bfhi(unsigned w) { return __uint_as_float(w & 0xffff0000u); }
__device__ __forceinline__ float sigm(float x) { return __builtin_amdgcn_rcpf(1.0f + __expf(-x)); }
constexpr int GM = 32768;
constexpr int LDP = 1024;

struct EpiIn {
    static constexpr bool PERM = true, AFTER_DRAIN = false;
    bf16_t* proj; float* small;
    __device__ __forceinline__ void operator()(const f32x4 (&acc)[2][2][4][2], const Unit& u, int wr, int wc, int fr, int fq) const {
        const int row0 = u.pm * BM + wr * 64 + fr;
        if (u.pn < 36) {
            bf16_t* base = proj + (size_t)(u.pn >> 2) * ((size_t)GM * LDP) + (u.pn & 3) * 256 + wc * 32 + 8 * fq;
#pragma unroll
            for (int ai = 0; ai < 2; ++ai)
#pragma unroll
                for (int m = 0; m < 4; ++m) { bf16_t* rowp = base + (size_t)(row0 + ai * HALF + m * 16) * LDP;
#pragma unroll
                    for (int bj = 0; bj < 2; ++bj) { const f32x4 v0 = acc[ai][bj][m][0], v1 = acc[ai][bj][m][1];
                        u32x4 w; w.x = cvt_pk_bf16(v0[0], v0[1]); w.y = cvt_pk_bf16(v0[2], v0[3]); w.z = cvt_pk_bf16(v1[0], v1[1]); w.w = cvt_pk_bf16(v1[2], v1[3]);
                        *(u32x4*)(rowp + bj * HALF) = w; } }
        } else if (wc == 0 && fq < 3) {
#pragma unroll
            for (int ai = 0; ai < 2; ++ai)
#pragma unroll
                for (int m = 0; m < 4; ++m) { float* p = small + (size_t)(row0 + ai * HALF + m * 16) * 32 + 8 * fq;
                    *(f32x4*)p = acc[ai][0][m][0]; *(f32x4*)(p + 4) = acc[ai][0][m][1]; }
        }
    }
};
struct EpiY {
    static constexpr bool PERM = true, AFTER_DRAIN = false;
    const bf16_t* gf; const bf16_t* gg; bf16_t* t1; bf16_t* y;
    __device__ __forceinline__ void operator()(const f32x4 (&acc)[2][2][4][2], const Unit& u, int wr, int wc, int fr, int fq) const {
        const int row0 = u.pm * BM + wr * 64 + fr, col0 = u.pn * BM + wc * 32 + 8 * fq;
        const bf16_t* const gf_ = gf; const bf16_t* const gg_ = gg; bf16_t* const t1_ = t1; bf16_t* const y_ = y;
        const bf16_t* gate = u.sel ? gg_ : gf_; bf16_t* dst = u.sel ? y_ : t1_;
        if (u.sel) asm volatile("s_waitcnt vmcnt(0)" ::: "memory");
#pragma unroll
        for (int ai = 0; ai < 2; ++ai) {
            u32x4 gw[4][2], tw[4][2];
#pragma unroll
            for (int m = 0; m < 4; ++m)
#pragma unroll
                for (int bj = 0; bj < 2; ++bj) { const size_t o = (size_t)(row0 + ai * HALF + m * 16) * LDP + col0 + bj * HALF;
                    gw[m][bj] = *(const u32x4*)(gate + o); tw[m][bj] = u.sel ? *(const u32x4*)(t1_ + o) : (u32x4){0u, 0u, 0u, 0u}; }
#pragma unroll
            for (int m = 0; m < 4; ++m)
#pragma unroll
                for (int bj = 0; bj < 2; ++bj) { const size_t o = (size_t)(row0 + ai * HALF + m * 16) * LDP + col0 + bj * HALF;
                    const u32x4 g = gw[m][bj], t = tw[m][bj]; const f32x4 v0 = acc[ai][bj][m][0], v1 = acc[ai][bj][m][1];
                    const float r0 = sigm(bflo(g.x)) * v0[0] + bflo(t.x), r1 = sigm(bfhi(g.x)) * v0[1] + bfhi(t.x), r2 = sigm(bflo(g.y)) * v0[2] + bflo(t.y), r3 = sigm(bfhi(g.y)) * v0[3] + bfhi(t.y);
                    const float r4 = sigm(bflo(g.z)) * v1[0] + bflo(t.z), r5 = sigm(bfhi(g.z)) * v1[1] + bfhi(t.z), r6 = sigm(bflo(g.w)) * v1[2] + bflo(t.w), r7 = sigm(bfhi(g.w)) * v1[3] + bfhi(t.w);
                    u32x4 w; w.x = cvt_pk_bf16(r0, r1); w.y = cvt_pk_bf16(r2, r3); w.z = cvt_pk_bf16(r4, r5); w.w = cvt_pk_bf16(r6, r7);
                    *(u32x4*)(dst + o) = w; }
        }
    }
};
struct EpiOut {
    static constexpr bool PERM = true, AFTER_DRAIN = false;
    const bf16_t* xn; const float* irx; const float* gmix; bf16_t* h1b; float* rowss;
    __device__ __forceinline__ void operator()(const f32x4 (&acc)[2][2][4][2], const Unit& u, int wr, int wc, int fr, int fq) const {
        const int col0 = u.pn * BM + wc * 32 + 8 * fq;
        f32x4 ig[2][2];
#pragma unroll
        for (int bj = 0; bj < 2; ++bj)
#pragma unroll
            for (int n = 0; n < 2; ++n) { const f32x4 g = *(const f32x4*)(gmix + col0 + bj * HALF + 4 * n); ig[bj][n] = (f32x4){__builtin_amdgcn_rcpf(g[0]), __builtin_amdgcn_rcpf(g[1]), __builtin_amdgcn_rcpf(g[2]), __builtin_amdgcn_rcpf(g[3])}; }
#pragma unroll
        for (int ai = 0; ai < 2; ++ai) {
            u32x4 pre[4][2]; float ir[4];
#pragma unroll
            for (int m = 0; m < 4; ++m) { const int row = u.pm * BM + ai * HALF + wr * 64 + m * 16 + fr; ir[m] = irx[row];
#pragma unroll
                for (int bj = 0; bj < 2; ++bj) pre[m][bj] = *(const u32x4*)(xn + (size_t)row * LDP + col0 + bj * HALF); }
#pragma unroll
            for (int m = 0; m < 4; ++m) { const int row = u.pm * BM + ai * HALF + wr * 64 + m * 16 + fr; const size_t ro = (size_t)row * LDP + col0; float ss = 0.f;
#pragma unroll
                for (int bj = 0; bj < 2; ++bj) { const size_t o = ro + bj * HALF; const u32x4 p = pre[m][bj];
                    const f32x4 h0 = (f32x4){bflo(p.x), bfhi(p.x), bflo(p.y), bfhi(p.y)} * ir[m] * ig[bj][0] + acc[ai][bj][m][0], h1 = (f32x4){bflo(p.z), bfhi(p.z), bflo(p.w), bfhi(p.w)} * ir[m] * ig[bj][1] + acc[ai][bj][m][1];
                    u32x4 w; w.x = cvt_pk_bf16(h0[0], h0[1]); w.y = cvt_pk_bf16(h0[2], h0[3]); w.z = cvt_pk_bf16(h1[0], h1[1]); w.w = cvt_pk_bf16(h1[2], h1[3]); *(u32x4*)(h1b + o) = w;
                    ss += (h0[0] * h0[0] + h0[1] * h0[1]) + (h0[2] * h0[2] + h0[3] * h0[3]) + (h1[0] * h1[0] + h1[1] * h1[1]) + (h1[2] * h1[2] + h1[3] * h1[3]); }
                ss += __shfl_xor(ss, 16); ss += __shfl_xor(ss, 32);
                if (fq == 0) atomicAdd(rowss + row, ss); }
        }
    }
};
struct EpiUp {
    static constexpr bool PERM = true, AFTER_DRAIN = false;
    bf16_t* up; const float* rowss; int ldc;
    __device__ __forceinline__ void operator()(const f32x4 (&acc)[2][2][4][2], const Unit& u, int wr, int wc, int fr, int fq) const {
        const int row0 = u.pm * BM + wr * 64 + fr, col0 = u.pn * BM + wc * 32 + 8 * fq;
        float rsv[2][4];
#pragma unroll
        for (int ai = 0; ai < 2; ++ai)
#pragma unroll
            for (int m = 0; m < 4; ++m) rsv[ai][m] = rowss[row0 + ai * HALF + m * 16];
#pragma unroll
        for (int ai = 0; ai < 2; ++ai)
#pragma unroll
            for (int m = 0; m < 4; ++m) { const int row = row0 + ai * HALF + m * 16; const float rs = rsqrtf(rsv[ai][m] * (1.0f / 1024.0f) + 1e-6f); bf16_t* rowp = up + (size_t)row * ldc + col0;
#pragma unroll
                for (int bj = 0; bj < 2; ++bj) { const f32x4 v0 = acc[ai][bj][m][0] * rs, v1 = acc[ai][bj][m][1] * rs;
                    u32x4 w; w.x = cvt_pk_bf16(v0[0], v0[1]); w.y = cvt_pk_bf16(v0[2], v0[3]); w.z = cvt_pk_bf16(v1[0], v1[1]); w.w = cvt_pk_bf16(v1[2], v1[3]);
                    *(u32x4*)(rowp + bj * HALF) = w; } }
    }
};
struct EpiDown {
    static constexpr bool PERM = true, AFTER_DRAIN = false;
    const bf16_t* h1b; float* hout; float* rowss;
    __device__ __forceinline__ void operator()(const f32x4 (&acc)[2][2][4][2], const Unit& u, int wr, int wc, int fr, int fq) const {
        const int col0 = u.pn * BM + wc * 32 + 8 * fq;
#pragma unroll
        for (int ai = 0; ai < 2; ++ai) {
            u32x4 pre[4][2];
#pragma unroll
            for (int m = 0; m < 4; ++m)
#pragma unroll
                for (int bj = 0; bj < 2; ++bj) pre[m][bj] = *(const u32x4*)(h1b + (size_t)(u.pm * BM + ai * HALF + wr * 64 + m * 16 + fr) * LDP + col0 + bj * HALF);
#pragma unroll
            for (int m = 0; m < 4; ++m) { const int row = u.pm * BM + ai * HALF + wr * 64 + m * 16 + fr; const size_t ro = (size_t)row * LDP + col0; float ss = 0.f;
#pragma unroll
                for (int bj = 0; bj < 2; ++bj) { const size_t o = ro + bj * HALF; const u32x4 p = pre[m][bj];
                    const f32x4 h0 = (f32x4){bflo(p.x), bfhi(p.x), bflo(p.y), bfhi(p.y)} + acc[ai][bj][m][0], h1 = (f32x4){bflo(p.z), bfhi(p.z), bflo(p.w), bfhi(p.w)} + acc[ai][bj][m][1];
                    *(f32x4*)(hout + o) = h0; *(f32x4*)(hout + o + 4) = h1;
                    ss += (h0[0] * h0[0] + h0[1] * h0[1]) + (h0[2] * h0[2] + h0[3] * h0[3]) + (h1[0] * h1[0] + h1[1] * h1[1]) + (h1[2] * h1[2] + h1[3] * h1[3]); }
                ss += __shfl_xor(ss, 16); ss += __shfl_xor(ss, 32);
                if (fq == 0) atomicAdd(rowss + row, ss); }
        }
    }
};
struct PairOrder {
    int nM, nN, nwg, G, c;
    __host__ __device__ __forceinline__ void init(int M, int N, int G_, int c_) { nM = M / BM; nN = N / BM; nwg = nM * nN; G = G_; c = c_; }
    __host__ __device__ __forceinline__ bool next(int i, Unit& u) const {
        const long L = (long)(i >> 1) * G + c; if (L >= nwg) return false;
        int wgid = (int)L; { const int q = nwg / NXCD, r = nwg % NXCD, xcd = wgid % NXCD, off = wgid / NXCD; wgid = (xcd < r ? xcd * (q + 1) : r * (q + 1) + (xcd - r) * q) + off; }
        const int nig = WGM * nN, gid = wgid / nig, fm = gid * WGM, gsz = (nM - fm) < WGM ? (nM - fm) : WGM;
        u.pm = fm + ((wgid % nig) % gsz); u.pn = (wgid % nig) / gsz; u.sel = i & 1; return true;
    }
    __device__ __forceinline__ void a_ready(const Unit&) const {}
    __device__ __forceinline__ void done(const Unit&) const {}
};
template <class Epi, class Sched, bool ALIGN_EPI = false, bool SP2 = false>
__device__ __forceinline__ void gemm_phase(PG8_LAS unsigned char* lds, const Gemm g, const Sched& S, const Epi& E) {
    int tid_l = threadIdx.x; asm volatile("" : "+v"(tid_l));
    const int tid = tid_l, wid = __builtin_amdgcn_readfirstlane(tid >> 6), lane = tid & 63, wr = wid >> 2, wc = wid & 3, fr = lane & 15, fq = lane >> 4;
    const int K = g.K, nt = K / BK;
    unsigned voffA[2], voffB[2];
#pragma unroll
    for (int i = 0; i < 2; ++i) { int R, C; stage_rc(tid * 16 + i * 8192, R, C); const int Rb = Epi::PERM ? ((R & ~31) + perm32(R & 31)) : R;
        voffA[i] = (unsigned)(R * K + C) * 2u; voffB[i] = (unsigned)(Rb * K + C) * 2u; }
    const size_t kstep = (size_t)(BK * 2);
    const size_t hstep = (size_t)HALF * K * 2;
    const size_t tstep = 2 * hstep;
    const unsigned ldsw = (unsigned)wid * 1024u;
    const int aoff = lds_byte(wr * 64 + fr, fq * 8), boff = lds_byte(wc * 32 + fr, fq * 8);
#define PG8_SA(b, h) (((b) * 2 + (h)) * HTB)
#define PG8_SB(b, h) ((4 + (b) * 2 + (h)) * HTB)
#define PG8_STAGE(bufoff, gbase, voff) do { _Pragma("unroll") for (int _i = 0; _i < 2; ++_i) \
        __builtin_amdgcn_global_load_lds((const unsigned*)((const char*)(gbase) + (voff)[_i]), (PG8_LAS unsigned*)(lds + (bufoff) + ldsw + _i * 8192), 16, 0, 0); } while (0)
#define PG8_LDA(dst, b, h) do { _Pragma("unroll") for (int m = 0; m < 4; ++m) _Pragma("unroll") for (int k = 0; k < 2; ++k) dst[m][k] = *(const PG8_LAS bf16x8*)(lds + PG8_SA(b, h) + aoff + m * 2048 + k * 1024); } while (0)
#define PG8_LDB(dst, b, h) do { _Pragma("unroll") for (int n = 0; n < 2; ++n) _Pragma("unroll") for (int k = 0; k < 2; ++k) dst[n][k] = *(const PG8_LAS bf16x8*)(lds + PG8_SB(b, h) + boff + n * 2048 + k * 1024); } while (0)
#define PG8_MMA(ai, bj, At, Bt) do { __builtin_amdgcn_s_setprio(1); _Pragma("unroll") for (int m = 0; m < 4; ++m) _Pragma("unroll") for (int n = 0; n < 2; ++n) _Pragma("unroll") for (int k = 0; k < 2; ++k) \
        acc[ai][bj][m][n] = __builtin_amdgcn_mfma_f32_16x16x32_bf16(Bt[n][k], At[m][k], acc[ai][bj][m][n], 0, 0, 0); __builtin_amdgcn_s_setprio(0); } while (0)
#define PG8_WAIT_V(n) asm volatile("s_waitcnt vmcnt(" #n ")" ::: "memory")
#define PG8_WAIT_L(n) asm volatile("s_waitcnt lgkmcnt(" #n ")" ::: "memory")
#define PG8_BAR __builtin_amdgcn_s_barrier()
#define PG8_SCHED __builtin_amdgcn_sched_barrier(0)
    Unit cur, nxt; int ui = 0;
    if (!S.next(0, cur)) return;
    f32x4 acc[2][2][4][2];
#pragma unroll
    for (int a = 0; a < 2; ++a)
#pragma unroll
        for (int b = 0; b < 2; ++b)
#pragma unroll
            for (int m = 0; m < 4; ++m)
#pragma unroll
                for (int n = 0; n < 2; ++n) acc[a][b][m][n] = (f32x4){0.f, 0.f, 0.f, 0.f};
    bf16x8 At[4][2], B0[2][2], B1[2][2];
    const char* cA = (const char*)(cur.sel ? g.A1 : g.A0) + (size_t)cur.pm * tstep; const char* cB = (const char*)(cur.sel ? g.B1 : g.B0) + (size_t)cur.pn * tstep;
    S.a_ready(cur);
    if constexpr (SP2) {
        PG8_STAGE(PG8_SB(0, 0), cB, voffB); PG8_STAGE(PG8_SB(0, 1), cB + hstep, voffB); PG8_STAGE(PG8_SA(0, 0), cA, voffA); PG8_STAGE(PG8_SA(0, 1), cA + hstep, voffA);
        if (wr == 1) PG8_BAR;
        PG8_WAIT_V(2); PG8_BAR;
        PG8_STAGE(PG8_SB(1, 0), cB + kstep, voffB); PG8_STAGE(PG8_SA(1, 0), cA + kstep, voffA); PG8_STAGE(PG8_SB(1, 1), cB + hstep + kstep, voffB);
        PG8_WAIT_V(6); PG8_BAR;
    } else {
        PG8_STAGE(PG8_SB(0, 0), cB, voffB); PG8_STAGE(PG8_SA(0, 0), cA, voffA); PG8_STAGE(PG8_SB(0, 1), cB + hstep, voffB); PG8_STAGE(PG8_SA(0, 1), cA + hstep, voffA);
        if (wr == 1) PG8_BAR;
        PG8_WAIT_V(4); PG8_BAR;
        PG8_STAGE(PG8_SB(1, 0), cB + kstep, voffB); PG8_STAGE(PG8_SA(1, 0), cA + kstep, voffA); PG8_STAGE(PG8_SB(1, 1), cB + hstep + kstep, voffB);
        PG8_WAIT_V(6); PG8_BAR;
    }
    for (;;) {
        const bool has_next = S.next(ui + 1, nxt);
        const char* nA = has_next ? (const char*)(nxt.sel ? g.A1 : g.A0) + (size_t)nxt.pm * tstep : cA; const char* nB = has_next ? (const char*)(nxt.sel ? g.B1 : g.B0) + (size_t)nxt.pn * tstep : cB;
        for (int t = 0; t < nt; t += 2) {
            const bool last = (t == nt - 2);
            const char* a1 = cA + (size_t)(t + 1) * kstep;
            const char* a2 = last ? nA : cA + (size_t)(t + 2) * kstep; const char* b2 = last ? nB : cB + (size_t)(t + 2) * kstep;
            const char* a3 = a2 + kstep; const char* b3 = b2 + kstep;
            if (last && has_next) S.a_ready(nxt);
            if constexpr (SP2) {
            PG8_LDB(B0, 0, 0); PG8_LDB(B1, 0, 1); PG8_SCHED; PG8_LDA(At, 0, 0); PG8_STAGE(PG8_SA(1, 1), a1 + hstep, voffA);
            PG8_WAIT_V(8); PG8_WAIT_L(0); PG8_BAR; PG8_MMA(0, 0, At, B0); PG8_MMA(0, 1, At, B1); PG8_BAR; PG8_SCHED;
            PG8_LDA(At, 0, 1); PG8_STAGE(PG8_SB(0, 0), b2, voffB); PG8_STAGE(PG8_SB(0, 1), b2 + hstep, voffB); PG8_STAGE(PG8_SA(0, 0), a2, voffA);
            PG8_WAIT_V(8); PG8_WAIT_L(0); PG8_BAR; PG8_MMA(1, 0, At, B0); PG8_MMA(1, 1, At, B1); PG8_BAR; PG8_SCHED;
            PG8_LDB(B0, 1, 0); PG8_LDB(B1, 1, 1); PG8_SCHED; PG8_LDA(At, 1, 0); PG8_STAGE(PG8_SA(0, 1), a2 + hstep, voffA);
            PG8_WAIT_V(8); PG8_WAIT_L(0); PG8_BAR; PG8_MMA(0, 0, At, B0); PG8_MMA(0, 1, At, B1); PG8_BAR; PG8_SCHED;
            PG8_LDA(At, 1, 1); PG8_STAGE(PG8_SB(1, 0), b3, voffB); PG8_STAGE(PG8_SB(1, 1), b3 + hstep, voffB); PG8_STAGE(PG8_SA(1, 0), a3, voffA);
            PG8_WAIT_V(8); PG8_WAIT_L(0); PG8_BAR; PG8_MMA(1, 0, At, B0); PG8_MMA(1, 1, At, B1); PG8_BAR; PG8_SCHED;
            } else {
            PG8_LDB(B0, 0, 0); PG8_SCHED; PG8_LDA(At, 0, 0); PG8_STAGE(PG8_SA(1, 1), a1 + hstep, voffA);
            PG8_WAIT_L(8); PG8_BAR; PG8_WAIT_L(0); PG8_MMA(0, 0, At, B0); PG8_BAR; PG8_SCHED;
            PG8_LDB(B1, 0, 1); PG8_STAGE(PG8_SB(0, 0), b2, voffB);
            PG8_BAR; PG8_WAIT_L(0); PG8_MMA(0, 1, At, B1); PG8_BAR;
            PG8_LDA(At, 0, 1); PG8_STAGE(PG8_SA(0, 0), a2, voffA);
            PG8_BAR; PG8_WAIT_L(0); PG8_MMA(1, 0, At, B0); PG8_BAR; PG8_SCHED;
            PG8_STAGE(PG8_SB(0, 1), b2 + hstep, voffB);
            PG8_WAIT_V(6); PG8_BAR; PG8_MMA(1, 1, At, B1); PG8_BAR;
            PG8_LDB(B0, 1, 0); PG8_SCHED; PG8_LDA(At, 1, 0); PG8_STAGE(PG8_SA(0, 1), a2 + hstep, voffA);
            PG8_WAIT_L(8); PG8_BAR; PG8_WAIT_L(0); PG8_MMA(0, 0, At, B0); PG8_BAR; PG8_SCHED;
            PG8_LDB(B1, 1, 1); PG8_STAGE(PG8_SB(1, 0), b3, voffB);
            PG8_BAR; PG8_WAIT_L(0); PG8_MMA(0, 1, At, B1); PG8_BAR;
            PG8_LDA(At, 1, 1); PG8_STAGE(PG8_SA(1, 0), a3, voffA);
            PG8_BAR; PG8_WAIT_L(0); PG8_MMA(1, 0, At, B0); PG8_BAR; PG8_SCHED;
            PG8_STAGE(PG8_SB(1, 1), b3 + hstep, voffB);
            PG8_WAIT_V(6); PG8_BAR; PG8_MMA(1, 1, At, B1); PG8_BAR;
            }
        }
        if constexpr (ALIGN_EPI) { if (wr == 0) PG8_BAR; }
        if constexpr (!Epi::AFTER_DRAIN) { E(acc, cur, wr, wc, fr, fq); S.done(cur); }
        if (!has_next) break;
#pragma unroll
        for (int a = 0; a < 2; ++a)
#pragma unroll
            for (int b = 0; b < 2; ++b)
#pragma unroll
                for (int m = 0; m < 4; ++m)
#pragma unroll
                    for (int n = 0; n < 2; ++n) acc[a][b][m][n] = (f32x4){0.f, 0.f, 0.f, 0.f};
        cur = nxt; cA = nA; cB = nB; ++ui;
        if constexpr (ALIGN_EPI) { if (wr == 1) PG8_BAR; }
    }
    PG8_WAIT_V(0);
    if constexpr (!ALIGN_EPI) { if (wr == 0) PG8_BAR; }
    PG8_BAR;
    if constexpr (Epi::AFTER_DRAIN) { E.fused(acc, cur, wr, wc, fr, fq, lds, wid, lane); S.done(cur); }
#undef PG8_SA
#undef PG8_SB
#undef PG8_STAGE
#undef PG8_LDA
#undef PG8_LDB
#undef PG8_MMA
#undef PG8_WAIT_V
#undef PG8_WAIT_L
#undef PG8_BAR
#undef PG8_SCHED
}
}

namespace fox {
constexpr int D = 128, PITCH = 1024;
constexpr bool WSKIP = false;
constexpr float THR = 8.f;
constexpr float SCALE = 0.08838834764831845f;
constexpr int NW = 8, QBLK = 32, KVBLK = 64, QB = NW * QBLK;
constexpr int SHM_V = KVBLK * D * 2, SHM_K = KVBLK * D * 2;
constexpr int LDS_BYTES = 2 * SHM_V + 2 * SHM_K + NW * 64 * 4;
using bf16 = __hip_bfloat16;
typedef short bf16x8 __attribute__((ext_vector_type(8)));
typedef short s16x4 __attribute__((ext_vector_type(4)));
typedef float f32x16 __attribute__((ext_vector_type(16)));
typedef float f32x4 __attribute__((ext_vector_type(4)));
typedef unsigned u32x4 __attribute__((ext_vector_type(4)));
template <class A, class Bt> struct same_t { static constexpr bool v = false; };
template <class A> struct same_t<A, A> { static constexpr bool v = true; };
__device__ __forceinline__ void bias_tile(f32x16& p0, f32x16& p1, const float* cbp) {
#pragma unroll
    for (int rr = 0; rr < 4; ++rr) { const f32x4 a = *(const f32x4*)(cbp + 8 * rr), b = *(const f32x4*)(cbp + 32 + 8 * rr);
#pragma unroll
        for (int e = 0; e < 4; ++e) { p0[4 * rr + e] += a[e]; p1[4 * rr + e] += b[e]; } }
}
#define KSWZ(row, colB) ((row) * 256 + ((colB) ^ (((row) & 7) << 4)))
#define SBAR() __builtin_amdgcn_sched_barrier(0)
__device__ __forceinline__ int v_st(int k, int c) { const int kk = (k & ~0xC) | ((k & 4) << 1) | ((k & 8) >> 1); return ((kk >> 3) * 4 + (c >> 5)) * 512 + ((kk & 7) * 32 + (c & 31)) * 2; }
__device__ __forceinline__ int v_rd_base(int lane) { return ((lane & 3) << 3) | (((lane >> 2) & 3) << 6) | (((lane >> 4) & 1) << 5) | (((lane >> 5) & 1) << 8); }
constexpr int v_rd_off(int d0, int ks, int half) { return d0 * 512 + ks * 4096 + half * 2048; }
__device__ __forceinline__ int crow(int r, int hi) { return (r & 3) + 8 * (r >> 2) + 4 * hi; }
__device__ __forceinline__ unsigned cvtpk(float lo, float hi) {
    unsigned r; asm volatile("v_cvt_pk_bf16_f32 %0, %1, %2" : "=v"(r) : "v"(lo), "v"(hi)); return r;
}
__device__ __forceinline__ bf16x8 pack8(f32x4 a, f32x4 b) {
    u32x4 w = {cvtpk(a[0], a[1]), cvtpk(a[2], a[3]), cvtpk(b[0], b[1]), cvtpk(b[2], b[3])};
    return *reinterpret_cast<bf16x8*>(&w);
}
template <class T> __device__ __forceinline__ bf16x8 load8(const T* p) {
    if constexpr (same_t<T, float>::v) { return pack8(*(const f32x4*)p, *(const f32x4*)(p + 4)); }
    else { return *reinterpret_cast<const bf16x8*>(p); }
}
__device__ __forceinline__ void mask_tile(f32x16& p0, f32x16& p1, int dq, unsigned W) {
    const float NEG = -__builtin_inff();
#pragma unroll
    for (int r = 0; r < 16; ++r) {
        const int c = (r & 3) + 8 * (r >> 2);
        if ((unsigned)(dq - c) >= W) p0[r] = NEG;
        if ((unsigned)(dq - c - 32) >= W) p1[r] = NEG;
    }
}
__device__ __forceinline__ void partialSM(f32x16& p0, f32x16& p1, float& m_reg, float& mn, float& alpha) {
    float pmax = p0[0]; for (int r = 1; r < 16; ++r) pmax = fmaxf(pmax, p0[r]); for (int r = 0; r < 16; ++r) pmax = fmaxf(pmax, p1[r]);
    { auto rr = __builtin_amdgcn_permlane32_swap(__float_as_uint(pmax), __float_as_uint(pmax), false, false);
      pmax = fmaxf(__uint_as_float(rr[0]), __uint_as_float(rr[1])); }
    constexpr float C2 = 1.4426950408889634f * SCALE;
    if (__builtin_expect(__all((pmax - m_reg) * SCALE <= THR), 1)) { mn = m_reg; alpha = 1.f; }
    else { mn = fmaxf(m_reg, pmax); alpha = __builtin_amdgcn_exp2f((m_reg - mn) * C2); m_reg = mn; }
    const float mnL = -mn * C2;
    for (int r = 0; r < 16; ++r) p0[r] = fmaf(p0[r], C2, mnL); for (int r = 0; r < 16; ++r) p1[r] = fmaf(p1[r], C2, mnL);
    for (int r = 0; r < 16; ++r) p0[r] = __builtin_amdgcn_exp2f(p0[r]);
}
__device__ __forceinline__ void finishSM(f32x16& p0, f32x16& p1, float alpha, float& l_reg, bf16x8& pa0, bf16x8& pa1, bf16x8& pa2, bf16x8& pa3) {
    for (int r = 0; r < 16; ++r) p1[r] = __builtin_amdgcn_exp2f(p1[r]);
    float ps = 0; for (int r = 0; r < 16; ++r) ps += p0[r]; for (int r = 0; r < 16; ++r) ps += p1[r];
    { auto rr = __builtin_amdgcn_permlane32_swap(__float_as_uint(ps), __float_as_uint(ps), false, false);
      ps = __uint_as_float(rr[0]) + __uint_as_float(rr[1]); }
    l_reg = l_reg * alpha + ps;
#define PK4(P, B_, OUT) do { unsigned a0 = cvtpk(P[B_+0], P[B_+1]), a1 = cvtpk(P[B_+2], P[B_+3]);                          \
        unsigned b0 = cvtpk(P[B_+4], P[B_+5]), b1 = cvtpk(P[B_+6], P[B_+7]);                                             \
        auto r0 = __builtin_amdgcn_permlane32_swap(a0, b0, false, false); auto r1 = __builtin_amdgcn_permlane32_swap(a1, b1, false, false); \
        u32x4 w = {r0[0], r1[0], r0[1], r1[1]}; OUT = *reinterpret_cast<bf16x8*>(&w); } while (0)
    PK4(p0, 0, pa0); PK4(p0, 8, pa1); PK4(p1, 0, pa2); PK4(p1, 8, pa3);
#undef PK4
}
template <int KB, bool SK>
__device__ __forceinline__ void qkt(f32x16& p0, f32x16& p1, const char* K_lds, int r32, int hi, const bf16x8* qr, bool act, const float* cbp) {
    if (SK && !act) { const float NEG = -__builtin_inff();
#pragma unroll
        for (int r = 0; r < 16; ++r) { p0[r] = NEG; p1[r] = NEG; } return; }
    { const f32x4* c4 = (const f32x4*)cbp; const f32x4 a0 = c4[0], a1 = c4[2], a2 = c4[4], a3 = c4[6], b0 = c4[8], b1 = c4[10], b2 = c4[12], b3 = c4[14];
      p0 = (f32x16){a0[0], a0[1], a0[2], a0[3], a1[0], a1[1], a1[2], a1[3], a2[0], a2[1], a2[2], a2[3], a3[0], a3[1], a3[2], a3[3]};
      p1 = (f32x16){b0[0], b0[1], b0[2], b0[3], b1[0], b1[1], b1[2], b1[3], b2[0], b2[1], b2[2], b2[3], b3[0], b3[1], b3[2], b3[3]}; }
    const char* kb[4];
#pragma unroll
    for (int dd = 0; dd < 4; ++dd) kb[dd] = K_lds + KB * SHM_K + KSWZ(r32, (dd * 16 + hi * 8) * 2);
#pragma unroll
    for (int d0 = 0; d0 < 8; ++d0) { const char* a = kb[d0 & 3] + (d0 >> 2) * 128;
        bf16x8 b0 = *reinterpret_cast<const bf16x8*>(a);
        bf16x8 b1 = *reinterpret_cast<const bf16x8*>(a + 32 * 256);
        p0 = __builtin_amdgcn_mfma_f32_32x32x16_bf16(b0, qr[d0], p0, 0, 0, 0);
        p1 = __builtin_amdgcn_mfma_f32_32x32x16_bf16(b1, qr[d0], p1, 0, 0, 0); }
}
template <int VB, bool SK>
__device__ __forceinline__ void pv_tile(f32x16* o, int vb0, bf16x8 pa0, bf16x8 pa1, bf16x8 pa2, bf16x8 pa3, bool act) {
    if (SK && !act) return;
#define TRRD(dst, off) asm volatile("ds_read_b64_tr_b16 %0, %1 offset:%2" : "=&v"(dst) : "v"(vb0), "i"(off) : "memory")
#define PV_D0(d0) do { s16x4 l0, l1, l2, l3, h0, h1, h2, h3; constexpr int b_ = VB * SHM_V + v_rd_off(d0, 0, 0);     \
        TRRD(l0, b_); TRRD(h0, b_ + 2048); TRRD(l1, b_ + 4096); TRRD(h1, b_ + 6144); TRRD(l2, b_ + 8192); TRRD(h2, b_ + 10240); TRRD(l3, b_ + 12288); TRRD(h3, b_ + 14336); \
        asm volatile("s_waitcnt lgkmcnt(0)" ::: "memory"); SBAR();                 \
        o[d0] = __builtin_amdgcn_mfma_f32_32x32x16_bf16(pa0, (bf16x8){l0[0], l0[1], l0[2], l0[3], h0[0], h0[1], h0[2], h0[3]}, o[d0], 0, 0, 0);   \
        o[d0] = __builtin_amdgcn_mfma_f32_32x32x16_bf16(pa1, (bf16x8){l1[0], l1[1], l1[2], l1[3], h1[0], h1[1], h1[2], h1[3]}, o[d0], 0, 0, 0);   \
        o[d0] = __builtin_amdgcn_mfma_f32_32x32x16_bf16(pa2, (bf16x8){l2[0], l2[1], l2[2], l2[3], h2[0], h2[1], h2[2], h2[3]}, o[d0], 0, 0, 0);   \
        o[d0] = __builtin_amdgcn_mfma_f32_32x32x16_bf16(pa3, (bf16x8){l3[0], l3[1], l3[2], l3[3], h3[0], h3[1], h3[2], h3[3]}, o[d0], 0, 0, 0); } while (0)
    PV_D0(0); PV_D0(1); PV_D0(2); PV_D0(3);
#undef PV_D0
#undef TRRD
}

template <class TIn, class TOut> struct BlockRef { const TIn* Q; const TIn* K; const TIn* V; TOut* O; int P0; };
template <class TIn> struct Seam {
    bf16x8 qr[8];
    bf16x8 st_v0, st_v1, st_k0, st_k1; f32x4 sf0, sf1, sf2, sf3;
    f32x4 tq[16];
};
__device__ __forceinline__ int swa_jlo(int P0, int W) { const int lowk = P0 - W + 1; return lowk > 0 ? lowk / KVBLK : 0; }
#define ROW(p, k0, rr) ((p) + (size_t)((k0) + (rr)) * PITCH + sc)
#define VMW() asm volatile("s_waitcnt vmcnt(0)" ::: "memory")
#define VMWN(n) asm volatile("s_waitcnt vmcnt(%0)" :: "i"(n) : "memory")
#define SLOAD_H(Kp, Vp, k0) do { S.st_v0 = load8<TIn>(ROW(Vp, k0, sr)); S.st_v1 = load8<TIn>(ROW(Vp, k0, 32 + sr));              \
                         S.st_k0 = load8<TIn>(ROW(Kp, k0, sr)); S.st_k1 = load8<TIn>(ROW(Kp, k0, 32 + sr)); } while (0)
#define SWRITE_HK(bf) do { *(bf16x8*)(K_lds + (bf) * SHM_K + kws) = S.st_k0; *(bf16x8*)(K_lds + (bf) * SHM_K + kws + 32 * 256) = S.st_k1; } while (0)
#define SWRITE_HV(bf) do { *(bf16x8*)(V_lds + (bf) * SHM_V + vst0) = S.st_v0; *(bf16x8*)(V_lds + (bf) * SHM_V + vst1) = S.st_v1; } while (0)
#define SWRITE_H(bf) do { SWRITE_HV(bf); SWRITE_HK(bf); } while (0)
#define SLOAD_F(p, k0) do { S.sf0 = *(const f32x4*)ROW(p, k0, sr); S.sf1 = *(const f32x4*)(ROW(p, k0, sr) + 4);                \
                            S.sf2 = *(const f32x4*)ROW(p, k0, 32 + sr); S.sf3 = *(const f32x4*)(ROW(p, k0, 32 + sr) + 4); } while (0)
#define SWRITE_KF(bf) do { *(bf16x8*)(K_lds + (bf) * SHM_K + kws) = pack8(S.sf0, S.sf1); *(bf16x8*)(K_lds + (bf) * SHM_K + kws + 32 * 256) = pack8(S.sf2, S.sf3); } while (0)
#define SWRITE_VF(bf) do { *(bf16x8*)(V_lds + (bf) * SHM_V + vst0) = pack8(S.sf0, S.sf1); *(bf16x8*)(V_lds + (bf) * SHM_V + vst1) = pack8(S.sf2, S.sf3); } while (0)
template <class TIn, class TOut>
__device__ __forceinline__ void causal_swa_prime(const BlockRef<TIn, TOut>& cur, int W, char* lds, Seam<TIn>& S) {
    constexpr bool F32 = same_t<TIn, float>::v;
    int tid_l = threadIdx.x; asm volatile("" : "+v"(tid_l));
    const int tid = tid_l, wid = __builtin_amdgcn_readfirstlane(tid >> 6), lane = tid & 63, r32 = lane & 31, hi = lane >> 5;
    const int sr = tid >> 4, sc = (tid & 15) * 8, kws = KSWZ(sr, sc * 2); char* K_lds = lds + 2 * SHM_V;
    const int kb0 = swa_jlo(cur.P0, W) * KVBLK;
    for (int d0 = 0; d0 < 8; ++d0) S.qr[d0] = load8<TIn>(cur.Q + (size_t)(wid * QBLK + r32) * PITCH + d0 * 16 + hi * 8);
    if constexpr (F32) { SLOAD_F((const float*)cur.K, kb0); VMW(); SWRITE_KF(0); SBAR(); SLOAD_F((const float*)cur.V, kb0); }
    else { SLOAD_H(cur.K, cur.V, kb0); VMW(); SWRITE_HK(0); }
    __syncthreads();
}
template <class TIn, class TOut>
__device__ __forceinline__ void causal_swa_block(const BlockRef<TIn, TOut>& cur, const BlockRef<TIn, TOut>& nxt, int skv, int W, char* lds, Seam<TIn>& S, const float* cbias) {
    constexpr bool F32 = same_t<TIn, float>::v;
    int tid_l = threadIdx.x; asm volatile("" : "+v"(tid_l));
    const int tid = tid_l, wid = __builtin_amdgcn_readfirstlane(tid >> 6), lane = tid & 63, r32 = lane & 31, hi = lane >> 5;
    const int j_lo = swa_jlo(cur.P0, W);
    int j_hi = (cur.P0 + QB - 1) / KVBLK + 1; if (j_hi > skv / KVBLK) j_hi = skv / KVBLK;
    const int NT = j_hi - j_lo;
    const int kbn = swa_jlo(nxt.P0, W) * KVBLK;
    const int qlo = cur.P0 + wid * QBLK, qm = qlo + r32 - 4 * hi;
    char* V_lds = lds; char* K_lds = lds + 2 * SHM_V;
    float* ws = (float*)(lds + 2 * SHM_V + 2 * SHM_K) + wid * 64; float* li_l = ws, * al_l = ws + 32;
    float m_reg = -1e30f, l_reg = 0; f32x16 o[4] = {};
    const int sr = tid >> 4, sc = (tid & 15) * 8, vst0 = v_st(sr, sc), vst1 = v_st(32 + sr, sc), kws = KSWZ(sr, sc * 2);
    const int vb0 = (int)(uintptr_t)V_lds + v_rd_base(lane);
    const TIn* Kh = cur.K; const TIn* Vh = cur.V;
#define RESC(a) do { if (__any((a) < 1.f)) { if (hi == 0) al_l[r32] = (a); asm volatile("s_waitcnt lgkmcnt(0)" ::: "memory");              \
                     for (int d_ = 0; d_ < 4; ++d_) for (int r = 0; r < 16; ++r) o[d_][r] *= al_l[crow(r, hi)]; } } while (0)
#define KBASE(t) ((j_lo + (t)) * KVBLK)
#define ACT(t) (KBASE(t) <= qlo + QBLK - 1 && KBASE(t) + KVBLK - 1 >= qlo - W + 1)
#define MASKT(P0_, P1_, t) do { const int kb_ = KBASE(t); if ((!SK || ACT(t)) && (kb_ + KVBLK - 1 > qlo || kb_ <= qlo + QBLK - 1 - W)) mask_tile(P0_, P1_, qm - kb_, (unsigned)W); } while (0)
    constexpr int NQL = F32 ? 16 : 8;
    constexpr bool SK = WSKIP && !F32;
#define SEAM_K0() do { VMWN(NQL); if constexpr (F32) { SWRITE_KF(0); SBAR(); SLOAD_F((const float*)nxt.V, kbn); } else { SWRITE_HK(0); } SBAR(); } while (0)
    f32x16 pA0, pA1, pB0, pB1; float mnA, mnB, alA, alB; bf16x8 pa0, pa1, pa2, pa3;
    if constexpr (F32) { VMW(); SWRITE_VF(0); SBAR(); } else { SWRITE_HV(0); SBAR(); }
    if (NT > 1) { if constexpr (F32) SLOAD_F((const float*)Kh, KBASE(1)); else SLOAD_H(Kh, Vh, KBASE(1)); }
    SBAR(); qkt<0, SK>(pA0, pA1, K_lds, r32, hi, S.qr, ACT(0), cbias + KBASE(0) + 4 * hi);
    if constexpr (F32) { if (NT > 1) { VMW(); SWRITE_KF(1); SBAR(); SLOAD_F((const float*)Vh, KBASE(1)); } }
    MASKT(pA0, pA1, 0); partialSM(pA0, pA1, m_reg, mnA, alA);
    if (NT > 1) { VMW(); if constexpr (F32) { SWRITE_VF(1); SBAR(); if (NT > 2) SLOAD_F((const float*)Kh, KBASE(2)); } else SWRITE_H(1); }
    __syncthreads();
#define HALF_STEP(PX0, PX1, mnX, alX, PY0, PY1, alY, t, KB, VB, SB) do {                                                      \
        SBAR(); qkt<KB, SK>(PX0, PX1, K_lds, r32, hi, S.qr, ACT(t), cbias + KBASE(t) + 4 * hi);                                             \
        finishSM(PY0, PY1, alY, l_reg, pa0, pa1, pa2, pa3); SBAR();                                                           \
        if ((t) + 1 < NT) { if constexpr (F32) { VMW(); SWRITE_KF(SB); SBAR(); SLOAD_F((const float*)Vh, KBASE((t) + 1)); }  \
                            else { SLOAD_H(Kh, Vh, KBASE((t) + 1)); } SBAR(); }                                               \
        pv_tile<VB, SK>(o, vb0, pa0, pa1, pa2, pa3, ACT((t) - 1)); MASKT(PX0, PX1, (t)); partialSM(PX0, PX1, m_reg, mnX, alX);                                        \
        __syncthreads();                                                                                                      \
        if ((t) + 1 < NT) { VMW(); if constexpr (F32) { SWRITE_VF(SB); SBAR(); if ((t) + 2 < NT) SLOAD_F((const float*)Kh, KBASE((t) + 2)); } \
                            else { SWRITE_H(SB); } }                                                                          \
        RESC(alX); __syncthreads(); } while (0)
    for (int t = 1; t + 1 < NT; t += 2) {
        HALF_STEP(pB0, pB1, mnB, alB, pA0, pA1, alA, t, 1, 0, 0);
        HALF_STEP(pA0, pA1, mnA, alA, pB0, pB1, alB, t + 1, 0, 1, 1);
    }
    const bool even = (NT & 1) == 0;
    if (even) { SBAR(); qkt<1, SK>(pB0, pB1, K_lds, r32, hi, S.qr, ACT(NT - 1), cbias + KBASE(NT - 1) + 4 * hi); SBAR(); }
#define QROW(e) (nxt.Q + (size_t)(wid * QBLK + r32) * PITCH + ((e) >> 1) * 16 + hi * 8 + ((e) & 1) * 4)
    if constexpr (F32) { SLOAD_F((const float*)nxt.K, kbn); SBAR();
#pragma unroll
        for (int e = 0; e < 8; ++e) S.tq[e] = *(const f32x4*)QROW(e); }
    else { SLOAD_H(nxt.K, nxt.V, kbn); SBAR();
#pragma unroll
        for (int d0 = 0; d0 < 8; ++d0) S.qr[d0] = load8<TIn>(nxt.Q + (size_t)(wid * QBLK + r32) * PITCH + d0 * 16 + hi * 8); }
    SBAR();
    finishSM(pA0, pA1, alA, l_reg, pa0, pa1, pa2, pa3); SBAR();
    if constexpr (F32) {
#pragma unroll
        for (int e = 8; e < 16; ++e) S.tq[e] = *(const f32x4*)QROW(e); SBAR(); }
#undef QROW
    pv_tile<0, SK>(o, vb0, pa0, pa1, pa2, pa3, ACT(even ? NT - 2 : NT - 1));
    if (even) { MASKT(pB0, pB1, NT - 1); partialSM(pB0, pB1, m_reg, mnB, alB); __syncthreads(); RESC(alB);
        finishSM(pB0, pB1, alB, l_reg, pa0, pa1, pa2, pa3); SBAR(); pv_tile<1, SK>(o, vb0, pa0, pa1, pa2, pa3, ACT(NT - 1)); }
    SBAR(); SEAM_K0();
    if (hi == 0) li_l[r32] = l_reg; asm volatile("s_waitcnt lgkmcnt(0)" ::: "memory");
    float rli[16];
#pragma unroll
    for (int r = 0; r < 16; ++r) rli[r] = __builtin_amdgcn_rcpf(li_l[crow(r, hi)]);
    TOut* Ow = cur.O + (size_t)(wid * QBLK) * PITCH;
#pragma unroll
    for (int r = 0; r < 16; ++r) { const int orow = crow(r, hi);
#pragma unroll
        for (int d0 = 0; d0 < 4; ++d0) { const float v = o[d0][r] * rli[r];
            if constexpr (same_t<TOut, float>::v) { Ow[(size_t)orow * PITCH + d0 * 32 + r32] = v; }
            else { const float vn = __shfl_xor(v, 1);
                   if ((r32 & 1) == 0) *(unsigned*)(Ow + (size_t)orow * PITCH + d0 * 32 + r32) = cvtpk(v, vn); } } }
    if constexpr (F32) {
#pragma unroll
        for (int d0 = 0; d0 < 8; ++d0) S.qr[d0] = pack8(S.tq[2 * d0], S.tq[2 * d0 + 1]); }
    __syncthreads();
#undef RESC
#undef KBASE
#undef ACT
#undef MASKT
#undef SEAM_K0
#undef HALF_STEP
}
#undef ROW
#undef VMW
#undef VMWN
#undef SLOAD_H
#undef SWRITE_HK
#undef SWRITE_HV
#undef SWRITE_H
#undef SLOAD_F
#undef SWRITE_KF
#undef SWRITE_VF
}

typedef unsigned short bf16_t;
typedef short bf16x8 __attribute__((ext_vector_type(8)));
typedef float f32x4 __attribute__((ext_vector_type(4)));
typedef unsigned u32x4 __attribute__((ext_vector_type(4)));
typedef unsigned u32x2 __attribute__((ext_vector_type(2)));
constexpr int DM = 1024, NB = 32, SEQ = 2048, NH = 8, HD = 128, DFF = 2816, NUP = 2 * DFF;
constexpr int MTOK = NB * SEQ;
constexpr int NG = 2, BG = NB / NG, GM = BG * SEQ;
constexpr int NIN = 37 * 256;
constexpr int NCH = BG * NH * 32;
static_assert(GM == pg8::GM, "group rows");
constexpr size_t MiB = 1u << 20;
constexpr size_t WS_CTL = 0;
constexpr size_t WS_WIN = 1 * MiB, WS_WBF = 20 * MiB, WS_WBG = 22 * MiB, WS_WOUT = 24 * MiB, WS_WUP = 26 * MiB, WS_WDN = 37 * MiB;
constexpr size_t WS_PROJ = 44 * MiB;
constexpr size_t WS_SMALL = 620 * MiB;
constexpr size_t WS_PREP = 624 * MiB;
constexpr size_t WS_END = 913 * MiB;
constexpr size_t PBUF = 64 * MiB;
constexpr size_t WS_H1B = WS_PROJ + 0 * PBUF;
constexpr size_t WS_T1 = WS_PROJ + 1 * PBUF;
constexpr size_t WS_Y = WS_PROJ + 2 * PBUF;
constexpr size_t WS_YGDN = WS_PROJ + 3 * PBUF;
constexpr size_t WS_YFOX = WS_PROJ + 5 * PBUF;
constexpr size_t WS_UP = WS_PROJ + 3 * PBUF;
constexpr size_t WS_ACT = WS_PREP;
constexpr size_t PROJ_STRIDE = (size_t)GM * 1024;
constexpr int LDS_BYTES = 163840;

__device__ __forceinline__ float bf2f(bf16_t b) { return __uint_as_float((unsigned)b << 16); }
__device__ __forceinline__ float bflo(unsigned w) { return __uint_as_float(w << 16); }
__device__ __forceinline__ float bfhi(unsigned w) { return __uint_as_float(w & 0xffff0000u); }
typedef float f32x2_t __attribute__((ext_vector_type(2))); typedef __bf16 bf16x2_t __attribute__((ext_vector_type(2)));
__device__ __forceinline__ unsigned pk2(float lo, float hi) { f32x2_t v = {lo, hi}; bf16x2_t b = __builtin_convertvector(v, bf16x2_t); return __builtin_bit_cast(unsigned, b); }
__device__ __forceinline__ bf16_t f2bf(float f) { return (bf16_t)(pk2(f, 0.f) & 0xffffu); }
__device__ __forceinline__ float siluf(float y) { return y * __builtin_amdgcn_rcpf(1.0f + __expf(-y)); }
__device__ __forceinline__ float wave_sum(float v) {
#pragma unroll
    for (int o = 1; o < 64; o <<= 1) v += __shfl_xor(v, o);
    return v;
}

struct Args { const float* in[16]; float* out; unsigned char* ws; int ph_lo, ph_hi; };
struct Ptrs {
    const float *x, *norm_mix, *w_in, *fox_f_bias, *gdn_conv_w, *gdn_a_log, *gdn_dt_bias, *gdn_norm, *w_bf, *w_bg, *w_out, *norm_ffn, *w_up, *ffn_conv_w, *w_down, *norm_final;
    float* out; unsigned char* ws;
};

template <int MODE> __device__ __forceinline__ int srccol(int n) {
    if (MODE == 0) return n;
    if (MODE == 1) {
        if (n < 3072) return n;
        if (n < 6144) return 3080 + (n - 3072);
        if (n < 9216) return 6168 + (n - 6144);
        const int s = n - 9216;
        if (s < 8) return 3072 + s;
        if (s < 16) return 6152 + (s - 8);
        if (s < 24) return 6160 + (s - 16);
        return -1;
    }
    { const int p = n >> 8, s = (n >> 7) & 1, i = n & 127; return s * DFF + 128 * p + i; }
}
template <int MODE> __device__ __forceinline__ void transpose_item(const float* W, int K, int N, const float* ksc, bf16_t* WT, float* scr, int item, int nblk, int lane) {
    const int kb = item / nblk, nb = item % nblk, k0 = 64 * kb, n0 = 32 * nb;
    const int sc = srccol<MODE>(n0 + (lane & 31));
    float tv[32];
    const int scc = sc >= 0 ? sc : 0;
#pragma unroll
    for (int i = 0; i < 32; ++i) tv[i] = W[(size_t)(k0 + 2 * i + (lane >> 5)) * N + scc];
    if (ksc) {
#pragma unroll
        for (int i = 0; i < 32; ++i) tv[i] *= ksc[k0 + 2 * i + (lane >> 5)]; }
#pragma unroll
    for (int i = 0; i < 32; ++i) scr[(2 * i + (lane >> 5)) * 33 + (lane & 31)] = (sc >= 0) ? tv[i] : 0.f;
    asm volatile("s_waitcnt lgkmcnt(0)" ::: "memory");
    const int c = lane & 7;
#pragma unroll
    for (int j = 0; j < 4; ++j) { const int n = (lane >> 3) + 8 * j; const float* s = scr + (8 * c) * 33 + n;
        u32x4 o; o.x = pk2(s[0 * 33], s[1 * 33]); o.y = pk2(s[2 * 33], s[3 * 33]); o.z = pk2(s[4 * 33], s[5 * 33]); o.w = pk2(s[6 * 33], s[7 * 33]);
        *(u32x4*)(WT + (size_t)(n0 + n) * K + k0 + 8 * c) = o; }
    asm volatile("s_waitcnt lgkmcnt(0)" ::: "memory");
}
__device__ __forceinline__ void phase_prologue(const Ptrs& P, char* lds, int tid, int cid) {
    const int lane = tid & 63, wave = tid >> 6;
    float* scr = (float*)(lds + wave * 16384);
    const int gw = cid * 8 + wave, NGW = 256 * 8;
    bf16_t* win_t = (bf16_t*)(P.ws + WS_WIN); bf16_t* wbf_t = (bf16_t*)(P.ws + WS_WBF); bf16_t* wbg_t = (bf16_t*)(P.ws + WS_WBG);
    bf16_t* wout_t = (bf16_t*)(P.ws + WS_WOUT); bf16_t* wup_t = (bf16_t*)(P.ws + WS_WUP); bf16_t* wdn_t = (bf16_t*)(P.ws + WS_WDN);
    constexpr int I_IN = 16 * (NIN / 32), I_SQ = 16 * 32, I_UP = 16 * (NUP / 32), I_DN = (DFF / 64) * 32;
    constexpr int NITEMS = I_IN + 3 * I_SQ + I_UP + I_DN;
    for (int it = gw; it < NITEMS; it += NGW) {
        int r = it;
        if (r < I_IN) { transpose_item<1>(P.w_in, DM, 9240, nullptr, win_t, scr, r, NIN / 32, lane); continue; } r -= I_IN;
        if (r < I_SQ) { transpose_item<0>(P.w_bf, DM, DM, nullptr, wbf_t, scr, r, 32, lane); continue; } r -= I_SQ;
        if (r < I_SQ) { transpose_item<0>(P.w_bg, DM, DM, nullptr, wbg_t, scr, r, 32, lane); continue; } r -= I_SQ;
        if (r < I_SQ) { transpose_item<0>(P.w_out, DM, DM, nullptr, wout_t, scr, r, 32, lane); continue; } r -= I_SQ;
        if (r < I_UP) { transpose_item<2>(P.w_up, DM, NUP, P.norm_ffn, wup_t, scr, r, NUP / 32, lane); continue; } r -= I_UP;
        transpose_item<0>(P.w_down, DFF, DM, nullptr, wdn_t, scr, r, 32, lane);
    }
    f32x4 gv[4];
#pragma unroll
    for (int j = 0; j < 4; ++j) gv[j] = ((const f32x4*)P.norm_mix)[lane + 64 * j];
    for (int m0 = gw; m0 < MTOK; m0 += 2 * NGW) {
        const int m1 = m0 + NGW;
        const f32x4* xr0 = (const f32x4*)(P.x + (size_t)m0 * DM) + lane; const f32x4* xr1 = (const f32x4*)(P.x + (size_t)m1 * DM) + lane;
        f32x4 v0[4], v1[4]; float s0 = 0.f, s1 = 0.f;
#pragma unroll
        for (int j = 0; j < 4; ++j) { v0[j] = xr0[64 * j]; v1[j] = xr1[64 * j]; }
#pragma unroll
        for (int j = 0; j < 4; ++j) { s0 += (v0[j][0] * v0[j][0] + v0[j][1] * v0[j][1]) + (v0[j][2] * v0[j][2] + v0[j][3] * v0[j][3]); s1 += (v1[j][0] * v1[j][0] + v1[j][1] * v1[j][1]) + (v1[j][2] * v1[j][2] + v1[j][3] * v1[j][3]); }
        const float rstd0 = rsqrtf(wave_sum(s0) * (1.f / DM) + 1e-6f), rstd1 = rsqrtf(wave_sum(s1) * (1.f / DM) + 1e-6f);
        if (lane == 0) { float* irx = (float*)(P.ws + WS_CTL + 512 * 1024); irx[m0] = __builtin_amdgcn_rcpf(rstd0); irx[m1] = __builtin_amdgcn_rcpf(rstd1); }
        const int g0 = m0 / GM, g1 = m1 / GM;
        u32x2* o0 = (u32x2*)((bf16_t*)(P.out + (size_t)g0 * GM * DM) + (size_t)(m0 - g0 * GM) * DM) + lane;
        u32x2* o1 = (u32x2*)((bf16_t*)(P.out + (size_t)g1 * GM * DM) + (size_t)(m1 - g1 * GM) * DM) + lane;
#pragma unroll
        for (int j = 0; j < 4; ++j) { const f32x4 t0 = v0[j] * rstd0 * gv[j], t1 = v1[j] * rstd1 * gv[j]; u32x2 w0, w1; w0.x = pk2(t0[0], t0[1]); w0.y = pk2(t0[2], t0[3]); w1.x = pk2(t1[0], t1[1]); w1.y = pk2(t1[2], t1[3]); o0[64 * j] = w0; o1[64 * j] = w1; }
    }
}

__device__ __forceinline__ f32x4 mma16(const bf16_t* A, int lda, const bf16_t* Bt, int ldb, int ksteps, f32x4 acc, int lane) {
    const int r = lane & 15, q = lane >> 4;
    const bf16_t* ap = A + r * lda + q * 8; const bf16_t* bp = Bt + r * ldb + q * 8;
    for (int ks = 0; ks < ksteps; ++ks) { const bf16x8 a = *(const bf16x8*)(ap + ks * 32); const bf16x8 b = *(const bf16x8*)(bp + ks * 32); acc = __builtin_amdgcn_mfma_f32_16x16x32_bf16(a, b, acc, 0, 0, 0); }
    return acc;
}
#define LBAR() do { asm volatile("s_waitcnt lgkmcnt(0)" ::: "memory"); __builtin_amdgcn_s_barrier(); asm volatile("" ::: "memory"); } while (0)
__device__ __forceinline__ f32x4 mma16s(const bf16_t* A, int lda, int sw, const bf16_t* Bt, int ldb, int ksteps, f32x4 acc, int lane) {
    const int r = lane & 15, q = lane >> 4;
    const bf16_t* ap = A + r * lda; const bf16_t* bp = Bt + r * ldb + q * 8;
    for (int ks = 0; ks < ksteps; ++ks) { const bf16x8 a = *(const bf16x8*)(ap + (((ks * 4 + q) ^ sw) << 3)); const bf16x8 b = *(const bf16x8*)(bp + ks * 32); acc = __builtin_amdgcn_mfma_f32_16x16x32_bf16(a, b, acc, 0, 0, 0); }
    return acc;
}
constexpr int PQ = 136, PC = 72;
struct PrepBufs { bf16_t *W, *QD, *KDT, *UHT, *AT; float* GL; };
__device__ __forceinline__ PrepBufs prep_bufs(unsigned char* ws) {
    PrepBufs b; b.W = (bf16_t*)(ws + WS_PREP); b.QD = (bf16_t*)(ws + WS_PREP + 64 * MiB); b.KDT = (bf16_t*)(ws + WS_PREP + 128 * MiB); b.UHT = (bf16_t*)(ws + WS_PREP + 192 * MiB);
    b.AT = (bf16_t*)(ws + WS_PREP + 256 * MiB); b.GL = (float*)(ws + WS_PREP + 288 * MiB); return b;
}
constexpr int PL_QS = 0, PL_KS = 17408, PL_KDT = 34816, PL_RAW = 53248, RAWP = 392  , PL_RT = PL_RAW + 67 * RAWP * 2, PL_GC = PL_RT + 256 * PC * 2, PL_CW = PL_GC + 512, PL_END = PL_CW + 6144;
constexpr int RAW_CHUNKS = 67 * 48;
#ifndef SEGSEL
#define SEGSEL 0
#endif
#define SEG_T0() unsigned long long seg_t0 = 0; if (SEGSEL && blockIdx.x == 0 && threadIdx.x == 0) seg_t0 = __builtin_amdgcn_s_memrealtime()
#define SEG_MARK(k) do { if (SEGSEL && blockIdx.x == 0 && threadIdx.x == 0) { const unsigned long long t_ = __builtin_amdgcn_s_memrealtime(); if (SEGSEL == (k)) atomicAdd((float*)(P.ws + WS_CTL + 768 * 1024), (float)(t_ - seg_t0) * 0.01f); seg_t0 = t_; } } while (0)
struct PrepStage { u32x4 raw[7]; float ga, gb; };
struct ConvW { f32x4 w[3][4]; };
struct PrepHold { u32x4 uh[2], w[2], at; int unit; };
__device__ __forceinline__ void prep_fetch(PrepStage& st, int unit, const Ptrs& P, int tid) {
    const int n = unit & 31, h = (unit >> 5) & 7, bl = unit >> 8;
    const int R0 = bl * SEQ + n * 64;
    const bf16_t* proj = (const bf16_t*)(P.ws + WS_PROJ); const float* small = (const float*)(P.ws + WS_SMALL);
#pragma unroll
    for (int i = 0; i < 7; ++i) { int c = tid + 512 * i; c = c < RAW_CHUNKS ? c : RAW_CHUNKS - 1; const int row = c / 48, c16 = c - row * 48, part = c16 >> 4, ch = (c16 & 15) * 8;
        const bool zero = (n == 0) && (row < 3);
        const int rr = zero ? 3 : row;
        u32x4 v = *(const u32x4*)(proj + (size_t)(3 + part) * PROJ_STRIDE + (size_t)(R0 - 3 + rr) * 1024 + h * HD + ch);
        if (zero) v = (u32x4){0u, 0u, 0u, 0u};
        st.raw[i] = v; }
    { const float* sm = small + (size_t)(R0 + (tid & 63)) * 32; st.ga = sm[8 + h]; st.gb = sm[16 + h]; }
}
__device__ __forceinline__ void prep_flush(const PrepHold& hd, const Ptrs& P, int tid) {
    const PrepBufs G = prep_bufs(P.ws);
#pragma unroll
    for (int i = 0; i < 2; ++i) { const int idx = tid + 512 * i; *(u32x4*)(G.UHT + (size_t)hd.unit * 8192 + idx * 8) = hd.uh[i]; *(u32x4*)(G.W + (size_t)hd.unit * 8192 + idx * 8) = hd.w[i]; }
    *(u32x4*)(G.AT + (size_t)hd.unit * 4096 + tid * 8) = hd.at;
}
__device__ __forceinline__ void gdn_prep_unit(char* lds, int unit, int unit_next, PrepStage& st, PrepHold& hd, const ConvW& cwr, const Ptrs& P, int tid_in, float neg_a, float dtb) {
    int tid = tid_in; asm volatile("" : "+v"(tid));
    const int lane = tid & 63, wid = tid >> 6, c16 = lane & 15, q4 = lane >> 4;
    const int h = (unit >> 5) & 7;
    bf16_t* Qs = (bf16_t*)(lds + PL_QS); bf16_t* Ks = (bf16_t*)(lds + PL_KS); bf16_t* KDTs = (bf16_t*)(lds + PL_KDT);
    bf16_t* RAW = (bf16_t*)(lds + PL_RAW);
    bf16_t* RT = (bf16_t*)(lds + PL_RT);
    float* gcs = (float*)(lds + PL_GC); float* bts = gcs + 64;
    bf16_t* UHs = (bf16_t*)(lds + PL_RAW + 4096); bf16_t* Wst = UHs + 8192; bf16_t* ATs = Wst + 64 * PQ;
    bf16_t* CH = (bf16_t*)lds;
    const PrepBufs G = prep_bufs(P.ws);
    SEG_T0();
#pragma unroll
    for (int i = 0; i < 7; ++i) { const int c = tid + 512 * i; const int row = c / 48, cc = c - row * 48; if (c < RAW_CHUNKS) *(u32x4*)(RAW + row * RAWP + cc * 8) = st.raw[i]; }
    if (wid == 0) {
        const float xx = st.ga + dtb;
        const float sp = xx > 20.f ? xx : log1pf(__expf(xx));
        float cum = neg_a * sp;
        const float beta = __builtin_amdgcn_rcpf(1.0f + __expf(-st.gb));
#pragma unroll
        for (int o = 1; o < 64; o <<= 1) { const float t = __shfl_up(cum, o); if (lane >= o) cum += t; }
        gcs[lane] = cum; bts[lane] = beta;
    }
    prep_flush(hd, P, tid);
    LBAR();
    SEG_MARK(1);
    prep_fetch(st, unit_next, P, tid);
    {
        const int cg = tid & 31, rg = tid >> 5, r0 = 4 * rg, c0 = 4 * cg;
        const f32x4 gc4 = *(const f32x4*)(gcs + r0), bt4 = *(const f32x4*)(bts + r0); const float glast = gcs[63];
        float eg[4], egl[4];
#pragma unroll
        for (int rr = 0; rr < 4; ++rr) { eg[rr] = __expf(gc4[rr]); egl[rr] = __expf(glast - gc4[rr]); }
        const int key = (cg >> 1) & 7;
        const int csw = ((((rg >> 1) ^ key) << 3) | ((rg & 1) << 2));
#pragma unroll
        for (int part = 0; part < 3; ++part) {
            float x[7][4];
#pragma unroll
            for (int i = 0; i < 7; ++i) { const u32x2 a = *(const u32x2*)(RAW + (r0 + i) * RAWP + part * 128 + c0); x[i][0] = bflo(a.x); x[i][1] = bfhi(a.x); x[i][2] = bflo(a.y); x[i][3] = bfhi(a.y); }
            float y[4][4]; float ss[4];
#pragma unroll
            for (int rr = 0; rr < 4; ++rr) { ss[rr] = 0.f;
#pragma unroll
                for (int e = 0; e < 4; ++e) { float v = cwr.w[part][0][e] * x[rr][e] + cwr.w[part][1][e] * x[rr + 1][e] + cwr.w[part][2][e] * x[rr + 2][e] + cwr.w[part][3][e] * x[rr + 3][e];
                    v = siluf(v); y[rr][e] = v; ss[rr] += v * v; } }
            if (part < 2) {
#pragma unroll
                for (int rr = 0; rr < 4; ++rr) { float t = ss[rr]; t += __shfl_xor(t, 1); t += __shfl_xor(t, 2); t += __shfl_xor(t, 4); t += __shfl_xor(t, 8); t += __shfl_xor(t, 16); ss[rr] = rsqrtf(t + 1e-6f); }
            }
            if (part == 0) {
#pragma unroll
                for (int rr = 0; rr < 4; ++rr) { const float sc = ss[rr] * 0.08838834764831845f; const float a0 = y[rr][0] * sc, a1 = y[rr][1] * sc, a2 = y[rr][2] * sc, a3 = y[rr][3] * sc;
                    u32x2 w; w.x = pk2(a0, a1); w.y = pk2(a2, a3); *(u32x2*)(Qs + (r0 + rr) * PQ + c0) = w;
                    u32x2 d; d.x = pk2(a0 * eg[rr], a1 * eg[rr]); d.y = pk2(a2 * eg[rr], a3 * eg[rr]); *(u32x2*)(G.QD + (size_t)unit * 8192 + (r0 + rr) * 128 + c0) = d; }
            } else if (part == 1) {
#pragma unroll
                for (int rr = 0; rr < 4; ++rr) {
#pragma unroll
                    for (int e = 0; e < 4; ++e) y[rr][e] *= ss[rr];
                    u32x2 w; w.x = pk2(y[rr][0], y[rr][1]); w.y = pk2(y[rr][2], y[rr][3]); *(u32x2*)(Ks + (r0 + rr) * PQ + c0) = w; }
#pragma unroll
                for (int e = 0; e < 4; ++e) { u32x2 w1, w2;
                    w1.x = pk2(y[0][e] * bt4[0] * eg[0], y[1][e] * bt4[1] * eg[1]); w1.y = pk2(y[2][e] * bt4[2] * eg[2], y[3][e] * bt4[3] * eg[3]);
                    w2.x = pk2(y[0][e] * egl[0], y[1][e] * egl[1]); w2.y = pk2(y[2][e] * egl[2], y[3][e] * egl[3]);
                    *(u32x2*)(RT + (128 + c0 + e) * PC + csw) = w1; *(u32x2*)(KDTs + (c0 + e) * PC + csw) = w2; }
            } else {
#pragma unroll
                for (int e = 0; e < 4; ++e) { u32x2 w1; w1.x = pk2(y[0][e] * bt4[0], y[1][e] * bt4[1]); w1.y = pk2(y[2][e] * bt4[2], y[3][e] * bt4[3]); *(u32x2*)(RT + (c0 + e) * PC + csw) = w1; }
            }
        }
    }
    LBAR();
    SEG_MARK(2);
    {
#pragma unroll
        for (int i = 0; i < 2; ++i) { const int idx = tid + 512 * i, row = idx >> 3, ch = idx & 7; *(u32x4*)(G.KDT + (size_t)unit * 8192 + row * 64 + ch * 8) = *(const u32x4*)(KDTs + row * PC + ((ch ^ ((row >> 3) & 7)) << 3)); }
    }
    const int mat = wid >> 2, ti = wid & 3;
    f32x4 res[4], res2[4];
#pragma unroll
    for (int tj = 0; tj < 4; ++tj) { f32x4 acc = {0.f, 0.f, 0.f, 0.f}, acc2 = {0.f, 0.f, 0.f, 0.f};
        if (tj <= ti) { if (mat == 0) acc = mma16(Ks + ti * 16 * PQ, PQ, Ks + tj * 16 * PQ, PQ, 4, acc, lane);
                        acc2 = mma16(Ks + tj * 16 * PQ, PQ, (mat ? Qs : Ks) + ti * 16 * PQ, PQ, 4, acc2, lane); }
        res[tj] = acc; res2[tj] = acc2; }
    LBAR();
    {
        const int iiL = ti * 16 + c16; const float gciL = gcs[iiL], btL = bts[iiL];
#pragma unroll
        for (int tj = 0; tj < 4; ++tj) {
            const int jc0 = tj * 16 + 4 * q4;
            const f32x4 gcj = *(const f32x4*)(gcs + jc0);
            float v[4];
#pragma unroll
            for (int jj = 0; jj < 4; ++jj) { const int jc = jc0 + jj; const float dec = (iiL >= jc) ? __expf(gciL - gcj[jj]) : 0.f;
                v[jj] = (mat == 0) ? ((iiL > jc) ? -res2[tj][jj] * dec * btL : 0.f) : ((iiL >= jc) ? res2[tj][jj] * dec : 0.f); }
            u32x2 w; w.x = pk2(v[0], v[1]); w.y = pk2(v[2], v[3]);
            if (mat == 0) *(u32x2*)(CH + iiL * PC + jc0) = w;
            else *(u32x2*)(ATs + iiL * PC + jc0) = w;
            if (mat == 0) {
                const int jcL = tj * 16 + c16, ii0 = ti * 16 + 4 * q4; const float gcjL = gcs[jcL];
                const f32x4 gci = *(const f32x4*)(gcs + ii0), bti = *(const f32x4*)(bts + ii0);
                float t[4];
#pragma unroll
                for (int jj = 0; jj < 4; ++jj) { const int ii = ii0 + jj; t[jj] = (ii > jcL) ? -res[tj][jj] * __expf(gci[jj] - gcjL) * bti[jj] : 0.f; }
                u32x2 w2; w2.x = pk2(t[0], t[1]); w2.y = pk2(t[2], t[3]);
                *(u32x2*)(CH + 2 * 64 * PC + jcL * PC + ii0) = w2; }
        }
    }
    LBAR();
    SEG_MARK(3);
    f32x4 pacc[4];
    if (wid >= 4) {
#pragma unroll
        for (int tj = 0; tj < 4; ++tj) { const u32x2 nw = *(const u32x2*)(CH + (ti * 16 + c16) * PC + tj * 16 + 4 * q4); const int ii = ti * 16 + c16, jc0 = tj * 16 + 4 * q4;
            pacc[tj][0] = bflo(nw.x) + (ii == jc0 ? 1.f : 0.f); pacc[tj][1] = bfhi(nw.x) + (ii == jc0 + 1 ? 1.f : 0.f); pacc[tj][2] = bflo(nw.y) + (ii == jc0 + 2 ? 1.f : 0.f); pacc[tj][3] = bfhi(nw.y) + (ii == jc0 + 3 ? 1.f : 0.f); }
    }
    for (int s = 0; s < 6; ++s) {
        const int cur = s & 1, nxt = cur ^ 1;
        bf16_t* Qr_c = CH + cur * 64 * PC; bf16_t* Qt_c = CH + (2 + cur) * 64 * PC; bf16_t* Qr_n = CH + nxt * 64 * PC; bf16_t* Qt_n = CH + (2 + nxt) * 64 * PC;
        bf16_t* Pr_c = CH + (4 + cur) * 64 * PC; bf16_t* Pr_p = CH + (4 + nxt) * 64 * PC;
        if (wid < 4) {
            if (s < 5) {
#pragma unroll
                for (int tj = 0; tj < 4; ++tj) { f32x4 a1 = {0.f, 0.f, 0.f, 0.f}, a2 = {0.f, 0.f, 0.f, 0.f};
                    const bf16_t* ap = Qr_c + (ti * 16 + c16) * PC + q4 * 8; const bf16_t* bp = Qt_c + (tj * 16 + c16) * PC + q4 * 8;
#pragma unroll
                    for (int ks = 0; ks < 2; ++ks) { const bf16x8 fa = *(const bf16x8*)(ap + ks * 32), fb = *(const bf16x8*)(bp + ks * 32);
                        a1 = __builtin_amdgcn_mfma_f32_16x16x32_bf16(fa, fb, a1, 0, 0, 0);
                        a2 = __builtin_amdgcn_mfma_f32_16x16x32_bf16(fb, fa, a2, 0, 0, 0); }
                    u32x2 w1, w2; w1.x = pk2(a1[0], a1[1]); w1.y = pk2(a1[2], a1[3]); w2.x = pk2(a2[0], a2[1]); w2.y = pk2(a2[2], a2[3]);
                    *(u32x2*)(Qt_n + (tj * 16 + c16) * PC + ti * 16 + 4 * q4) = w1;
                    *(u32x2*)(Qr_n + (ti * 16 + c16) * PC + tj * 16 + 4 * q4) = w2; }
            }
        } else {
#pragma unroll
            for (int tj = 0; tj < 4; ++tj) {
                if (s >= 1) { const bf16_t* ap = Qt_c + (tj * 16 + c16) * PC + q4 * 8; const bf16_t* bp = Pr_p + (ti * 16 + c16) * PC + q4 * 8;
#pragma unroll
                    for (int ks = 0; ks < 2; ++ks) { const bf16x8 fa = *(const bf16x8*)(ap + ks * 32), fb = *(const bf16x8*)(bp + ks * 32); pacc[tj] = __builtin_amdgcn_mfma_f32_16x16x32_bf16(fa, fb, pacc[tj], 0, 0, 0); } }
                u32x2 w; w.x = pk2(pacc[tj][0], pacc[tj][1]); w.y = pk2(pacc[tj][2], pacc[tj][3]);
                *(u32x2*)(Pr_c + (ti * 16 + c16) * PC + tj * 16 + 4 * q4) = w; }
        }
        LBAR();
    }
    SEG_MARK(4);
    {
        const bf16_t* Tm = CH + 5 * 64 * PC;
#pragma unroll
        for (int t2 = 0; t2 < 2; ++t2) { const int tch = 2 * wid + t2; const int swl = (2 * tch + (c16 >> 3)) & 7;
#pragma unroll
            for (int tj = 0; tj < 4; ++tj) { f32x4 acc = {0.f, 0.f, 0.f, 0.f};
#pragma unroll
                for (int ks = 0; ks < 2; ++ks) { const bf16x8 fr = *(const bf16x8*)(RT + (tch * 16 + c16) * PC + (((ks * 4 + q4) ^ swl) << 3)); const bf16x8 ft = *(const bf16x8*)(Tm + (tj * 16 + c16) * PC + ks * 32 + q4 * 8);
                    acc = (tch < 8) ? __builtin_amdgcn_mfma_f32_16x16x32_bf16(ft, fr, acc, 0, 0, 0) : __builtin_amdgcn_mfma_f32_16x16x32_bf16(fr, ft, acc, 0, 0, 0); }
                u32x2 w; w.x = pk2(acc[0], acc[1]); w.y = pk2(acc[2], acc[3]);
                if (tch < 8) *(u32x2*)(UHs + ((((tch * 4 + tj) * 4 + q4) * 16 + c16) * 4)) = w;
                else *(u32x2*)(Wst + (tj * 16 + c16) * PQ + (tch - 8) * 16 + 4 * q4) = w;
            } }
        G.GL[unit] = __expf(gcs[63]);
    }
    LBAR();
#pragma unroll
    for (int i = 0; i < 2; ++i) { const int idx = tid + 512 * i; hd.uh[i] = *(const u32x4*)(UHs + idx * 8); hd.w[i] = *(const u32x4*)(Wst + (idx >> 4) * PQ + (idx & 15) * 8); }
    hd.at = *(const u32x4*)(ATs + (tid >> 3) * PC + (tid & 7) * 8); hd.unit = unit;
    LBAR();
    SEG_MARK(5);
}

__device__ __forceinline__ void gdn_seq_unit(char* lds, int bh, const Ptrs& P, int tid) {
    const int lane = tid & 63, wid = tid >> 6, c16 = lane & 15, q4 = lane >> 4;
    const int bl = bh >> 3, h = bh & 7;
    bf16_t* ST = (bf16_t*)lds;
    bf16_t* Wl = ST + 128 * PQ;
    bf16_t* QDl = Wl + 64 * PQ;
    bf16_t* ATl = QDl + 64 * PQ;
    bf16_t* KDTl = ATl + 64 * PC;
    bf16_t* UTl = KDTl + 128 * PC;
    bf16_t* GZl = UTl + 128 * PC;
    float* SSl = (float*)(GZl + 64 * PQ);
    const PrepBufs G = prep_bufs(P.ws);
    const bf16_t* gz = (const bf16_t*)(P.ws + WS_PROJ) + 6 * PROJ_STRIDE + (size_t)(bl * SEQ) * 1024 + h * HD;
    bf16_t* yg = (bf16_t*)(P.ws + WS_YGDN) + (size_t)(bl * SEQ) * 1024 + h * HD;
    f32x4 Sacc[8];
#pragma unroll
    for (int t = 0; t < 8; ++t) Sacc[t] = (f32x4){0.f, 0.f, 0.f, 0.f};
    for (int i = lane; i < 16 * PQ / 2; i += 64) ((unsigned*)(ST + wid * 16 * PQ))[i] = 0u;
    const f32x4 gn = *(const f32x4*)(P.gdn_norm + 16 * wid + 4 * q4);
    const int r16 = tid >> 4, ch16 = (tid & 15) * 8;
    const int r8 = tid >> 3, ch8 = (tid & 7) * 8;
    u32x4 sW[2], sQ[2], sA, sK[2], sG[2]; u32x2 uhn[4]; float gln;
    {
        const size_t ub = (size_t)(bh * 32) * 8192;
#pragma unroll
        for (int i = 0; i < 2; ++i) { const int idx = tid + 512 * i; sW[i] = *(const u32x4*)(G.W + ub + idx * 8); sQ[i] = *(const u32x4*)(G.QD + ub + idx * 8); sK[i] = *(const u32x4*)(G.KDT + ub + idx * 8);
            sG[i] = *(const u32x4*)(gz + (size_t)(r16 + 32 * i) * 1024 + ch16); }
        sA = *(const u32x4*)(G.AT + (size_t)(bh * 32) * 4096 + tid * 8);
#pragma unroll
        for (int t = 0; t < 4; ++t) uhn[t] = *(const u32x2*)(G.UHT + ub + ((wid * 4 + t) * 64 + lane) * 4);
        gln = G.GL[bh * 32];
    }
    for (int n = 0; n < 32; ++n) {
        const int unit = bh * 32 + n;
        const size_t ub = (size_t)unit * 8192;
#pragma unroll
        for (int i = 0; i < 2; ++i) { const int idx = tid + 512 * i;
            *(u32x4*)(Wl + (idx >> 4) * PQ + (idx & 15) * 8) = sW[i]; *(u32x4*)(QDl + (idx >> 4) * PQ + (idx & 15) * 8) = sQ[i]; *(u32x4*)(KDTl + (idx >> 3) * PC + (idx & 7) * 8) = sK[i]; }
        *(u32x4*)(ATl + r8 * PC + ch8) = sA;
        const float gl = gln;
        u32x2 uh[4];
#pragma unroll
        for (int t = 0; t < 4; ++t) uh[t] = uhn[t];
        LBAR();
        const int nn = (n + 1 < 32) ? n + 1 : 31;
        { const size_t un = (size_t)(bh * 32 + nn) * 8192;
#pragma unroll
            for (int i = 0; i < 2; ++i) { const int idx = tid + 512 * i; sW[i] = *(const u32x4*)(G.W + un + idx * 8); sQ[i] = *(const u32x4*)(G.QD + un + idx * 8); sK[i] = *(const u32x4*)(G.KDT + un + idx * 8); }
            sA = *(const u32x4*)(G.AT + (size_t)(bh * 32 + nn) * 4096 + tid * 8);
#pragma unroll
            for (int t = 0; t < 4; ++t) uhn[t] = *(const u32x2*)(G.UHT + un + ((wid * 4 + t) * 64 + lane) * 4);
            gln = G.GL[bh * 32 + nn]; }
        { const int np = (n > 0) ? n - 1 : 0;
#pragma unroll
            for (int i = 0; i < 2; ++i) { const u32x4 v = *(const u32x4*)(GZl + (r16 + 32 * i) * PQ + ch16); *(u32x4*)(yg + (size_t)(np * 64 + r16 + 32 * i) * 1024 + ch16) = v; } }
        f32x4 ws[4], os[4];
#pragma unroll
        for (int t = 0; t < 4; ++t) { ws[t] = (f32x4){0.f, 0.f, 0.f, 0.f}; os[t] = (f32x4){0.f, 0.f, 0.f, 0.f}; }
#pragma unroll
        for (int ks = 0; ks < 4; ++ks) { const bf16x8 b = *(const bf16x8*)(ST + (16 * wid + c16) * PQ + ks * 32 + q4 * 8);
#pragma unroll
            for (int t = 0; t < 4; ++t) { const bf16x8 a = *(const bf16x8*)(Wl + (16 * t + c16) * PQ + ks * 32 + q4 * 8); ws[t] = __builtin_amdgcn_mfma_f32_16x16x32_bf16(a, b, ws[t], 0, 0, 0);
                const bf16x8 a2 = *(const bf16x8*)(QDl + (16 * t + c16) * PQ + ks * 32 + q4 * 8); os[t] = __builtin_amdgcn_mfma_f32_16x16x32_bf16(b, a2, os[t], 0, 0, 0); } }
#pragma unroll
        for (int t = 0; t < 4; ++t) { u32x2 w; w.x = pk2(bflo(uh[t].x) - ws[t][0], bfhi(uh[t].x) - ws[t][1]); w.y = pk2(bflo(uh[t].y) - ws[t][2], bfhi(uh[t].y) - ws[t][3]);
            *(u32x2*)(UTl + (16 * wid + c16) * PC + 16 * t + 4 * q4) = w; }
        LBAR();
#pragma unroll
        for (int i = 0; i < 2; ++i) *(u32x4*)(GZl + (r16 + 32 * i) * PQ + ch16) = sG[i];
#pragma unroll
        for (int i = 0; i < 2; ++i) sG[i] = *(const u32x4*)(gz + (size_t)(nn * 64 + r16 + 32 * i) * 1024 + ch16);
#pragma unroll
        for (int ks = 0; ks < 2; ++ks) { const bf16x8 b = *(const bf16x8*)(UTl + (16 * wid + c16) * PC + ks * 32 + q4 * 8);
#pragma unroll
            for (int t = 0; t < 4; ++t) { const bf16x8 a = *(const bf16x8*)(ATl + (16 * t + c16) * PC + ks * 32 + q4 * 8); os[t] = __builtin_amdgcn_mfma_f32_16x16x32_bf16(b, a, os[t], 0, 0, 0); } }
#pragma unroll
        for (int t = 0; t < 8; ++t) Sacc[t] = Sacc[t] * gl;
#pragma unroll
        for (int ks = 0; ks < 2; ++ks) { const bf16x8 a = *(const bf16x8*)(UTl + (16 * wid + c16) * PC + ks * 32 + q4 * 8);
#pragma unroll
            for (int t = 0; t < 8; ++t) { const bf16x8 b = *(const bf16x8*)(KDTl + (16 * t + c16) * PC + ks * 32 + q4 * 8); Sacc[t] = __builtin_amdgcn_mfma_f32_16x16x32_bf16(b, a, Sacc[t], 0, 0, 0); } }
#pragma unroll
        for (int t = 0; t < 8; ++t) { u32x2 w; w.x = pk2(Sacc[t][0], Sacc[t][1]); w.y = pk2(Sacc[t][2], Sacc[t][3]); *(u32x2*)(ST + (16 * wid + c16) * PQ + 16 * t + 4 * q4) = w; }
#pragma unroll
        for (int t = 0; t < 4; ++t) { float s = (os[t][0] * os[t][0] + os[t][1] * os[t][1]) + (os[t][2] * os[t][2] + os[t][3] * os[t][3]); s += __shfl_xor(s, 16); s += __shfl_xor(s, 32);
            if (q4 == 0) SSl[wid * 64 + 16 * t + c16] = s; }
        LBAR();
        float tot = 0.f;
#pragma unroll
        for (int w = 0; w < 8; ++w) tot += SSl[w * 64 + lane];
        const float rstd_l = rsqrtf(tot * (1.0f / 128.0f) + 1e-6f);
#pragma unroll
        for (int t = 0; t < 4; ++t) { const int row = 16 * t + c16; const float rs = __shfl(rstd_l, row);
            u32x2* gp = (u32x2*)(GZl + row * PQ + 16 * wid + 4 * q4); const u32x2 gw = *gp; u32x2 w;
            w.x = pk2(os[t][0] * rs * gn[0] * siluf(bflo(gw.x)), os[t][1] * rs * gn[1] * siluf(bfhi(gw.x)));
            w.y = pk2(os[t][2] * rs * gn[2] * siluf(bflo(gw.y)), os[t][3] * rs * gn[3] * siluf(bfhi(gw.y))); *gp = w; }
    }
    LBAR();
#pragma unroll
    for (int i = 0; i < 2; ++i) { const u32x4 v = *(const u32x4*)(GZl + (r16 + 32 * i) * PQ + ch16); *(u32x4*)(yg + (size_t)(31 * 64 + r16 + 32 * i) * 1024 + ch16) = v; }
    __syncthreads();
}

__device__ __forceinline__ void fox_item(char* lds, int item, const Ptrs& P, int tid, bool need_bias) {
    using bf = fox::bf16;
    const int lane = tid & 63, wid = tid >> 6;
    const int bh = item >> 2, xq = item & 3, bl = bh >> 3, h = bh & 7;
    float* cb = (float*)(lds + fox::LDS_BYTES);
    float* tmp = cb + SEQ;
    const float* small = (const float*)(P.ws + WS_SMALL);
    if (need_bias) {
        const float fb = P.fox_f_bias[h];
        float lf[4]; float run = 0.f;
#pragma unroll
        for (int e = 0; e < 4; ++e) { const float xv = small[(size_t)(bl * SEQ + 4 * tid + e) * 32 + h] + fb;
            const float l = (xv < -20.f) ? xv : -log1pf(__expf(-xv)); run += l; lf[e] = run; }
        float inc = run;
#pragma unroll
        for (int o = 1; o < 64; o <<= 1) { const float t = __shfl_up(inc, o); if (lane >= o) inc += t; }
        if (lane == 63) tmp[wid] = inc;
        __syncthreads();
        float off = inc - run;
        for (int w = 0; w < wid; ++w) off += tmp[w];
#pragma unroll
        for (int e = 0; e < 4; ++e) cb[4 * tid + e] = -(off + lf[e]) * 11.313708498984761f;
        __syncthreads();
    }
    bf* fq = (bf*)(P.ws + WS_PROJ); const bf* fk = fq + PROJ_STRIDE; const bf* fv = fq + 2 * PROJ_STRIDE;
    const size_t hb = (size_t)(bl * SEQ) * 1024 + h * HD;
    fox::BlockRef<bf, bf> b0, b1;
    bf* yo = (bf*)(P.ws + WS_YFOX);
    b0.Q = fq + hb + (size_t)(xq * 256) * 1024; b0.O = yo + hb + (size_t)(xq * 256) * 1024; b0.K = fk + hb; b0.V = fv + hb; b0.P0 = xq * 256;
    b1.Q = fq + hb + (size_t)((7 - xq) * 256) * 1024; b1.O = yo + hb + (size_t)((7 - xq) * 256) * 1024; b1.K = fk + hb; b1.V = fv + hb; b1.P0 = (7 - xq) * 256;
    fox::Seam<bf> S;
    fox::causal_swa_prime<bf, bf>(b0, 1 << 20, lds, S);
    fox::causal_swa_block<bf, bf>(b0, b1, SEQ, 1 << 20, lds, S, cb);
    fox::causal_swa_block<bf, bf>(b1, b1, SEQ, 1 << 20, lds, S, cb);
    __syncthreads();
}

__device__ __forceinline__ void phase_convgate(const Ptrs& P, int tid, int cid) {
    const bf16_t* up = (const bf16_t*)(P.ws + WS_UP); bf16_t* act = (bf16_t*)(P.ws + WS_ACT);
    constexpr int NFG = DFF / 8;
    constexpr int RPB = GM / 256; static_assert(SEQ % RPB == 0, "a slab never straddles a sequence start");
    if (tid < NFG) {
        const int fg = tid, p = fg >> 4, i0 = (fg & 15) * 8, f0 = p * 128 + i0;
        const int cg0 = p * 256 + i0, cv0 = cg0 + 128;
        float wg[3][8], wv[3][8];
#pragma unroll
        for (int i = 0; i < 3; ++i)
#pragma unroll
            for (int j = 0; j < 8; ++j) { wg[i][j] = P.ffn_conv_w[i * NUP + f0 + j]; wv[i][j] = P.ffn_conv_w[i * NUP + DFF + f0 + j]; }
        const int r0 = cid * RPB;
        float g1[8], g2[8], v1[8], v2[8];
#pragma unroll
        for (int j = 0; j < 8; ++j) { g1[j] = 0.f; g2[j] = 0.f; v1[j] = 0.f; v2[j] = 0.f; }
        if ((r0 & (SEQ - 1)) != 0) {
            const u32x4 a1 = *(const u32x4*)(up + (size_t)(r0 - 1) * NUP + cg0), a2 = *(const u32x4*)(up + (size_t)(r0 - 2) * NUP + cg0);
            const u32x4 b1 = *(const u32x4*)(up + (size_t)(r0 - 1) * NUP + cv0), b2 = *(const u32x4*)(up + (size_t)(r0 - 2) * NUP + cv0);
            g1[0] = bflo(a1.x); g1[1] = bfhi(a1.x); g1[2] = bflo(a1.y); g1[3] = bfhi(a1.y); g1[4] = bflo(a1.z); g1[5] = bfhi(a1.z); g1[6] = bflo(a1.w); g1[7] = bfhi(a1.w);
            g2[0] = bflo(a2.x); g2[1] = bfhi(a2.x); g2[2] = bflo(a2.y); g2[3] = bfhi(a2.y); g2[4] = bflo(a2.z); g2[5] = bfhi(a2.z); g2[6] = bflo(a2.w); g2[7] = bfhi(a2.w);
            v1[0] = bflo(b1.x); v1[1] = bfhi(b1.x); v1[2] = bflo(b1.y); v1[3] = bfhi(b1.y); v1[4] = bflo(b1.z); v1[5] = bfhi(b1.z); v1[6] = bflo(b1.w); v1[7] = bfhi(b1.w);
            v2[0] = bflo(b2.x); v2[1] = bfhi(b2.x); v2[2] = bflo(b2.y); v2[3] = bfhi(b2.y); v2[4] = bflo(b2.z); v2[5] = bfhi(b2.z); v2[6] = bflo(b2.w); v2[7] = bfhi(b2.w);
        }
        for (int rb = 0; rb < RPB; rb += 8) {
            u32x4 ga[8], va[8];
#pragma unroll
            for (int r = 0; r < 8; ++r) { ga[r] = *(const u32x4*)(up + (size_t)(r0 + rb + r) * NUP + cg0); va[r] = *(const u32x4*)(up + (size_t)(r0 + rb + r) * NUP + cv0); }
#pragma unroll
            for (int r = 0; r < 8; ++r) {
                const u32x4 a = ga[r], b = va[r];
                float g0[8], v0[8];
                g0[0] = bflo(a.x); g0[1] = bfhi(a.x); g0[2] = bflo(a.y); g0[3] = bfhi(a.y); g0[4] = bflo(a.z); g0[5] = bfhi(a.z); g0[6] = bflo(a.w); g0[7] = bfhi(a.w);
                v0[0] = bflo(b.x); v0[1] = bfhi(b.x); v0[2] = bflo(b.y); v0[3] = bfhi(b.y); v0[4] = bflo(b.z); v0[5] = bfhi(b.z); v0[6] = bflo(b.w); v0[7] = bfhi(b.w);
                float o[8];
#pragma unroll
                for (int j = 0; j < 8; ++j) { const float cgv = wg[0][j] * g2[j] + wg[1][j] * g1[j] + wg[2][j] * g0[j]; const float cvv = wv[0][j] * v2[j] + wv[1][j] * v1[j] + wv[2][j] * v0[j];
                    o[j] = siluf(cgv) * cvv; g2[j] = g1[j]; g1[j] = g0[j]; v2[j] = v1[j]; v1[j] = v0[j]; }
                u32x4 w; w.x = pk2(o[0], o[1]); w.y = pk2(o[2], o[3]); w.z = pk2(o[4], o[5]); w.w = pk2(o[6], o[7]);
                *(u32x4*)(act + (size_t)(r0 + rb + r) * DFF + f0) = w;
            }
        }
    }
}

__device__ __forceinline__ void phase_final(const Ptrs& P, int tid, int cid, float pert) {
    const int lane = tid & 63, wave = tid >> 6;
    const int gw = cid * 8 + wave, NGW = 256 * 8;
    const float* rowss2 = (const float*)(P.ws + WS_CTL) + MTOK;
    f32x4 gv[4];
#pragma unroll
    for (int j = 0; j < 4; ++j) gv[j] = ((const f32x4*)P.norm_final)[lane + 64 * j];
    for (int m0 = gw; m0 < MTOK; m0 += 2 * NGW) {
        const int m1 = m0 + NGW;
        const float rstd0 = rsqrtf(rowss2[m0] * (1.f / DM) + 1e-6f), rstd1 = rsqrtf(rowss2[m1] * (1.f / DM) + 1e-6f);
        f32x4* o0 = (f32x4*)(P.out + (size_t)m0 * DM) + lane; f32x4* o1 = (f32x4*)(P.out + (size_t)m1 * DM) + lane;
        f32x4 a0[4], a1[4];
#pragma unroll
        for (int j = 0; j < 4; ++j) { a0[j] = o0[64 * j]; a1[j] = o1[64 * j]; }
#pragma unroll
        for (int j = 0; j < 4; ++j) { o0[64 * j] = a0[j] * rstd0 * gv[j] + pert; o1[64 * j] = a1[j] * rstd1 * gv[j] + pert; }
    }
}

#define LAS __attribute__((address_space(3)))
#define XB_TMO      128
#define XB_XCNT(j)  (256  + 64 * (j))
#define XB_XSUB(j)  (1280 + 64 * (j))
#define XB_XGEN(j)  (2304 + 64 * (j))
#define XB_TOP      3328
#define XB_TOPGEN   3392
#define XCD_BAR_WORDS 3456
#define XB_SPIN_CAP (1u << 18)

__device__ __forceinline__ unsigned xb_ld(unsigned* p)              { return __hip_atomic_load(p, __ATOMIC_RELAXED, __HIP_MEMORY_SCOPE_AGENT); }
__device__ __forceinline__ unsigned xb_add(unsigned* p, unsigned v) { return __hip_atomic_fetch_add(p, v, __ATOMIC_RELAXED, __HIP_MEMORY_SCOPE_AGENT); }
__device__ __forceinline__ unsigned xb_xcc_id() { return (unsigned)__builtin_amdgcn_s_getreg((3 << 11) | 20) & 0xFu; }
#define XB_SPIN(cond, bar) do { unsigned _sp = 0; while (cond) { __builtin_amdgcn_s_sleep(1); \
    if ((++_sp & 255u) == 0u) { if (xb_ld(&(bar)[XB_TMO])) break; if (_sp > XB_SPIN_CAP) { atomicAdd(&(bar)[XB_TMO], 1u); break; } } } } while (0)

struct XcdBarrier {
    unsigned* bar; unsigned x;
    volatile LAS unsigned* st;
};

__device__ __forceinline__ XcdBarrier xcd_barrier_post(unsigned* bar, volatile LAS unsigned* st) {
    XcdBarrier b; b.bar = bar; b.x = xb_xcc_id(); b.st = st;
    if (threadIdx.x == 0) (void)xb_add(&bar[XB_XCNT(b.x)], 1u);
    return b;
}
__device__ __forceinline__ void xcd_barrier_complete(unsigned* bar, unsigned x, unsigned& nloc, unsigned& nx) {
    const unsigned G = gridDim.x * gridDim.y * gridDim.z;
    unsigned sum, cnt, mine, sp = 0u;
    for (;;) {
        sum = 0u; cnt = 0u; mine = 0u;
#pragma unroll
        for (unsigned j = 0; j < 16; ++j) { const unsigned c = xb_ld(&bar[XB_XCNT(j)]); sum += c; cnt += (c > 0u) ? 1u : 0u; mine = (j == x) ? c : mine; }
        if (sum == G) break;
        __builtin_amdgcn_s_sleep(1);
        if ((++sp & 255u) == 0u) { if (xb_ld(&bar[XB_TMO])) break; if (sp > XB_SPIN_CAP) { atomicAdd(&bar[XB_TMO], 1u); break; } }
    }
    nloc = mine > 0u ? mine : 1u; nx = cnt > 0u ? cnt : 1u;
}

__device__ __forceinline__ void xcd_barrier(const XcdBarrier& b) {
    asm volatile("s_waitcnt vmcnt(0)" ::: "memory");
    __syncthreads();
    if (threadIdx.x == 0) {
        unsigned* bar = b.bar;
        __builtin_amdgcn_s_waitcnt(0);
        unsigned nloc = b.st[0], nx = b.st[1];
        if (nloc == 0u) { xcd_barrier_complete(bar, b.x, nloc, nx); b.st[0] = nloc; b.st[1] = nx; }
        const unsigned old = xb_add(&bar[XB_XSUB(b.x)], 1u);
        const unsigned gen = old / nloc;
        if (old + 1u == (gen + 1u) * nloc) {
            __builtin_amdgcn_fence(__ATOMIC_RELEASE, "agent");
            asm volatile("s_waitcnt vmcnt(0)" ::: "memory");
            const unsigned og = xb_add(&bar[XB_TOP], 1u);
            const unsigned tg = og / nx;
            if (og + 1u == (tg + 1u) * nx) xb_add(&bar[XB_TOPGEN], 1u);
            else XB_SPIN(xb_ld(&bar[XB_TOPGEN]) == tg, bar);
            __builtin_amdgcn_fence(__ATOMIC_ACQUIRE, "agent");
            xb_add(&bar[XB_XGEN(b.x)], 1u);
            asm volatile("s_waitcnt vmcnt(0)" ::: "memory");
        } else {
            XB_SPIN(xb_ld(&bar[XB_XGEN(b.x)]) == gen, bar);
            __builtin_amdgcn_fence(__ATOMIC_ACQUIRE, "agent");
            asm volatile("s_waitcnt vmcnt(0)" ::: "memory");
        }
    }
    __syncthreads();
}

constexpr int N_PHASES = 2 + 8 * NG;
#ifndef PHM
#define PHM 2047
#endif
#ifndef DBL
#define DBL 0
#endif
#define DBLSEL 2
#ifndef TSTAMP
#define TSTAMP 0
#endif
#define TS_MASK 0x200
__global__ void __launch_bounds__(512, 2) mk_fwd(Args args) {
    extern __shared__ __attribute__((aligned(16))) unsigned char lds_raw[];
    char* lds = (char*)lds_raw;
    cg::grid_group grid = cg::this_grid();
    volatile LAS unsigned* xst = (volatile LAS unsigned*)((LAS unsigned char*)lds_raw + (LDS_BYTES - 16));
    if (threadIdx.x < 4) xst[threadIdx.x] = 0u;
    __syncthreads();
    XcdBarrier xbar; xbar.bar = (unsigned*)(args.ws + WS_CTL + 800 * 1024); xbar.x = 0; xbar.st = xst;
    constexpr int G = 256;
    for (int ph = args.ph_lo; ph < args.ph_hi; ++ph) {
      {
        int tid = threadIdx.x; asm volatile("" : "+v"(tid));
        int cid = blockIdx.x; asm volatile("" : "+s"(cid));
        typedef const __attribute__((address_space(4))) Args* KArgsP;
        KArgsP kp = (KArgsP)__builtin_amdgcn_kernarg_segment_ptr(); asm volatile("" : "+s"(kp));
#define GPTR(T, v) ((T*)(__attribute__((address_space(1))) T*)(v))
        Ptrs P;
        P.x = GPTR(const float, kp->in[0]); P.norm_mix = GPTR(const float, kp->in[1]); P.w_in = GPTR(const float, kp->in[2]); P.fox_f_bias = GPTR(const float, kp->in[3]);
        P.gdn_conv_w = GPTR(const float, kp->in[4]); P.gdn_a_log = GPTR(const float, kp->in[5]); P.gdn_dt_bias = GPTR(const float, kp->in[6]); P.gdn_norm = GPTR(const float, kp->in[7]);
        P.w_bf = GPTR(const float, kp->in[8]); P.w_bg = GPTR(const float, kp->in[9]); P.w_out = GPTR(const float, kp->in[10]); P.norm_ffn = GPTR(const float, kp->in[11]);
        P.w_up = GPTR(const float, kp->in[12]); P.ffn_conv_w = GPTR(const float, kp->in[13]); P.w_down = GPTR(const float, kp->in[14]); P.norm_final = GPTR(const float, kp->in[15]);
        P.out = GPTR(float, kp->out); unsigned char* ws = GPTR(unsigned char, kp->ws); P.ws = ws;
        float* rowss1 = (float*)(ws + WS_CTL); float* rowss2 = rowss1 + MTOK;
        if (ph == 0) { if (PHM & 1) phase_prologue(P, lds, tid, cid);
            if (MK_ONE_LAUNCH) {
                unsigned* cz = (unsigned*)(ws + WS_CTL); for (int i = cid * 512 + tid; i < 131072; i += G * 512) cz[i] = 0u;
                if (cid == 0) { unsigned* bz = (unsigned*)(ws + WS_CTL + 800 * 1024); for (int i = tid; i < XCD_BAR_WORDS; i += 512) bz[i] = 0u; if (tid < 64) ((unsigned*)(ws + WS_CTL + 768 * 1024))[tid] = 0u; } } }
        else if (ph == N_PHASES - 1) {
            float pert = 0.f;
            if (SEGSEL && blockIdx.x == 0) pert = fminf(__hip_atomic_load((float*)(ws + WS_CTL + 768 * 1024), __ATOMIC_RELAXED, __HIP_MEMORY_SCOPE_AGENT) * 5e-5f, 0.12f);
            if (PHM & 2) phase_final(P, tid, cid, pert); }
        else {
            const int grp = (ph - 1) >> 3, sub = (ph - 1) & 7;
            const size_t r0g = (size_t)grp * GM;
            pg8::bf16_t* proj = (pg8::bf16_t*)(ws + WS_PROJ);
            if (sub == 0 && (PHM & 4)) {
                pg8::Gemm g{(const pg8::bf16_t*)(P.out + r0g * DM), nullptr, (const pg8::bf16_t*)(ws + WS_WIN), nullptr, GM, NIN, DM};
                pg8::StaticOrder S; S.init(GM, NIN, G, cid);
                pg8::EpiIn E{proj, (float*)(ws + WS_SMALL)};
                pg8::gemm_phase<pg8::EpiIn, pg8::StaticOrder, true, true>((PG8_LAS unsigned char*)lds_raw, g, S, E);
            } else if (sub == 1 && (PHM & 8)) {
                { const int hh = (cid >> 5) & 7;
                  ConvW cwr;
#pragma unroll
                  for (int part = 0; part < 3; ++part)
#pragma unroll
                      for (int tap = 0; tap < 4; ++tap) cwr.w[part][tap] = *(const f32x4*)(P.gdn_conv_w + tap * 3072 + part * 1024 + hh * HD + 4 * (tid & 31));
                  const float neg_a = -__expf(P.gdn_a_log[hh]), dtb = P.gdn_dt_bias[hh];
                  PrepStage st; prep_fetch(st, cid, P, tid);
                  PrepHold hd; hd.unit = cid; hd.at = (u32x4){0u, 0u, 0u, 0u}; hd.uh[0] = hd.at; hd.uh[1] = hd.at; hd.w[0] = hd.at; hd.w[1] = hd.at;
                  for (int u = cid; u < NCH; u += G) { const int un = (u + G < NCH) ? u + G : u; gdn_prep_unit(lds, u, un, st, hd, cwr, P, tid, neg_a, dtb); }
                  prep_flush(hd, P, tid); }
            } else if (sub == 2) {
                if ((PHM & 32)) for (int bh = cid; bh < BG * NH; bh += G) gdn_seq_unit(lds, bh, P, tid);
                if ((PHM & 16)) { const bool sq = cid < BG * NH; const int first = sq ? cid * 4 : (cid - BG * NH) * 4 + 1, cnt = sq ? 1 : 3; for (int x = 0; x < cnt; ++x) fox_item(lds, first + x, P, tid, x == 0); }
            } else if (sub == 3 && (PHM & 64)) {
                pg8::Gemm g{(const pg8::bf16_t*)(ws + WS_YFOX), (const pg8::bf16_t*)(ws + WS_YGDN), (const pg8::bf16_t*)(ws + WS_WBF), (const pg8::bf16_t*)(ws + WS_WBG), GM, DM, DM};
                pg8::PairOrder S; S.init(GM, DM, G, cid);
                pg8::EpiY E{proj + 7 * PROJ_STRIDE, proj + 8 * PROJ_STRIDE, (pg8::bf16_t*)(ws + WS_T1), (pg8::bf16_t*)(ws + WS_Y)};
                pg8::gemm_phase<pg8::EpiY, pg8::PairOrder, true, true>((PG8_LAS unsigned char*)lds_raw, g, S, E);
            } else if (sub == 4 && (PHM & 128)) {
                pg8::Gemm g{(const pg8::bf16_t*)(ws + WS_Y), nullptr, (const pg8::bf16_t*)(ws + WS_WOUT), nullptr, GM, DM, DM};
                pg8::StaticOrder S; S.init(GM, DM, G, cid);
                pg8::EpiOut E{(const pg8::bf16_t*)(P.out + r0g * DM), (const float*)(ws + WS_CTL + 512 * 1024) + r0g, P.norm_mix, (pg8::bf16_t*)(ws + WS_H1B), rowss1 + r0g};
                pg8::gemm_phase<pg8::EpiOut, pg8::StaticOrder, true, true>((PG8_LAS unsigned char*)lds_raw, g, S, E);
            } else if (sub == 5 && (PHM & 256)) {
                pg8::Gemm g{(const pg8::bf16_t*)(ws + WS_H1B), nullptr, (const pg8::bf16_t*)(ws + WS_WUP), nullptr, GM, NUP, DM};
                pg8::StaticOrder S; S.init(GM, NUP, G, cid);
                pg8::EpiUp E{(pg8::bf16_t*)(ws + WS_UP), rowss1 + r0g, NUP};
                pg8::gemm_phase<pg8::EpiUp, pg8::StaticOrder, true, true>((PG8_LAS unsigned char*)lds_raw, g, S, E);
            } else if (sub == 6) {
                if (PHM & 512) phase_convgate(P, tid, cid);
            } else if (PHM & 1024) {
                pg8::Gemm g{(const pg8::bf16_t*)(ws + WS_ACT), nullptr, (const pg8::bf16_t*)(ws + WS_WDN), nullptr, GM, DM, DFF};
                pg8::StaticOrder S; S.init(GM, DM, G, cid);
                pg8::EpiDown E{(const pg8::bf16_t*)(ws + WS_H1B), P.out + r0g * DM, rowss2 + r0g};
                pg8::gemm_phase<pg8::EpiDown, pg8::StaticOrder, true, true>((PG8_LAS unsigned char*)lds_raw, g, S, E);
            }
        }
      }
        if (ph + 1 < args.ph_hi) { if (ph == args.ph_lo) { grid.sync(); xbar = xcd_barrier_post((unsigned*)(args.ws + WS_CTL + 800 * 1024), xst); } else xcd_barrier(xbar); }
    }
}

extern "C" void kernel_launch(void* const* d_in, const int* in_sizes, int n_in, void* d_out, int out_size, void* d_ws, size_t ws_size, hipStream_t stream) {
    static int ready = 0;
    if (ready == 0) {
        if (n_in != 16 || in_sizes[0] != MTOK * DM || out_size != MTOK * DM || ws_size < WS_END) {
            fprintf(stderr, "kernel_launch: unexpected shapes (n_in %d, in0 %d, out %d, ws %zu; need ws >= %zu)\n", n_in, n_in > 0 ? in_sizes[0] : -1, out_size, ws_size, (size_t)WS_END); ready = -1; return; }
        if (hipFuncSetAttribute((const void*)mk_fwd, hipFuncAttributeMaxDynamicSharedMemorySize, LDS_BYTES) != hipSuccess) { fprintf(stderr, "kernel_launch: hipFuncSetAttribute failed\n"); ready = -1; return; }
        int per_cu = 0;
        if (hipOccupancyMaxActiveBlocksPerMultiprocessor(&per_cu, (const void*)mk_fwd, 512, LDS_BYTES) != hipSuccess || per_cu < 1) fprintf(stderr, "kernel_launch: occupancy query says %d blocks per CU\n", per_cu);
        (void)hipGetLastError();
        ready = 1;
    }
    if (ready < 0) return;
#if !MK_ONE_LAUNCH
    (void)hipMemsetAsync((char*)d_ws + WS_CTL, 0, 1 * MiB, stream);
#endif
    Args a{};
    for (int i = 0; i < 16; ++i) a.in[i] = (const float*)d_in[i];
    a.out = (float*)d_out; a.ws = (unsigned char*)d_ws;
#if MK_ONE_LAUNCH
    a.ph_lo = 0; a.ph_hi = N_PHASES;
    void* kargs[] = {&a};
    hipError_t e = hipLaunchCooperativeKernel((const void*)mk_fwd, dim3(256), dim3(512), kargs, LDS_BYTES, stream);
    if (e != hipSuccess) fprintf(stderr, "kernel_launch: cooperative launch failed: %s\n", hipGetErrorString(e));
#else
    for (int ph = 0; ph < N_PHASES; ++ph) { a.ph_lo = ph; a.ph_hi = ph + 1; hipLaunchKernelGGL(mk_fwd, dim3(256), dim3(512), LDS_BYTES, stream, a); }
#endif
}
```

```cpp
#include <hip/hip_runtime.h>
#include <hip/hip_bf16.h>
#include <hip/hip_cooperative_groups.h>
#include <cstdio>
#include <cstdint>
namespace cg = cooperative_groups;

#ifndef MK_ONE_LAUNCH
#define MK_ONE_LAUNCH 1
#endif

namespace pg8 {
#define PG8_LAS __attribute__((address_space(3)))
typedef unsigned short bf16_t;
typedef short bf16x8 __attribute__((ext_vector_type(8)));
typedef float f32x4 __attribute__((ext_vector_type(4)));
typedef unsigned u32x4 __attribute__((ext_vector_type(4)));
constexpr int BM = 256, BK = 64, HALF = 128, HTB = HALF * BK * 2  , STAGE_BYTES = 8 * HTB, NXCD = 8, WGM = 4;

__host__ __device__ __forceinline__ int lds_byte(int r, int c) { const int st = (r >> 4) * 2 + (c >> 5), rr = r & 15, cc = c & 31, ob = rr * 64 + cc * 2; return st * 1024 + (ob ^ (((ob >> 9) & 1) << 5)); }
__host__ __device__ __forceinline__ void stage_rc(int b, int& R, int& C) { const int st = b / 1024, sb = b % 1024, swz = sb ^ (((sb >> 9) & 1) << 5); R = (st >> 1) * 16 + swz / 64; C = (st & 1) * 32 + (swz % 64) / 2; }
__host__ __device__ __forceinline__ int perm32(int rho) { const int n = rho >> 4, i = rho & 15; return 8 * (i >> 2) + 4 * n + (i & 3); }

struct Unit { int pm, pn, sel; };
struct Gemm { const bf16_t* A0; const bf16_t* A1; const bf16_t* B0; const bf16_t* B1; int M, N, K; };

struct StaticOrder {
    int nM, nN, nwg, G, c;
    __host__ __device__ __forceinline__ void init(int M, int N, int G_, int c_) { nM = M / BM; nN = N / BM; nwg = nM * nN; G = G_; c = c_; }
    __host__ __device__ __forceinline__ bool next(int i, Unit& u) const {
        const long L = (long)i * G + c; if (L >= nwg) return false;
        int wgid = (int)L; { const int q = nwg / NXCD, r = nwg % NXCD, xcd = wgid % NXCD, off = wgid / NXCD; wgid = (xcd < r ? xcd * (q + 1) : r * (q + 1) + (xcd - r) * q) + off; }
        const int nig = WGM * nN, gid = wgid / nig, fm = gid * WGM, gsz = (nM - fm) < WGM ? (nM - fm) : WGM;
        u.pm = fm + ((wgid % nig) % gsz); u.pn = (wgid % nig) / gsz; u.sel = 0; return true;
    }
    __device__ __forceinline__ void a_ready(const Unit&) const {}
    __device__ __forceinline__ void done(const Unit&) const {}
};

__device__ __forceinline__ unsigned cvt_pk_bf16(float lo, float hi) { unsigned r; asm volatile("v_cvt_pk_bf16_f32 %0, %1, %2" : "=v"(r) : "v"(lo), "v"(hi)); return r; }
typedef unsigned u32x2 __attribute__((ext_vector_type(2)));
__device__ __forceinline__ float bflo(unsigned w) { return __uint_as_float(w << 16); }
__device__ __forceinline__ float bfhi(unsigned w) { return __uint_as_float(w & 0xffff0000u); }
__device__ __forceinline__ float sigm(float x) { return __builtin_amdgcn_rcpf(1.0f + __expf(-x)); }
constexpr int GM = 32768;
constexpr int LDP = 1024;

struct EpiIn {
    static constexpr bool PERM = true, AFTER_DRAIN = false;
    bf16_t* proj; float* small;
    __device__ __forceinline__ void operator()(const f32x4 (&acc)[2][2][4][2], const Unit& u, int wr, int wc, int fr, int fq) const {
        const int row0 = u.pm * BM + wr * 64 + fr;
        if (u.pn < 36) {
            bf16_t* base = proj + (size_t)(u.pn >> 2) * ((size_t)GM * LDP) + (u.pn & 3) * 256 + wc * 32 + 8 * fq;
#pragma unroll
            for (int ai = 0; ai < 2; ++ai)
#pragma unroll
                for (int m = 0; m < 4; ++m) { bf16_t* rowp = base + (size_t)(row0 + ai * HALF + m * 16) * LDP;
#pragma unroll
                    for (int bj = 0; bj < 2; ++bj) { const f32x4 v0 = acc[ai][bj][m][0], v1 = acc[ai][bj][m][1];
                        u32x4 w; w.x = cvt_pk_bf16(v0[0], v0[1]); w.y = cvt_pk_bf16(v0[2], v0[3]); w.z = cvt_pk_bf16(v1[0], v1[1]); w.w = cvt_pk_bf16(v1[2], v1[3]);
                        *(u32x4*)(rowp + bj * HALF) = w; } }
        } else if (wc == 0 && fq < 3) {
#pragma unroll
            for (int ai = 0; ai < 2; ++ai)
#pragma unroll
                for (int m = 0; m < 4; ++m) { float* p = small + (size_t)(row0 + ai * HALF + m * 16) * 32 + 8 * fq;
                    *(f32x4*)p = acc[ai][0][m][0]; *(f32x4*)(p + 4) = acc[ai][0][m][1]; }
        }
    }
};
struct EpiY {
    static constexpr bool PERM = true, AFTER_DRAIN = false;
    const bf16_t* gf; const bf16_t* gg; bf16_t* t1; bf16_t* y;
    __device__ __forceinline__ void operator()(const f32x4 (&acc)[2][2][4][2], const Unit& u, int wr, int wc, int fr, int fq) const {
        const int row0 = u.pm * BM + wr * 64 + fr, col0 = u.pn * BM + wc * 32 + 8 * fq;
        const bf16_t* const gf_ = gf; const bf16_t* const gg_ = gg; bf16_t* const t1_ = t1; bf16_t* const y_ = y;
        const bf16_t* gate = u.sel ? gg_ : gf_; bf16_t* dst = u.sel ? y_ : t1_;
        if (u.sel) asm volatile("s_waitcnt vmcnt(0)" ::: "memory");
#pragma unroll
        for (int ai = 0; ai < 2; ++ai) {
            u32x4 gw[4][2], tw[4][2];
#pragma unroll
            for (int m = 0; m < 4; ++m)
#pragma unroll
                for (int bj = 0; bj < 2; ++bj) { const size_t o = (size_t)(row0 + ai * HALF + m * 16) * LDP + col0 + bj * HALF;
                    gw[m][bj] = *(const u32x4*)(gate + o); tw[m][bj] = u.sel ? *(const u32x4*)(t1_ + o) : (u32x4){0u, 0u, 0u, 0u}; }
#pragma unroll
            for (int m = 0; m < 4; ++m)
#pragma unroll
                for (int bj = 0; bj < 2; ++bj) { const size_t o = (size_t)(row0 + ai * HALF + m * 16) * LDP + col0 + bj * HALF;
                    const u32x4 g = gw[m][bj], t = tw[m][bj]; const f32x4 v0 = acc[ai][bj][m][0], v1 = acc[ai][bj][m][1];
                    const float r0 = sigm(bflo(g.x)) * v0[0] + bflo(t.x), r1 = sigm(bfhi(g.x)) * v0[1] + bfhi(t.x), r2 = sigm(bflo(g.y)) * v0[2] + bflo(t.y), r3 = sigm(bfhi(g.y)) * v0[3] + bfhi(t.y);
                    const float r4 = sigm(bflo(g.z)) * v1[0] + bflo(t.z), r5 = sigm(bfhi(g.z)) * v1[1] + bfhi(t.z), r6 = sigm(bflo(g.w)) * v1[2] + bflo(t.w), r7 = sigm(bfhi(g.w)) * v1[3] + bfhi(t.w);
                    u32x4 w; w.x = cvt_pk_bf16(r0, r1); w.y = cvt_pk_bf16(r2, r3); w.z = cvt_pk_bf16(r4, r5); w.w = cvt_pk_bf16(r6, r7);
                    *(u32x4*)(dst + o) = w; }
        }
    }
};
struct EpiOut {
    static constexpr bool PERM = true, AFTER_DRAIN = false;
    const bf16_t* xn; const float* irx; const float* gmix; bf16_t* h1b; float* rowss;
    __device__ __forceinline__ void operator()(const f32x4 (&acc)[2][2][4][2], const Unit& u, int wr, int wc, int fr, int fq) const {
        const int col0 = u.pn * BM + wc * 32 + 8 * fq;
        f32x4 ig[2][2];
#pragma unroll
        for (int bj = 0; bj < 2; ++bj)
#pragma unroll
            for (int n = 0; n < 2; ++n) { const f32x4 g = *(const f32x4*)(gmix + col0 + bj * HALF + 4 * n); ig[bj][n] = (f32x4){__builtin_amdgcn_rcpf(g[0]), __builtin_amdgcn_rcpf(g[1]), __builtin_amdgcn_rcpf(g[2]), __builtin_amdgcn_rcpf(g[3])}; }
#pragma unroll
        for (int ai = 0; ai < 2; ++ai) {
            u32x4 pre[4][2]; float ir[4];
#pragma unroll
            for (int m = 0; m < 4; ++m) { const int row = u.pm * BM + ai * HALF + wr * 64 + m * 16 + fr; ir[m] = irx[row];
#pragma unroll
                for (int bj = 0; bj < 2; ++bj) pre[m][bj] = *(const u32x4*)(xn + (size_t)row * LDP + col0 + bj * HALF); }
#pragma unroll
            for (int m = 0; m < 4; ++m) { const int row = u.pm * BM + ai * HALF + wr * 64 + m * 16 + fr; const size_t ro = (size_t)row * LDP + col0; float ss = 0.f;
#pragma unroll
                for (int bj = 0; bj < 2; ++bj) { const size_t o = ro + bj * HALF; const u32x4 p = pre[m][bj];
                    const f32x4 h0 = (f32x4){bflo(p.x), bfhi(p.x), bflo(p.y), bfhi(p.y)} * ir[m] * ig[bj][0] + acc[ai][bj][m][0], h1 = (f32x4){bflo(p.z), bfhi(p.z), bflo(p.w), bfhi(p.w)} * ir[m] * ig[bj][1] + acc[ai][bj][m][1];
                    u32x4 w; w.x = cvt_pk_bf16(h0[0], h0[1]); w.y = cvt_pk_bf16(h0[2], h0[3]); w.z = cvt_pk_bf16(h1[0], h1[1]); w.w = cvt_pk_bf16(h1[2], h1[3]); *(u32x4*)(h1b + o) = w;
                    ss += (h0[0] * h0[0] + h0[1] * h0[1]) + (h0[2] * h0[2] + h0[3] * h0[3]) + (h1[0] * h1[0] + h1[1] * h1[1]) + (h1[2] * h1[2] + h1[3] * h1[3]); }
                ss += __shfl_xor(ss, 16); ss += __shfl_xor(ss, 32);
                if (fq == 0) atomicAdd(rowss + row, ss); }
        }
    }
};
struct EpiUp {
    static constexpr bool PERM = true, AFTER_DRAIN = false;
    bf16_t* up; const float* rowss; int ldc;
    __device__ __forceinline__ void operator()(const f32x4 (&acc)[2][2][4][2], const Unit& u, int wr, int wc, int fr, int fq) const {
        const int row0 = u.pm * BM + wr * 64 + fr, col0 = u.pn * BM + wc * 32 + 8 * fq;
        float rsv[2][4];
#pragma unroll
        for (int ai = 0; ai < 2; ++ai)
#pragma unroll
            for (int m = 0; m < 4; ++m) rsv[ai][m] = rowss[row0 + ai * HALF + m * 16];
#pragma unroll
        for (int ai = 0; ai < 2; ++ai)
#pragma unroll
            for (int m = 0; m < 4; ++m) { const int row = row0 + ai * HALF + m * 16; const float rs = rsqrtf(rsv[ai][m] * (1.0f / 1024.0f) + 1e-6f); bf16_t* rowp = up + (size_t)row * ldc + col0;
#pragma unroll
                for (int bj = 0; bj < 2; ++bj) { const f32x4 v0 = acc[ai][bj][m][0] * rs, v1 = acc[ai][bj][m][1] * rs;
                    u32x4 w; w.x = cvt_pk_bf16(v0[0], v0[1]); w.y = cvt_pk_bf16(v0[2], v0[3]); w.z = cvt_pk_bf16(v1[0], v1[1]); w.w = cvt_pk_bf16(v1[2], v1[3]);
                    *(u32x4*)(rowp + bj * HALF) = w; } }
    }
};
struct EpiDown {
    static constexpr bool PERM = true, AFTER_DRAIN = false;
    const bf16_t* h1b; float* hout; float* rowss;
    __device__ __forceinline__ void operator()(const f32x4 (&acc)[2][2][4][2], const Unit& u, int wr, int wc, int fr, int fq) const {
        const int col0 = u.pn * BM + wc * 32 + 8 * fq;
#pragma unroll
        for (int ai = 0; ai < 2; ++ai) {
            u32x4 pre[4][2];
#pragma unroll
            for (int m = 0; m < 4; ++m)
#pragma unroll
                for (int bj = 0; bj < 2; ++bj) pre[m][bj] = *(const u32x4*)(h1b + (size_t)(u.pm * BM + ai * HALF + wr * 64 + m * 16 + fr) * LDP + col0 + bj * HALF);
#pragma unroll
            for (int m = 0; m < 4; ++m) { const int row = u.pm * BM + ai * HALF + wr * 64 + m * 16 + fr; const size_t ro = (size_t)row * LDP + col0; float ss = 0.f;
#pragma unroll
                for (int bj = 0; bj < 2; ++bj) { const size_t o = ro + bj * HALF; const u32x4 p = pre[m][bj];
                    const f32x4 h0 = (f32x4){bflo(p.x), bfhi(p.x), bflo(p.y), bfhi(p.y)} + acc[ai][bj][m][0], h1 = (f32x4){bflo(p.z), bfhi(p.z), bflo(p.w), bfhi(p.w)} + acc[ai][bj][m][1];
                    *(f32x4*)(hout + o) = h0; *(f32x4*)(hout + o + 4) = h1;
                    ss += (h0[0] * h0[0] + h0[1] * h0[1]) + (h0[2] * h0[2] + h0[3] * h0[3]) + (h1[0] * h1[0] + h1[1] * h1[1]) + (h1[2] * h1[2] + h1[3] * h1[3]); }
                ss += __shfl_xor(ss, 16); ss += __shfl_xor(ss, 32);
                if (fq == 0) atomicAdd(rowss + row, ss); }
        }
    }
};
struct PairOrder {
    int nM, nN, nwg, G, c;
    __host__ __device__ __forceinline__ void init(int M, int N, int G_, int c_) { nM = M / BM; nN = N / BM; nwg = nM * nN; G = G_; c = c_; }
    __host__ __device__ __forceinline__ bool next(int i, Unit& u) const {
        const long L = (long)(i >> 1) * G + c; if (L >= nwg) return false;
        int wgid = (int)L; { const int q = nwg / NXCD, r = nwg % NXCD, xcd = wgid % NXCD, off = wgid / NXCD; wgid = (xcd < r ? xcd * (q + 1) : r * (q + 1) + (xcd - r) * q) + off; }
        const int nig = WGM * nN, gid = wgid / nig, fm = gid * WGM, gsz = (nM - fm) < WGM ? (nM - fm) : WGM;
        u.pm = fm + ((wgid % nig) % gsz); u.pn = (wgid % nig) / gsz; u.sel = i & 1; return true;
    }
    __device__ __forceinline__ void a_ready(const Unit&) const {}
    __device__ __forceinline__ void done(const Unit&) const {}
};
template <class Epi, class Sched, bool ALIGN_EPI = false, bool SP2 = false>
__device__ __forceinline__ void gemm_phase(PG8_LAS unsigned char* lds, const Gemm g, const Sched& S, const Epi& E) {
    int tid_l = threadIdx.x; asm volatile("" : "+v"(tid_l));
    const int tid = tid_l, wid = __builtin_amdgcn_readfirstlane(tid >> 6), lane = tid & 63, wr = wid >> 2, wc = wid & 3, fr = lane & 15, fq = lane >> 4;
    const int K = g.K, nt = K / BK;
    unsigned voffA[2], voffB[2];
#pragma unroll
    for (int i = 0; i < 2; ++i) { int R, C; stage_rc(tid * 16 + i * 8192, R, C); const int Rb = Epi::PERM ? ((R & ~31) + perm32(R & 31)) : R;
        voffA[i] = (unsigned)(R * K + C) * 2u; voffB[i] = (unsigned)(Rb * K + C) * 2u; }
    const size_t kstep = (size_t)(BK * 2);
    const size_t hstep = (size_t)HALF * K * 2;
    const size_t tstep = 2 * hstep;
    const unsigned ldsw = (unsigned)wid * 1024u;
    const int aoff = lds_byte(wr * 64 + fr, fq * 8), boff = lds_byte(wc * 32 + fr, fq * 8);
#define PG8_SA(b, h) (((b) * 2 + (h)) * HTB)
#define PG8_SB(b, h) ((4 + (b) * 2 + (h)) * HTB)
#define PG8_STAGE(bufoff, gbase, voff) do { _Pragma("unroll") for (int _i = 0; _i < 2; ++_i) \
        __builtin_amdgcn_global_load_lds((const unsigned*)((const char*)(gbase) + (voff)[_i]), (PG8_LAS unsigned*)(lds + (bufoff) + ldsw + _i * 8192), 16, 0, 0); } while (0)
#define PG8_LDA(dst, b, h) do { _Pragma("unroll") for (int m = 0; m < 4; ++m) _Pragma("unroll") for (int k = 0; k < 2; ++k) dst[m][k] = *(const PG8_LAS bf16x8*)(lds + PG8_SA(b, h) + aoff + m * 2048 + k * 1024); } while (0)
#define PG8_LDB(dst, b, h) do { _Pragma("unroll") for (int n = 0; n < 2; ++n) _Pragma("unroll") for (int k = 0; k < 2; ++k) dst[n][k] = *(const PG8_LAS bf16x8*)(lds + PG8_SB(b, h) + boff + n * 2048 + k * 1024); } while (0)
#define PG8_MMA(ai, bj, At, Bt) do { __builtin_amdgcn_s_setprio(1); _Pragma("unroll") for (int m = 0; m < 4; ++m) _Pragma("unroll") for (int n = 0; n < 2; ++n) _Pragma("unroll") for (int k = 0; k < 2; ++k) \
        acc[ai][bj][m][n] = __builtin_amdgcn_mfma_f32_16x16x32_bf16(Bt[n][k], At[m][k], acc[ai][bj][m][n], 0, 0, 0); __builtin_amdgcn_s_setprio(0); } while (0)
#define PG8_WAIT_V(n) asm volatile("s_waitcnt vmcnt(" #n ")" ::: "memory")
#define PG8_WAIT_L(n) asm volatile("s_waitcnt lgkmcnt(" #n ")" ::: "memory")
#define PG8_BAR __builtin_amdgcn_s_barrier()
#define PG8_SCHED __builtin_amdgcn_sched_barrier(0)
    Unit cur, nxt; int ui = 0;
    if (!S.next(0, cur)) return;
    f32x4 acc[2][2][4][2];
#pragma unroll
    for (int a = 0; a < 2; ++a)
#pragma unroll
        for (int b = 0; b < 2; ++b)
#pragma unroll
            for (int m = 0; m < 4; ++m)
#pragma unroll
                for (int n = 0; n < 2; ++n) acc[a][b][m][n] = (f32x4){0.f, 0.f, 0.f, 0.f};
    bf16x8 At[4][2], B0[2][2], B1[2][2];
    const char* cA = (const char*)(cur.sel ? g.A1 : g.A0) + (size_t)cur.pm * tstep; const char* cB = (const char*)(cur.sel ? g.B1 : g.B0) + (size_t)cur.pn * tstep;
    S.a_ready(cur);
    if constexpr (SP2) {
        PG8_STAGE(PG8_SB(0, 0), cB, voffB); PG8_STAGE(PG8_SB(0, 1), cB + hstep, voffB); PG8_STAGE(PG8_SA(0, 0), cA, voffA); PG8_STAGE(PG8_SA(0, 1), cA + hstep, voffA);
        if (wr == 1) PG8_BAR;
        PG8_WAIT_V(2); PG8_BAR;
        PG8_STAGE(PG8_SB(1, 0), cB + kstep, voffB); PG8_STAGE(PG8_SA(1, 0), cA + kstep, voffA); PG8_STAGE(PG8_SB(1, 1), cB + hstep + kstep, voffB);
        PG8_WAIT_V(6); PG8_BAR;
    } else {
        PG8_STAGE(PG8_SB(0, 0), cB, voffB); PG8_STAGE(PG8_SA(0, 0), cA, voffA); PG8_STAGE(PG8_SB(0, 1), cB + hstep, voffB); PG8_STAGE(PG8_SA(0, 1), cA + hstep, voffA);
        if (wr == 1) PG8_BAR;
        PG8_WAIT_V(4); PG8_BAR;
        PG8_STAGE(PG8_SB(1, 0), cB + kstep, voffB); PG8_STAGE(PG8_SA(1, 0), cA + kstep, voffA); PG8_STAGE(PG8_SB(1, 1), cB + hstep + kstep, voffB);
        PG8_WAIT_V(6); PG8_BAR;
    }
    for (;;) {
        const bool has_next = S.next(ui + 1, nxt);
        const char* nA = has_next ? (const char*)(nxt.sel ? g.A1 : g.A0) + (size_t)nxt.pm * tstep : cA; const char* nB = has_next ? (const char*)(nxt.sel ? g.B1 : g.B0) + (size_t)nxt.pn * tstep : cB;
        for (int t = 0; t < nt; t += 2) {
            const bool last = (t == nt - 2);
            const char* a1 = cA + (size_t)(t + 1) * kstep;
            const char* a2 = last ? nA : cA + (size_t)(t + 2) * kstep; const char* b2 = last ? nB : cB + (size_t)(t + 2) * kstep;
            const char* a3 = a2 + kstep; const char* b3 = b2 + kstep;
            if (last && has_next) S.a_ready(nxt);
            if constexpr (SP2) {
            PG8_LDB(B0, 0, 0); PG8_LDB(B1, 0, 1); PG8_SCHED; PG8_LDA(At, 0, 0); PG8_STAGE(PG8_SA(1, 1), a1 + hstep, voffA);
            PG8_WAIT_V(8); PG8_WAIT_L(0); PG8_BAR; PG8_MMA(0, 0, At, B0); PG8_MMA(0, 1, At, B1); PG8_BAR; PG8_SCHED;
            PG8_LDA(At, 0, 1); PG8_STAGE(PG8_SB(0, 0), b2, voffB); PG8_STAGE(PG8_SB(0, 1), b2 + hstep, voffB); PG8_STAGE(PG8_SA(0, 0), a2, voffA);
            PG8_WAIT_V(8); PG8_WAIT_L(0); PG8_BAR; PG8_MMA(1, 0, At, B0); PG8_MMA(1, 1, At, B1); PG8_BAR; PG8_SCHED;
            PG8_LDB(B0, 1, 0); PG8_LDB(B1, 1, 1); PG8_SCHED; PG8_LDA(At, 1, 0); PG8_STAGE(PG8_SA(0, 1), a2 + hstep, voffA);
            PG8_WAIT_V(8); PG8_WAIT_L(0); PG8_BAR; PG8_MMA(0, 0, At, B0); PG8_MMA(0, 1, At, B1); PG8_BAR; PG8_SCHED;
            PG8_LDA(At, 1, 1); PG8_STAGE(PG8_SB(1, 0), b3, voffB); PG8_STAGE(PG8_SB(1, 1), b3 + hstep, voffB); PG8_STAGE(PG8_SA(1, 0), a3, voffA);
            PG8_WAIT_V(8); PG8_WAIT_L(0); PG8_BAR; PG8_MMA(1, 0, At, B0); PG8_MMA(1, 1, At, B1); PG8_BAR; PG8_SCHED;
            } else {
            PG8_LDB(B0, 0, 0); PG8_SCHED; PG8_LDA(At, 0, 0); PG8_STAGE(PG8_SA(1, 1), a1 + hstep, voffA);
            PG8_WAIT_L(8); PG8_BAR; PG8_WAIT_L(0); PG8_MMA(0, 0, At, B0); PG8_BAR; PG8_SCHED;
            PG8_LDB(B1, 0, 1); PG8_STAGE(PG8_SB(0, 0), b2, voffB);
            PG8_BAR; PG8_WAIT_L(0); PG8_MMA(0, 1, At, B1); PG8_BAR;
            PG8_LDA(At, 0, 1); PG8_STAGE(PG8_SA(0, 0), a2, voffA);
            PG8_BAR; PG8_WAIT_L(0); PG8_MMA(1, 0, At, B0); PG8_BAR; PG8_SCHED;
            PG8_STAGE(PG8_SB(0, 1), b2 + hstep, voffB);
            PG8_WAIT_V(6); PG8_BAR; PG8_MMA(1, 1, At, B1); PG8_BAR;
            PG8_LDB(B0, 1, 0); PG8_SCHED; PG8_LDA(At, 1, 0); PG8_STAGE(PG8_SA(0, 1), a2 + hstep, voffA);
            PG8_WAIT_L(8); PG8_BAR; PG8_WAIT_L(0); PG8_MMA(0, 0, At, B0); PG8_BAR; PG8_SCHED;
            PG8_LDB(B1, 1, 1); PG8_STAGE(PG8_SB(1, 0), b3, voffB);
            PG8_BAR; PG8_WAIT_L(0); PG8_MMA(0, 1, At, B1); PG8_BAR;
            PG8_LDA(At, 1, 1); PG8_STAGE(PG8_SA(1, 0), a3, voffA);
            PG8_BAR; PG8_WAIT_L(0); PG8_MMA(1, 0, At, B0); PG8_BAR; PG8_SCHED;
            PG8_STAGE(PG8_SB(1, 1), b3 + hstep, voffB);
            PG8_WAIT_V(6); PG8_BAR; PG8_MMA(1, 1, At, B1); PG8_BAR;
            }
        }
        if constexpr (ALIGN_EPI) { if (wr == 0) PG8_BAR; }
        if constexpr (!Epi::AFTER_DRAIN) { E(acc, cur, wr, wc, fr, fq); S.done(cur); }
        if (!has_next) break;
#pragma unroll
        for (int a = 0; a < 2; ++a)
#pragma unroll
            for (int b = 0; b < 2; ++b)
#pragma unroll
                for (int m = 0; m < 4; ++m)
#pragma unroll
                    for (int n = 0; n < 2; ++n) acc[a][b][m][n] = (f32x4){0.f, 0.f, 0.f, 0.f};
        cur = nxt; cA = nA; cB = nB; ++ui;
        if constexpr (ALIGN_EPI) { if (wr == 1) PG8_BAR; }
    }
    PG8_WAIT_V(0);
    if constexpr (!ALIGN_EPI) { if (wr == 0) PG8_BAR; }
    PG8_BAR;
    if constexpr (Epi::AFTER_DRAIN) { E.fused(acc, cur, wr, wc, fr, fq, lds, wid, lane); S.done(cur); }
#undef PG8_SA
#undef PG8_SB
#undef PG8_STAGE
#undef PG8_LDA
#undef PG8_LDB
#undef PG8_MMA
#undef PG8_WAIT_V
#undef PG8_WAIT_L
#undef PG8_BAR
#undef PG8_SCHED
}
}

namespace fox {
constexpr int D = 128, PITCH = 1024;
constexpr bool WSKIP = false;
constexpr float THR = 8.f;
constexpr float SCALE = 0.08838834764831845f;
constexpr int NW = 8, QBLK = 32, KVBLK = 64, QB = NW * QBLK;
constexpr int SHM_V = KVBLK * D * 2, SHM_K = KVBLK * D * 2;
constexpr int LDS_BYTES = 2 * SHM_V + 2 * SHM_K + NW * 64 * 4;
using bf16 = __hip_bfloat16;
typedef short bf16x8 __attribute__((ext_vector_type(8)));
typedef short s16x4 __attribute__((ext_vector_type(4)));
typedef float f32x16 __attribute__((ext_vector_type(16)));
typedef float f32x4 __attribute__((ext_vector_type(4)));
typedef unsigned u32x4 __attribute__((ext_vector_type(4)));
template <class A, class Bt> struct same_t { static constexpr bool v = false; };
template <class A> struct same_t<A, A> { static constexpr bool v = true; };
__device__ __forceinline__ void bias_tile(f32x16& p0, f32x16& p1, const float* cbp) {
#pragma unroll
    for (int rr = 0; rr < 4; ++rr) { const f32x4 a = *(const f32x4*)(cbp + 8 * rr), b = *(const f32x4*)(cbp + 32 + 8 * rr);
#pragma unroll
        for (int e = 0; e < 4; ++e) { p0[4 * rr + e] += a[e]; p1[4 * rr + e] += b[e]; } }
}
#define KSWZ(row, colB) ((row) * 256 + ((colB) ^ (((row) & 7) << 4)))
#define SBAR() __builtin_amdgcn_sched_barrier(0)
__device__ __forceinline__ int v_st(int k, int c) { const int kk = (k & ~0xC) | ((k & 4) << 1) | ((k & 8) >> 1); return ((kk >> 3) * 4 + (c >> 5)) * 512 + ((kk & 7) * 32 + (c & 31)) * 2; }
__device__ __forceinline__ int v_rd_base(int lane) { return ((lane & 3) << 3) | (((lane >> 2) & 3) << 6) | (((lane >> 4) & 1) << 5) | (((lane >> 5) & 1) << 8); }
constexpr int v_rd_off(int d0, int ks, int half) { return d0 * 512 + ks * 4096 + half * 2048; }
__device__ __forceinline__ int crow(int r, int hi) { return (r & 3) + 8 * (r >> 2) + 4 * hi; }
__device__ __forceinline__ unsigned cvtpk(float lo, float hi) {
    unsigned r; asm volatile("v_cvt_pk_bf16_f32 %0, %1, %2" : "=v"(r) : "v"(lo), "v"(hi)); return r;
}
__device__ __forceinline__ bf16x8 pack8(f32x4 a, f32x4 b) {
    u32x4 w = {cvtpk(a[0], a[1]), cvtpk(a[2], a[3]), cvtpk(b[0], b[1]), cvtpk(b[2], b[3])};
    return *reinterpret_cast<bf16x8*>(&w);
}
template <class T> __device__ __forceinline__ bf16x8 load8(const T* p) {
    if constexpr (same_t<T, float>::v) { return pack8(*(const f32x4*)p, *(const f32x4*)(p + 4)); }
    else { return *reinterpret_cast<const bf16x8*>(p); }
}
__device__ __forceinline__ void mask_tile(f32x16& p0, f32x16& p1, int dq, unsigned W) {
    const float NEG = -__builtin_inff();
#pragma unroll
    for (int r = 0; r < 16; ++r) {
        const int c = (r & 3) + 8 * (r >> 2);
        if ((unsigned)(dq - c) >= W) p0[r] = NEG;
        if ((unsigned)(dq - c - 32) >= W) p1[r] = NEG;
    }
}
__device__ __forceinline__ void partialSM(f32x16& p0, f32x16& p1, float& m_reg, float& mn, float& alpha) {
    float pmax = p0[0]; for (int r = 1; r < 16; ++r) pmax = fmaxf(pmax, p0[r]); for (int r = 0; r < 16; ++r) pmax = fmaxf(pmax, p1[r]);
    { auto rr = __builtin_amdgcn_permlane32_swap(__float_as_uint(pmax), __float_as_uint(pmax), false, false);
      pmax = fmaxf(__uint_as_float(rr[0]), __uint_as_float(rr[1])); }
    constexpr float C2 = 1.4426950408889634f * SCALE;
    if (__builtin_expect(__all((pmax - m_reg) * SCALE <= THR), 1)) { mn = m_reg; alpha = 1.f; }
    else { mn = fmaxf(m_reg, pmax); alpha = __builtin_amdgcn_exp2f((m_reg - mn) * C2); m_reg = mn; }
    const float mnL = -mn * C2;
    for (int r = 0; r < 16; ++r) p0[r] = fmaf(p0[r], C2, mnL); for (int r = 0; r < 16; ++r) p1[r] = fmaf(p1[r], C2, mnL);
    for (int r = 0; r < 16; ++r) p0[r] = __builtin_amdgcn_exp2f(p0[r]);
}
__device__ __forceinline__ void finishSM(f32x16& p0, f32x16& p1, float alpha, float& l_reg, bf16x8& pa0, bf16x8& pa1, bf16x8& pa2, bf16x8& pa3) {
    for (int r = 0; r < 16; ++r) p1[r] = __builtin_amdgcn_exp2f(p1[r]);
    float ps = 0; for (int r = 0; r < 16; ++r) ps += p0[r]; for (int r = 0; r < 16; ++r) ps += p1[r];
    { auto rr = __builtin_amdgcn_permlane32_swap(__float_as_uint(ps), __float_as_uint(ps), false, false);
      ps = __uint_as_float(rr[0]) + __uint_as_float(rr[1]); }
    l_reg = l_reg * alpha + ps;
#define PK4(P, B_, OUT) do { unsigned a0 = cvtpk(P[B_+0], P[B_+1]), a1 = cvtpk(P[B_+2], P[B_+3]);                          \
        unsigned b0 = cvtpk(P[B_+4], P[B_+5]), b1 = cvtpk(P[B_+6], P[B_+7]);                                             \
        auto r0 = __builtin_amdgcn_permlane32_swap(a0, b0, false, false); auto r1 = __builtin_amdgcn_permlane32_swap(a1, b1, false, false); \
        u32x4 w = {r0[0], r1[0], r0[1], r1[1]}; OUT = *reinterpret_cast<bf16x8*>(&w); } while (0)
    PK4(p0, 0, pa0); PK4(p0, 8, pa1); PK4(p1, 0, pa2); PK4(p1, 8, pa3);
#undef PK4
}
template <int KB, bool SK>
__device__ __forceinline__ void qkt(f32x16& p0, f32x16& p1, const char* K_lds, int r32, int hi, const bf16x8* qr, bool act, const float* cbp) {
    if (SK && !act) { const float NEG = -__builtin_inff();
#pragma unroll
        for (int r = 0; r < 16; ++r) { p0[r] = NEG; p1[r] = NEG; } return; }
    { const f32x4* c4 = (const f32x4*)cbp; const f32x4 a0 = c4[0], a1 = c4[2], a2 = c4[4], a3 = c4[6], b0 = c4[8], b1 = c4[10], b2 = c4[12], b3 = c4[14];
      p0 = (f32x16){a0[0], a0[1], a0[2], a0[3], a1[0], a1[1], a1[2], a1[3], a2[0], a2[1], a2[2], a2[3], a3[0], a3[1], a3[2], a3[3]};
      p1 = (f32x16){b0[0], b0[1], b0[2], b0[3], b1[0], b1[1], b1[2], b1[3], b2[0], b2[1], b2[2], b2[3], b3[0], b3[1], b3[2], b3[3]}; }
    const char* kb[4];
#pragma unroll
    for (int dd = 0; dd < 4; ++dd) kb[dd] = K_lds + KB * SHM_K + KSWZ(r32, (dd * 16 + hi * 8) * 2);
#pragma unroll
    for (int d0 = 0; d0 < 8; ++d0) { const char* a = kb[d0 & 3] + (d0 >> 2) * 128;
        bf16x8 b0 = *reinterpret_cast<const bf16x8*>(a);
        bf16x8 b1 = *reinterpret_cast<const bf16x8*>(a + 32 * 256);
        p0 = __builtin_amdgcn_mfma_f32_32x32x16_bf16(b0, qr[d0], p0, 0, 0, 0);
        p1 = __builtin_amdgcn_mfma_f32_32x32x16_bf16(b1, qr[d0], p1, 0, 0, 0); }
}
template <int VB, bool SK>
__device__ __forceinline__ void pv_tile(f32x16* o, int vb0, bf16x8 pa0, bf16x8 pa1, bf16x8 pa2, bf16x8 pa3, bool act) {
    if (SK && !act) return;
#define TRRD(dst, off) asm volatile("ds_read_b64_tr_b16 %0, %1 offset:%2" : "=&v"(dst) : "v"(vb0), "i"(off) : "memory")
#define PV_D0(d0) do { s16x4 l0, l1, l2, l3, h0, h1, h2, h3; constexpr int b_ = VB * SHM_V + v_rd_off(d0, 0, 0);     \
        TRRD(l0, b_); TRRD(h0, b_ + 2048); TRRD(l1, b_ + 4096); TRRD(h1, b_ + 6144); TRRD(l2, b_ + 8192); TRRD(h2, b_ + 10240); TRRD(l3, b_ + 12288); TRRD(h3, b_ + 14336); \
        asm volatile("s_waitcnt lgkmcnt(0)" ::: "memory"); SBAR();                 \
        o[d0] = __builtin_amdgcn_mfma_f32_32x32x16_bf16(pa0, (bf16x8){l0[0], l0[1], l0[2], l0[3], h0[0], h0[1], h0[2], h0[3]}, o[d0], 0, 0, 0);   \
        o[d0] = __builtin_amdgcn_mfma_f32_32x32x16_bf16(pa1, (bf16x8){l1[0], l1[1], l1[2], l1[3], h1[0], h1[1], h1[2], h1[3]}, o[d0], 0, 0, 0);   \
        o[d0] = __builtin_amdgcn_mfma_f32_32x32x16_bf16(pa2, (bf16x8){l2[0], l2[1], l2[2], l2[3], h2[0], h2[1], h2[2], h2[3]}, o[d0], 0, 0, 0);   \
        o[d0] = __builtin_amdgcn_mfma_f32_32x32x16_bf16(pa3, (bf16x8){l3[0], l3[1], l3[2], l3[3], h3[0], h3[1], h3[2], h3[3]}, o[d0], 0, 0, 0); } while (0)
    PV_D0(0); PV_D0(1); PV_D0(2); PV_D0(3);
#undef PV_D0
#undef TRRD
}

template <class TIn, class TOut> struct BlockRef { const TIn* Q; const TIn* K; const TIn* V; TOut* O; int P0; };
template <class TIn> struct Seam {
    bf16x8 qr[8];
    bf16x8 st_v0, st_v1, st_k0, st_k1; f32x4 sf0, sf1, sf2, sf3;
    f32x4 tq[16];
};
__device__ __forceinline__ int swa_jlo(int P0, int W) { const int lowk = P0 - W + 1; return lowk > 0 ? lowk / KVBLK : 0; }
#define ROW(p, k0, rr) ((p) + (size_t)((k0) + (rr)) * PITCH + sc)
#define VMW() asm volatile("s_waitcnt vmcnt(0)" ::: "memory")
#define VMWN(n) asm volatile("s_waitcnt vmcnt(%0)" :: "i"(n) : "memory")
#define SLOAD_H(Kp, Vp, k0) do { S.st_v0 = load8<TIn>(ROW(Vp, k0, sr)); S.st_v1 = load8<TIn>(ROW(Vp, k0, 32 + sr));              \
                         S.st_k0 = load8<TIn>(ROW(Kp, k0, sr)); S.st_k1 = load8<TIn>(ROW(Kp, k0, 32 + sr)); } while (0)
#define SWRITE_HK(bf) do { *(bf16x8*)(K_lds + (bf) * SHM_K + kws) = S.st_k0; *(bf16x8*)(K_lds + (bf) * SHM_K + kws + 32 * 256) = S.st_k1; } while (0)
#define SWRITE_HV(bf) do { *(bf16x8*)(V_lds + (bf) * SHM_V + vst0) = S.st_v0; *(bf16x8*)(V_lds + (bf) * SHM_V + vst1) = S.st_v1; } while (0)
#define SWRITE_H(bf) do { SWRITE_HV(bf); SWRITE_HK(bf); } while (0)
#define SLOAD_F(p, k0) do { S.sf0 = *(const f32x4*)ROW(p, k0, sr); S.sf1 = *(const f32x4*)(ROW(p, k0, sr) + 4);                \
                            S.sf2 = *(const f32x4*)ROW(p, k0, 32 + sr); S.sf3 = *(const f32x4*)(ROW(p, k0, 32 + sr) + 4); } while (0)
#define SWRITE_KF(bf) do { *(bf16x8*)(K_lds + (bf) * SHM_K + kws) = pack8(S.sf0, S.sf1); *(bf16x8*)(K_lds + (bf) * SHM_K + kws + 32 * 256) = pack8(S.sf2, S.sf3); } while (0)
#define SWRITE_VF(bf) do { *(bf16x8*)(V_lds + (bf) * SHM_V + vst0) = pack8(S.sf0, S.sf1); *(bf16x8*)(V_lds + (bf) * SHM_V + vst1) = pack8(S.sf2, S.sf3); } while (0)
template <class TIn, class TOut>
__device__ __forceinline__ void causal_swa_prime(const BlockRef<TIn, TOut>& cur, int W, char* lds, Seam<TIn>& S) {
    constexpr bool F32 = same_t<TIn, float>::v;
    int tid_l = threadIdx.x; asm volatile("" : "+v"(tid_l));
    const int tid = tid_l, wid = __builtin_amdgcn_readfirstlane(tid >> 6), lane = tid & 63, r32 = lane & 31, hi = lane >> 5;
    const int sr = tid >> 4, sc = (tid & 15) * 8, kws = KSWZ(sr, sc * 2); char* K_lds = lds + 2 * SHM_V;
    const int kb0 = swa_jlo(cur.P0, W) * KVBLK;
    for (int d0 = 0; d0 < 8; ++d0) S.qr[d0] = load8<TIn>(cur.Q + (size_t)(wid * QBLK + r32) * PITCH + d0 * 16 + hi * 8);
    if constexpr (F32) { SLOAD_F((const float*)cur.K, kb0); VMW(); SWRITE_KF(0); SBAR(); SLOAD_F((const float*)cur.V, kb0); }
    else { SLOAD_H(cur.K, cur.V, kb0); VMW(); SWRITE_HK(0); }
    __syncthreads();
}
template <class TIn, class TOut>
__device__ __forceinline__ void causal_swa_block(const BlockRef<TIn, TOut>& cur, const BlockRef<TIn, TOut>& nxt, int skv, int W, char* lds, Seam<TIn>& S, const float* cbias) {
    constexpr bool F32 = same_t<TIn, float>::v;
    int tid_l = threadIdx.x; asm volatile("" : "+v"(tid_l));
    const int tid = tid_l, wid = __builtin_amdgcn_readfirstlane(tid >> 6), lane = tid & 63, r32 = lane & 31, hi = lane >> 5;
    const int j_lo = swa_jlo(cur.P0, W);
    int j_hi = (cur.P0 + QB - 1) / KVBLK + 1; if (j_hi > skv / KVBLK) j_hi = skv / KVBLK;
    const int NT = j_hi - j_lo;
    const int kbn = swa_jlo(nxt.P0, W) * KVBLK;
    const int qlo = cur.P0 + wid * QBLK, qm = qlo + r32 - 4 * hi;
    char* V_lds = lds; char* K_lds = lds + 2 * SHM_V;
    float* ws = (float*)(lds + 2 * SHM_V + 2 * SHM_K) + wid * 64; float* li_l = ws, * al_l = ws + 32;
    float m_reg = -1e30f, l_reg = 0; f32x16 o[4] = {};
    const int sr = tid >> 4, sc = (tid & 15) * 8, vst0 = v_st(sr, sc), vst1 = v_st(32 + sr, sc), kws = KSWZ(sr, sc * 2);
    const int vb0 = (int)(uintptr_t)V_lds + v_rd_base(lane);
    const TIn* Kh = cur.K; const TIn* Vh = cur.V;
#define RESC(a) do { if (__any((a) < 1.f)) { if (hi == 0) al_l[r32] = (a); asm volatile("s_waitcnt lgkmcnt(0)" ::: "memory");              \
                     for (int d_ = 0; d_ < 4; ++d_) for (int r = 0; r < 16; ++r) o[d_][r] *= al_l[crow(r, hi)]; } } while (0)
#define KBASE(t) ((j_lo + (t)) * KVBLK)
#define ACT(t) (KBASE(t) <= qlo + QBLK - 1 && KBASE(t) + KVBLK - 1 >= qlo - W + 1)
#define MASKT(P0_, P1_, t) do { const int kb_ = KBASE(t); if ((!SK || ACT(t)) && (kb_ + KVBLK - 1 > qlo || kb_ <= qlo + QBLK - 1 - W)) mask_tile(P0_, P1_, qm - kb_, (unsigned)W); } while (0)
    constexpr int NQL = F32 ? 16 : 8;
    constexpr bool SK = WSKIP && !F32;
#define SEAM_K0() do { VMWN(NQL); if constexpr (F32) { SWRITE_KF(0); SBAR(); SLOAD_F((const float*)nxt.V, kbn); } else { SWRITE_HK(0); } SBAR(); } while (0)
    f32x16 pA0, pA1, pB0, pB1; float mnA, mnB, alA, alB; bf16x8 pa0, pa1, pa2, pa3;
    if constexpr (F32) { VMW(); SWRITE_VF(0); SBAR(); } else { SWRITE_HV(0); SBAR(); }
    if (NT > 1) { if constexpr (F32) SLOAD_F((const float*)Kh, KBASE(1)); else SLOAD_H(Kh, Vh, KBASE(1)); }
    SBAR(); qkt<0, SK>(pA0, pA1, K_lds, r32, hi, S.qr, ACT(0), cbias + KBASE(0) + 4 * hi);
    if constexpr (F32) { if (NT > 1) { VMW(); SWRITE_KF(1); SBAR(); SLOAD_F((const float*)Vh, KBASE(1)); } }
    MASKT(pA0, pA1, 0); partialSM(pA0, pA1, m_reg, mnA, alA);
    if (NT > 1) { VMW(); if constexpr (F32) { SWRITE_VF(1); SBAR(); if (NT > 2) SLOAD_F((const float*)Kh, KBASE(2)); } else SWRITE_H(1); }
    __syncthreads();
#define HALF_STEP(PX0, PX1, mnX, alX, PY0, PY1, alY, t, KB, VB, SB) do {                                                      \
        SBAR(); qkt<KB, SK>(PX0, PX1, K_lds, r32, hi, S.qr, ACT(t), cbias + KBASE(t) + 4 * hi);                                             \
        finishSM(PY0, PY1, alY, l_reg, pa0, pa1, pa2, pa3); SBAR();                                                           \
        if ((t) + 1 < NT) { if constexpr (F32) { VMW(); SWRITE_KF(SB); SBAR(); SLOAD_F((const float*)Vh, KBASE((t) + 1)); }  \
                            else { SLOAD_H(Kh, Vh, KBASE((t) + 1)); } SBAR(); }                                               \
        pv_tile<VB, SK>(o, vb0, pa0, pa1, pa2, pa3, ACT((t) - 1)); MASKT(PX0, PX1, (t)); partialSM(PX0, PX1, m_reg, mnX, alX);                                        \
        __syncthreads();                                                                                                      \
        if ((t) + 1 < NT) { VMW(); if constexpr (F32) { SWRITE_VF(SB); SBAR(); if ((t) + 2 < NT) SLOAD_F((const float*)Kh, KBASE((t) + 2)); } \
                            else { SWRITE_H(SB); } }                                                                          \
        RESC(alX); __syncthreads(); } while (0)
    for (int t = 1; t + 1 < NT; t += 2) {
        HALF_STEP(pB0, pB1, mnB, alB, pA0, pA1, alA, t, 1, 0, 0);
        HALF_STEP(pA0, pA1, mnA, alA, pB0, pB1, alB, t + 1, 0, 1, 1);
    }
    const bool even = (NT & 1) == 0;
    if (even) { SBAR(); qkt<1, SK>(pB0, pB1, K_lds, r32, hi, S.qr, ACT(NT - 1), cbias + KBASE(NT - 1) + 4 * hi); SBAR(); }
#define QROW(e) (nxt.Q + (size_t)(wid * QBLK + r32) * PITCH + ((e) >> 1) * 16 + hi * 8 + ((e) & 1) * 4)
    if constexpr (F32) { SLOAD_F((const float*)nxt.K, kbn); SBAR();
#pragma unroll
        for (int e = 0; e < 8; ++e) S.tq[e] = *(const f32x4*)QROW(e); }
    else { SLOAD_H(nxt.K, nxt.V, kbn); SBAR();
#pragma unroll
        for (int d0 = 0; d0 < 8; ++d0) S.qr[d0] = load8<TIn>(nxt.Q + (size_t)(wid * QBLK + r32) * PITCH + d0 * 16 + hi * 8); }
    SBAR();
    finishSM(pA0, pA1, alA, l_reg, pa0, pa1, pa2, pa3); SBAR();
    if constexpr (F32) {
#pragma unroll
        for (int e = 8; e < 16; ++e) S.tq[e] = *(const f32x4*)QROW(e); SBAR(); }
#undef QROW
    pv_tile<0, SK>(o, vb0, pa0, pa1, pa2, pa3, ACT(even ? NT - 2 : NT - 1));
    if (even) { MASKT(pB0, pB1, NT - 1); partialSM(pB0, pB1, m_reg, mnB, alB); __syncthreads(); RESC(alB);
        finishSM(pB0, pB1, alB, l_reg, pa0, pa1, pa2, pa3); SBAR(); pv_tile<1, SK>(o, vb0, pa0, pa1, pa2, pa3, ACT(NT - 1)); }
    SBAR(); SEAM_K0();
    if (hi == 0) li_l[r32] = l_reg; asm volatile("s_waitcnt lgkmcnt(0)" ::: "memory");
    float rli[16];
#pragma unroll
    for (int r = 0; r < 16; ++r) rli[r] = __builtin_amdgcn_rcpf(li_l[crow(r, hi)]);
    TOut* Ow = cur.O + (size_t)(wid * QBLK) * PITCH;
#pragma unroll
    for (int r = 0; r < 16; ++r) { const int orow = crow(r, hi);
#pragma unroll
        for (int d0 = 0; d0 < 4; ++d0) { const float v = o[d0][r] * rli[r];
            if constexpr (same_t<TOut, float>::v) { Ow[(size_t)orow * PITCH + d0 * 32 + r32] = v; }
            else { const float vn = __shfl_xor(v, 1);
                   if ((r32 & 1) == 0) *(unsigned*)(Ow + (size_t)orow * PITCH + d0 * 32 + r32) = cvtpk(v, vn); } } }
    if constexpr (F32) {
#pragma unroll
        for (int d0 = 0; d0 < 8; ++d0) S.qr[d0] = pack8(S.tq[2 * d0], S.tq[2 * d0 + 1]); }
    __syncthreads();
#undef RESC
#undef KBASE
#undef ACT
#undef MASKT
#undef SEAM_K0
#undef HALF_STEP
}
#undef ROW
#undef VMW
#undef VMWN
#undef SLOAD_H
#undef SWRITE_HK
#undef SWRITE_HV
#undef SWRITE_H
#undef SLOAD_F
#undef SWRITE_KF
#undef SWRITE_VF
}

typedef unsigned short bf16_t;
typedef short bf16x8 __attribute__((ext_vector_type(8)));
typedef float f32x4 __attribute__((ext_vector_type(4)));
typedef unsigned u32x4 __attribute__((ext_vector_type(4)));
typedef unsigned u32x2 __attribute__((ext_vector_type(2)));
constexpr int DM = 1024, NB = 32, SEQ = 2048, NH = 8, HD = 128, DFF = 2816, NUP = 2 * DFF;
constexpr int MTOK = NB * SEQ;
constexpr int NG = 2, BG = NB / NG, GM = BG * SEQ;
constexpr int NIN = 37 * 256;
constexpr int NCH = BG * NH * 32;
static_assert(GM == pg8::GM, "group rows");
constexpr size_t MiB = 1u << 20;
constexpr size_t WS_CTL = 0;
constexpr size_t WS_WIN = 1 * MiB, WS_WBF = 20 * MiB, WS_WBG = 22 * MiB, WS_WOUT = 24 * MiB, WS_WUP = 26 * MiB, WS_WDN = 37 * MiB;
constexpr size_t WS_PROJ = 44 * MiB;
constexpr size_t WS_SMALL = 620 * MiB;
constexpr size_t WS_PREP = 624 * MiB;
constexpr size_t WS_END = 913 * MiB;
constexpr size_t PBUF = 64 * MiB;
constexpr size_t WS_H1B = WS_PROJ + 0 * PBUF;
constexpr size_t WS_T1 = WS_PROJ + 1 * PBUF;
constexpr size_t WS_Y = WS_PROJ + 2 * PBUF;
constexpr size_t WS_YGDN = WS_PROJ + 3 * PBUF;
constexpr size_t WS_YFOX = WS_PROJ + 5 * PBUF;
constexpr size_t WS_UP = WS_PROJ + 3 * PBUF;
constexpr size_t WS_ACT = WS_PREP;
constexpr size_t PROJ_STRIDE = (size_t)GM * 1024;
constexpr int LDS_BYTES = 163840;

__device__ __forceinline__ float bf2f(bf16_t b) { return __uint_as_float((unsigned)b << 16); }
__device__ __forceinline__ float bflo(unsigned w) { return __uint_as_float(w << 16); }
__device__ __forceinline__ float bfhi(unsigned w) { return __uint_as_float(w & 0xffff0000u); }
typedef float f32x2_t __attribute__((ext_vector_type(2))); typedef __bf16 bf16x2_t __attribute__((ext_vector_type(2)));
__device__ __forceinline__ unsigned pk2(float lo, float hi) { f32x2_t v = {lo, hi}; bf16x2_t b = __builtin_convertvector(v, bf16x2_t); return __builtin_bit_cast(unsigned, b); }
__device__ __forceinline__ bf16_t f2bf(float f) { return (bf16_t)(pk2(f, 0.f) & 0xffffu); }
__device__ __forceinline__ float siluf(float y) { return y * __builtin_amdgcn_rcpf(1.0f + __expf(-y)); }
__device__ __forceinline__ float wave_sum(float v) {
#pragma unroll
    for (int o = 1; o < 64; o <<= 1) v += __shfl_xor(v, o);
    return v;
}

struct Args { const float* in[16]; float* out; unsigned char* ws; int ph_lo, ph_hi; };
struct Ptrs {
    const float *x, *norm_mix, *w_in, *fox_f_bias, *gdn_conv_w, *gdn_a_log, *gdn_dt_bias, *gdn_norm, *w_bf, *w_bg, *w_out, *norm_ffn, *w_up, *ffn_conv_w, *w_down, *norm_final;
    float* out; unsigned char* ws;
};

template <int MODE> __device__ __forceinline__ int srccol(int n) {
    if (MODE == 0) return n;
    if (MODE == 1) {
        if (n < 3072) return n;
        if (n < 6144) return 3080 + (n - 3072);
        if (n < 9216) return 6168 + (n - 6144);
        const int s = n - 9216;
        if (s < 8) return 3072 + s;
        if (s < 16) return 6152 + (s - 8);
        if (s < 24) return 6160 + (s - 16);
        return -1;
    }
    { const int p = n >> 8, s = (n >> 7) & 1, i = n & 127; return s * DFF + 128 * p + i; }
}
template <int MODE> __device__ __forceinline__ void transpose_item(const float* W, int K, int N, const float* ksc, bf16_t* WT, float* scr, int item, int nblk, int lane) {
    const int kb = item / nblk, nb = item % nblk, k0 = 64 * kb, n0 = 32 * nb;
    const int sc = srccol<MODE>(n0 + (lane & 31));
    float tv[32];
    const int scc = sc >= 0 ? sc : 0;
#pragma unroll
    for (int i = 0; i < 32; ++i) tv[i] = W[(size_t)(k0 + 2 * i + (lane >> 5)) * N + scc];
    if (ksc) {
#pragma unroll
        for (int i = 0; i < 32; ++i) tv[i] *= ksc[k0 + 2 * i + (lane >> 5)]; }
#pragma unroll
    for (int i = 0; i < 32; ++i) scr[(2 * i + (lane >> 5)) * 33 + (lane & 31)] = (sc >= 0) ? tv[i] : 0.f;
    asm volatile("s_waitcnt lgkmcnt(0)" ::: "memory");
    const int c = lane & 7;
#pragma unroll
    for (int j = 0; j < 4; ++j) { const int n = (lane >> 3) + 8 * j; const float* s = scr + (8 * c) * 33 + n;
        u32x4 o; o.x = pk2(s[0 * 33], s[1 * 33]); o.y = pk2(s[2 * 33], s[3 * 33]); o.z = pk2(s[4 * 33], s[5 * 33]); o.w = pk2(s[6 * 33], s[7 * 33]);
        *(u32x4*)(WT + (size_t)(n0 + n) * K + k0 + 8 * c) = o; }
    asm volatile("s_waitcnt lgkmcnt(0)" ::: "memory");
}
__device__ __forceinline__ void phase_prologue(const Ptrs& P, char* lds, int tid, int cid) {
    const int lane = tid & 63, wave = tid >> 6;
    float* scr = (float*)(lds + wave * 16384);
    const int gw = cid * 8 + wave, NGW = 256 * 8;
    bf16_t* win_t = (bf16_t*)(P.ws + WS_WIN); bf16_t* wbf_t = (bf16_t*)(P.ws + WS_WBF); bf16_t* wbg_t = (bf16_t*)(P.ws + WS_WBG);
    bf16_t* wout_t = (bf16_t*)(P.ws + WS_WOUT); bf16_t* wup_t = (bf16_t*)(P.ws + WS_WUP); bf16_t* wdn_t = (bf16_t*)(P.ws + WS_WDN);
    constexpr int I_IN = 16 * (NIN / 32), I_SQ = 16 * 32, I_UP = 16 * (NUP / 32), I_DN = (DFF / 64) * 32;
    constexpr int NITEMS = I_IN + 3 * I_SQ + I_UP + I_DN;
    for (int it = gw; it < NITEMS; it += NGW) {
        int r = it;
        if (r < I_IN) { transpose_item<1>(P.w_in, DM, 9240, nullptr, win_t, scr, r, NIN / 32, lane); continue; } r -= I_IN;
        if (r < I_SQ) { transpose_item<0>(P.w_bf, DM, DM, nullptr, wbf_t, scr, r, 32, lane); continue; } r -= I_SQ;
        if (r < I_SQ) { transpose_item<0>(P.w_bg, DM, DM, nullptr, wbg_t, scr, r, 32, lane); continue; } r -= I_SQ;
        if (r < I_SQ) { transpose_item<0>(P.w_out, DM, DM, nullptr, wout_t, scr, r, 32, lane); continue; } r -= I_SQ;
        if (r < I_UP) { transpose_item<2>(P.w_up, DM, NUP, P.norm_ffn, wup_t, scr, r, NUP / 32, lane); continue; } r -= I_UP;
        transpose_item<0>(P.w_down, DFF, DM, nullptr, wdn_t, scr, r, 32, lane);
    }
    f32x4 gv[4];
#pragma unroll
    for (int j = 0; j < 4; ++j) gv[j] = ((const f32x4*)P.norm_mix)[lane + 64 * j];
    for (int m0 = gw; m0 < MTOK; m0 += 2 * NGW) {
        const int m1 = m0 + NGW;
        const f32x4* xr0 = (const f32x4*)(P.x + (size_t)m0 * DM) + lane; const f32x4* xr1 = (const f32x4*)(P.x + (size_t)m1 * DM) + lane;
        f32x4 v0[4], v1[4]; float s0 = 0.f, s1 = 0.f;
#pragma unroll
        for (int j = 0; j < 4; ++j) { v0[j] = xr0[64 * j]; v1[j] = xr1[64 * j]; }
#pragma unroll
        for (int j = 0; j < 4; ++j) { s0 += (v0[j][0] * v0[j][0] + v0[j][1] * v0[j][1]) + (v0[j][2] * v0[j][2] + v0[j][3] * v0[j][3]); s1 += (v1[j][0] * v1[j][0] + v1[j][1] * v1[j][1]) + (v1[j][2] * v1[j][2] + v1[j][3] * v1[j][3]); }
        const float rstd0 = rsqrtf(wave_sum(s0) * (1.f / DM) + 1e-6f), rstd1 = rsqrtf(wave_sum(s1) * (1.f / DM) + 1e-6f);
        if (lane == 0) { float* irx = (float*)(P.ws + WS_CTL + 512 * 1024); irx[m0] = __builtin_amdgcn_rcpf(rstd0); irx[m1] = __builtin_amdgcn_rcpf(rstd1); }
        const int g0 = m0 / GM, g1 = m1 / GM;
        u32x2* o0 = (u32x2*)((bf16_t*)(P.out + (size_t)g0 * GM * DM) + (size_t)(m0 - g0 * GM) * DM) + lane;
        u32x2* o1 = (u32x2*)((bf16_t*)(P.out + (size_t)g1 * GM * DM) + (size_t)(m1 - g1 * GM) * DM) + lane;
#pragma unroll
        for (int j = 0; j < 4; ++j) { const f32x4 t0 = v0[j] * rstd0 * gv[j], t1 = v1[j] * rstd1 * gv[j]; u32x2 w0, w1; w0.x = pk2(t0[0], t0[1]); w0.y = pk2(t0[2], t0[3]); w1.x = pk2(t1[0], t1[1]); w1.y = pk2(t1[2], t1[3]); o0[64 * j] = w0; o1[64 * j] = w1; }
    }
}

__device__ __forceinline__ f32x4 mma16(const bf16_t* A, int lda, const bf16_t* Bt, int ldb, int ksteps, f32x4 acc, int lane) {
    const int r = lane & 15, q = lane >> 4;
    const bf16_t* ap = A + r * lda + q * 8; const bf16_t* bp = Bt + r * ldb + q * 8;
    for (int ks = 0; ks < ksteps; ++ks) { const bf16x8 a = *(const bf16x8*)(ap + ks * 32); const bf16x8 b = *(const bf16x8*)(bp + ks * 32); acc = __builtin_amdgcn_mfma_f32_16x16x32_bf16(a, b, acc, 0, 0, 0); }
    return acc;
}
#define LBAR() do { asm volatile("s_waitcnt lgkmcnt(0)" ::: "memory"); __builtin_amdgcn_s_barrier(); asm volatile("" ::: "memory"); } while (0)
__device__ __forceinline__ f32x4 mma16s(const bf16_t* A, int lda, int sw, const bf16_t* Bt, int ldb, int ksteps, f32x4 acc, int lane) {
    const int r = lane & 15, q = lane >> 4;
    const bf16_t* ap = A + r * lda; const bf16_t* bp = Bt + r * ldb + q * 8;
    for (int ks = 0; ks < ksteps; ++ks) { const bf16x8 a = *(const bf16x8*)(ap + (((ks * 4 + q) ^ sw) << 3)); const bf16x8 b = *(const bf16x8*)(bp + ks * 32); acc = __builtin_amdgcn_mfma_f32_16x16x32_bf16(a, b, acc, 0, 0, 0); }
    return acc;
}
constexpr int PQ = 136, PC = 72;
struct PrepBufs { bf16_t *W, *QD, *KDT, *UHT, *AT; float* GL; };
__device__ __forceinline__ PrepBufs prep_bufs(unsigned char* ws) {
    PrepBufs b; b.W = (bf16_t*)(ws + WS_PREP); b.QD = (bf16_t*)(ws + WS_PREP + 64 * MiB); b.KDT = (bf16_t*)(ws + WS_PREP + 128 * MiB); b.UHT = (bf16_t*)(ws + WS_PREP + 192 * MiB);
    b.AT = (bf16_t*)(ws + WS_PREP + 256 * MiB); b.GL = (float*)(ws + WS_PREP + 288 * MiB); return b;
}
constexpr int PL_QS = 0, PL_KS = 17408, PL_KDT = 34816, PL_RAW = 53248, RAWP = 392  , PL_RT = PL_RAW + 67 * RAWP * 2, PL_GC = PL_RT + 256 * PC * 2, PL_CW = PL_GC + 512, PL_END = PL_CW + 6144;
constexpr int RAW_CHUNKS = 67 * 48;
#ifndef SEGSEL
#define SEGSEL 0
#endif
#define SEG_T0() unsigned long long seg_t0 = 0; if (SEGSEL && blockIdx.x == 0 && threadIdx.x == 0) seg_t0 = __builtin_amdgcn_s_memrealtime()
#define SEG_MARK(k) do { if (SEGSEL && blockIdx.x == 0 && threadIdx.x == 0) { const unsigned long long t_ = __builtin_amdgcn_s_memrealtime(); if (SEGSEL == (k)) atomicAdd((float*)(P.ws + WS_CTL + 768 * 1024), (float)(t_ - seg_t0) * 0.01f); seg_t0 = t_; } } while (0)
struct PrepStage { u32x4 raw[7]; float ga, gb; };
struct ConvW { f32x4 w[3][4]; };
struct PrepHold { u32x4 uh[2], w[2], at; int unit; };
__device__ __forceinline__ void prep_fetch(PrepStage& st, int unit, const Ptrs& P, int tid) {
    const int n = unit & 31, h = (unit >> 5) & 7, bl = unit >> 8;
    const int R0 = bl * SEQ + n * 64;
    const bf16_t* proj = (const bf16_t*)(P.ws + WS_PROJ); const float* small = (const float*)(P.ws + WS_SMALL);
#pragma unroll
    for (int i = 0; i < 7; ++i) { int c = tid + 512 * i; c = c < RAW_CHUNKS ? c : RAW_CHUNKS - 1; const int row = c / 48, c16 = c - row * 48, part = c16 >> 4, ch = (c16 & 15) * 8;
        const bool zero = (n == 0) && (row < 3);
        const int rr = zero ? 3 : row;
        u32x4 v = *(const u32x4*)(proj + (size_t)(3 + part) * PROJ_STRIDE + (size_t)(R0 - 3 + rr) * 1024 + h * HD + ch);
        if (zero) v = (u32x4){0u, 0u, 0u, 0u};
        st.raw[i] = v; }
    { const float* sm = small + (size_t)(R0 + (tid & 63)) * 32; st.ga = sm[8 + h]; st.gb = sm[16 + h]; }
}
__device__ __forceinline__ void prep_flush(const PrepHold& hd, const Ptrs& P, int tid) {
    const PrepBufs G = prep_bufs(P.ws);
#pragma unroll
    for (int i = 0; i < 2; ++i) { const int idx = tid + 512 * i; *(u32x4*)(G.UHT + (size_t)hd.unit * 8192 + idx * 8) = hd.uh[i]; *(u32x4*)(G.W + (size_t)hd.unit * 8192 + idx * 8) = hd.w[i]; }
    *(u32x4*)(G.AT + (size_t)hd.unit * 4096 + tid * 8) = hd.at;
}
__device__ __forceinline__ void gdn_prep_unit(char* lds, int unit, int unit_next, PrepStage& st, PrepHold& hd, const ConvW& cwr, const Ptrs& P, int tid_in, float neg_a, float dtb) {
    int tid = tid_in; asm volatile("" : "+v"(tid));
    const int lane = tid & 63, wid = tid >> 6, c16 = lane & 15, q4 = lane >> 4;
    const int h = (unit >> 5) & 7;
    bf16_t* Qs = (bf16_t*)(lds + PL_QS); bf16_t* Ks = (bf16_t*)(lds + PL_KS); bf16_t* KDTs = (bf16_t*)(lds + PL_KDT);
    bf16_t* RAW = (bf16_t*)(lds + PL_RAW);
    bf16_t* RT = (bf16_t*)(lds + PL_RT);
    float* gcs = (float*)(lds + PL_GC); float* bts = gcs + 64;
    bf16_t* UHs = (bf16_t*)(lds + PL_RAW + 4096); bf16_t* Wst = UHs + 8192; bf16_t* ATs = Wst + 64 * PQ;
    bf16_t* CH = (bf16_t*)lds;
    const PrepBufs G = prep_bufs(P.ws);
    SEG_T0();
#pragma unroll
    for (int i = 0; i < 7; ++i) { const int c = tid + 512 * i; const int row = c / 48, cc = c - row * 48; if (c < RAW_CHUNKS) *(u32x4*)(RAW + row * RAWP + cc * 8) = st.raw[i]; }
    if (wid == 0) {
        const float xx = st.ga + dtb;
        const float sp = xx > 20.f ? xx : log1pf(__expf(xx));
        float cum = neg_a * sp;
        const float beta = __builtin_amdgcn_rcpf(1.0f + __expf(-st.gb));
#pragma unroll
        for (int o = 1; o < 64; o <<= 1) { const float t = __shfl_up(cum, o); if (lane >= o) cum += t; }
        gcs[lane] = cum; bts[lane] = beta;
    }
    prep_flush(hd, P, tid);
    LBAR();
    SEG_MARK(1);
    prep_fetch(st, unit_next, P, tid);
    {
        const int cg = tid & 31, rg = tid >> 5, r0 = 4 * rg, c0 = 4 * cg;
        const f32x4 gc4 = *(const f32x4*)(gcs + r0), bt4 = *(const f32x4*)(bts + r0); const float glast = gcs[63];
        float eg[4], egl[4];
#pragma unroll
        for (int rr = 0; rr < 4; ++rr) { eg[rr] = __expf(gc4[rr]); egl[rr] = __expf(glast - gc4[rr]); }
        const int key = (cg >> 1) & 7;
        const int csw = ((((rg >> 1) ^ key) << 3) | ((rg & 1) << 2));
#pragma unroll
        for (int part = 0; part < 3; ++part) {
            float x[7][4];
#pragma unroll
            for (int i = 0; i < 7; ++i) { const u32x2 a = *(const u32x2*)(RAW + (r0 + i) * RAWP + part * 128 + c0); x[i][0] = bflo(a.x); x[i][1] = bfhi(a.x); x[i][2] = bflo(a.y); x[i][3] = bfhi(a.y); }
            float y[4][4]; float ss[4];
#pragma unroll
            for (int rr = 0; rr < 4; ++rr) { ss[rr] = 0.f;
#pragma unroll
                for (int e = 0; e < 4; ++e) { float v = cwr.w[part][0][e] * x[rr][e] + cwr.w[part][1][e] * x[rr + 1][e] + cwr.w[part][2][e] * x[rr + 2][e] + cwr.w[part][3][e] * x[rr + 3][e];
                    v = siluf(v); y[rr][e] = v; ss[rr] += v * v; } }
            if (part < 2) {
#pragma unroll
                for (int rr = 0; rr < 4; ++rr) { float t = ss[rr]; t += __shfl_xor(t, 1); t += __shfl_xor(t, 2); t += __shfl_xor(t, 4); t += __shfl_xor(t, 8); t += __shfl_xor(t, 16); ss[rr] = rsqrtf(t + 1e-6f); }
            }
            if (part == 0) {
#pragma unroll
                for (int rr = 0; rr < 4; ++rr) { const float sc = ss[rr] * 0.08838834764831845f; const float a0 = y[rr][0] * sc, a1 = y[rr][1] * sc, a2 = y[rr][2] * sc, a3 = y[rr][3] * sc;
                    u32x2 w; w.x = pk2(a0, a1); w.y = pk2(a2, a3); *(u32x2*)(Qs + (r0 + rr) * PQ + c0) = w;
                    u32x2 d; d.x = pk2(a0 * eg[rr], a1 * eg[rr]); d.y = pk2(a2 * eg[rr], a3 * eg[rr]); *(u32x2*)(G.QD + (size_t)unit * 8192 + (r0 + rr) * 128 + c0) = d; }
            } else if (part == 1) {
#pragma unroll
                for (int rr = 0; rr < 4; ++rr) {
#pragma unroll
                    for (int e = 0; e < 4; ++e) y[rr][e] *= ss[rr];
                    u32x2 w; w.x = pk2(y[rr][0], y[rr][1]); w.y = pk2(y[rr][2], y[rr][3]); *(u32x2*)(Ks + (r0 + rr) * PQ + c0) = w; }
#pragma unroll
                for (int e = 0; e < 4; ++e) { u32x2 w1, w2;
                    w1.x = pk2(y[0][e] * bt4[0] * eg[0], y[1][e] * bt4[1] * eg[1]); w1.y = pk2(y[2][e] * bt4[2] * eg[2], y[3][e] * bt4[3] * eg[3]);
                    w2.x = pk2(y[0][e] * egl[0], y[1][e] * egl[1]); w2.y = pk2(y[2][e] * egl[2], y[3][e] * egl[3]);
                    *(u32x2*)(RT + (128 + c0 + e) * PC + csw) = w1; *(u32x2*)(KDTs + (c0 + e) * PC + csw) = w2; }
            } else {
#pragma unroll
                for (int e = 0; e < 4; ++e) { u32x2 w1; w1.x = pk2(y[0][e] * bt4[0], y[1][e] * bt4[1]); w1.y = pk2(y[2][e] * bt4[2], y[3][e] * bt4[3]); *(u32x2*)(RT + (c0 + e) * PC + csw) = w1; }
            }
        }
    }
    LBAR();
    SEG_MARK(2);
    {
#pragma unroll
        for (int i = 0; i < 2; ++i) { const int idx = tid + 512 * i, row = idx >> 3, ch = idx & 7; *(u32x4*)(G.KDT + (size_t)unit * 8192 + row * 64 + ch * 8) = *(const u32x4*)(KDTs + row * PC + ((ch ^ ((row >> 3) & 7)) << 3)); }
    }
    const int mat = wid >> 2, ti = wid & 3;
    f32x4 res[4], res2[4];
#pragma unroll
    for (int tj = 0; tj < 4; ++tj) { f32x4 acc = {0.f, 0.f, 0.f, 0.f}, acc2 = {0.f, 0.f, 0.f, 0.f};
        if (tj <= ti) { if (mat == 0) acc = mma16(Ks + ti * 16 * PQ, PQ, Ks + tj * 16 * PQ, PQ, 4, acc, lane);
                        acc2 = mma16(Ks + tj * 16 * PQ, PQ, (mat ? Qs : Ks) + ti * 16 * PQ, PQ, 4, acc2, lane); }
        res[tj] = acc; res2[tj] = acc2; }
    LBAR();
    {
        const int iiL = ti * 16 + c16; const float gciL = gcs[iiL], btL = bts[iiL];
#pragma unroll
        for (int tj = 0; tj < 4; ++tj) {
            const int jc0 = tj * 16 + 4 * q4;
            const f32x4 gcj = *(const f32x4*)(gcs + jc0);
            float v[4];
#pragma unroll
            for (int jj = 0; jj < 4; ++jj) { const int jc = jc0 + jj; const float dec = (iiL >= jc) ? __expf(gciL - gcj[jj]) : 0.f;
                v[jj] = (mat == 0) ? ((iiL > jc) ? -res2[tj][jj] * dec * btL : 0.f) : ((iiL >= jc) ? res2[tj][jj] * dec : 0.f); }
            u32x2 w; w.x = pk2(v[0], v[1]); w.y = pk2(v[2], v[3]);
            if (mat == 0) *(u32x2*)(CH + iiL * PC + jc0) = w;
            else *(u32x2*)(ATs + iiL * PC + jc0) = w;
            if (mat == 0) {
                const int jcL = tj * 16 + c16, ii0 = ti * 16 + 4 * q4; const float gcjL = gcs[jcL];
                const f32x4 gci = *(const f32x4*)(gcs + ii0), bti = *(const f32x4*)(bts + ii0);
                float t[4];
#pragma unroll
                for (int jj = 0; jj < 4; ++jj) { const int ii = ii0 + jj; t[jj] = (ii > jcL) ? -res[tj][jj] * __expf(gci[jj] - gcjL) * bti[jj] : 0.f; }
                u32x2 w2; w2.x = pk2(t[0], t[1]); w2.y = pk2(t[2], t[3]);
                *(u32x2*)(CH + 2 * 64 * PC + jcL * PC + ii0) = w2; }
        }
    }
    LBAR();
    SEG_MARK(3);
    f32x4 pacc[4];
    if (wid >= 4) {
#pragma unroll
        for (int tj = 0; tj < 4; ++tj) { const u32x2 nw = *(const u32x2*)(CH + (ti * 16 + c16) * PC + tj * 16 + 4 * q4); const int ii = ti * 16 + c16, jc0 = tj * 16 + 4 * q4;
            pacc[tj][0] = bflo(nw.x) + (ii == jc0 ? 1.f : 0.f); pacc[tj][1] = bfhi(nw.x) + (ii == jc0 + 1 ? 1.f : 0.f); pacc[tj][2] = bflo(nw.y) + (ii == jc0 + 2 ? 1.f : 0.f); pacc[tj][3] = bfhi(nw.y) + (ii == jc0 + 3 ? 1.f : 0.f); }
    }
    for (int s = 0; s < 6; ++s) {
        const int cur = s & 1, nxt = cur ^ 1;
        bf16_t* Qr_c = CH + cur * 64 * PC; bf16_t* Qt_c = CH + (2 + cur) * 64 * PC; bf16_t* Qr_n = CH + nxt * 64 * PC; bf16_t* Qt_n = CH + (2 + nxt) * 64 * PC;
        bf16_t* Pr_c = CH + (4 + cur) * 64 * PC; bf16_t* Pr_p = CH + (4 + nxt) * 64 * PC;
        if (wid < 4) {
            if (s < 5) {
#pragma unroll
                for (int tj = 0; tj < 4; ++tj) { f32x4 a1 = {0.f, 0.f, 0.f, 0.f}, a2 = {0.f, 0.f, 0.f, 0.f};
                    const bf16_t* ap = Qr_c + (ti * 16 + c16) * PC + q4 * 8; const bf16_t* bp = Qt_c + (tj * 16 + c16) * PC + q4 * 8;
#pragma unroll
                    for (int ks = 0; ks < 2; ++ks) { const bf16x8 fa = *(const bf16x8*)(ap + ks * 32), fb = *(const bf16x8*)(bp + ks * 32);
                        a1 = __builtin_amdgcn_mfma_f32_16x16x32_bf16(fa, fb, a1, 0, 0, 0);
                        a2 = __builtin_amdgcn_mfma_f32_16x16x32_bf16(fb, fa, a2, 0, 0, 0); }
                    u32x2 w1, w2; w1.x = pk2(a1[0], a1[1]); w1.y = pk2(a1[2], a1[3]); w2.x = pk2(a2[0], a2[1]); w2.y = pk2(a2[2], a2[3]);
                    *(u32x2*)(Qt_n + (tj * 16 + c16) * PC + ti * 16 + 4 * q4) = w1;
                    *(u32x2*)(Qr_n + (ti * 16 + c16) * PC + tj * 16 + 4 * q4) = w2; }
            }
        } else {
#pragma unroll
            for (int tj = 0; tj < 4; ++tj) {
                if (s >= 1) { const bf16_t* ap = Qt_c + (tj * 16 + c16) * PC + q4 * 8; const bf16_t* bp = Pr_p + (ti * 16 + c16) * PC + q4 * 8;
#pragma unroll
                    for (int ks = 0; ks < 2; ++ks) { const bf16x8 fa = *(const bf16x8*)(ap + ks * 32), fb = *(const bf16x8*)(bp + ks * 32); pacc[tj] = __builtin_amdgcn_mfma_f32_16x16x32_bf16(fa, fb, pacc[tj], 0, 0, 0); } }
                u32x2 w; w.x = pk2(pacc[tj][0], pacc[tj][1]); w.y = pk2(pacc[tj][2], pacc[tj][3]);
                *(u32x2*)(Pr_c + (ti * 16 + c16) * PC + tj * 16 + 4 * q4) = w; }
        }
        LBAR();
    }
    SEG_MARK(4);
    {
        const bf16_t* Tm = CH + 5 * 64 * PC;
#pragma unroll
        for (int t2 = 0; t2 < 2; ++t2) { const int tch = 2 * wid + t2; const int swl = (2 * tch + (c16 >> 3)) & 7;
#pragma unroll
            for (int tj = 0; tj < 4; ++tj) { f32x4 acc = {0.f, 0.f, 0.f, 0.f};
#pragma unroll
                for (int ks = 0; ks < 2; ++ks) { const bf16x8 fr = *(const bf16x8*)(RT + (tch * 16 + c16) * PC + (((ks * 4 + q4) ^ swl) << 3)); const bf16x8 ft = *(const bf16x8*)(Tm + (tj * 16 + c16) * PC + ks * 32 + q4 * 8);
                    acc = (tch < 8) ? __builtin_amdgcn_mfma_f32_16x16x32_bf16(ft, fr, acc, 0, 0, 0) : __builtin_amdgcn_mfma_f32_16x16x32_bf16(fr, ft, acc, 0, 0, 0); }
                u32x2 w; w.x = pk2(acc[0], acc[1]); w.y = pk2(acc[2], acc[3]);
                if (tch < 8) *(u32x2*)(UHs + ((((tch * 4 + tj) * 4 + q4) * 16 + c16) * 4)) = w;
                else *(u32x2*)(Wst + (tj * 16 + c16) * PQ + (tch - 8) * 16 + 4 * q4) = w;
            } }
        G.GL[unit] = __expf(gcs[63]);
    }
    LBAR();
#pragma unroll
    for (int i = 0; i < 2; ++i) { const int idx = tid + 512 * i; hd.uh[i] = *(const u32x4*)(UHs + idx * 8); hd.w[i] = *(const u32x4*)(Wst + (idx >> 4) * PQ + (idx & 15) * 8); }
    hd.at = *(const u32x4*)(ATs + (tid >> 3) * PC + (tid & 7) * 8); hd.unit = unit;
    LBAR();
    SEG_MARK(5);
}

__device__ __forceinline__ void gdn_seq_unit(char* lds, int bh, const Ptrs& P, int tid) {
    const int lane = tid & 63, wid = tid >> 6, c16 = lane & 15, q4 = lane >> 4;
    const int bl = bh >> 3, h = bh & 7;
    bf16_t* ST = (bf16_t*)lds;
    bf16_t* Wl = ST + 128 * PQ;
    bf16_t* QDl = Wl + 64 * PQ;
    bf16_t* ATl = QDl + 64 * PQ;
    bf16_t* KDTl = ATl + 64 * PC;
    bf16_t* UTl = KDTl + 128 * PC;
    bf16_t* GZl = UTl + 128 * PC;
    float* SSl = (float*)(GZl + 64 * PQ);
    const PrepBufs G = prep_bufs(P.ws);
    const bf16_t* gz = (const bf16_t*)(P.ws + WS_PROJ) + 6 * PROJ_STRIDE + (size_t)(bl * SEQ) * 1024 + h * HD;
    bf16_t* yg = (bf16_t*)(P.ws + WS_YGDN) + (size_t)(bl * SEQ) * 1024 + h * HD;
    f32x4 Sacc[8];
#pragma unroll
    for (int t = 0; t < 8; ++t) Sacc[t] = (f32x4){0.f, 0.f, 0.f, 0.f};
    for (int i = lane; i < 16 * PQ / 2; i += 64) ((unsigned*)(ST + wid * 16 * PQ))[i] = 0u;
    const f32x4 gn = *(const f32x4*)(P.gdn_norm + 16 * wid + 4 * q4);
    const int r16 = tid >> 4, ch16 = (tid & 15) * 8;
    const int r8 = tid >> 3, ch8 = (tid & 7) * 8;
    u32x4 sW[2], sQ[2], sA, sK[2], sG[2]; u32x2 uhn[4]; float gln;
    {
        const size_t ub = (size_t)(bh * 32) * 8192;
#pragma unroll
        for (int i = 0; i < 2; ++i) { const int idx = tid + 512 * i; sW[i] = *(const u32x4*)(G.W + ub + idx * 8); sQ[i] = *(const u32x4*)(G.QD + ub + idx * 8); sK[i] = *(const u32x4*)(G.KDT + ub + idx * 8);
            sG[i] = *(const u32x4*)(gz + (size_t)(r16 + 32 * i) * 1024 + ch16); }
        sA = *(const u32x4*)(G.AT + (size_t)(bh * 32) * 4096 + tid * 8);
#pragma unroll
        for (int t = 0; t < 4; ++t) uhn[t] = *(const u32x2*)(G.UHT + ub + ((wid * 4 + t) * 64 + lane) * 4);
        gln = G.GL[bh * 32];
    }
    for (int n = 0; n < 32; ++n) {
        const int unit = bh * 32 + n;
        const size_t ub = (size_t)unit * 8192;
#pragma unroll
        for (int i = 0; i < 2; ++i) { const int idx = tid + 512 * i;
            *(u32x4*)(Wl + (idx >> 4) * PQ + (idx & 15) * 8) = sW[i]; *(u32x4*)(QDl + (idx >> 4) * PQ + (idx & 15) * 8) = sQ[i]; *(u32x4*)(KDTl + (idx >> 3) * PC + (idx & 7) * 8) = sK[i]; }
        *(u32x4*)(ATl + r8 * PC + ch8) = sA;
        const float gl = gln;
        u32x2 uh[4];
#pragma unroll
        for (int t = 0; t < 4; ++t) uh[t] = uhn[t];
        LBAR();
        const int nn = (n + 1 < 32) ? n + 1 : 31;
        { const size_t un = (size_t)(bh * 32 + nn) * 8192;
#pragma unroll
            for (int i = 0; i < 2; ++i) { const int idx = tid + 512 * i; sW[i] = *(const u32x4*)(G.W + un + idx * 8); sQ[i] = *(const u32x4*)(G.QD + un + idx * 8); sK[i] = *(const u32x4*)(G.KDT + un + idx * 8); }
            sA = *(const u32x4*)(G.AT + (size_t)(bh * 32 + nn) * 4096 + tid * 8);
#pragma unroll
            for (int t = 0; t < 4; ++t) uhn[t] = *(const u32x2*)(G.UHT + un + ((wid * 4 + t) * 64 + lane) * 4);
            gln = G.GL[bh * 32 + nn]; }
        { const int np = (n > 0) ? n - 1 : 0;
#pragma unroll
            for (int i = 0; i < 2; ++i) { const u32x4 v = *(const u32x4*)(GZl + (r16 + 32 * i) * PQ + ch16); *(u32x4*)(yg + (size_t)(np * 64 + r16 + 32 * i) * 1024 + ch16) = v; } }
        f32x4 ws[4], os[4];
#pragma unroll
        for (int t = 0; t < 4; ++t) { ws[t] = (f32x4){0.f, 0.f, 0.f, 0.f}; os[t] = (f32x4){0.f, 0.f, 0.f, 0.f}; }
#pragma unroll
        for (int ks = 0; ks < 4; ++ks) { const bf16x8 b = *(const bf16x8*)(ST + (16 * wid + c16) * PQ + ks * 32 + q4 * 8);
#pragma unroll
            for (int t = 0; t < 4; ++t) { const bf16x8 a = *(const bf16x8*)(Wl + (16 * t + c16) * PQ + ks * 32 + q4 * 8); ws[t] = __builtin_amdgcn_mfma_f32_16x16x32_bf16(a, b, ws[t], 0, 0, 0);
                const bf16x8 a2 = *(const bf16x8*)(QDl + (16 * t + c16) * PQ + ks * 32 + q4 * 8); os[t] = __builtin_amdgcn_mfma_f32_16x16x32_bf16(b, a2, os[t], 0, 0, 0); } }
#pragma unroll
        for (int t = 0; t < 4; ++t) { u32x2 w; w.x = pk2(bflo(uh[t].x) - ws[t][0], bfhi(uh[t].x) - ws[t][1]); w.y = pk2(bflo(uh[t].y) - ws[t][2], bfhi(uh[t].y) - ws[t][3]);
            *(u32x2*)(UTl + (16 * wid + c16) * PC + 16 * t + 4 * q4) = w; }
        LBAR();
#pragma unroll
        for (int i = 0; i < 2; ++i) *(u32x4*)(GZl + (r16 + 32 * i) * PQ + ch16) = sG[i];
#pragma unroll
        for (int i = 0; i < 2; ++i) sG[i] = *(const u32x4*)(gz + (size_t)(nn * 64 + r16 + 32 * i) * 1024 + ch16);
#pragma unroll
        for (int ks = 0; ks < 2; ++ks) { const bf16x8 b = *(const bf16x8*)(UTl + (16 * wid + c16) * PC + ks * 32 + q4 * 8);
#pragma unroll
            for (int t = 0; t < 4; ++t) { const bf16x8 a = *(const bf16x8*)(ATl + (16 * t + c16) * PC + ks * 32 + q4 * 8); os[t] = __builtin_amdgcn_mfma_f32_16x16x32_bf16(b, a, os[t], 0, 0, 0); } }
#pragma unroll
        for (int t = 0; t < 8; ++t) Sacc[t] = Sacc[t] * gl;
#pragma unroll
        for (int ks = 0; ks < 2; ++ks) { const bf16x8 a = *(const bf16x8*)(UTl + (16 * wid + c16) * PC + ks * 32 + q4 * 8);
#pragma unroll
            for (int t = 0; t < 8; ++t) { const bf16x8 b = *(const bf16x8*)(KDTl + (16 * t + c16) * PC + ks * 32 + q4 * 8); Sacc[t] = __builtin_amdgcn_mfma_f32_16x16x32_bf16(b, a, Sacc[t], 0, 0, 0); } }
#pragma unroll
        for (int t = 0; t < 8; ++t) { u32x2 w; w.x = pk2(Sacc[t][0], Sacc[t][1]); w.y = pk2(Sacc[t][2], Sacc[t][3]); *(u32x2*)(ST + (16 * wid + c16) * PQ + 16 * t + 4 * q4) = w; }
#pragma unroll
        for (int t = 0; t < 4; ++t) { float s = (os[t][0] * os[t][0] + os[t][1] * os[t][1]) + (os[t][2] * os[t][2] + os[t][3] * os[t][3]); s += __shfl_xor(s, 16); s += __shfl_xor(s, 32);
            if (q4 == 0) SSl[wid * 64 + 16 * t + c16] = s; }
        LBAR();
        float tot = 0.f;
#pragma unroll
        for (int w = 0; w < 8; ++w) tot += SSl[w * 64 + lane];
        const float rstd_l = rsqrtf(tot * (1.0f / 128.0f) + 1e-6f);
#pragma unroll
        for (int t = 0; t < 4; ++t) { const int row = 16 * t + c16; const float rs = __shfl(rstd_l, row);
            u32x2* gp = (u32x2*)(GZl + row * PQ + 16 * wid + 4 * q4); const u32x2 gw = *gp; u32x2 w;
            w.x = pk2(os[t][0] * rs * gn[0] * siluf(bflo(gw.x)), os[t][1] * rs * gn[1] * siluf(bfhi(gw.x)));
            w.y = pk2(os[t][2] * rs * gn[2] * siluf(bflo(gw.y)), os[t][3] * rs * gn[3] * siluf(bfhi(gw.y))); *gp = w; }
    }
    LBAR();
#pragma unroll
    for (int i = 0; i < 2; ++i) { const u32x4 v = *(const u32x4*)(GZl + (r16 + 32 * i) * PQ + ch16); *(u32x4*)(yg + (size_t)(31 * 64 + r16 + 32 * i) * 1024 + ch16) = v; }
    __syncthreads();
}

__device__ __forceinline__ void fox_item(char* lds, int item, const Ptrs& P, int tid, bool need_bias) {
    using bf = fox::bf16;
    const int lane = tid & 63, wid = tid >> 6;
    const int bh = item >> 2, xq = item & 3, bl = bh >> 3, h = bh & 7;
    float* cb = (float*)(lds + fox::LDS_BYTES);
    float* tmp = cb + SEQ;
    const float* small = (const float*)(P.ws + WS_SMALL);
    if (need_bias) {
        const float fb = P.fox_f_bias[h];
        float lf[4]; float run = 0.f;
#pragma unroll
        for (int e = 0; e < 4; ++e) { const float xv = small[(size_t)(bl * SEQ + 4 * tid + e) * 32 + h] + fb;
            const float l = (xv < -20.f) ? xv : -log1pf(__expf(-xv)); run += l; lf[e] = run; }
        float inc = run;
#pragma unroll
        for (int o = 1; o < 64; o <<= 1) { const float t = __shfl_up(inc, o); if (lane >= o) inc += t; }
        if (lane == 63) tmp[wid] = inc;
        __syncthreads();
        float off = inc - run;
        for (int w = 0; w < wid; ++w) off += tmp[w];
#pragma unroll
        for (int e = 0; e < 4; ++e) cb[4 * tid + e] = -(off + lf[e]) * 11.313708498984761f;
        __syncthreads();
    }
    bf* fq = (bf*)(P.ws + WS_PROJ); const bf* fk = fq + PROJ_STRIDE; const bf* fv = fq + 2 * PROJ_STRIDE;
    const size_t hb = (size_t)(bl * SEQ) * 1024 + h * HD;
    fox::BlockRef<bf, bf> b0, b1;
    bf* yo = (bf*)(P.ws + WS_YFOX);
    b0.Q = fq + hb + (size_t)(xq * 256) * 1024; b0.O = yo + hb + (size_t)(xq * 256) * 1024; b0.K = fk + hb; b0.V = fv + hb; b0.P0 = xq * 256;
    b1.Q = fq + hb + (size_t)((7 - xq) * 256) * 1024; b1.O = yo + hb + (size_t)((7 - xq) * 256) * 1024; b1.K = fk + hb; b1.V = fv + hb; b1.P0 = (7 - xq) * 256;
    fox::Seam<bf> S;
    fox::causal_swa_prime<bf, bf>(b0, 1 << 20, lds, S);
    fox::causal_swa_block<bf, bf>(b0, b1, SEQ, 1 << 20, lds, S, cb);
    fox::causal_swa_block<bf, bf>(b1, b1, SEQ, 1 << 20, lds, S, cb);
    __syncthreads();
}

__device__ __forceinline__ void phase_convgate(const Ptrs& P, int tid, int cid) {
    const bf16_t* up = (const bf16_t*)(P.ws + WS_UP); bf16_t* act = (bf16_t*)(P.ws + WS_ACT);
    constexpr int NFG = DFF / 8;
    constexpr int RPB = GM / 256; static_assert(SEQ % RPB == 0, "a slab never straddles a sequence start");
    if (tid < NFG) {
        const int fg = tid, p = fg >> 4, i0 = (fg & 15) * 8, f0 = p * 128 + i0;
        const int cg0 = p * 256 + i0, cv0 = cg0 + 128;
        float wg[3][8], wv[3][8];
#pragma unroll
        for (int i = 0; i < 3; ++i)
#pragma unroll
            for (int j = 0; j < 8; ++j) { wg[i][j] = P.ffn_conv_w[i * NUP + f0 + j]; wv[i][j] = P.ffn_conv_w[i * NUP + DFF + f0 + j]; }
        const int r0 = cid * RPB;
        float g1[8], g2[8], v1[8], v2[8];
#pragma unroll
        for (int j = 0; j < 8; ++j) { g1[j] = 0.f; g2[j] = 0.f; v1[j] = 0.f; v2[j] = 0.f; }
        if ((r0 & (SEQ - 1)) != 0) {
            const u32x4 a1 = *(const u32x4*)(up + (size_t)(r0 - 1) * NUP + cg0), a2 = *(const u32x4*)(up + (size_t)(r0 - 2) * NUP + cg0);
            const u32x4 b1 = *(const u32x4*)(up + (size_t)(r0 - 1) * NUP + cv0), b2 = *(const u32x4*)(up + (size_t)(r0 - 2) * NUP + cv0);
            g1[0] = bflo(a1.x); g1[1] = bfhi(a1.x); g1[2] = bflo(a1.y); g1[3] = bfhi(a1.y); g1[4] = bflo(a1.z); g1[5] = bfhi(a1.z); g1[6] = bflo(a1.w); g1[7] = bfhi(a1.w);
            g2[0] = bflo(a2.x); g2[1] = bfhi(a2.x); g2[2] = bflo(a2.y); g2[3] = bfhi(a2.y); g2[4] = bflo(a2.z); g2[5] = bfhi(a2.z); g2[6] = bflo(a2.w); g2[7] = bfhi(a2.w);
            v1[0] = bflo(b1.x); v1[1] = bfhi(b1.x); v1[2] = bflo(b1.y); v1[3] = bfhi(b1.y); v1[4] = bflo(b1.z); v1[5] = bfhi(b1.z); v1[6] = bflo(b1.w); v1[7] = bfhi(b1.w);
            v2[0] = bflo(b2.x); v2[1] = bfhi(b2.x); v2[2] = bflo(b2.y); v2[3] = bfhi(b2.y); v2[4] = bflo(b2.z); v2[5] = bfhi(b2.z); v2[6] = bflo(b2.w); v2[7] = bfhi(b2.w);
        }
        for (int rb = 0; rb < RPB; rb += 8) {
            u32x4 ga[8], va[8];
#pragma unroll
            for (int r = 0; r < 8; ++r) { ga[r] = *(const u32x4*)(up + (size_t)(r0 + rb + r) * NUP + cg0); va[r] = *(const u32x4*)(up + (size_t)(r0 + rb + r) * NUP + cv0); }
#pragma unroll
            for (int r = 0; r < 8; ++r) {
                const u32x4 a = ga[r], b = va[r];
                float g0[8], v0[8];
                g0[0] = bflo(a.x); g0[1] = bfhi(a.x); g0[2] = bflo(a.y); g0[3] = bfhi(a.y); g0[4] = bflo(a.z); g0[5] = bfhi(a.z); g0[6] = bflo(a.w); g0[7] = bfhi(a.w);
                v0[0] = bflo(b.x); v0[1] = bfhi(b.x); v0[2] = bflo(b.y); v0[3] = bfhi(b.y); v0[4] = bflo(b.z); v0[5] = bfhi(b.z); v0[6] = bflo(b.w); v0[7] = bfhi(b.w);
                float o[8];
#pragma unroll
                for (int j = 0; j < 8; ++j) { const float cgv = wg[0][j] * g2[j] + wg[1][j] * g1[j] + wg[2][j] * g0[j]; const float cvv = wv[0][j] * v2[j] + wv[1][j] * v1[j] + wv[2][j] * v0[j];
                    o[j] = siluf(cgv) * cvv; g2[j] = g1[j]; g1[j] = g0[j]; v2[j] = v1[j]; v1[j] = v0[j]; }
                u32x4 w; w.x = pk2(o[0], o[1]); w.y = pk2(o[2], o[3]); w.z = pk2(o[4], o[5]); w.w = pk2(o[6], o[7]);
                *(u32x4*)(act + (size_t)(r0 + rb + r) * DFF + f0) = w;
            }
        }
    }
}

__device__ __forceinline__ void phase_final(const Ptrs& P, int tid, int cid, float pert) {
    const int lane = tid & 63, wave = tid >> 6;
    const int gw = cid * 8 + wave, NGW = 256 * 8;
    const float* rowss2 = (const float*)(P.ws + WS_CTL) + MTOK;
    f32x4 gv[4];
#pragma unroll
    for (int j = 0; j < 4; ++j) gv[j] = ((const f32x4*)P.norm_final)[lane + 64 * j];
    for (int m0 = gw; m0 < MTOK; m0 += 2 * NGW) {
        const int m1 = m0 + NGW;
        const float rstd0 = rsqrtf(rowss2[m0] * (1.f / DM) + 1e-6f), rstd1 = rsqrtf(rowss2[m1] * (1.f / DM) + 1e-6f);
        f32x4* o0 = (f32x4*)(P.out + (size_t)m0 * DM) + lane; f32x4* o1 = (f32x4*)(P.out + (size_t)m1 * DM) + lane;
        f32x4 a0[4], a1[4];
#pragma unroll
        for (int j = 0; j < 4; ++j) { a0[j] = o0[64 * j]; a1[j] = o1[64 * j]; }
#pragma unroll
        for (int j = 0; j < 4; ++j) { o0[64 * j] = a0[j] * rstd0 * gv[j] + pert; o1[64 * j] = a1[j] * rstd1 * gv[j] + pert; }
    }
}

#define LAS __attribute__((address_space(3)))
#define XB_TMO      128
#define XB_XCNT(j)  (256  + 64 * (j))
#define XB_XSUB(j)  (1280 + 64 * (j))
#define XB_XGEN(j)  (2304 + 64 * (j))
#define XB_TOP      3328
#define XB_TOPGEN   3392
#define XCD_BAR_WORDS 3456
#define XB_SPIN_CAP (1u << 18)

__device__ __forceinline__ unsigned xb_ld(unsigned* p)              { return __hip_atomic_load(p, __ATOMIC_RELAXED, __HIP_MEMORY_SCOPE_AGENT); }
__device__ __forceinline__ unsigned xb_add(unsigned* p, unsigned v) { return __hip_atomic_fetch_add(p, v, __ATOMIC_RELAXED, __HIP_MEMORY_SCOPE_AGENT); }
__device__ __forceinline__ unsigned xb_xcc_id() { return (unsigned)__builtin_amdgcn_s_getreg((3 << 11) | 20) & 0xFu; }
#define XB_SPIN(cond, bar) do { unsigned _sp = 0; while (cond) { __builtin_amdgcn_s_sleep(1); \
    if ((++_sp & 255u) == 0u) { if (xb_ld(&(bar)[XB_TMO])) break; if (_sp > XB_SPIN_CAP) { atomicAdd(&(bar)[XB_TMO], 1u); break; } } } } while (0)

struct XcdBarrier {
    unsigned* bar; unsigned x;
    volatile LAS unsigned* st;
};

__device__ __forceinline__ XcdBarrier xcd_barrier_post(unsigned* bar, volatile LAS unsigned* st) {
    XcdBarrier b; b.bar = bar; b.x = xb_xcc_id(); b.st = st;
    if (threadIdx.x == 0) (void)xb_add(&bar[XB_XCNT(b.x)], 1u);
    return b;
}
__device__ __forceinline__ void xcd_barrier_complete(unsigned* bar, unsigned x, unsigned& nloc, unsigned& nx) {
    const unsigned G = gridDim.x * gridDim.y * gridDim.z;
    unsigned sum, cnt, mine, sp = 0u;
    for (;;) {
        sum = 0u; cnt = 0u; mine = 0u;
#pragma unroll
        for (unsigned j = 0; j < 16; ++j) { const unsigned c = xb_ld(&bar[XB_XCNT(j)]); sum += c; cnt += (c > 0u) ? 1u : 0u; mine = (j == x) ? c : mine; }
        if (sum == G) break;
        __builtin_amdgcn_s_sleep(1);
        if ((++sp & 255u) == 0u) { if (xb_ld(&bar[XB_TMO])) break; if (sp > XB_SPIN_CAP) { atomicAdd(&bar[XB_TMO], 1u); break; } }
    }
    nloc = mine > 0u ? mine : 1u; nx = cnt > 0u ? cnt : 1u;
}

__device__ __forceinline__ void xcd_barrier(const XcdBarrier& b) {
    asm volatile("s_waitcnt vmcnt(0)" ::: "memory");
    __syncthreads();
    if (threadIdx.x == 0) {
        unsigned* bar = b.bar;
        __builtin_amdgcn_s_waitcnt(0);
        unsigned nloc = b.st[0], nx = b.st[1];
        if (nloc == 0u) { xcd_barrier_complete(bar, b.x, nloc, nx); b.st[0] = nloc; b.st[1] = nx; }
        const unsigned old = xb_add(&bar[XB_XSUB(b.x)], 1u);
        const unsigned gen = old / nloc;
        if (old + 1u == (gen + 1u) * nloc) {
            __builtin_amdgcn_fence(__ATOMIC_RELEASE, "agent");
            asm volatile("s_waitcnt vmcnt(0)" ::: "memory");
            const unsigned og = xb_add(&bar[XB_TOP], 1u);
            const unsigned tg = og / nx;
            if (og + 1u == (tg + 1u) * nx) xb_add(&bar[XB_TOPGEN], 1u);
            else XB_SPIN(xb_ld(&bar[XB_TOPGEN]) == tg, bar);
            __builtin_amdgcn_fence(__ATOMIC_ACQUIRE, "agent");
            xb_add(&bar[XB_XGEN(b.x)], 1u);
            asm volatile("s_waitcnt vmcnt(0)" ::: "memory");
        } else {
            XB_SPIN(xb_ld(&bar[XB_XGEN(b.x)]) == gen, bar);
            __builtin_amdgcn_fence(__ATOMIC_ACQUIRE, "agent");
            asm volatile("s_waitcnt vmcnt(0)" ::: "memory");
        }
    }
    __syncthreads();
}

constexpr int N_PHASES = 2 + 8 * NG;
#ifndef PHM
#define PHM 2047
#endif
#ifndef DBL
#define DBL 0
#endif
#define DBLSEL 2
#ifndef TSTAMP
#define TSTAMP 0
#endif
#define TS_MASK 0x200
__global__ void __launch_bounds__(512, 2) mk_fwd(Args args) {
    extern __shared__ __attribute__((aligned(16))) unsigned char lds_raw[];
    char* lds = (char*)lds_raw;
    cg::grid_group grid = cg::this_grid();
    volatile LAS unsigned* xst = (volatile LAS unsigned*)((LAS unsigned char*)lds_raw + (LDS_BYTES - 16));
    if (threadIdx.x < 4) xst[threadIdx.x] = 0u;
    __syncthreads();
    XcdBarrier xbar; xbar.bar = (unsigned*)(args.ws + WS_CTL + 800 * 1024); xbar.x = 0; xbar.st = xst;
    constexpr int G = 256;
    for (int ph = args.ph_lo; ph < args.ph_hi; ++ph) {
      {
        int tid = threadIdx.x; asm volatile("" : "+v"(tid));
        int cid = blockIdx.x; asm volatile("" : "+s"(cid));
        typedef const __attribute__((address_space(4))) Args* KArgsP;
        KArgsP kp = (KArgsP)__builtin_amdgcn_kernarg_segment_ptr(); asm volatile("" : "+s"(kp));
#define GPTR(T, v) ((T*)(__attribute__((address_space(1))) T*)(v))
        Ptrs P;
        P.x = GPTR(const float, kp->in[0]); P.norm_mix = GPTR(const float, kp->in[1]); P.w_in = GPTR(const float, kp->in[2]); P.fox_f_bias = GPTR(const float, kp->in[3]);
        P.gdn_conv_w = GPTR(const float, kp->in[4]); P.gdn_a_log = GPTR(const float, kp->in[5]); P.gdn_dt_bias = GPTR(const float, kp->in[6]); P.gdn_norm = GPTR(const float, kp->in[7]);
        P.w_bf = GPTR(const float, kp->in[8]); P.w_bg = GPTR(const float, kp->in[9]); P.w_out = GPTR(const float, kp->in[10]); P.norm_ffn = GPTR(const float, kp->in[11]);
        P.w_up = GPTR(const float, kp->in[12]); P.ffn_conv_w = GPTR(const float, kp->in[13]); P.w_down = GPTR(const float, kp->in[14]); P.norm_final = GPTR(const float, kp->in[15]);
        P.out = GPTR(float, kp->out); unsigned char* ws = GPTR(unsigned char, kp->ws); P.ws = ws;
        float* rowss1 = (float*)(ws + WS_CTL); float* rowss2 = rowss1 + MTOK;
        if (ph == 0) { if (PHM & 1) phase_prologue(P, lds, tid, cid);
            if (MK_ONE_LAUNCH) {
                unsigned* cz = (unsigned*)(ws + WS_CTL); for (int i = cid * 512 + tid; i < 131072; i += G * 512) cz[i] = 0u;
                if (cid == 0) { unsigned* bz = (unsigned*)(ws + WS_CTL + 800 * 1024); for (int i = tid; i < XCD_BAR_WORDS; i += 512) bz[i] = 0u; if (tid < 64) ((unsigned*)(ws + WS_CTL + 768 * 1024))[tid] = 0u; } } }
        else if (ph == N_PHASES - 1) {
            float pert = 0.f;
            if (SEGSEL && blockIdx.x == 0) pert = fminf(__hip_atomic_load((float*)(ws + WS_CTL + 768 * 1024), __ATOMIC_RELAXED, __HIP_MEMORY_SCOPE_AGENT) * 5e-5f, 0.12f);
            if (PHM & 2) phase_final(P, tid, cid, pert); }
        else {
            const int grp = (ph - 1) >> 3, sub = (ph - 1) & 7;
            const size_t r0g = (size_t)grp * GM;
            pg8::bf16_t* proj = (pg8::bf16_t*)(ws + WS_PROJ);
            if (sub == 0 && (PHM & 4)) {
                pg8::Gemm g{(const pg8::bf16_t*)(P.out + r0g * DM), nullptr, (const pg8::bf16_t*)(ws + WS_WIN), nullptr, GM, NIN, DM};
                pg8::StaticOrder S; S.init(GM, NIN, G, cid);
                pg8::EpiIn E{proj, (float*)(ws + WS_SMALL)};
                pg8::gemm_phase<pg8::EpiIn, pg8::StaticOrder, true, true>((PG8_LAS unsigned char*)lds_raw, g, S, E);
            } else if (sub == 1 && (PHM & 8)) {
                { const int hh = (cid >> 5) & 7;
                  ConvW cwr;
#pragma unroll
                  for (int part = 0; part < 3; ++part)
#pragma unroll
                      for (int tap = 0; tap < 4; ++tap) cwr.w[part][tap] = *(const f32x4*)(P.gdn_conv_w + tap * 3072 + part * 1024 + hh * HD + 4 * (tid & 31));
                  const float neg_a = -__expf(P.gdn_a_log[hh]), dtb = P.gdn_dt_bias[hh];
                  PrepStage st; prep_fetch(st, cid, P, tid);
                  PrepHold hd; hd.unit = cid; hd.at = (u32x4){0u, 0u, 0u, 0u}; hd.uh[0] = hd.at; hd.uh[1] = hd.at; hd.w[0] = hd.at; hd.w[1] = hd.at;
                  for (int u = cid; u < NCH; u += G) { const int un = (u + G < NCH) ? u + G : u; gdn_prep_unit(lds, u, un, st, hd, cwr, P, tid, neg_a, dtb); }
                  prep_flush(hd, P, tid); }
            } else if (sub == 2) {
                if ((PHM & 32)) for (int bh = cid; bh < BG * NH; bh += G) gdn_seq_unit(lds, bh, P, tid);
                if ((PHM & 16)) { const bool sq = cid < BG * NH; const int first = sq ? cid * 4 : (cid - BG * NH) * 4 + 1, cnt = sq ? 1 : 3; for (int x = 0; x < cnt; ++x) fox_item(lds, first + x, P, tid, x == 0); }
            } else if (sub == 3 && (PHM & 64)) {
                pg8::Gemm g{(const pg8::bf16_t*)(ws + WS_YFOX), (const pg8::bf16_t*)(ws + WS_YGDN), (const pg8::bf16_t*)(ws + WS_WBF), (const pg8::bf16_t*)(ws + WS_WBG), GM, DM, DM};
                pg8::PairOrder S; S.init(GM, DM, G, cid);
                pg8::EpiY E{proj + 7 * PROJ_STRIDE, proj + 8 * PROJ_STRIDE, (pg8::bf16_t*)(ws + WS_T1), (pg8::bf16_t*)(ws + WS_Y)};
                pg8::gemm_phase<pg8::EpiY, pg8::PairOrder, true, true>((PG8_LAS unsigned char*)lds_raw, g, S, E);
            } else if (sub == 4 && (PHM & 128)) {
                pg8::Gemm g{(const pg8::bf16_t*)(ws + WS_Y), nullptr, (const pg8::bf16_t*)(ws + WS_WOUT), nullptr, GM, DM, DM};
                pg8::StaticOrder S; S.init(GM, DM, G, cid);
                pg8::EpiOut E{(const pg8::bf16_t*)(P.out + r0g * DM), (const float*)(ws + WS_CTL + 512 * 1024) + r0g, P.norm_mix, (pg8::bf16_t*)(ws + WS_H1B), rowss1 + r0g};
                pg8::gemm_phase<pg8::EpiOut, pg8::StaticOrder, true, true>((PG8_LAS unsigned char*)lds_raw, g, S, E);
            } else if (sub == 5 && (PHM & 256)) {
                pg8::Gemm g{(const pg8::bf16_t*)(ws + WS_H1B), nullptr, (const pg8::bf16_t*)(ws + WS_WUP), nullptr, GM, NUP, DM};
                pg8::StaticOrder S; S.init(GM, NUP, G, cid);
                pg8::EpiUp E{(pg8::bf16_t*)(ws + WS_UP), rowss1 + r0g, NUP};
                pg8::gemm_phase<pg8::EpiUp, pg8::StaticOrder, true, true>((PG8_LAS unsigned char*)lds_raw, g, S, E);
            } else if (sub == 6) {
                if (PHM & 512) phase_convgate(P, tid, cid);
            } else if (PHM & 1024) {
                pg8::Gemm g{(const pg8::bf16_t*)(ws + WS_ACT), nullptr, (const pg8::bf16_t*)(ws + WS_WDN), nullptr, GM, DM, DFF};
                pg8::StaticOrder S; S.init(GM, DM, G, cid);
                pg8::EpiDown E{(const pg8::bf16_t*)(ws + WS_H1B), P.out + r0g * DM, rowss2 + r0g};
                pg8::gemm_phase<pg8::EpiDown, pg8::StaticOrder, true, true>((PG8_LAS unsigned char*)lds_raw, g, S, E);
            }
        }
      }
        if (ph + 1 < args.ph_hi) { if (ph == args.ph_lo) { grid.sync(); xbar = xcd_barrier_post((unsigned*)(args.ws + WS_CTL + 800 * 1024), xst); } else xcd_barrier(xbar); }
    }
}

extern "C" void kernel_launch(void* const* d_in, const int* in_sizes, int n_in, void* d_out, int out_size, void* d_ws, size_t ws_size, hipStream_t stream) {
    static int ready = 0;
    if (ready == 0) {
        if (n_in != 16 || in_sizes[0] != MTOK * DM || out_size != MTOK * DM || ws_size < WS_END) {
            fprintf(stderr, "kernel_launch: unexpected shapes (n_in %d, in0 %d, out %d, ws %zu; need ws >= %zu)\n", n_in, n_in > 0 ? in_sizes[0] : -1, out_size, ws_size, (size_t)WS_END); ready = -1; return; }
        if (hipFuncSetAttribute((const void*)mk_fwd, hipFuncAttributeMaxDynamicSharedMemorySize, LDS_BYTES) != hipSuccess) { fprintf(stderr, "kernel_launch: hipFuncSetAttribute failed\n"); ready = -1; return; }
        int per_cu = 0;
        if (hipOccupancyMaxActiveBlocksPerMultiprocessor(&per_cu, (const void*)mk_fwd, 512, LDS_BYTES) != hipSuccess || per_cu < 1) fprintf(stderr, "kernel_launch: occupancy query says %d blocks per CU\n", per_cu);
        (void)hipGetLastError();
        ready = 1;
    }
    if (ready < 0) return;
#if !MK_ONE_LAUNCH
    (void)hipMemsetAsync((char*)d_ws + WS_CTL, 0, 1 * MiB, stream);
#endif
    Args a{};
    for (int i = 0; i < 16; ++i) a.in[i] = (const float*)d_in[i];
    a.out = (float*)d_out; a.ws = (unsigned char*)d_ws;
#if MK_ONE_LAUNCH
    a.ph_lo = 0; a.ph_hi = N_PHASES;
    void* kargs[] = {&a};
    hipError_t e = hipLaunchCooperativeKernel((const void*)mk_fwd, dim3(256), dim3(512), kargs, LDS_BYTES, stream);
    if (e != hipSuccess) fprintf(stderr, "kernel_launch: cooperative launch failed: %s\n", hipGetErrorString(e));
#else
    for (int ph = 0; ph < N_PHASES; ++ph) { a.ph_lo = ph; a.ph_hi = ph + 1; hipLaunchKernelGGL(mk_fwd, dim3(256), dim3(512), LDS_BYTES, stream, a); }
#endif
}
```

```cpp
#include <hip/hip_runtime.h>
#include <hip/hip_bf16.h>
#include <hip/hip_cooperative_groups.h>
#include <cstdio>
#include <cstdint>
namespace cg = cooperative_groups;

#ifndef MK_ONE_LAUNCH
#define MK_ONE_LAUNCH 1
#endif

namespace pg8 {
#define PG8_LAS __attribute__((address_space(3)))
typedef unsigned short bf16_t;
typedef short bf16x8 __attribute__((ext_vector_type(8)));
typedef float f32x4 __attribute__((ext_vector_type(4)));
typedef unsigned u32x4 __attribute__((ext_vector_type(4)));
constexpr int BM = 256, BK = 64, HALF = 128, HTB = HALF * BK * 2  , STAGE_BYTES = 8 * HTB, NXCD = 8, WGM = 4;

__host__ __device__ __forceinline__ int lds_byte(int r, int c) { const int st = (r >> 4) * 2 + (c >> 5), rr = r & 15, cc = c & 31, ob = rr * 64 + cc * 2; return st * 1024 + (ob ^ (((ob >> 9) & 1) << 5)); }
__host__ __device__ __forceinline__ void stage_rc(int b, int& R, int& C) { const int st = b / 1024, sb = b % 1024, swz = sb ^ (((sb >> 9) & 1) << 5); R = (st >> 1) * 16 + swz / 64; C = (st & 1) * 32 + (swz % 64) / 2; }
__host__ __device__ __forceinline__ int perm32(int rho) { const int n = rho >> 4, i = rho & 15; return 8 * (i >> 2) + 4 * n + (i & 3); }

struct Unit { int pm, pn, sel; };
struct Gemm { const bf16_t* A0; const bf16_t* A1; const bf16_t* B0; const bf16_t* B1; int M, N, K; };

struct StaticOrder {
    int nM, nN, nwg, G, c;
    __host__ __device__ __forceinline__ void init(int M, int N, int G_, int c_) { nM = M / BM; nN = N / BM; nwg = nM * nN; G = G_; c = c_; }
    __host__ __device__ __forceinline__ bool next(int i, Unit& u) const {
        const long L = (long)i * G + c; if (L >= nwg) return false;
        int wgid = (int)L; { const int q = nwg / NXCD, r = nwg % NXCD, xcd = wgid % NXCD, off = wgid / NXCD; wgid = (xcd < r ? xcd * (q + 1) : r * (q + 1) + (xcd - r) * q) + off; }
        const int nig = WGM * nN, gid = wgid / nig, fm = gid * WGM, gsz = (nM - fm) < WGM ? (nM - fm) : WGM;
        u.pm = fm + ((wgid % nig) % gsz); u.pn = (wgid % nig) / gsz; u.sel = 0; return true;
    }
    __device__ __forceinline__ void a_ready(const Unit&) const {}
    __device__ __forceinline__ void done(const Unit&) const {}
};

__device__ __forceinline__ unsigned cvt_pk_bf16(float lo, float hi) { unsigned r; asm volatile("v_cvt_pk_bf16_f32 %0, %1, %2" : "=v"(r) : "v"(lo), "v"(hi)); return r; }
typedef unsigned u32x2 __attribute__((ext_vector_type(2)));
__device__ __forceinline__ float bflo(unsigned w) { return __uint_as_float(w << 16); }
__device__ __forceinline__ float bfhi(unsigned w) { return __uint_as_float(w & 0xffff0000u); }
__device__ __forceinline__ float sigm(float x) { return __builtin_amdgcn_rcpf(1.0f + __expf(-x)); }
constexpr int GM = 32768;
constexpr int LDP = 1024;

struct EpiIn {
    static constexpr bool PERM = true, AFTER_DRAIN = false;
    bf16_t* proj; float* small;
    __device__ __forceinline__ void operator()(const f32x4 (&acc)[2][2][4][2], const Unit& u, int wr, int wc, int fr, int fq) const {
        const int row0 = u.pm * BM + wr * 64 + fr;
        if (u.pn < 36) {
            bf16_t* base = proj + (size_t)(u.pn >> 2) * ((size_t)GM * LDP) + (u.pn & 3) * 256 + wc * 32 + 8 * fq;
#pragma unroll
            for (int ai = 0; ai < 2; ++ai)
#pragma unroll
                for (int m = 0; m < 4; ++m) { bf16_t* rowp = base + (size_t)(row0 + ai * HALF + m * 16) * LDP;
#pragma unroll
                    for (int bj = 0; bj < 2; ++bj) { const f32x4 v0 = acc[ai][bj][m][0], v1 = acc[ai][bj][m][1];
                        u32x4 w; w.x = cvt_pk_bf16(v0[0], v0[1]); w.y = cvt_pk_bf16(v0[2], v0[3]); w.z = cvt_pk_bf16(v1[0], v1[1]); w.w = cvt_pk_bf16(v1[2], v1[3]);
                        *(u32x4*)(rowp + bj * HALF) = w; } }
        } else if (wc == 0 && fq < 3) {
#pragma unroll
            for (int ai = 0; ai < 2; ++ai)
#pragma unroll
                for (int m = 0; m < 4; ++m) { float* p = small + (size_t)(row0 + ai * HALF + m * 16) * 32 + 8 * fq;
                    *(f32x4*)p = acc[ai][0][m][0]; *(f32x4*)(p + 4) = acc[ai][0][m][1]; }
        }
    }
};
struct EpiY {
    static constexpr bool PERM = true, AFTER_DRAIN = false;
    const bf16_t* gf; const bf16_t* gg; bf16_t* t1; bf16_t* y;
    __device__ __forceinline__ void operator()(const f32x4 (&acc)[2][2][4][2], const Unit& u, int wr, int wc, int fr, int fq) const {
        const int row0 = u.pm * BM + wr * 64 + fr, col0 = u.pn * BM + wc * 32 + 8 * fq;
        const bf16_t* const gf_ = gf; const bf16_t* const gg_ = gg; bf16_t* const t1_ = t1; bf16_t* const y_ = y;
        const bf16_t* gate = u.sel ? gg_ : gf_; bf16_t* dst = u.sel ? y_ : t1_;
        if (u.sel) asm volatile("s_waitcnt vmcnt(0)" ::: "memory");
#pragma unroll
        for (int ai = 0; ai < 2; ++ai) {
            u32x4 gw[4][2], tw[4][2];
#pragma unroll
            for (int m = 0; m < 4; ++m)
#pragma unroll
                for (int bj = 0; bj < 2; ++bj) { const size_t o = (size_t)(row0 + ai * HALF + m * 16) * LDP + col0 + bj * HALF;
                    gw[m][bj] = *(const u32x4*)(gate + o); tw[m][bj] = u.sel ? *(const u32x4*)(t1_ + o) : (u32x4){0u, 0u, 0u, 0u}; }
#pragma unroll
            for (int m = 0; m < 4; ++m)
#pragma unroll
                for (int bj = 0; bj < 2; ++bj) { const size_t o = (size_t)(row0 + ai * HALF + m * 16) * LDP + col0 + bj * HALF;
                    const u32x4 g = gw[m][bj], t = tw[m][bj]; const f32x4 v0 = acc[ai][bj][m][0], v1 = acc[ai][bj][m][1];
                    const float r0 = sigm(bflo(g.x)) * v0[0] + bflo(t.x), r1 = sigm(bfhi(g.x)) * v0[1] + bfhi(t.x), r2 = sigm(bflo(g.y)) * v0[2] + bflo(t.y), r3 = sigm(bfhi(g.y)) * v0[3] + bfhi(t.y);
                    const float r4 = sigm(bflo(g.z)) * v1[0] + bflo(t.z), r5 = sigm(bfhi(g.z)) * v1[1] + bfhi(t.z), r6 = sigm(bflo(g.w)) * v1[2] + bflo(t.w), r7 = sigm(bfhi(g.w)) * v1[3] + bfhi(t.w);
                    u32x4 w; w.x = cvt_pk_bf16(r0, r1); w.y = cvt_pk_bf16(r2, r3); w.z = cvt_pk_bf16(r4, r5); w.w = cvt_pk_bf16(r6, r7);
                    *(u32x4*)(dst + o) = w; }
        }
    }
};
struct EpiOut {
    static constexpr bool PERM = true, AFTER_DRAIN = false;
    const bf16_t* xn; const float* irx; const float* gmix; bf16_t* h1b; float* rowss;
    __device__ __forceinline__ void operator()(const f32x4 (&acc)[2][2][4][2], const Unit& u, int wr, int wc, int fr, int fq) const {
        const int col0 = u.pn * BM + wc * 32 + 8 * fq;
        f32x4 ig[2][2];
#pragma unroll
        for (int bj = 0; bj < 2; ++bj)
#pragma unroll
            for (int n = 0; n < 2; ++n) { const f32x4 g = *(const f32x4*)(gmix + col0 + bj * HALF + 4 * n); ig[bj][n] = (f32x4){__builtin_amdgcn_rcpf(g[0]), __builtin_amdgcn_rcpf(g[1]), __builtin_amdgcn_rcpf(g[2]), __builtin_amdgcn_rcpf(g[3])}; }
#pragma unroll
        for (int ai = 0; ai < 2; ++ai) {
            u32x4 pre[4][2]; float ir[4];
#pragma unroll
            for (int m = 0; m < 4; ++m) { const int row = u.pm * BM + ai * HALF + wr * 64 + m * 16 + fr; ir[m] = irx[row];
#pragma unroll
                for (int bj = 0; bj < 2; ++bj) pre[m][bj] = *(const u32x4*)(xn + (size_t)row * LDP + col0 + bj * HALF); }
#pragma unroll
            for (int m = 0; m < 4; ++m) { const int row = u.pm * BM + ai * HALF + wr * 64 + m * 16 + fr; const size_t ro = (size_t)row * LDP + col0; float ss = 0.f;
#pragma unroll
                for (int bj = 0; bj < 2; ++bj) { const size_t o = ro + bj * HALF; const u32x4 p = pre[m][bj];
                    const f32x4 h0 = (f32x4){bflo(p.x), bfhi(p.x), bflo(p.y), bfhi(p.y)} * ir[m] * ig[bj][0] + acc[ai][bj][m][0], h1 = (f32x4){bflo(p.z), bfhi(p.z), bflo(p.w), bfhi(p.w)} * ir[m] * ig[bj][1] + acc[ai][bj][m][1];
                    u32x4 w; w.x = cvt_pk_bf16(h0[0], h0[1]); w.y = cvt_pk_bf16(h0[2], h0[3]); w.z = cvt_pk_bf16(h1[0], h1[1]); w.w = cvt_pk_bf16(h1[2], h1[3]); *(u32x4*)(h1b + o) = w;
                    ss += (h0[0] * h0[0] + h0[1] * h0[1]) + (h0[2] * h0[2] + h0[3] * h0[3]) + (h1[0] * h1[0] + h1[1] * h1[1]) + (h1[2] * h1[2] + h1[3] * h1[3]); }
                ss += __shfl_xor(ss, 16); ss += __shfl_xor(ss, 32);
                if (fq == 0) atomicAdd(rowss + row, ss); }
        }
    }
};
struct EpiUp {
    static constexpr bool PERM = true, AFTER_DRAIN = false;
    bf16_t* up; const float* rowss; int ldc;
    __device__ __forceinline__ void operator()(const f32x4 (&acc)[2][2][4][2], const Unit& u, int wr, int wc, int fr, int fq) const {
        const int row0 = u.pm * BM + wr * 64 + fr, col0 = u.pn * BM + wc * 32 + 8 * fq;
        float rsv[2][4];
#pragma unroll
        for (int ai = 0; ai < 2; ++ai)
#pragma unroll
            for (int m = 0; m < 4; ++m) rsv[ai][m] = rowss[row0 + ai * HALF + m * 16];
#pragma unroll
        for (int ai = 0; ai < 2; ++ai)
#pragma unroll
            for (int m = 0; m < 4; ++m) { const int row = row0 + ai * HALF + m * 16; const float rs = rsqrtf(rsv[ai][m] * (1.0f / 1024.0f) + 1e-6f); bf16_t* rowp = up + (size_t)row * ldc + col0;
#pragma unroll
                for (int bj = 0; bj < 2; ++bj) { const f32x4 v0 = acc[ai][bj][m][0] * rs, v1 = acc[ai][bj][m][1] * rs;
                    u32x4 w; w.x = cvt_pk_bf16(v0[0], v0[1]); w.y = cvt_pk_bf16(v0[2], v0[3]); w.z = cvt_pk_bf16(v1[0], v1[1]); w.w = cvt_pk_bf16(v1[2], v1[3]);
                    *(u32x4*)(rowp + bj * HALF) = w; } }
    }
};
struct EpiDown {
    static constexpr bool PERM = true, AFTER_DRAIN = false;
    const bf16_t* h1b; float* hout; float* rowss;
    __device__ __forceinline__ void operator()(const f32x4 (&acc)[2][2][4][2], const Unit& u, int wr, int wc, int fr, int fq) const {
        const int col0 = u.pn * BM + wc * 32 + 8 * fq;
#pragma unroll
        for (int ai = 0; ai < 2; ++ai) {
            u32x4 pre[4][2];
#pragma unroll
            for (int m = 0; m < 4; ++m)
#pragma unroll
                for (int bj = 0; bj < 2; ++bj) pre[m][bj] = *(const u32x4*)(h1b + (size_t)(u.pm * BM + ai * HALF + wr * 64 + m * 16 + fr) * LDP + col0 + bj * HALF);
#pragma unroll
            for (int m = 0; m < 4; ++m) { const int row = u.pm * BM + ai * HALF + wr * 64 + m * 16 + fr; const size_t ro = (size_t)row * LDP + col0; float ss = 0.f;
#pragma unroll
                for (int bj = 0; bj < 2; ++bj) { const size_t o = ro + bj * HALF; const u32x4 p = pre[m][bj];
                    const f32x4 h0 = (f32x4){bflo(p.x), bfhi(p.x), bflo(p.y), bfhi(p.y)} + acc[ai][bj][m][0], h1 = (f32x4){bflo(p.z), bfhi(p.z), bflo(p.w), bfhi(p.w)} + acc[ai][bj][m][1];
                    *(f32x4*)(hout + o) = h0; *(f32x4*)(hout + o + 4) = h1;
                    ss += (h0[0] * h0[0] + h0[1] * h0[1]) + (h0[2] * h0[2] + h0[3] * h0[3]) + (h1[0] * h1[0] + h1[1] * h1[1]) + (h1[2] * h1[2] + h1[3] * h1[3]); }
                ss += __shfl_xor(ss, 16); ss += __shfl_xor(ss, 32);
                if (fq == 0) atomicAdd(rowss + row, ss); }
        }
    }
};
struct PairOrder {
    int nM, nN, nwg, G, c;
    __host__ __device__ __forceinline__ void init(int M, int N, int G_, int c_) { nM = M / BM; nN = N / BM; nwg = nM * nN; G = G_; c = c_; }
    __host__ __device__ __forceinline__ bool next(int i, Unit& u) const {
        const long L = (long)(i >> 1) * G + c; if (L >= nwg) return false;
        int wgid = (int)L; { const int q = nwg / NXCD, r = nwg % NXCD, xcd = wgid % NXCD, off = wgid / NXCD; wgid = (xcd < r ? xcd * (q + 1) : r * (q + 1) + (xcd - r) * q) + off; }
        const int nig = WGM * nN, gid = wgid / nig, fm = gid * WGM, gsz = (nM - fm) < WGM ? (nM - fm) : WGM;
        u.pm = fm + ((wgid % nig) % gsz); u.pn = (wgid % nig) / gsz; u.sel = i & 1; return true;
    }
    __device__ __forceinline__ void a_ready(const Unit&) const {}
    __device__ __forceinline__ void done(const Unit&) const {}
};
template <class Epi, class Sched, bool ALIGN_EPI = false, bool SP2 = false>
__device__ __forceinline__ void gemm_phase(PG8_LAS unsigned char* lds, const Gemm g, const Sched& S, const Epi& E) {
    int tid_l = threadIdx.x; asm volatile("" : "+v"(tid_l));
    const int tid = tid_l, wid = __builtin_amdgcn_readfirstlane(tid >> 6), lane = tid & 63, wr = wid >> 2, wc = wid & 3, fr = lane & 15, fq = lane >> 4;
    const int K = g.K, nt = K / BK;
    unsigned voffA[2], voffB[2];
#pragma unroll
    for (int i = 0; i < 2; ++i) { int R, C; stage_rc(tid * 16 + i * 8192, R, C); const int Rb = Epi::PERM ? ((R & ~31) + perm32(R & 31)) : R;
        voffA[i] = (unsigned)(R * K + C) * 2u; voffB[i] = (unsigned)(Rb * K + C) * 2u; }
    const size_t kstep = (size_t)(BK * 2);
    const size_t hstep = (size_t)HALF * K * 2;
    const size_t tstep = 2 * hstep;
    const unsigned ldsw = (unsigned)wid * 1024u;
    const int aoff = lds_byte(wr * 64 + fr, fq * 8), boff = lds_byte(wc * 32 + fr, fq * 8);
#define PG8_SA(b, h) (((b) * 2 + (h)) * HTB)
#define PG8_SB(b, h) ((4 + (b) * 2 + (h)) * HTB)
#define PG8_STAGE(bufoff, gbase, voff) do { _Pragma("unroll") for (int _i = 0; _i < 2; ++_i) \
        __builtin_amdgcn_global_load_lds((const unsigned*)((const char*)(gbase) + (voff)[_i]), (PG8_LAS unsigned*)(lds + (bufoff) + ldsw + _i * 8192), 16, 0, 0); } while (0)
#define PG8_LDA(dst, b, h) do { _Pragma("unroll") for (int m = 0; m < 4; ++m) _Pragma("unroll") for (int k = 0; k < 2; ++k) dst[m][k] = *(const PG8_LAS bf16x8*)(lds + PG8_SA(b, h) + aoff + m * 2048 + k * 1024); } while (0)
#define PG8_LDB(dst, b, h) do { _Pragma("unroll") for (int n = 0; n < 2; ++n) _Pragma("unroll") for (int k = 0; k < 2; ++k) dst[n][k] = *(const PG8_LAS bf16x8*)(lds + PG8_SB(b, h) + boff + n * 2048 + k * 1024); } while (0)
#define PG8_MMA(ai, bj, At, Bt) do { __builtin_amdgcn_s_setprio(1); _Pragma("unroll") for (int m = 0; m < 4; ++m) _Pragma("unroll") for (int n = 0; n < 2; ++n) _Pragma("unroll") for (int k = 0; k < 2; ++k) \
        acc[ai][bj][m][n] = __builtin_amdgcn_mfma_f32_16x16x32_bf16(Bt[n][k], At[m][k], acc[ai][bj][m][n], 0, 0, 0); __builtin_amdgcn_s_setprio(0); } while (0)
#define PG8_WAIT_V(n) asm volatile("s_waitcnt vmcnt(" #n ")" ::: "memory")
#define PG8_WAIT_L(n) asm volatile("s_waitcnt lgkmcnt(" #n ")" ::: "memory")
#define PG8_BAR __builtin_amdgcn_s_barrier()
#define PG8_SCHED __builtin_amdgcn_sched_barrier(0)
    Unit cur, nxt; int ui = 0;
    if (!S.next(0, cur)) return;
    f32x4 acc[2][2][4][2];
#pragma unroll
    for (int a = 0; a < 2; ++a)
#pragma unroll
        for (int b = 0; b < 2; ++b)
#pragma unroll
            for (int m = 0; m < 4; ++m)
#pragma unroll
                for (int n = 0; n < 2; ++n) acc[a][b][m][n] = (f32x4){0.f, 0.f, 0.f, 0.f};
    bf16x8 At[4][2], B0[2][2], B1[2][2];
    const char* cA = (const char*)(cur.sel ? g.A1 : g.A0) + (size_t)cur.pm * tstep; const char* cB = (const char*)(cur.sel ? g.B1 : g.B0) + (size_t)cur.pn * tstep;
    S.a_ready(cur);
    if constexpr (SP2) {
        PG8_STAGE(PG8_SB(0, 0), cB, voffB); PG8_STAGE(PG8_SB(0, 1), cB + hstep, voffB); PG8_STAGE(PG8_SA(0, 0), cA, voffA); PG8_STAGE(PG8_SA(0, 1), cA + hstep, voffA);
        if (wr == 1) PG8_BAR;
        PG8_WAIT_V(2); PG8_BAR;
        PG8_STAGE(PG8_SB(1, 0), cB + kstep, voffB); PG8_STAGE(PG8_SA(1, 0), cA + kstep, voffA); PG8_STAGE(PG8_SB(1, 1), cB + hstep + kstep, voffB);
        PG8_WAIT_V(6); PG8_BAR;
    } else {
        PG8_STAGE(PG8_SB(0, 0), cB, voffB); PG8_STAGE(PG8_SA(0, 0), cA, voffA); PG8_STAGE(PG8_SB(0, 1), cB + hstep, voffB); PG8_STAGE(PG8_SA(0, 1), cA + hstep, voffA);
        if (wr == 1) PG8_BAR;
        PG8_WAIT_V(4); PG8_BAR;
        PG8_STAGE(PG8_SB(1, 0), cB + kstep, voffB); PG8_STAGE(PG8_SA(1, 0), cA + kstep, voffA); PG8_STAGE(PG8_SB(1, 1), cB + hstep + kstep, voffB);
        PG8_WAIT_V(6); PG8_BAR;
    }
    for (;;) {
        const bool has_next = S.next(ui + 1, nxt);
        const char* nA = has_next ? (const char*)(nxt.sel ? g.A1 : g.A0) + (size_t)nxt.pm * tstep : cA; const char* nB = has_next ? (const char*)(nxt.sel ? g.B1 : g.B0) + (size_t)nxt.pn * tstep : cB;
        for (int t = 0; t < nt; t += 2) {
            const bool last = (t == nt - 2);
            const char* a1 = cA + (size_t)(t + 1) * kstep;
            const char* a2 = last ? nA : cA + (size_t)(t + 2) * kstep; const char* b2 = last ? nB : cB + (size_t)(t + 2) * kstep;
            const char* a3 = a2 + kstep; const char* b3 = b2 + kstep;
            if (last && has_next) S.a_ready(nxt);
            if constexpr (SP2) {
            PG8_LDB(B0, 0, 0); PG8_LDB(B1, 0, 1); PG8_SCHED; PG8_LDA(At, 0, 0); PG8_STAGE(PG8_SA(1, 1), a1 + hstep, voffA);
            PG8_WAIT_V(8); PG8_WAIT_L(0); PG8_BAR; PG8_MMA(0, 0, At, B0); PG8_MMA(0, 1, At, B1); PG8_BAR; PG8_SCHED;
            PG8_LDA(At, 0, 1); PG8_STAGE(PG8_SB(0, 0), b2, voffB); PG8_STAGE(PG8_SB(0, 1), b2 + hstep, voffB); PG8_STAGE(PG8_SA(0, 0), a2, voffA);
            PG8_WAIT_V(8); PG8_WAIT_L(0); PG8_BAR; PG8_MMA(1, 0, At, B0); PG8_MMA(1, 1, At, B1); PG8_BAR; PG8_SCHED;
            PG8_LDB(B0, 1, 0); PG8_LDB(B1, 1, 1); PG8_SCHED; PG8_LDA(At, 1, 0); PG8_STAGE(PG8_SA(0, 1), a2 + hstep, voffA);
            PG8_WAIT_V(8); PG8_WAIT_L(0); PG8_BAR; PG8_MMA(0, 0, At, B0); PG8_MMA(0, 1, At, B1); PG8_BAR; PG8_SCHED;
            PG8_LDA(At, 1, 1); PG8_STAGE(PG8_SB(1, 0), b3, voffB); PG8_STAGE(PG8_SB(1, 1), b3 + hstep, voffB); PG8_STAGE(PG8_SA(1, 0), a3, voffA);
            PG8_WAIT_V(8); PG8_WAIT_L(0); PG8_BAR; PG8_MMA(1, 0, At, B0); PG8_MMA(1, 1, At, B1); PG8_BAR; PG8_SCHED;
            } else {
            PG8_LDB(B0, 0, 0); PG8_SCHED; PG8_LDA(At, 0, 0); PG8_STAGE(PG8_SA(1, 1), a1 + hstep, voffA);
            PG8_WAIT_L(8); PG8_BAR; PG8_WAIT_L(0); PG8_MMA(0, 0, At, B0); PG8_BAR; PG8_SCHED;
            PG8_LDB(B1, 0, 1); PG8_STAGE(PG8_SB(0, 0), b2, voffB);
            PG8_BAR; PG8_WAIT_L(0); PG8_MMA(0, 1, At, B1); PG8_BAR;
            PG8_LDA(At, 0, 1); PG8_STAGE(PG8_SA(0, 0), a2, voffA);
            PG8_BAR; PG8_WAIT_L(0); PG8_MMA(1, 0, At, B0); PG8_BAR; PG8_SCHED;
            PG8_STAGE(PG8_SB(0, 1), b2 + hstep, voffB);
            PG8_WAIT_V(6); PG8_BAR; PG8_MMA(1, 1, At, B1); PG8_BAR;
            PG8_LDB(B0, 1, 0); PG8_SCHED; PG8_LDA(At, 1, 0); PG8_STAGE(PG8_SA(0, 1), a2 + hstep, voffA);
            PG8_WAIT_L(8); PG8_BAR; PG8_WAIT_L(0); PG8_MMA(0, 0, At, B0); PG8_BAR; PG8_SCHED;
            PG8_LDB(B1, 1, 1); PG8_STAGE(PG8_SB(1, 0), b3, voffB);
            PG8_BAR; PG8_WAIT_L(0); PG8_MMA(0, 1, At, B1); PG8_BAR;
            PG8_LDA(At, 1, 1); PG8_STAGE(PG8_SA(1, 0), a3, voffA);
            PG8_BAR; PG8_WAIT_L(0); PG8_MMA(1, 0, At, B0); PG8_BAR; PG8_SCHED;
            PG8_STAGE(PG8_SB(1, 1), b3 + hstep, voffB);
            PG8_WAIT_V(6); PG8_BAR; PG8_MMA(1, 1, At, B1); PG8_BAR;
            }
        }
        if constexpr (ALIGN_EPI) { if (wr == 0) PG8_BAR; }
        if constexpr (!Epi::AFTER_DRAIN) { E(acc, cur, wr, wc, fr, fq); S.done(cur); }
        if (!has_next) break;
#pragma unroll
        for (int a = 0; a < 2; ++a)
#pragma unroll
            for (int b = 0; b < 2; ++b)
#pragma unroll
                for (int m = 0; m < 4; ++m)
#pragma unroll
                    for (int n = 0; n < 2; ++n) acc[a][b][m][n] = (f32x4){0.f, 0.f, 0.f, 0.f};
        cur = nxt; cA = nA; cB = nB; ++ui;
        if constexpr (ALIGN_EPI) { if (wr == 1) PG8_BAR; }
    }
    PG8_WAIT_V(0);
    if constexpr (!ALIGN_EPI) { if (wr == 0) PG8_BAR; }
    PG8_BAR;
    if constexpr (Epi::AFTER_DRAIN) { E.fused(acc, cur, wr, wc, fr, fq, lds, wid, lane); S.done(cur); }
#undef PG8_SA
#undef PG8_SB
#undef PG8_STAGE
#undef PG8_LDA
#undef PG8_LDB
#undef PG8_MMA
#undef PG8_WAIT_V
#undef PG8_WAIT_L
#undef PG8_BAR
#undef PG8_SCHED
}
}

namespace fox {
constexpr int D = 128, PITCH = 1024;
constexpr bool WSKIP = false;
constexpr float THR = 8.f;
constexpr float SCALE = 0.08838834764831845f;
constexpr int NW = 8, QBLK = 32, KVBLK = 64, QB = NW * QBLK;
constexpr int SHM_V = KVBLK * D * 2, SHM_K = KVBLK * D * 2;
constexpr int LDS_BYTES = 2 * SHM_V + 2 * SHM_K + NW * 64 * 4;
using bf16 = __hip_bfloat16;
typedef short bf16x8 __attribute__((ext_vector_type(8)));
typedef short s16x4 __attribute__((ext_vector_type(4)));
typedef float f32x16 __attribute__((ext_vector_type(16)));
typedef float f32x4 __attribute__((ext_vector_type(4)));
typedef unsigned u32x4 __attribute__((ext_vector_type(4)));
template <class A, class Bt> struct same_t { static constexpr bool v = false; };
template <class A> struct same_t<A, A> { static constexpr bool v = true; };
__device__ __forceinline__ void bias_tile(f32x16& p0, f32x16& p1, const float* cbp) {
#pragma unroll
    for (int rr = 0; rr < 4; ++rr) { const f32x4 a = *(const f32x4*)(cbp + 8 * rr), b = *(const f32x4*)(cbp + 32 + 8 * rr);
#pragma unroll
        for (int e = 0; e < 4; ++e) { p0[4 * rr + e] += a[e]; p1[4 * rr + e] += b[e]; } }
}
#define KSWZ(row, colB) ((row) * 256 + ((colB) ^ (((row) & 7) << 4)))
#define SBAR() __builtin_amdgcn_sched_barrier(0)
__device__ __forceinline__ int v_st(int k, int c) { const int kk = (k & ~0xC) | ((k & 4) << 1) | ((k & 8) >> 1); return ((kk >> 3) * 4 + (c >> 5)) * 512 + ((kk & 7) * 32 + (c & 31)) * 2; }
__device__ __forceinline__ int v_rd_base(int lane) { return ((lane & 3) << 3) | (((lane >> 2) & 3) << 6) | (((lane >> 4) & 1) << 5) | (((lane >> 5) & 1) << 8); }
constexpr int v_rd_off(int d0, int ks, int half) { return d0 * 512 + ks * 4096 + half * 2048; }
__device__ __forceinline__ int crow(int r, int hi) { return (r & 3) + 8 * (r >> 2) + 4 * hi; }
__device__ __forceinline__ unsigned cvtpk(float lo, float hi) {
    unsigned r; asm volatile("v_cvt_pk_bf16_f32 %0, %1, %2" : "=v"(r) : "v"(lo), "v"(hi)); return r;
}
__device__ __forceinline__ bf16x8 pack8(f32x4 a, f32x4 b) {
    u32x4 w = {cvtpk(a[0], a[1]), cvtpk(a[2], a[3]), cvtpk(b[0], b[1]), cvtpk(b[2], b[3])};
    return *reinterpret_cast<bf16x8*>(&w);
}
template <class T> __device__ __forceinline__ bf16x8 load8(const T* p) {
    if constexpr (same_t<T, float>::v) { return pack8(*(const f32x4*)p, *(const f32x4*)(p + 4)); }
    else { return *reinterpret_cast<const bf16x8*>(p); }
}
__device__ __forceinline__ void mask_tile(f32x16& p0, f32x16& p1, int dq, unsigned W) {
    const float NEG = -__builtin_inff();
#pragma unroll
    for (int r = 0; r < 16; ++r) {
        const int c = (r & 3) + 8 * (r >> 2);
        if ((unsigned)(dq - c) >= W) p0[r] = NEG;
        if ((unsigned)(dq - c - 32) >= W) p1[r] = NEG;
    }
}
__device__ __forceinline__ void partialSM(f32x16& p0, f32x16& p1, float& m_reg, float& mn, float& alpha) {
    float pmax = p0[0]; for (int r = 1; r < 16; ++r) pmax = fmaxf(pmax, p0[r]); for (int r = 0; r < 16; ++r) pmax = fmaxf(pmax, p1[r]);
    { auto rr = __builtin_amdgcn_permlane32_swap(__float_as_uint(pmax), __float_as_uint(pmax), false, false);
      pmax = fmaxf(__uint_as_float(rr[0]), __uint_as_float(rr[1])); }
    constexpr float C2 = 1.4426950408889634f * SCALE;
    if (__builtin_expect(__all((pmax - m_reg) * SCALE <= THR), 1)) { mn = m_reg; alpha = 1.f; }
    else { mn = fmaxf(m_reg, pmax); alpha = __builtin_amdgcn_exp2f((m_reg - mn) * C2); m_reg = mn; }
    const float mnL = -mn * C2;
    for (int r = 0; r < 16; ++r) p0[r] = fmaf(p0[r], C2, mnL); for (int r = 0; r < 16; ++r) p1[r] = fmaf(p1[r], C2, mnL);
    for (int r = 0; r < 16; ++r) p0[r] = __builtin_amdgcn_exp2f(p0[r]);
}
__device__ __forceinline__ void finishSM(f32x16& p0, f32x16& p1, float alpha, float& l_reg, bf16x8& pa0, bf16x8& pa1, bf16x8& pa2, bf16x8& pa3) {
    for (int r = 0; r < 16; ++r) p1[r] = __builtin_amdgcn_exp2f(p1[r]);
    float ps = 0; for (int r = 0; r < 16; ++r) ps += p0[r]; for (int r = 0; r < 16; ++r) ps += p1[r];
    { auto rr = __builtin_amdgcn_permlane32_swap(__float_as_uint(ps), __float_as_uint(ps), false, false);
      ps = __uint_as_float(rr[0]) + __uint_as_float(rr[1]); }
    l_reg = l_reg * alpha + ps;
#define PK4(P, B_, OUT) do { unsigned a0 = cvtpk(P[B_+0], P[B_+1]), a1 = cvtpk(P[B_+2], P[B_+3]);                          \
        unsigned b0 = cvtpk(P[B_+4], P[B_+5]), b1 = cvtpk(P[B_+6], P[B_+7]);                                             \
        auto r0 = __builtin_amdgcn_permlane32_swap(a0, b0, false, false); auto r1 = __builtin_amdgcn_permlane32_swap(a1, b1, false, false); \
        u32x4 w = {r0[0], r1[0], r0[1], r1[1]}; OUT = *reinterpret_cast<bf16x8*>(&w); } while (0)
    PK4(p0, 0, pa0); PK4(p0, 8, pa1); PK4(p1, 0, pa2); PK4(p1, 8, pa3);
#undef PK4
}
template <int KB, bool SK>
__device__ __forceinline__ void qkt(f32x16& p0, f32x16& p1, const char* K_lds, int r32, int hi, const bf16x8* qr, bool act, const float* cbp) {
    if (SK && !act) { const float NEG = -__builtin_inff();
#pragma unroll
        for (int r = 0; r < 16; ++r) { p0[r] = NEG; p1[r] = NEG; } return; }
    { const f32x4* c4 = (const f32x4*)cbp; const f32x4 a0 = c4[0], a1 = c4[2], a2 = c4[4], a3 = c4[6], b0 = c4[8], b1 = c4[10], b2 = c4[12], b3 = c4[14];
      p0 = (f32x16){a0[0], a0[1], a0[2], a0[3], a1[0], a1[1], a1[2], a1[3], a2[0], a2[1], a2[2], a2[3], a3[0], a3[1], a3[2], a3[3]};
      p1 = (f32x16){b0[0], b0[1], b0[2], b0[3], b1[0], b1[1], b1[2], b1[3], b2[0], b2[1], b2[2], b2[3], b3[0], b3[1], b3[2], b3[3]}; }
    const char* kb[4];
#pragma unroll
    for (int dd = 0; dd < 4; ++dd) kb[dd] = K_lds + KB * SHM_K + KSWZ(r32, (dd * 16 + hi * 8) * 2);
#pragma unroll
    for (int d0 = 0; d0 < 8; ++d0) { const char* a = kb[d0 & 3] + (d0 >> 2) * 128;
        bf16x8 b0 = *reinterpret_cast<const bf16x8*>(a);
        bf16x8 b1 = *reinterpret_cast<const bf16x8*>(a + 32 * 256);
        p0 = __builtin_amdgcn_mfma_f32_32x32x16_bf16(b0, qr[d0], p0, 0, 0, 0);
        p1 = __builtin_amdgcn_mfma_f32_32x32x16_bf16(b1, qr[d0], p1, 0, 0, 0); }
}
template <int VB, bool SK>
__device__ __forceinline__ void pv_tile(f32x16* o, int vb0, bf16x8 pa0, bf16x8 pa1, bf16x8 pa2, bf16x8 pa3, bool act) {
    if (SK && !act) return;
#define TRRD(dst, off) asm volatile("ds_read_b64_tr_b16 %0, %1 offset:%2" : "=&v"(dst) : "v"(vb0), "i"(off) : "memory")
#define PV_D0(d0) do { s16x4 l0, l1, l2, l3, h0, h1, h2, h3; constexpr int b_ = VB * SHM_V + v_rd_off(d0, 0, 0);     \
        TRRD(l0, b_); TRRD(h0, b_ + 2048); TRRD(l1, b_ + 4096); TRRD(h1, b_ + 6144); TRRD(l2, b_ + 8192); TRRD(h2, b_ + 10240); TRRD(l3, b_ + 12288); TRRD(h3, b_ + 14336); \
        asm volatile("s_waitcnt lgkmcnt(0)" ::: "memory"); SBAR();                 \
        o[d0] = __builtin_amdgcn_mfma_f32_32x32x16_bf16(pa0, (bf16x8){l0[0], l0[1], l0[2], l0[3], h0[0], h0[1], h0[2], h0[3]}, o[d0], 0, 0, 0);   \
        o[d0] = __builtin_amdgcn_mfma_f32_32x32x16_bf16(pa1, (bf16x8){l1[0], l1[1], l1[2], l1[3], h1[0], h1[1], h1[2], h1[3]}, o[d0], 0, 0, 0);   \
        o[d0] = __builtin_amdgcn_mfma_f32_32x32x16_bf16(pa2, (bf16x8){l2[0], l2[1], l2[2], l2[3], h2[0], h2[1], h2[2], h2[3]}, o[d0], 0, 0, 0);   \
        o[d0] = __builtin_amdgcn_mfma_f32_32x32x16_bf16(pa3, (bf16x8){l3[0], l3[1], l3[2], l3[3], h3[0], h3[1], h3[2], h3[3]}, o[d0], 0, 0, 0); } while (0)
    PV_D0(0); PV_D0(1); PV_D0(2); PV_D0(3);
#undef PV_D0
#undef TRRD
}

template <class TIn, class TOut> struct BlockRef { const TIn* Q; const TIn* K; const TIn* V; TOut* O; int P0; };
template <class TIn> struct Seam {
    bf16x8 qr[8];
    bf16x8 st_v0, st_v1, st_k0, st_k1; f32x4 sf0, sf1, sf2, sf3;
    f32x4 tq[16];
};
__device__ __forceinline__ int swa_jlo(int P0, int W) { const int lowk = P0 - W + 1; return lowk > 0 ? lowk / KVBLK : 0; }
#define ROW(p, k0, rr) ((p) + (size_t)((k0) + (rr)) * PITCH + sc)
#define VMW() asm volatile("s_waitcnt vmcnt(0)" ::: "memory")
#define VMWN(n) asm volatile("s_waitcnt vmcnt(%0)" :: "i"(n) : "memory")
#define SLOAD_H(Kp, Vp, k0) do { S.st_v0 = load8<TIn>(ROW(Vp, k0, sr)); S.st_v1 = load8<TIn>(ROW(Vp, k0, 32 + sr));              \
                         S.st_k0 = load8<TIn>(ROW(Kp, k0, sr)); S.st_k1 = load8<TIn>(ROW(Kp, k0, 32 + sr)); } while (0)
#define SWRITE_HK(bf) do { *(bf16x8*)(K_lds + (bf) * SHM_K + kws) = S.st_k0; *(bf16x8*)(K_lds + (bf) * SHM_K + kws + 32 * 256) = S.st_k1; } while (0)
#define SWRITE_HV(bf) do { *(bf16x8*)(V_lds + (bf) * SHM_V + vst0) = S.st_v0; *(bf16x8*)(V_lds + (bf) * SHM_V + vst1) = S.st_v1; } while (0)
#define SWRITE_H(bf) do { SWRITE_HV(bf); SWRITE_HK(bf); } while (0)
#define SLOAD_F(p, k0) do { S.sf0 = *(const f32x4*)ROW(p, k0, sr); S.sf1 = *(const f32x4*)(ROW(p, k0, sr) + 4);                \
                            S.sf2 = *(const f32x4*)ROW(p, k0, 32 + sr); S.sf3 = *(const f32x4*)(ROW(p, k0, 32 + sr) + 4); } while (0)
#define SWRITE_KF(bf) do { *(bf16x8*)(K_lds + (bf) * SHM_K + kws) = pack8(S.sf0, S.sf1); *(bf16x8*)(K_lds + (bf) * SHM_K + kws + 32 * 256) = pack8(S.sf2, S.sf3); } while (0)
#define SWRITE_VF(bf) do { *(bf16x8*)(V_lds + (bf) * SHM_V + vst0) = pack8(S.sf0, S.sf1); *(bf16x8*)(V_lds + (bf) * SHM_V + vst1) = pack8(S.sf2, S.sf3); } while (0)
template <class TIn, class TOut>
__device__ __forceinline__ void causal_swa_prime(const BlockRef<TIn, TOut>& cur, int W, char* lds, Seam<TIn>& S) {
    constexpr bool F32 = same_t<TIn, float>::v;
    int tid_l = threadIdx.x; asm volatile("" : "+v"(tid_l));
    const int tid = tid_l, wid = __builtin_amdgcn_readfirstlane(tid >> 6), lane = tid & 63, r32 = lane & 31, hi = lane >> 5;
    const int sr = tid >> 4, sc = (tid & 15) * 8, kws = KSWZ(sr, sc * 2); char* K_lds = lds + 2 * SHM_V;
    const int kb0 = swa_jlo(cur.P0, W) * KVBLK;
    for (int d0 = 0; d0 < 8; ++d0) S.qr[d0] = load8<TIn>(cur.Q + (size_t)(wid * QBLK + r32) * PITCH + d0 * 16 + hi * 8);
    if constexpr (F32) { SLOAD_F((const float*)cur.K, kb0); VMW(); SWRITE_KF(0); SBAR(); SLOAD_F((const float*)cur.V, kb0); }
    else { SLOAD_H(cur.K, cur.V, kb0); VMW(); SWRITE_HK(0); }
    __syncthreads();
}
template <class TIn, class TOut>
__device__ __forceinline__ void causal_swa_block(const BlockRef<TIn, TOut>& cur, const BlockRef<TIn, TOut>& nxt, int skv, int W, char* lds, Seam<TIn>& S, const float* cbias) {
    constexpr bool F32 = same_t<TIn, float>::v;
    int tid_l = threadIdx.x; asm volatile("" : "+v"(tid_l));
    const int tid = tid_l, wid = __builtin_amdgcn_readfirstlane(tid >> 6), lane = tid & 63, r32 = lane & 31, hi = lane >> 5;
    const int j_lo = swa_jlo(cur.P0, W);
    int j_hi = (cur.P0 + QB - 1) / KVBLK + 1; if (j_hi > skv / KVBLK) j_hi = skv / KVBLK;
    const int NT = j_hi - j_lo;
    const int kbn = swa_jlo(nxt.P0, W) * KVBLK;
    const int qlo = cur.P0 + wid * QBLK, qm = qlo + r32 - 4 * hi;
    char* V_lds = lds; char* K_lds = lds + 2 * SHM_V;
    float* ws = (float*)(lds + 2 * SHM_V + 2 * SHM_K) + wid * 64; float* li_l = ws, * al_l = ws + 32;
    float m_reg = -1e30f, l_reg = 0; f32x16 o[4] = {};
    const int sr = tid >> 4, sc = (tid & 15) * 8, vst0 = v_st(sr, sc), vst1 = v_st(32 + sr, sc), kws = KSWZ(sr, sc * 2);
    const int vb0 = (int)(uintptr_t)V_lds + v_rd_base(lane);
    const TIn* Kh = cur.K; const TIn* Vh = cur.V;
#define RESC(a) do { if (__any((a) < 1.f)) { if (hi == 0) al_l[r32] = (a); asm volatile("s_waitcnt lgkmcnt(0)" ::: "memory");              \
                     for (int d_ = 0; d_ < 4; ++d_) for (int r = 0; r < 16; ++r) o[d_][r] *= al_l[crow(r, hi)]; } } while (0)
#define KBASE(t) ((j_lo + (t)) * KVBLK)
#define ACT(t) (KBASE(t) <= qlo + QBLK - 1 && KBASE(t) + KVBLK - 1 >= qlo - W + 1)
#define MASKT(P0_, P1_, t) do { const int kb_ = KBASE(t); if ((!SK || ACT(t)) && (kb_ + KVBLK - 1 > qlo || kb_ <= qlo + QBLK - 1 - W)) mask_tile(P0_, P1_, qm - kb_, (unsigned)W); } while (0)
    constexpr int NQL = F32 ? 16 : 8;
    constexpr bool SK = WSKIP && !F32;
#define SEAM_K0() do { VMWN(NQL); if constexpr (F32) { SWRITE_KF(0); SBAR(); SLOAD_F((const float*)nxt.V, kbn); } else { SWRITE_HK(0); } SBAR(); } while (0)
    f32x16 pA0, pA1, pB0, pB1; float mnA, mnB, alA, alB; bf16x8 pa0, pa1, pa2, pa3;
    if constexpr (F32) { VMW(); SWRITE_VF(0); SBAR(); } else { SWRITE_HV(0); SBAR(); }
    if (NT > 1) { if constexpr (F32) SLOAD_F((const float*)Kh, KBASE(1)); else SLOAD_H(Kh, Vh, KBASE(1)); }
    SBAR(); qkt<0, SK>(pA0, pA1, K_lds, r32, hi, S.qr, ACT(0), cbias + KBASE(0) + 4 * hi);
    if constexpr (F32) { if (NT > 1) { VMW(); SWRITE_KF(1); SBAR(); SLOAD_F((const float*)Vh, KBASE(1)); } }
    MASKT(pA0, pA1, 0); partialSM(pA0, pA1, m_reg, mnA, alA);
    if (NT > 1) { VMW(); if constexpr (F32) { SWRITE_VF(1); SBAR(); if (NT > 2) SLOAD_F((const float*)Kh, KBASE(2)); } else SWRITE_H(1); }
    __syncthreads();
#define HALF_STEP(PX0, PX1, mnX, alX, PY0, PY1, alY, t, KB, VB, SB) do {                                                      \
        SBAR(); qkt<KB, SK>(PX0, PX1, K_lds, r32, hi, S.qr, ACT(t), cbias + KBASE(t) + 4 * hi);                                             \
        finishSM(PY0, PY1, alY, l_reg, pa0, pa1, pa2, pa3); SBAR();                                                           \
        if ((t) + 1 < NT) { if constexpr (F32) { VMW(); SWRITE_KF(SB); SBAR(); SLOAD_F((const float*)Vh, KBASE((t) + 1)); }  \
                            else { SLOAD_H(Kh, Vh, KBASE((t) + 1)); } SBAR(); }                                               \
        pv_tile<VB, SK>(o, vb0, pa0, pa1, pa2, pa3, ACT((t) - 1)); MASKT(PX0, PX1, (t)); partialSM(PX0, PX1, m_reg, mnX, alX);                                        \
        __syncthreads();                                                                                                      \
        if ((t) + 1 < NT) { VMW(); if constexpr (F32) { SWRITE_VF(SB); SBAR(); if ((t) + 2 < NT) SLOAD_F((const float*)Kh, KBASE((t) + 2)); } \
                            else { SWRITE_H(SB); } }                                                                          \
        RESC(alX); __syncthreads(); } while (0)
    for (int t = 1; t + 1 < NT; t += 2) {
        HALF_STEP(pB0, pB1, mnB, alB, pA0, pA1, alA, t, 1, 0, 0);
        HALF_STEP(pA0, pA1, mnA, alA, pB0, pB1, alB, t + 1, 0, 1, 1);
    }
    const bool even = (NT & 1) == 0;
    if (even) { SBAR(); qkt<1, SK>(pB0, pB1, K_lds, r32, hi, S.qr, ACT(NT - 1), cbias + KBASE(NT - 1) + 4 * hi); SBAR(); }
#define QROW(e) (nxt.Q + (size_t)(wid * QBLK + r32) * PITCH + ((e) >> 1) * 16 + hi * 8 + ((e) & 1) * 4)
    if constexpr (F32) { SLOAD_F((const float*)nxt.K, kbn); SBAR();
#pragma unroll
        for (int e = 0; e < 8; ++e) S.tq[e] = *(const f32x4*)QROW(e); }
    else { SLOAD_H(nxt.K, nxt.V, kbn); SBAR();
#pragma unroll
        for (int d0 = 0; d0 < 8; ++d0) S.qr[d0] = load8<TIn>(nxt.Q + (size_t)(wid * QBLK + r32) * PITCH + d0 * 16 + hi * 8); }
    SBAR();
    finishSM(pA0, pA1, alA, l_reg, pa0, pa1, pa2, pa3); SBAR();
    if constexpr (F32) {
#pragma unroll
        for (int e = 8; e < 16; ++e) S.tq[e] = *(const f32x4*)QROW(e); SBAR(); }
#undef QROW
    pv_tile<0, SK>(o, vb0, pa0, pa1, pa2, pa3, ACT(even ? NT - 2 : NT - 1));
    if (even) { MASKT(pB0, pB1, NT - 1); partialSM(pB0, pB1, m_reg, mnB, alB); __syncthreads(); RESC(alB);
        finishSM(pB0, pB1, alB, l_reg, pa0, pa1, pa2, pa3); SBAR(); pv_tile<1, SK>(o, vb0, pa0, pa1, pa2, pa3, ACT(NT - 1)); }
    SBAR(); SEAM_K0();
    if (hi == 0) li_l[r32] = l_reg; asm volatile("s_waitcnt lgkmcnt(0)" ::: "memory");
    float rli[16];
#pragma unroll
    for (int r = 0; r < 16; ++r) rli[r] = __builtin_amdgcn_rcpf(li_l[crow(r, hi)]);
    TOut* Ow = cur.O + (size_t)(wid * QBLK) * PITCH;
#pragma unroll
    for (int r = 0; r < 16; ++r) { const int orow = crow(r, hi);
#pragma unroll
        for (int d0 = 0; d0 < 4; ++d0) { const float v = o[d0][r] * rli[r];
            if constexpr (same_t<TOut, float>::v) { Ow[(size_t)orow * PITCH + d0 * 32 + r32] = v; }
            else { const float vn = __shfl_xor(v, 1);
                   if ((r32 & 1) == 0) *(unsigned*)(Ow + (size_t)orow * PITCH + d0 * 32 + r32) = cvtpk(v, vn); } } }
    if constexpr (F32) {
#pragma unroll
        for (int d0 = 0; d0 < 8; ++d0) S.qr[d0] = pack8(S.tq[2 * d0], S.tq[2 * d0 + 1]); }
    __syncthreads();
#undef RESC
#undef KBASE
#undef ACT
#undef MASKT
#undef SEAM_K0
#undef HALF_STEP
}
#undef ROW
#undef VMW
#undef VMWN
#undef SLOAD_H
#undef SWRITE_HK
#undef SWRITE_HV
#undef SWRITE_H
#undef SLOAD_F
#undef SWRITE_KF
#undef SWRITE_VF
}

typedef unsigned short bf16_t;
typedef short bf16x8 __attribute__((ext_vector_type(8)));
typedef float f32x4 __attribute__((ext_vector_type(4)));
typedef unsigned u32x4 __attribute__((ext_vector_type(4)));
typedef unsigned u32x2 __attribute__((ext_vector_type(2)));
constexpr int DM = 1024, NB = 32, SEQ = 2048, NH = 8, HD = 128, DFF = 2816, NUP = 2 * DFF;
constexpr int MTOK = NB * SEQ;
constexpr int NG = 2, BG = NB / NG, GM = BG * SEQ;
constexpr int NIN = 37 * 256;
constexpr int NCH = BG * NH * 32;
static_assert(GM == pg8::GM, "group rows");
constexpr size_t MiB = 1u << 20;
constexpr size_t WS_CTL = 0;
constexpr size_t WS_WIN = 1 * MiB, WS_WBF = 20 * MiB, WS_WBG = 22 * MiB, WS_WOUT = 24 * MiB, WS_WUP = 26 * MiB, WS_WDN = 37 * MiB;
constexpr size_t WS_PROJ = 44 * MiB;
constexpr size_t WS_SMALL = 620 * MiB;
constexpr size_t WS_PREP = 624 * MiB;
constexpr size_t WS_END = 913 * MiB;
constexpr size_t PBUF = 64 * MiB;
constexpr size_t WS_H1B = WS_PROJ + 0 * PBUF;
constexpr size_t WS_T1 = WS_PROJ + 1 * PBUF;
constexpr size_t WS_Y = WS_PROJ + 2 * PBUF;
constexpr size_t WS_YGDN = WS_PROJ + 3 * PBUF;
constexpr size_t WS_YFOX = WS_PROJ + 5 * PBUF;
constexpr size_t WS_UP = WS_PROJ + 3 * PBUF;
constexpr size_t WS_ACT = WS_PREP;
constexpr size_t PROJ_STRIDE = (size_t)GM * 1024;
constexpr int LDS_BYTES = 163840;

__device__ __forceinline__ float bf2f(bf16_t b) { return __uint_as_float((unsigned)b << 16); }
__device__ __forceinline__ float bflo(unsigned w) { return __uint_as_float(w << 16); }
__device__ __forceinline__ float bfhi(unsigned w) { return __uint_as_float(w & 0xffff0000u); }
typedef float f32x2_t __attribute__((ext_vector_type(2))); typedef __bf16 bf16x2_t __attribute__((ext_vector_type(2)));
__device__ __forceinline__ unsigned pk2(float lo, float hi) { f32x2_t v = {lo, hi}; bf16x2_t b = __builtin_convertvector(v, bf16x2_t); return __builtin_bit_cast(unsigned, b); }
__device__ __forceinline__ bf16_t f2bf(float f) { return (bf16_t)(pk2(f, 0.f) & 0xffffu); }
__device__ __forceinline__ float siluf(float y) { return y * __builtin_amdgcn_rcpf(1.0f + __expf(-y)); }
__device__ __forceinline__ float wave_sum(float v) {
#pragma unroll
    for (int o = 1; o < 64; o <<= 1) v += __shfl_xor(v, o);
    return v;
}

struct Args { const float* in[16]; float* out; unsigned char* ws; int ph_lo, ph_hi; };
struct Ptrs {
    const float *x, *norm_mix, *w_in, *fox_f_bias, *gdn_conv_w, *gdn_a_log, *gdn_dt_bias, *gdn_norm, *w_bf, *w_bg, *w_out, *norm_ffn, *w_up, *ffn_conv_w, *w_down, *norm_final;
    float* out; unsigned char* ws;
};

template <int MODE> __device__ __forceinline__ int srccol(int n) {
    if (MODE == 0) return n;
    if (MODE == 1) {
        if (n < 3072) return n;
        if (n < 6144) return 3080 + (n - 3072);
        if (n < 9216) return 6168 + (n - 6144);
        const int s = n - 9216;
        if (s < 8) return 3072 + s;
        if (s < 16) return 6152 + (s - 8);
        if (s < 24) return 6160 + (s - 16);
        return -1;
    }
    { const int p = n >> 8, s = (n >> 7) & 1, i = n & 127; return s * DFF + 128 * p + i; }
}
template <int MODE> __device__ __forceinline__ void transpose_item(const float* W, int K, int N, const float* ksc, bf16_t* WT, float* scr, int item, int nblk, int lane) {
    const int kb = item / nblk, nb = item % nblk, k0 = 64 * kb, n0 = 32 * nb;
    const int sc = srccol<MODE>(n0 + (lane & 31));
    float tv[32];
    const int scc = sc >= 0 ? sc : 0;
#pragma unroll
    for (int i = 0; i < 32; ++i) tv[i] = W[(size_t)(k0 + 2 * i + (lane >> 5)) * N + scc];
    if (ksc) {
#pragma unroll
        for (int i = 0; i < 32; ++i) tv[i] *= ksc[k0 + 2 * i + (lane >> 5)]; }
#pragma unroll
    for (int i = 0; i < 32; ++i) scr[(2 * i + (lane >> 5)) * 33 + (lane & 31)] = (sc >= 0) ? tv[i] : 0.f;
    asm volatile("s_waitcnt lgkmcnt(0)" ::: "memory");
    const int c = lane & 7;
#pragma unroll
    for (int j = 0; j < 4; ++j) { const int n = (lane >> 3) + 8 * j; const float* s = scr + (8 * c) * 33 + n;
        u32x4 o; o.x = pk2(s[0 * 33], s[1 * 33]); o.y = pk2(s[2 * 33], s[3 * 33]); o.z = pk2(s[4 * 33], s[5 * 33]); o.w = pk2(s[6 * 33], s[7 * 33]);
        *(u32x4*)(WT + (size_t)(n0 + n) * K + k0 + 8 * c) = o; }
    asm volatile("s_waitcnt lgkmcnt(0)" ::: "memory");
}
__device__ __forceinline__ void phase_prologue(const Ptrs& P, char* lds, int tid, int cid) {
    const int lane = tid & 63, wave = tid >> 6;
    float* scr = (float*)(lds + wave * 16384);
    const int gw = cid * 8 + wave, NGW = 256 * 8;
    bf16_t* win_t = (bf16_t*)(P.ws + WS_WIN); bf16_t* wbf_t = (bf16_t*)(P.ws + WS_WBF); bf16_t* wbg_t = (bf16_t*)(P.ws + WS_WBG);
    bf16_t* wout_t = (bf16_t*)(P.ws + WS_WOUT); bf16_t* wup_t = (bf16_t*)(P.ws + WS_WUP); bf16_t* wdn_t = (bf16_t*)(P.ws + WS_WDN);
    constexpr int I_IN = 16 * (NIN / 32), I_SQ = 16 * 32, I_UP = 16 * (NUP / 32), I_DN = (DFF / 64) * 32;
    constexpr int NITEMS = I_IN + 3 * I_SQ + I_UP + I_DN;
    for (int it = gw; it < NITEMS; it += NGW) {
        int r = it;
        if (r < I_IN) { transpose_item<1>(P.w_in, DM, 9240, nullptr, win_t, scr, r, NIN / 32, lane); continue; } r -= I_IN;
        if (r < I_SQ) { transpose_item<0>(P.w_bf, DM, DM, nullptr, wbf_t, scr, r, 32, lane); continue; } r -= I_SQ;
        if (r < I_SQ) { transpose_item<0>(P.w_bg, DM, DM, nullptr, wbg_t, scr, r, 32, lane); continue; } r -= I_SQ;
        if (r < I_SQ) { transpose_item<0>(P.w_out, DM, DM, nullptr, wout_t, scr, r, 32, lane); continue; } r -= I_SQ;
        if (r < I_UP) { transpose_item<2>(P.w_up, DM, NUP, P.norm_ffn, wup_t, scr, r, NUP / 32, lane); continue; } r -= I_UP;
        transpose_item<0>(P.w_down, DFF, DM, nullptr, wdn_t, scr, r, 32, lane);
    }
    f32x4 gv[4];
#pragma unroll
    for (int j = 0; j < 4; ++j) gv[j] = ((const f32x4*)P.norm_mix)[lane + 64 * j];
    for (int m0 = gw; m0 < MTOK; m0 += 2 * NGW) {
        const int m1 = m0 + NGW;
        const f32x4* xr0 = (const f32x4*)(P.x + (size_t)m0 * DM) + lane; const f32x4* xr1 = (const f32x4*)(P.x + (size_t)m1 * DM) + lane;
        f32x4 v0[4], v1[4]; float s0 = 0.f, s1 = 0.f;
#pragma unroll
        for (int j = 0; j < 4; ++j) { v0[j] = __builtin_nontemporal_load(xr0 + 64 * j); v1[j] = __builtin_nontemporal_load(xr1 + 64 * j); }
#pragma unroll
        for (int j = 0; j < 4; ++j) { s0 += (v0[j][0] * v0[j][0] + v0[j][1] * v0[j][1]) + (v0[j][2] * v0[j][2] + v0[j][3] * v0[j][3]); s1 += (v1[j][0] * v1[j][0] + v1[j][1] * v1[j][1]) + (v1[j][2] * v1[j][2] + v1[j][3] * v1[j][3]); }
        const float rstd0 = rsqrtf(wave_sum(s0) * (1.f / DM) + 1e-6f), rstd1 = rsqrtf(wave_sum(s1) * (1.f / DM) + 1e-6f);
        if (lane == 0) { float* irx = (float*)(P.ws + WS_CTL + 512 * 1024); irx[m0] = __builtin_amdgcn_rcpf(rstd0); irx[m1] = __builtin_amdgcn_rcpf(rstd1); }
        const int g0 = m0 / GM, g1 = m1 / GM;
        u32x2* o0 = (u32x2*)((bf16_t*)(P.out + (size_t)g0 * GM * DM) + (size_t)(m0 - g0 * GM) * DM) + lane;
        u32x2* o1 = (u32x2*)((bf16_t*)(P.out + (size_t)g1 * GM * DM) + (size_t)(m1 - g1 * GM) * DM) + lane;
#pragma unroll
        for (int j = 0; j < 4; ++j) { const f32x4 t0 = v0[j] * rstd0 * gv[j], t1 = v1[j] * rstd1 * gv[j]; u32x2 w0, w1; w0.x = pk2(t0[0], t0[1]); w0.y = pk2(t0[2], t0[3]); w1.x = pk2(t1[0], t1[1]); w1.y = pk2(t1[2], t1[3]); o0[64 * j] = w0; o1[64 * j] = w1; }
    }
}

__device__ __forceinline__ f32x4 mma16(const bf16_t* A, int lda, const bf16_t* Bt, int ldb, int ksteps, f32x4 acc, int lane) {
    const int r = lane & 15, q = lane >> 4;
    const bf16_t* ap = A + r * lda + q * 8; const bf16_t* bp = Bt + r * ldb + q * 8;
    for (int ks = 0; ks < ksteps; ++ks) { const bf16x8 a = *(const bf16x8*)(ap + ks * 32); const bf16x8 b = *(const bf16x8*)(bp + ks * 32); acc = __builtin_amdgcn_mfma_f32_16x16x32_bf16(a, b, acc, 0, 0, 0); }
    return acc;
}
#define LBAR() do { asm volatile("s_waitcnt lgkmcnt(0)" ::: "memory"); __builtin_amdgcn_s_barrier(); asm volatile("" ::: "memory"); } while (0)
__device__ __forceinline__ f32x4 mma16s(const bf16_t* A, int lda, int sw, const bf16_t* Bt, int ldb, int ksteps, f32x4 acc, int lane) {
    const int r = lane & 15, q = lane >> 4;
    const bf16_t* ap = A + r * lda; const bf16_t* bp = Bt + r * ldb + q * 8;
    for (int ks = 0; ks < ksteps; ++ks) { const bf16x8 a = *(const bf16x8*)(ap + (((ks * 4 + q) ^ sw) << 3)); const bf16x8 b = *(const bf16x8*)(bp + ks * 32); acc = __builtin_amdgcn_mfma_f32_16x16x32_bf16(a, b, acc, 0, 0, 0); }
    return acc;
}
constexpr int PQ = 136, PC = 72;
struct PrepBufs { bf16_t *W, *QD, *KDT, *UHT, *AT; float* GL; };
__device__ __forceinline__ PrepBufs prep_bufs(unsigned char* ws) {
    PrepBufs b; b.W = (bf16_t*)(ws + WS_PREP); b.QD = (bf16_t*)(ws + WS_PREP + 64 * MiB); b.KDT = (bf16_t*)(ws + WS_PREP + 128 * MiB); b.UHT = (bf16_t*)(ws + WS_PREP + 192 * MiB);
    b.AT = (bf16_t*)(ws + WS_PREP + 256 * MiB); b.GL = (float*)(ws + WS_PREP + 288 * MiB); return b;
}
constexpr int PL_QS = 0, PL_KS = 17408, PL_KDT = 34816, PL_RAW = 53248, RAWP = 392  , PL_RT = PL_RAW + 67 * RAWP * 2, PL_GC = PL_RT + 256 * PC * 2, PL_CW = PL_GC + 512, PL_END = PL_CW + 6144;
constexpr int RAW_CHUNKS = 67 * 48;
#ifndef SEGSEL
#define SEGSEL 0
#endif
#define SEG_T0() unsigned long long seg_t0 = 0; if (SEGSEL && blockIdx.x == 0 && threadIdx.x == 0) seg_t0 = __builtin_amdgcn_s_memrealtime()
#define SEG_MARK(k) do { if (SEGSEL && blockIdx.x == 0 && threadIdx.x == 0) { const unsigned long long t_ = __builtin_amdgcn_s_memrealtime(); if (SEGSEL == (k)) atomicAdd((float*)(P.ws + WS_CTL + 768 * 1024), (float)(t_ - seg_t0) * 0.01f); seg_t0 = t_; } } while (0)
struct PrepStage { u32x4 raw[7]; float ga, gb; };
struct ConvW { f32x4 w[3][4]; };
struct PrepHold { u32x4 uh[2], w[2], at; int unit; };
__device__ __forceinline__ void prep_fetch(PrepStage& st, int unit, const Ptrs& P, int tid) {
    const int n = unit & 31, h = (unit >> 5) & 7, bl = unit >> 8;
    const int R0 = bl * SEQ + n * 64;
    const bf16_t* proj = (const bf16_t*)(P.ws + WS_PROJ); const float* small = (const float*)(P.ws + WS_SMALL);
#pragma unroll
    for (int i = 0; i < 7; ++i) { int c = tid + 512 * i; c = c < RAW_CHUNKS ? c : RAW_CHUNKS - 1; const int row = c / 48, c16 = c - row * 48, part = c16 >> 4, ch = (c16 & 15) * 8;
        const bool zero = (n == 0) && (row < 3);
        const int rr = zero ? 3 : row;
        u32x4 v = *(const u32x4*)(proj + (size_t)(3 + part) * PROJ_STRIDE + (size_t)(R0 - 3 + rr) * 1024 + h * HD + ch);
        if (zero) v = (u32x4){0u, 0u, 0u, 0u};
        st.raw[i] = v; }
    { const float* sm = small + (size_t)(R0 + (tid & 63)) * 32; st.ga = sm[8 + h]; st.gb = sm[16 + h]; }
}
__device__ __forceinline__ void prep_flush(const PrepHold& hd, const Ptrs& P, int tid) {
    const PrepBufs G = prep_bufs(P.ws);
#pragma unroll
    for (int i = 0; i < 2; ++i) { const int idx = tid + 512 * i; *(u32x4*)(G.UHT + (size_t)hd.unit * 8192 + idx * 8) = hd.uh[i]; *(u32x4*)(G.W + (size_t)hd.unit * 8192 + idx * 8) = hd.w[i]; }
    *(u32x4*)(G.AT + (size_t)hd.unit * 4096 + tid * 8) = hd.at;
}
__device__ __forceinline__ void gdn_prep_unit(char* lds, int unit, int unit_next, PrepStage& st, PrepHold& hd, const ConvW& cwr, const Ptrs& P, int tid_in, float neg_a, float dtb) {
    int tid = tid_in; asm volatile("" : "+v"(tid));
    const int lane = tid & 63, wid = tid >> 6, c16 = lane & 15, q4 = lane >> 4;
    const int h = (unit >> 5) & 7;
    bf16_t* Qs = (bf16_t*)(lds + PL_QS); bf16_t* Ks = (bf16_t*)(lds + PL_KS); bf16_t* KDTs = (bf16_t*)(lds + PL_KDT);
    bf16_t* RAW = (bf16_t*)(lds + PL_RAW);
    bf16_t* RT = (bf16_t*)(lds + PL_RT);
    float* gcs = (float*)(lds + PL_GC); float* bts = gcs + 64;
    bf16_t* UHs = (bf16_t*)(lds + PL_RAW + 4096); bf16_t* Wst = UHs + 8192; bf16_t* ATs = Wst + 64 * PQ;
    bf16_t* CH = (bf16_t*)lds;
    const PrepBufs G = prep_bufs(P.ws);
    SEG_T0();
#pragma unroll
    for (int i = 0; i < 7; ++i) { const int c = tid + 512 * i; const int row = c / 48, cc = c - row * 48; if (c < RAW_CHUNKS) *(u32x4*)(RAW + row * RAWP + cc * 8) = st.raw[i]; }
    if (wid == 0) {
        const float xx = st.ga + dtb;
        const float sp = xx > 20.f ? xx : log1pf(__expf(xx));
        float cum = neg_a * sp;
        const float beta = __builtin_amdgcn_rcpf(1.0f + __expf(-st.gb));
#pragma unroll
        for (int o = 1; o < 64; o <<= 1) { const float t = __shfl_up(cum, o); if (lane >= o) cum += t; }
        gcs[lane] = cum; bts[lane] = beta;
    }
    prep_flush(hd, P, tid);
    LBAR();
    SEG_MARK(1);
    prep_fetch(st, unit_next, P, tid);
    {
        const int cg = tid & 31, rg = tid >> 5, r0 = 4 * rg, c0 = 4 * cg;
        const f32x4 gc4 = *(const f32x4*)(gcs + r0), bt4 = *(const f32x4*)(bts + r0); const float glast = gcs[63];
        float eg[4], egl[4];
#pragma unroll
        for (int rr = 0; rr < 4; ++rr) { eg[rr] = __expf(gc4[rr]); egl[rr] = __expf(glast - gc4[rr]); }
        const int key = (cg >> 1) & 7;
        const int csw = ((((rg >> 1) ^ key) << 3) | ((rg & 1) << 2));
#pragma unroll
        for (int part = 0; part < 3; ++part) {
            float x[7][4];
#pragma unroll
            for (int i = 0; i < 7; ++i) { const u32x2 a = *(const u32x2*)(RAW + (r0 + i) * RAWP + part * 128 + c0); x[i][0] = bflo(a.x); x[i][1] = bfhi(a.x); x[i][2] = bflo(a.y); x[i][3] = bfhi(a.y); }
            float y[4][4]; float ss[4];
#pragma unroll
            for (int rr = 0; rr < 4; ++rr) { ss[rr] = 0.f;
#pragma unroll
                for (int e = 0; e < 4; ++e) { float v = cwr.w[part][0][e] * x[rr][e] + cwr.w[part][1][e] * x[rr + 1][e] + cwr.w[part][2][e] * x[rr + 2][e] + cwr.w[part][3][e] * x[rr + 3][e];
                    v = siluf(v); y[rr][e] = v; ss[rr] += v * v; } }
            if (part < 2) {
#pragma unroll
                for (int rr = 0; rr < 4; ++rr) { float t = ss[rr]; t += __shfl_xor(t, 1); t += __shfl_xor(t, 2); t += __shfl_xor(t, 4); t += __shfl_xor(t, 8); t += __shfl_xor(t, 16); ss[rr] = rsqrtf(t + 1e-6f); }
            }
            if (part == 0) {
#pragma unroll
                for (int rr = 0; rr < 4; ++rr) { const float sc = ss[rr] * 0.08838834764831845f; const float a0 = y[rr][0] * sc, a1 = y[rr][1] * sc, a2 = y[rr][2] * sc, a3 = y[rr][3] * sc;
                    u32x2 w; w.x = pk2(a0, a1); w.y = pk2(a2, a3); *(u32x2*)(Qs + (r0 + rr) * PQ + c0) = w;
                    u32x2 d; d.x = pk2(a0 * eg[rr], a1 * eg[rr]); d.y = pk2(a2 * eg[rr], a3 * eg[rr]); *(u32x2*)(G.QD + (size_t)unit * 8192 + (r0 + rr) * 128 + c0) = d; }
            } else if (part == 1) {
#pragma unroll
                for (int rr = 0; rr < 4; ++rr) {
#pragma unroll
                    for (int e = 0; e < 4; ++e) y[rr][e] *= ss[rr];
                    u32x2 w; w.x = pk2(y[rr][0], y[rr][1]); w.y = pk2(y[rr][2], y[rr][3]); *(u32x2*)(Ks + (r0 + rr) * PQ + c0) = w; }
#pragma unroll
                for (int e = 0; e < 4; ++e) { u32x2 w1, w2;
                    w1.x = pk2(y[0][e] * bt4[0] * eg[0], y[1][e] * bt4[1] * eg[1]); w1.y = pk2(y[2][e] * bt4[2] * eg[2], y[3][e] * bt4[3] * eg[3]);
                    w2.x = pk2(y[0][e] * egl[0], y[1][e] * egl[1]); w2.y = pk2(y[2][e] * egl[2], y[3][e] * egl[3]);
                    *(u32x2*)(RT + (128 + c0 + e) * PC + csw) = w1; *(u32x2*)(KDTs + (c0 + e) * PC + csw) = w2; }
            } else {
#pragma unroll
                for (int e = 0; e < 4; ++e) { u32x2 w1; w1.x = pk2(y[0][e] * bt4[0], y[1][e] * bt4[1]); w1.y = pk2(y[2][e] * bt4[2], y[3][e] * bt4[3]); *(u32x2*)(RT + (c0 + e) * PC + csw) = w1; }
            }
        }
    }
    LBAR();
    SEG_MARK(2);
    {
#pragma unroll
        for (int i = 0; i < 2; ++i) { const int idx = tid + 512 * i, row = idx >> 3, ch = idx & 7; *(u32x4*)(G.KDT + (size_t)unit * 8192 + row * 64 + ch * 8) = *(const u32x4*)(KDTs + row * PC + ((ch ^ ((row >> 3) & 7)) << 3)); }
    }
    const int mat = wid >> 2, ti = wid & 3;
    f32x4 res[4], res2[4];
#pragma unroll
    for (int tj = 0; tj < 4; ++tj) { f32x4 acc = {0.f, 0.f, 0.f, 0.f}, acc2 = {0.f, 0.f, 0.f, 0.f};
        if (tj <= ti) { if (mat == 0) acc = mma16(Ks + ti * 16 * PQ, PQ, Ks + tj * 16 * PQ, PQ, 4, acc, lane);
                        acc2 = mma16(Ks + tj * 16 * PQ, PQ, (mat ? Qs : Ks) + ti * 16 * PQ, PQ, 4, acc2, lane); }
        res[tj] = acc; res2[tj] = acc2; }
    LBAR();
    {
        const int iiL = ti * 16 + c16; const float gciL = gcs[iiL], btL = bts[iiL];
#pragma unroll
        for (int tj = 0; tj < 4; ++tj) {
            const int jc0 = tj * 16 + 4 * q4;
            const f32x4 gcj = *(const f32x4*)(gcs + jc0);
            float v[4];
#pragma unroll
            for (int jj = 0; jj < 4; ++jj) { const int jc = jc0 + jj; const float dec = (iiL >= jc) ? __expf(gciL - gcj[jj]) : 0.f;
                v[jj] = (mat == 0) ? ((iiL > jc) ? -res2[tj][jj] * dec * btL : 0.f) : ((iiL >= jc) ? res2[tj][jj] * dec : 0.f); }
            u32x2 w; w.x = pk2(v[0], v[1]); w.y = pk2(v[2], v[3]);
            if (mat == 0) *(u32x2*)(CH + iiL * PC + jc0) = w;
            else *(u32x2*)(ATs + iiL * PC + jc0) = w;
            if (mat == 0) {
                const int jcL = tj * 16 + c16, ii0 = ti * 16 + 4 * q4; const float gcjL = gcs[jcL];
                const f32x4 gci = *(const f32x4*)(gcs + ii0), bti = *(const f32x4*)(bts + ii0);
                float t[4];
#pragma unroll
                for (int jj = 0; jj < 4; ++jj) { const int ii = ii0 + jj; t[jj] = (ii > jcL) ? -res[tj][jj] * __expf(gci[jj] - gcjL) * bti[jj] : 0.f; }
                u32x2 w2; w2.x = pk2(t[0], t[1]); w2.y = pk2(t[2], t[3]);
                *(u32x2*)(CH + 2 * 64 * PC + jcL * PC + ii0) = w2; }
        }
    }
    LBAR();
    SEG_MARK(3);
    f32x4 pacc[4];
    if (wid >= 4) {
#pragma unroll
        for (int tj = 0; tj < 4; ++tj) { const u32x2 nw = *(const u32x2*)(CH + (ti * 16 + c16) * PC + tj * 16 + 4 * q4); const int ii = ti * 16 + c16, jc0 = tj * 16 + 4 * q4;
            pacc[tj][0] = bflo(nw.x) + (ii == jc0 ? 1.f : 0.f); pacc[tj][1] = bfhi(nw.x) + (ii == jc0 + 1 ? 1.f : 0.f); pacc[tj][2] = bflo(nw.y) + (ii == jc0 + 2 ? 1.f : 0.f); pacc[tj][3] = bfhi(nw.y) + (ii == jc0 + 3 ? 1.f : 0.f); }
    }
    for (int s = 0; s < 6; ++s) {
        const int cur = s & 1, nxt = cur ^ 1;
        bf16_t* Qr_c = CH + cur * 64 * PC; bf16_t* Qt_c = CH + (2 + cur) * 64 * PC; bf16_t* Qr_n = CH + nxt * 64 * PC; bf16_t* Qt_n = CH + (2 + nxt) * 64 * PC;
        bf16_t* Pr_c = CH + (4 + cur) * 64 * PC; bf16_t* Pr_p = CH + (4 + nxt) * 64 * PC;
        if (wid < 4) {
            if (s < 5) {
#pragma unroll
                for (int tj = 0; tj < 4; ++tj) { f32x4 a1 = {0.f, 0.f, 0.f, 0.f}, a2 = {0.f, 0.f, 0.f, 0.f};
                    const bf16_t* ap = Qr_c + (ti * 16 + c16) * PC + q4 * 8; const bf16_t* bp = Qt_c + (tj * 16 + c16) * PC + q4 * 8;
#pragma unroll
                    for (int ks = 0; ks < 2; ++ks) { const bf16x8 fa = *(const bf16x8*)(ap + ks * 32), fb = *(const bf16x8*)(bp + ks * 32);
                        a1 = __builtin_amdgcn_mfma_f32_16x16x32_bf16(fa, fb, a1, 0, 0, 0);
                        a2 = __builtin_amdgcn_mfma_f32_16x16x32_bf16(fb, fa, a2, 0, 0, 0); }
                    u32x2 w1, w2; w1.x = pk2(a1[0], a1[1]); w1.y = pk2(a1[2], a1[3]); w2.x = pk2(a2[0], a2[1]); w2.y = pk2(a2[2], a2[3]);
                    *(u32x2*)(Qt_n + (tj * 16 + c16) * PC + ti * 16 + 4 * q4) = w1;
                    *(u32x2*)(Qr_n + (ti * 16 + c16) * PC + tj * 16 + 4 * q4) = w2; }
            }
        } else {
#pragma unroll
            for (int tj = 0; tj < 4; ++tj) {
                if (s >= 1) { const bf16_t* ap = Qt_c + (tj * 16 + c16) * PC + q4 * 8; const bf16_t* bp = Pr_p + (ti * 16 + c16) * PC + q4 * 8;
#pragma unroll
                    for (int ks = 0; ks < 2; ++ks) { const bf16x8 fa = *(const bf16x8*)(ap + ks * 32), fb = *(const bf16x8*)(bp + ks * 32); pacc[tj] = __builtin_amdgcn_mfma_f32_16x16x32_bf16(fa, fb, pacc[tj], 0, 0, 0); } }
                u32x2 w; w.x = pk2(pacc[tj][0], pacc[tj][1]); w.y = pk2(pacc[tj][2], pacc[tj][3]);
                *(u32x2*)(Pr_c + (ti * 16 + c16) * PC + tj * 16 + 4 * q4) = w; }
        }
        LBAR();
    }
    SEG_MARK(4);
    {
        const bf16_t* Tm = CH + 5 * 64 * PC;
#pragma unroll
        for (int t2 = 0; t2 < 2; ++t2) { const int tch = 2 * wid + t2; const int swl = (2 * tch + (c16 >> 3)) & 7;
#pragma unroll
            for (int tj = 0; tj < 4; ++tj) { f32x4 acc = {0.f, 0.f, 0.f, 0.f};
#pragma unroll
                for (int ks = 0; ks < 2; ++ks) { const bf16x8 fr = *(const bf16x8*)(RT + (tch * 16 + c16) * PC + (((ks * 4 + q4) ^ swl) << 3)); const bf16x8 ft = *(const bf16x8*)(Tm + (tj * 16 + c16) * PC + ks * 32 + q4 * 8);
                    acc = (tch < 8) ? __builtin_amdgcn_mfma_f32_16x16x32_bf16(ft, fr, acc, 0, 0, 0) : __builtin_amdgcn_mfma_f32_16x16x32_bf16(fr, ft, acc, 0, 0, 0); }
                u32x2 w; w.x = pk2(acc[0], acc[1]); w.y = pk2(acc[2], acc[3]);
                if (tch < 8) *(u32x2*)(UHs + ((((tch * 4 + tj) * 4 + q4) * 16 + c16) * 4)) = w;
                else *(u32x2*)(Wst + (tj * 16 + c16) * PQ + (tch - 8) * 16 + 4 * q4) = w;
            } }
        G.GL[unit] = __expf(gcs[63]);
    }
    LBAR();
#pragma unroll
    for (int i = 0; i < 2; ++i) { const int idx = tid + 512 * i; hd.uh[i] = *(const u32x4*)(UHs + idx * 8); hd.w[i] = *(const u32x4*)(Wst + (idx >> 4) * PQ + (idx & 15) * 8); }
    hd.at = *(const u32x4*)(ATs + (tid >> 3) * PC + (tid & 7) * 8); hd.unit = unit;
    LBAR();
    SEG_MARK(5);
}

__device__ __forceinline__ void gdn_seq_unit(char* lds, int bh, const Ptrs& P, int tid) {
    const int lane = tid & 63, wid = tid >> 6, c16 = lane & 15, q4 = lane >> 4;
    const int bl = bh >> 3, h = bh & 7;
    bf16_t* ST = (bf16_t*)lds;
    bf16_t* Wl = ST + 128 * PQ;
    bf16_t* QDl = Wl + 64 * PQ;
    bf16_t* ATl = QDl + 64 * PQ;
    bf16_t* KDTl = ATl + 64 * PC;
    bf16_t* UTl = KDTl + 128 * PC;
    bf16_t* GZl = UTl + 128 * PC;
    float* SSl = (float*)(GZl + 64 * PQ);
    const PrepBufs G = prep_bufs(P.ws);
    const bf16_t* gz = (const bf16_t*)(P.ws + WS_PROJ) + 6 * PROJ_STRIDE + (size_t)(bl * SEQ) * 1024 + h * HD;
    bf16_t* yg = (bf16_t*)(P.ws + WS_YGDN) + (size_t)(bl * SEQ) * 1024 + h * HD;
    f32x4 Sacc[8];
#pragma unroll
    for (int t = 0; t < 8; ++t) Sacc[t] = (f32x4){0.f, 0.f, 0.f, 0.f};
    for (int i = lane; i < 16 * PQ / 2; i += 64) ((unsigned*)(ST + wid * 16 * PQ))[i] = 0u;
    const f32x4 gn = *(const f32x4*)(P.gdn_norm + 16 * wid + 4 * q4);
    const int r16 = tid >> 4, ch16 = (tid & 15) * 8;
    const int r8 = tid >> 3, ch8 = (tid & 7) * 8;
    u32x4 sW[2], sQ[2], sA, sK[2], sG[2]; u32x2 uhn[4]; float gln;
    {
        const size_t ub = (size_t)(bh * 32) * 8192;
#pragma unroll
        for (int i = 0; i < 2; ++i) { const int idx = tid + 512 * i; sW[i] = *(const u32x4*)(G.W + ub + idx * 8); sQ[i] = *(const u32x4*)(G.QD + ub + idx * 8); sK[i] = *(const u32x4*)(G.KDT + ub + idx * 8);
            sG[i] = *(const u32x4*)(gz + (size_t)(r16 + 32 * i) * 1024 + ch16); }
        sA = *(const u32x4*)(G.AT + (size_t)(bh * 32) * 4096 + tid * 8);
#pragma unroll
        for (int t = 0; t < 4; ++t) uhn[t] = *(const u32x2*)(G.UHT + ub + ((wid * 4 + t) * 64 + lane) * 4);
        gln = G.GL[bh * 32];
    }
    for (int n = 0; n < 32; ++n) {
        const int unit = bh * 32 + n;
        const size_t ub = (size_t)unit * 8192;
#pragma unroll
        for (int i = 0; i < 2; ++i) { const int idx = tid + 512 * i;
            *(u32x4*)(Wl + (idx >> 4) * PQ + (idx & 15) * 8) = sW[i]; *(u32x4*)(QDl + (idx >> 4) * PQ + (idx & 15) * 8) = sQ[i]; *(u32x4*)(KDTl + (idx >> 3) * PC + (idx & 7) * 8) = sK[i]; }
        *(u32x4*)(ATl + r8 * PC + ch8) = sA;
        const float gl = gln;
        u32x2 uh[4];
#pragma unroll
        for (int t = 0; t < 4; ++t) uh[t] = uhn[t];
        LBAR();
        const int nn = (n + 1 < 32) ? n + 1 : 31;
        { const size_t un = (size_t)(bh * 32 + nn) * 8192;
#pragma unroll
            for (int i = 0; i < 2; ++i) { const int idx = tid + 512 * i; sW[i] = *(const u32x4*)(G.W + un + idx * 8); sQ[i] = *(const u32x4*)(G.QD + un + idx * 8); sK[i] = *(const u32x4*)(G.KDT + un + idx * 8); }
            sA = *(const u32x4*)(G.AT + (size_t)(bh * 32 + nn) * 4096 + tid * 8);
#pragma unroll
            for (int t = 0; t < 4; ++t) uhn[t] = *(const u32x2*)(G.UHT + un + ((wid * 4 + t) * 64 + lane) * 4);
            gln = G.GL[bh * 32 + nn]; }
        { const int np = (n > 0) ? n - 1 : 0;
#pragma unroll
            for (int i = 0; i < 2; ++i) { const u32x4 v = *(const u32x4*)(GZl + (r16 + 32 * i) * PQ + ch16); *(u32x4*)(yg + (size_t)(np * 64 + r16 + 32 * i) * 1024 + ch16) = v; } }
        f32x4 ws[4], os[4];
#pragma unroll
        for (int t = 0; t < 4; ++t) { ws[t] = (f32x4){0.f, 0.f, 0.f, 0.f}; os[t] = (f32x4){0.f, 0.f, 0.f, 0.f}; }
#pragma unroll
        for (int ks = 0; ks < 4; ++ks) { const bf16x8 b = *(const bf16x8*)(ST + (16 * wid + c16) * PQ + ks * 32 + q4 * 8);
#pragma unroll
            for (int t = 0; t < 4; ++t) { const bf16x8 a = *(const bf16x8*)(Wl + (16 * t + c16) * PQ + ks * 32 + q4 * 8); ws[t] = __builtin_amdgcn_mfma_f32_16x16x32_bf16(a, b, ws[t], 0, 0, 0);
                const bf16x8 a2 = *(const bf16x8*)(QDl + (16 * t + c16) * PQ + ks * 32 + q4 * 8); os[t] = __builtin_amdgcn_mfma_f32_16x16x32_bf16(b, a2, os[t], 0, 0, 0); } }
#pragma unroll
        for (int t = 0; t < 4; ++t) { u32x2 w; w.x = pk2(bflo(uh[t].x) - ws[t][0], bfhi(uh[t].x) - ws[t][1]); w.y = pk2(bflo(uh[t].y) - ws[t][2], bfhi(uh[t].y) - ws[t][3]);
            *(u32x2*)(UTl + (16 * wid + c16) * PC + 16 * t + 4 * q4) = w; }
        LBAR();
#pragma unroll
        for (int i = 0; i < 2; ++i) *(u32x4*)(GZl + (r16 + 32 * i) * PQ + ch16) = sG[i];
#pragma unroll
        for (int i = 0; i < 2; ++i) sG[i] = *(const u32x4*)(gz + (size_t)(nn * 64 + r16 + 32 * i) * 1024 + ch16);
#pragma unroll
        for (int ks = 0; ks < 2; ++ks) { const bf16x8 b = *(const bf16x8*)(UTl + (16 * wid + c16) * PC + ks * 32 + q4 * 8);
#pragma unroll
            for (int t = 0; t < 4; ++t) { const bf16x8 a = *(const bf16x8*)(ATl + (16 * t + c16) * PC + ks * 32 + q4 * 8); os[t] = __builtin_amdgcn_mfma_f32_16x16x32_bf16(b, a, os[t], 0, 0, 0); } }
#pragma unroll
        for (int t = 0; t < 8; ++t) Sacc[t] = Sacc[t] * gl;
#pragma unroll
        for (int ks = 0; ks < 2; ++ks) { const bf16x8 a = *(const bf16x8*)(UTl + (16 * wid + c16) * PC + ks * 32 + q4 * 8);
#pragma unroll
            for (int t = 0; t < 8; ++t) { const bf16x8 b = *(const bf16x8*)(KDTl + (16 * t + c16) * PC + ks * 32 + q4 * 8); Sacc[t] = __builtin_amdgcn_mfma_f32_16x16x32_bf16(b, a, Sacc[t], 0, 0, 0); } }
#pragma unroll
        for (int t = 0; t < 8; ++t) { u32x2 w; w.x = pk2(Sacc[t][0], Sacc[t][1]); w.y = pk2(Sacc[t][2], Sacc[t][3]); *(u32x2*)(ST + (16 * wid + c16) * PQ + 16 * t + 4 * q4) = w; }
#pragma unroll
        for (int t = 0; t < 4; ++t) { float s = (os[t][0] * os[t][0] + os[t][1] * os[t][1]) + (os[t][2] * os[t][2] + os[t][3] * os[t][3]); s += __shfl_xor(s, 16); s += __shfl_xor(s, 32);
            if (q4 == 0) SSl[wid * 64 + 16 * t + c16] = s; }
        LBAR();
        float tot = 0.f;
#pragma unroll
        for (int w = 0; w < 8; ++w) tot += SSl[w * 64 + lane];
        const float rstd_l = rsqrtf(tot * (1.0f / 128.0f) + 1e-6f);
#pragma unroll
        for (int t = 0; t < 4; ++t) { const int row = 16 * t + c16; const float rs = __shfl(rstd_l, row);
            u32x2* gp = (u32x2*)(GZl + row * PQ + 16 * wid + 4 * q4); const u32x2 gw = *gp; u32x2 w;
            w.x = pk2(os[t][0] * rs * gn[0] * siluf(bflo(gw.x)), os[t][1] * rs * gn[1] * siluf(bfhi(gw.x)));
            w.y = pk2(os[t][2] * rs * gn[2] * siluf(bflo(gw.y)), os[t][3] * rs * gn[3] * siluf(bfhi(gw.y))); *gp = w; }
    }
    LBAR();
#pragma unroll
    for (int i = 0; i < 2; ++i) { const u32x4 v = *(const u32x4*)(GZl + (r16 + 32 * i) * PQ + ch16); *(u32x4*)(yg + (size_t)(31 * 64 + r16 + 32 * i) * 1024 + ch16) = v; }
    __syncthreads();
}

__device__ __forceinline__ void fox_item(char* lds, int item, const Ptrs& P, int tid, bool need_bias) {
    using bf = fox::bf16;
    const int lane = tid & 63, wid = tid >> 6;
    const int bh = item >> 2, xq = item & 3, bl = bh >> 3, h = bh & 7;
    float* cb = (float*)(lds + fox::LDS_BYTES);
    float* tmp = cb + SEQ;
    const float* small = (const float*)(P.ws + WS_SMALL);
    if (need_bias) {
        const float fb = P.fox_f_bias[h];
        float lf[4]; float run = 0.f;
#pragma unroll
        for (int e = 0; e < 4; ++e) { const float xv = small[(size_t)(bl * SEQ + 4 * tid + e) * 32 + h] + fb;
            const float l = (xv < -20.f) ? xv : -log1pf(__expf(-xv)); run += l; lf[e] = run; }
        float inc = run;
#pragma unroll
        for (int o = 1; o < 64; o <<= 1) { const float t = __shfl_up(inc, o); if (lane >= o) inc += t; }
        if (lane == 63) tmp[wid] = inc;
        __syncthreads();
        float off = inc - run;
        for (int w = 0; w < wid; ++w) off += tmp[w];
#pragma unroll
        for (int e = 0; e < 4; ++e) cb[4 * tid + e] = -(off + lf[e]) * 11.313708498984761f;
        __syncthreads();
    }
    bf* fq = (bf*)(P.ws + WS_PROJ); const bf* fk = fq + PROJ_STRIDE; const bf* fv = fq + 2 * PROJ_STRIDE;
    const size_t hb = (size_t)(bl * SEQ) * 1024 + h * HD;
    fox::BlockRef<bf, bf> b0, b1;
    bf* yo = (bf*)(P.ws + WS_YFOX);
    b0.Q = fq + hb + (size_t)(xq * 256) * 1024; b0.O = yo + hb + (size_t)(xq * 256) * 1024; b0.K = fk + hb; b0.V = fv + hb; b0.P0 = xq * 256;
    b1.Q = fq + hb + (size_t)((7 - xq) * 256) * 1024; b1.O = yo + hb + (size_t)((7 - xq) * 256) * 1024; b1.K = fk + hb; b1.V = fv + hb; b1.P0 = (7 - xq) * 256;
    fox::Seam<bf> S;
    fox::causal_swa_prime<bf, bf>(b0, 1 << 20, lds, S);
    fox::causal_swa_block<bf, bf>(b0, b1, SEQ, 1 << 20, lds, S, cb);
    fox::causal_swa_block<bf, bf>(b1, b1, SEQ, 1 << 20, lds, S, cb);
    __syncthreads();
}

__device__ __forceinline__ void phase_convgate(const Ptrs& P, int tid, int cid) {
    const bf16_t* up = (const bf16_t*)(P.ws + WS_UP); bf16_t* act = (bf16_t*)(P.ws + WS_ACT);
    constexpr int NFG = DFF / 8;
    constexpr int RPB = GM / 256; static_assert(SEQ % RPB == 0, "a slab never straddles a sequence start");
    if (tid < NFG) {
        const int fg = tid, p = fg >> 4, i0 = (fg & 15) * 8, f0 = p * 128 + i0;
        const int cg0 = p * 256 + i0, cv0 = cg0 + 128;
        float wg[3][8], wv[3][8];
#pragma unroll
        for (int i = 0; i < 3; ++i)
#pragma unroll
            for (int j = 0; j < 8; ++j) { wg[i][j] = P.ffn_conv_w[i * NUP + f0 + j]; wv[i][j] = P.ffn_conv_w[i * NUP + DFF + f0 + j]; }
        const int r0 = cid * RPB;
        float g1[8], g2[8], v1[8], v2[8];
#pragma unroll
        for (int j = 0; j < 8; ++j) { g1[j] = 0.f; g2[j] = 0.f; v1[j] = 0.f; v2[j] = 0.f; }
        if ((r0 & (SEQ - 1)) != 0) {
            const u32x4 a1 = *(const u32x4*)(up + (size_t)(r0 - 1) * NUP + cg0), a2 = *(const u32x4*)(up + (size_t)(r0 - 2) * NUP + cg0);
            const u32x4 b1 = *(const u32x4*)(up + (size_t)(r0 - 1) * NUP + cv0), b2 = *(const u32x4*)(up + (size_t)(r0 - 2) * NUP + cv0);
            g1[0] = bflo(a1.x); g1[1] = bfhi(a1.x); g1[2] = bflo(a1.y); g1[3] = bfhi(a1.y); g1[4] = bflo(a1.z); g1[5] = bfhi(a1.z); g1[6] = bflo(a1.w); g1[7] = bfhi(a1.w);
            g2[0] = bflo(a2.x); g2[1] = bfhi(a2.x); g2[2] = bflo(a2.y); g2[3] = bfhi(a2.y); g2[4] = bflo(a2.z); g2[5] = bfhi(a2.z); g2[6] = bflo(a2.w); g2[7] = bfhi(a2.w);
            v1[0] = bflo(b1.x); v1[1] = bfhi(b1.x); v1[2] = bflo(b1.y); v1[3] = bfhi(b1.y); v1[4] = bflo(b1.z); v1[5] = bfhi(b1.z); v1[6] = bflo(b1.w); v1[7] = bfhi(b1.w);
            v2[0] = bflo(b2.x); v2[1] = bfhi(b2.x); v2[2] = bflo(b2.y); v2[3] = bfhi(b2.y); v2[4] = bflo(b2.z); v2[5] = bfhi(b2.z); v2[6] = bflo(b2.w); v2[7] = bfhi(b2.w);
        }
        for (int rb = 0; rb < RPB; rb += 8) {
            u32x4 ga[8], va[8];
#pragma unroll
            for (int r = 0; r < 8; ++r) { ga[r] = __builtin_nontemporal_load((const u32x4*)(up + (size_t)(r0 + rb + r) * NUP + cg0)); va[r] = __builtin_nontemporal_load((const u32x4*)(up + (size_t)(r0 + rb + r) * NUP + cv0)); }
#pragma unroll
            for (int r = 0; r < 8; ++r) {
                const u32x4 a = ga[r], b = va[r];
                float g0[8], v0[8];
                g0[0] = bflo(a.x); g0[1] = bfhi(a.x); g0[2] = bflo(a.y); g0[3] = bfhi(a.y); g0[4] = bflo(a.z); g0[5] = bfhi(a.z); g0[6] = bflo(a.w); g0[7] = bfhi(a.w);
                v0[0] = bflo(b.x); v0[1] = bfhi(b.x); v0[2] = bflo(b.y); v0[3] = bfhi(b.y); v0[4] = bflo(b.z); v0[5] = bfhi(b.z); v0[6] = bflo(b.w); v0[7] = bfhi(b.w);
                float o[8];
#pragma unroll
                for (int j = 0; j < 8; ++j) { const float cgv = wg[0][j] * g2[j] + wg[1][j] * g1[j] + wg[2][j] * g0[j]; const float cvv = wv[0][j] * v2[j] + wv[1][j] * v1[j] + wv[2][j] * v0[j];
                    o[j] = siluf(cgv) * cvv; g2[j] = g1[j]; g1[j] = g0[j]; v2[j] = v1[j]; v1[j] = v0[j]; }
                u32x4 w; w.x = pk2(o[0], o[1]); w.y = pk2(o[2], o[3]); w.z = pk2(o[4], o[5]); w.w = pk2(o[6], o[7]);
                *(u32x4*)(act + (size_t)(r0 + rb + r) * DFF + f0) = w;
            }
        }
    }
}

__device__ __forceinline__ void phase_final(const Ptrs& P, int tid, int cid, float pert) {
    const int lane = tid & 63, wave = tid >> 6;
    const int gw = cid * 8 + wave, NGW = 256 * 8;
    const float* rowss2 = (const float*)(P.ws + WS_CTL) + MTOK;
    f32x4 gv[4];
#pragma unroll
    for (int j = 0; j < 4; ++j) gv[j] = ((const f32x4*)P.norm_final)[lane + 64 * j];
    for (int m0 = gw; m0 < MTOK; m0 += 2 * NGW) {
        const int m1 = m0 + NGW;
        const float rstd0 = rsqrtf(rowss2[m0] * (1.f / DM) + 1e-6f), rstd1 = rsqrtf(rowss2[m1] * (1.f / DM) + 1e-6f);
        f32x4* o0 = (f32x4*)(P.out + (size_t)m0 * DM) + lane; f32x4* o1 = (f32x4*)(P.out + (size_t)m1 * DM) + lane;
        f32x4 a0[4], a1[4];
#pragma unroll
        for (int j = 0; j < 4; ++j) { a0[j] = __builtin_nontemporal_load(o0 + 64 * j); a1[j] = __builtin_nontemporal_load(o1 + 64 * j); }
#pragma unroll
        for (int j = 0; j < 4; ++j) { __builtin_nontemporal_store(a0[j] * rstd0 * gv[j] + pert, o0 + 64 * j); __builtin_nontemporal_store(a1[j] * rstd1 * gv[j] + pert, o1 + 64 * j); }
    }
}

#define LAS __attribute__((address_space(3)))
#define XB_TMO      128
#define XB_XCNT(j)  (256  + 64 * (j))
#define XB_XSUB(j)  (1280 + 64 * (j))
#define XB_XGEN(j)  (2304 + 64 * (j))
#define XB_TOP      3328
#define XB_TOPGEN   3392
#define XCD_BAR_WORDS 3456
#define XB_SPIN_CAP (1u << 18)

__device__ __forceinline__ unsigned xb_ld(unsigned* p)              { return __hip_atomic_load(p, __ATOMIC_RELAXED, __HIP_MEMORY_SCOPE_AGENT); }
__device__ __forceinline__ unsigned xb_add(unsigned* p, unsigned v) { return __hip_atomic_fetch_add(p, v, __ATOMIC_RELAXED, __HIP_MEMORY_SCOPE_AGENT); }
__device__ __forceinline__ unsigned xb_xcc_id() { return (unsigned)__builtin_amdgcn_s_getreg((3 << 11) | 20) & 0xFu; }
#define XB_SPIN(cond, bar) do { unsigned _sp = 0; while (cond) { __builtin_amdgcn_s_sleep(1); \
    if ((++_sp & 255u) == 0u) { if (xb_ld(&(bar)[XB_TMO])) break; if (_sp > XB_SPIN_CAP) { atomicAdd(&(bar)[XB_TMO], 1u); break; } } } } while (0)

struct XcdBarrier {
    unsigned* bar; unsigned x;
    volatile LAS unsigned* st;
};

__device__ __forceinline__ XcdBarrier xcd_barrier_post(unsigned* bar, volatile LAS unsigned* st) {
    XcdBarrier b; b.bar = bar; b.x = xb_xcc_id(); b.st = st;
    if (threadIdx.x == 0) (void)xb_add(&bar[XB_XCNT(b.x)], 1u);
    return b;
}
__device__ __forceinline__ void xcd_barrier_complete(unsigned* bar, unsigned x, unsigned& nloc, unsigned& nx) {
    const unsigned G = gridDim.x * gridDim.y * gridDim.z;
    unsigned sum, cnt, mine, sp = 0u;
    for (;;) {
        sum = 0u; cnt = 0u; mine = 0u;
#pragma unroll
        for (unsigned j = 0; j < 16; ++j) { const unsigned c = xb_ld(&bar[XB_XCNT(j)]); sum += c; cnt += (c > 0u) ? 1u : 0u; mine = (j == x) ? c : mine; }
        if (sum == G) break;
        __builtin_amdgcn_s_sleep(1);
        if ((++sp & 255u) == 0u) { if (xb_ld(&bar[XB_TMO])) break; if (sp > XB_SPIN_CAP) { atomicAdd(&bar[XB_TMO], 1u); break; } }
    }
    nloc = mine > 0u ? mine : 1u; nx = cnt > 0u ? cnt : 1u;
}

__device__ __forceinline__ void xcd_barrier(const XcdBarrier& b) {
    asm volatile("s_waitcnt vmcnt(0)" ::: "memory");
    __syncthreads();
    if (threadIdx.x == 0) {
        unsigned* bar = b.bar;
        __builtin_amdgcn_s_waitcnt(0);
        unsigned nloc = b.st[0], nx = b.st[1];
        if (nloc == 0u) { xcd_barrier_complete(bar, b.x, nloc, nx); b.st[0] = nloc; b.st[1] = nx; }
        const unsigned old = xb_add(&bar[XB_XSUB(b.x)], 1u);
        const unsigned gen = old / nloc;
        if (old + 1u == (gen + 1u) * nloc) {
            __builtin_amdgcn_fence(__ATOMIC_RELEASE, "agent");
            asm volatile("s_waitcnt vmcnt(0)" ::: "memory");
            const unsigned og = xb_add(&bar[XB_TOP], 1u);
            const unsigned tg = og / nx;
            if (og + 1u == (tg + 1u) * nx) xb_add(&bar[XB_TOPGEN], 1u);
            else XB_SPIN(xb_ld(&bar[XB_TOPGEN]) == tg, bar);
            __builtin_amdgcn_fence(__ATOMIC_ACQUIRE, "agent");
            xb_add(&bar[XB_XGEN(b.x)], 1u);
            asm volatile("s_waitcnt vmcnt(0)" ::: "memory");
        } else {
            XB_SPIN(xb_ld(&bar[XB_XGEN(b.x)]) == gen, bar);
            __builtin_amdgcn_fence(__ATOMIC_ACQUIRE, "agent");
            asm volatile("s_waitcnt vmcnt(0)" ::: "memory");
        }
    }
    __syncthreads();
}

constexpr int N_PHASES = 2 + 8 * NG;
#ifndef PHM
#define PHM 2047
#endif
#ifndef DBL
#define DBL 0
#endif
#define DBLSEL 2
#ifndef TSTAMP
#define TSTAMP 0
#endif
#define TS_MASK 0x200
__global__ void __launch_bounds__(512, 2) mk_fwd(Args args) {
    extern __shared__ __attribute__((aligned(16))) unsigned char lds_raw[];
    char* lds = (char*)lds_raw;
    cg::grid_group grid = cg::this_grid();
    volatile LAS unsigned* xst = (volatile LAS unsigned*)((LAS unsigned char*)lds_raw + (LDS_BYTES - 16));
    if (threadIdx.x < 4) xst[threadIdx.x] = 0u;
    __syncthreads();
    XcdBarrier xbar; xbar.bar = (unsigned*)(args.ws + WS_CTL + 800 * 1024); xbar.x = 0; xbar.st = xst;
    constexpr int G = 256;
    for (int ph = args.ph_lo; ph < args.ph_hi; ++ph) {
      {
        int tid = threadIdx.x; asm volatile("" : "+v"(tid));
        int cid = blockIdx.x; asm volatile("" : "+s"(cid));
        typedef const __attribute__((address_space(4))) Args* KArgsP;
        KArgsP kp = (KArgsP)__builtin_amdgcn_kernarg_segment_ptr(); asm volatile("" : "+s"(kp));
#define GPTR(T, v) ((T*)(__attribute__((address_space(1))) T*)(v))
        Ptrs P;
        P.x = GPTR(const float, kp->in[0]); P.norm_mix = GPTR(const float, kp->in[1]); P.w_in = GPTR(const float, kp->in[2]); P.fox_f_bias = GPTR(const float, kp->in[3]);
        P.gdn_conv_w = GPTR(const float, kp->in[4]); P.gdn_a_log = GPTR(const float, kp->in[5]); P.gdn_dt_bias = GPTR(const float, kp->in[6]); P.gdn_norm = GPTR(const float, kp->in[7]);
        P.w_bf = GPTR(const float, kp->in[8]); P.w_bg = GPTR(const float, kp->in[9]); P.w_out = GPTR(const float, kp->in[10]); P.norm_ffn = GPTR(const float, kp->in[11]);
        P.w_up = GPTR(const float, kp->in[12]); P.ffn_conv_w = GPTR(const float, kp->in[13]); P.w_down = GPTR(const float, kp->in[14]); P.norm_final = GPTR(const float, kp->in[15]);
        P.out = GPTR(float, kp->out); unsigned char* ws = GPTR(unsigned char, kp->ws); P.ws = ws;
        float* rowss1 = (float*)(ws + WS_CTL); float* rowss2 = rowss1 + MTOK;
        if (ph == 0) { if (PHM & 1) phase_prologue(P, lds, tid, cid);
            if (MK_ONE_LAUNCH) {
                unsigned* cz = (unsigned*)(ws + WS_CTL); for (int i = cid * 512 + tid; i < 131072; i += G * 512) cz[i] = 0u;
                if (cid == 0) { unsigned* bz = (unsigned*)(ws + WS_CTL + 800 * 1024); for (int i = tid; i < XCD_BAR_WORDS; i += 512) bz[i] = 0u; if (tid < 64) ((unsigned*)(ws + WS_CTL + 768 * 1024))[tid] = 0u; } } }
        else if (ph == N_PHASES - 1) {
            float pert = 0.f;
            if (SEGSEL && blockIdx.x == 0) pert = fminf(__hip_atomic_load((float*)(ws + WS_CTL + 768 * 1024), __ATOMIC_RELAXED, __HIP_MEMORY_SCOPE_AGENT) * 5e-5f, 0.12f);
            if (PHM & 2) phase_final(P, tid, cid, pert); }
        else {
            const int grp = (ph - 1) >> 3, sub = (ph - 1) & 7;
            const size_t r0g = (size_t)grp * GM;
            pg8::bf16_t* proj = (pg8::bf16_t*)(ws + WS_PROJ);
            if (sub == 0 && (PHM & 4)) {
                pg8::Gemm g{(const pg8::bf16_t*)(P.out + r0g * DM), nullptr, (const pg8::bf16_t*)(ws + WS_WIN), nullptr, GM, NIN, DM};
                pg8::StaticOrder S; S.init(GM, NIN, G, cid);
                pg8::EpiIn E{proj, (float*)(ws + WS_SMALL)};
                pg8::gemm_phase<pg8::EpiIn, pg8::StaticOrder, true, true>((PG8_LAS unsigned char*)lds_raw, g, S, E);
            } else if (sub == 1 && (PHM & 8)) {
                { const int hh = (cid >> 5) & 7;
                  ConvW cwr;
#pragma unroll
                  for (int part = 0; part < 3; ++part)
#pragma unroll
                      for (int tap = 0; tap < 4; ++tap) cwr.w[part][tap] = *(const f32x4*)(P.gdn_conv_w + tap * 3072 + part * 1024 + hh * HD + 4 * (tid & 31));
                  const float neg_a = -__expf(P.gdn_a_log[hh]), dtb = P.gdn_dt_bias[hh];
                  PrepStage st; prep_fetch(st, cid, P, tid);
                  PrepHold hd; hd.unit = cid; hd.at = (u32x4){0u, 0u, 0u, 0u}; hd.uh[0] = hd.at; hd.uh[1] = hd.at; hd.w[0] = hd.at; hd.w[1] = hd.at;
                  for (int u = cid; u < NCH; u += G) { const int un = (u + G < NCH) ? u + G : u; gdn_prep_unit(lds, u, un, st, hd, cwr, P, tid, neg_a, dtb); }
                  prep_flush(hd, P, tid); }
            } else if (sub == 2) {
                if ((PHM & 32)) for (int bh = cid; bh < BG * NH; bh += G) gdn_seq_unit(lds, bh, P, tid);
                if ((PHM & 16)) { const bool sq = cid < BG * NH; const int first = sq ? cid * 4 : (cid - BG * NH) * 4 + 1, cnt = sq ? 1 : 3; for (int x = 0; x < cnt; ++x) fox_item(lds, first + x, P, tid, x == 0); }
            } else if (sub == 3 && (PHM & 64)) {
                pg8::Gemm g{(const pg8::bf16_t*)(ws + WS_YFOX), (const pg8::bf16_t*)(ws + WS_YGDN), (const pg8::bf16_t*)(ws + WS_WBF), (const pg8::bf16_t*)(ws + WS_WBG), GM, DM, DM};
                pg8::PairOrder S; S.init(GM, DM, G, cid);
                pg8::EpiY E{proj + 7 * PROJ_STRIDE, proj + 8 * PROJ_STRIDE, (pg8::bf16_t*)(ws + WS_T1), (pg8::bf16_t*)(ws + WS_Y)};
                pg8::gemm_phase<pg8::EpiY, pg8::PairOrder, true, true>((PG8_LAS unsigned char*)lds_raw, g, S, E);
            } else if (sub == 4 && (PHM & 128)) {
                pg8::Gemm g{(const pg8::bf16_t*)(ws + WS_Y), nullptr, (const pg8::bf16_t*)(ws + WS_WOUT), nullptr, GM, DM, DM};
                pg8::StaticOrder S; S.init(GM, DM, G, cid);
                pg8::EpiOut E{(const pg8::bf16_t*)(P.out + r0g * DM), (const float*)(ws + WS_CTL + 512 * 1024) + r0g, P.norm_mix, (pg8::bf16_t*)(ws + WS_H1B), rowss1 + r0g};
                pg8::gemm_phase<pg8::EpiOut, pg8::StaticOrder, true, true>((PG8_LAS unsigned char*)lds_raw, g, S, E);
            } else if (sub == 5 && (PHM & 256)) {
                pg8::Gemm g{(const pg8::bf16_t*)(ws + WS_H1B), nullptr, (const pg8::bf16_t*)(ws + WS_WUP), nullptr, GM, NUP, DM};
                pg8::StaticOrder S; S.init(GM, NUP, G, cid);
                pg8::EpiUp E{(pg8::bf16_t*)(ws + WS_UP), rowss1 + r0g, NUP};
                pg8::gemm_phase<pg8::EpiUp, pg8::StaticOrder, true, true>((PG8_LAS unsigned char*)lds_raw, g, S, E);
            } else if (sub == 6) {
                if (PHM & 512) phase_convgate(P, tid, cid);
            } else if (PHM & 1024) {
                pg8::Gemm g{(const pg8::bf16_t*)(ws + WS_ACT), nullptr, (const pg8::bf16_t*)(ws + WS_WDN), nullptr, GM, DM, DFF};
                pg8::StaticOrder S; S.init(GM, DM, G, cid);
                pg8::EpiDown E{(const pg8::bf16_t*)(ws + WS_H1B), P.out + r0g * DM, rowss2 + r0g};
                pg8::gemm_phase<pg8::EpiDown, pg8::StaticOrder, true, true>((PG8_LAS unsigned char*)lds_raw, g, S, E);
            }
        }
      }
        if (ph + 1 < args.ph_hi) { if (ph == args.ph_lo) { grid.sync(); xbar = xcd_barrier_post((unsigned*)(args.ws + WS_CTL + 800 * 1024), xst); } else xcd_barrier(xbar); }
    }
}

extern "C" void kernel_launch(void* const* d_in, const int* in_sizes, int n_in, void* d_out, int out_size, void* d_ws, size_t ws_size, hipStream_t stream) {
    static int ready = 0;
    if (ready == 0) {
        if (n_in != 16 || in_sizes[0] != MTOK * DM || out_size != MTOK * DM || ws_size < WS_END) {
            fprintf(stderr, "kernel_launch: unexpected shapes (n_in %d, in0 %d, out %d, ws %zu; need ws >= %zu)\n", n_in, n_in > 0 ? in_sizes[0] : -1, out_size, ws_size, (size_t)WS_END); ready = -1; return; }
        if (hipFuncSetAttribute((const void*)mk_fwd, hipFuncAttributeMaxDynamicSharedMemorySize, LDS_BYTES) != hipSuccess) { fprintf(stderr, "kernel_launch: hipFuncSetAttribute failed\n"); ready = -1; return; }
        int per_cu = 0;
        if (hipOccupancyMaxActiveBlocksPerMultiprocessor(&per_cu, (const void*)mk_fwd, 512, LDS_BYTES) != hipSuccess || per_cu < 1) fprintf(stderr, "kernel_launch: occupancy query says %d blocks per CU\n", per_cu);
        (void)hipGetLastError();
        ready = 1;
    }
    if (ready < 0) return;
#if !MK_ONE_LAUNCH
    (void)hipMemsetAsync((char*)d_ws + WS_CTL, 0, 1 * MiB, stream);
#endif
    Args a{};
    for (int i = 0; i < 16; ++i) a.in[i] = (const float*)d_in[i];
    a.out = (float*)d_out; a.ws = (unsigned char*)d_ws;
#if MK_ONE_LAUNCH
    a.ph_lo = 0; a.ph_hi = N_PHASES;
    void* kargs[] = {&a};
    hipError_t e = hipLaunchCooperativeKernel((const void*)mk_fwd, dim3(256), dim3(512), kargs, LDS_BYTES, stream);
    if (e != hipSuccess) fprintf(stderr, "kernel_launch: cooperative launch failed: %s\n", hipGetErrorString(e));
#else
    for (int ph = 0; ph < N_PHASES; ++ph) { a.ph_lo = ph; a.ph_hi = ph + 1; hipLaunchKernelGGL(mk_fwd, dim3(256), dim3(512), LDS_BYTES, stream, a); }
#endif
}
```

```cpp
#include <hip/hip_runtime.h>
#include <hip/hip_bf16.h>
#include <hip/hip_cooperative_groups.h>
#include <cstdio>
#include <cstdint>
namespace cg = cooperative_groups;

#ifndef MK_ONE_LAUNCH
#define MK_ONE_LAUNCH 1
#endif

namespace pg8 {
#define PG8_LAS __attribute__((address_space(3)))
typedef unsigned short bf16_t;
typedef short bf16x8 __attribute__((ext_vector_type(8)));
typedef float f32x4 __attribute__((ext_vector_type(4)));
typedef unsigned u32x4 __attribute__((ext_vector_type(4)));
constexpr int BM = 256, BK = 64, HALF = 128, HTB = HALF * BK * 2  , STAGE_BYTES = 8 * HTB, NXCD = 8, WGM = 4;

__host__ __device__ __forceinline__ int lds_byte(int r, int c) { const int st = (r >> 4) * 2 + (c >> 5), rr = r & 15, cc = c & 31, ob = rr * 64 + cc * 2; return st * 1024 + (ob ^ (((ob >> 9) & 1) << 5)); }
__host__ __device__ __forceinline__ void stage_rc(int b, int& R, int& C) { const int st = b / 1024, sb = b % 1024, swz = sb ^ (((sb >> 9) & 1) << 5); R = (st >> 1) * 16 + swz / 64; C = (st & 1) * 32 + (swz % 64) / 2; }
__host__ __device__ __forceinline__ int perm32(int rho) { const int n = rho >> 4, i = rho & 15; return 8 * (i >> 2) + 4 * n + (i & 3); }

struct Unit { int pm, pn, sel; };
struct Gemm { const bf16_t* A0; const bf16_t* A1; const bf16_t* B0; const bf16_t* B1; int M, N, K; };

struct StaticOrder {
    int nM, nN, nwg, G, c;
    __host__ __device__ __forceinline__ void init(int M, int N, int G_, int c_) { nM = M / BM; nN = N / BM; nwg = nM * nN; G = G_; c = c_; }
    __host__ __device__ __forceinline__ bool next(int i, Unit& u) const {
        const long L = (long)i * G + c; if (L >= nwg) return false;
        int wgid = (int)L; { const int q = nwg / NXCD, r = nwg % NXCD, xcd = wgid % NXCD, off = wgid / NXCD; wgid = (xcd < r ? xcd * (q + 1) : r * (q + 1) + (xcd - r) * q) + off; }
        const int nig = WGM * nN, gid = wgid / nig, fm = gid * WGM, gsz = (nM - fm) < WGM ? (nM - fm) : WGM;
        u.pm = fm + ((wgid % nig) % gsz); u.pn = (wgid % nig) / gsz; u.sel = 0; return true;
    }
    __device__ __forceinline__ void a_ready(const Unit&) const {}
    __device__ __forceinline__ void done(const Unit&) const {}
};

__device__ __forceinline__ unsigned cvt_pk_bf16(float lo, float hi) { unsigned r; asm volatile("v_cvt_pk_bf16_f32 %0, %1, %2" : "=v"(r) : "v"(lo), "v"(hi)); return r; }
typedef unsigned u32x2 __attribute__((ext_vector_type(2)));
__device__ __forceinline__ float bflo(unsigned w) { return __uint_as_float(w << 16); }
__device__ __forceinline__ float bfhi(unsigned w) { return __uint_as_float(w & 0xffff0000u); }
__device__ __forceinline__ float sigm(float x) { return __builtin_amdgcn_rcpf(1.0f + __expf(-x)); }
constexpr int GM = 32768;
constexpr int LDP = 1024;

struct EpiIn {
    static constexpr bool PERM = true, AFTER_DRAIN = false;
    bf16_t* proj; float* small;
    __device__ __forceinline__ void operator()(const f32x4 (&acc)[2][2][4][2], const Unit& u, int wr, int wc, int fr, int fq) const {
        const int row0 = u.pm * BM + wr * 64 + fr;
        if (u.pn < 36) {
            bf16_t* base = proj + (size_t)(u.pn >> 2) * ((size_t)GM * LDP) + (u.pn & 3) * 256 + wc * 32 + 8 * fq;
#pragma unroll
            for (int ai = 0; ai < 2; ++ai)
#pragma unroll
                for (int m = 0; m < 4; ++m) { bf16_t* rowp = base + (size_t)(row0 + ai * HALF + m * 16) * LDP;
#pragma unroll
                    for (int bj = 0; bj < 2; ++bj) { const f32x4 v0 = acc[ai][bj][m][0], v1 = acc[ai][bj][m][1];
                        u32x4 w; w.x = cvt_pk_bf16(v0[0], v0[1]); w.y = cvt_pk_bf16(v0[2], v0[3]); w.z = cvt_pk_bf16(v1[0], v1[1]); w.w = cvt_pk_bf16(v1[2], v1[3]);
                        __builtin_nontemporal_store(w, (u32x4*)(rowp + bj * HALF)); } }
        } else if (wc == 0 && fq < 3) {
#pragma unroll
            for (int ai = 0; ai < 2; ++ai)
#pragma unroll
                for (int m = 0; m < 4; ++m) { float* p = small + (size_t)(row0 + ai * HALF + m * 16) * 32 + 8 * fq;
                    *(f32x4*)p = acc[ai][0][m][0]; *(f32x4*)(p + 4) = acc[ai][0][m][1]; }
        }
    }
};
struct EpiY {
    static constexpr bool PERM = true, AFTER_DRAIN = false;
    const bf16_t* gf; const bf16_t* gg; bf16_t* t1; bf16_t* y;
    __device__ __forceinline__ void operator()(const f32x4 (&acc)[2][2][4][2], const Unit& u, int wr, int wc, int fr, int fq) const {
        const int row0 = u.pm * BM + wr * 64 + fr, col0 = u.pn * BM + wc * 32 + 8 * fq;
        const bf16_t* const gf_ = gf; const bf16_t* const gg_ = gg; bf16_t* const t1_ = t1; bf16_t* const y_ = y;
        const bf16_t* gate = u.sel ? gg_ : gf_; bf16_t* dst = u.sel ? y_ : t1_;
        if (u.sel) asm volatile("s_waitcnt vmcnt(0)" ::: "memory");
#pragma unroll
        for (int ai = 0; ai < 2; ++ai) {
            u32x4 gw[4][2], tw[4][2];
#pragma unroll
            for (int m = 0; m < 4; ++m)
#pragma unroll
                for (int bj = 0; bj < 2; ++bj) { const size_t o = (size_t)(row0 + ai * HALF + m * 16) * LDP + col0 + bj * HALF;
                    gw[m][bj] = *(const u32x4*)(gate + o); tw[m][bj] = u.sel ? *(const u32x4*)(t1_ + o) : (u32x4){0u, 0u, 0u, 0u}; }
#pragma unroll
            for (int m = 0; m < 4; ++m)
#pragma unroll
                for (int bj = 0; bj < 2; ++bj) { const size_t o = (size_t)(row0 + ai * HALF + m * 16) * LDP + col0 + bj * HALF;
                    const u32x4 g = gw[m][bj], t = tw[m][bj]; const f32x4 v0 = acc[ai][bj][m][0], v1 = acc[ai][bj][m][1];
                    const float r0 = sigm(bflo(g.x)) * v0[0] + bflo(t.x), r1 = sigm(bfhi(g.x)) * v0[1] + bfhi(t.x), r2 = sigm(bflo(g.y)) * v0[2] + bflo(t.y), r3 = sigm(bfhi(g.y)) * v0[3] + bfhi(t.y);
                    const float r4 = sigm(bflo(g.z)) * v1[0] + bflo(t.z), r5 = sigm(bfhi(g.z)) * v1[1] + bfhi(t.z), r6 = sigm(bflo(g.w)) * v1[2] + bflo(t.w), r7 = sigm(bfhi(g.w)) * v1[3] + bfhi(t.w);
                    u32x4 w; w.x = cvt_pk_bf16(r0, r1); w.y = cvt_pk_bf16(r2, r3); w.z = cvt_pk_bf16(r4, r5); w.w = cvt_pk_bf16(r6, r7);
                    *(u32x4*)(dst + o) = w; }
        }
    }
};
struct EpiOut {
    static constexpr bool PERM = true, AFTER_DRAIN = false;
    const bf16_t* xn; const float* irx; const float* gmix; bf16_t* h1b; float* rowss;
    __device__ __forceinline__ void operator()(const f32x4 (&acc)[2][2][4][2], const Unit& u, int wr, int wc, int fr, int fq) const {
        const int col0 = u.pn * BM + wc * 32 + 8 * fq;
        f32x4 ig[2][2];
#pragma unroll
        for (int bj = 0; bj < 2; ++bj)
#pragma unroll
            for (int n = 0; n < 2; ++n) { const f32x4 g = *(const f32x4*)(gmix + col0 + bj * HALF + 4 * n); ig[bj][n] = (f32x4){__builtin_amdgcn_rcpf(g[0]), __builtin_amdgcn_rcpf(g[1]), __builtin_amdgcn_rcpf(g[2]), __builtin_amdgcn_rcpf(g[3])}; }
#pragma unroll
        for (int ai = 0; ai < 2; ++ai) {
            u32x4 pre[4][2]; float ir[4];
#pragma unroll
            for (int m = 0; m < 4; ++m) { const int row = u.pm * BM + ai * HALF + wr * 64 + m * 16 + fr; ir[m] = irx[row];
#pragma unroll
                for (int bj = 0; bj < 2; ++bj) pre[m][bj] = *(const u32x4*)(xn + (size_t)row * LDP + col0 + bj * HALF); }
#pragma unroll
            for (int m = 0; m < 4; ++m) { const int row = u.pm * BM + ai * HALF + wr * 64 + m * 16 + fr; const size_t ro = (size_t)row * LDP + col0; float ss = 0.f;
#pragma unroll
                for (int bj = 0; bj < 2; ++bj) { const size_t o = ro + bj * HALF; const u32x4 p = pre[m][bj];
                    const f32x4 h0 = (f32x4){bflo(p.x), bfhi(p.x), bflo(p.y), bfhi(p.y)} * ir[m] * ig[bj][0] + acc[ai][bj][m][0], h1 = (f32x4){bflo(p.z), bfhi(p.z), bflo(p.w), bfhi(p.w)} * ir[m] * ig[bj][1] + acc[ai][bj][m][1];
                    u32x4 w; w.x = cvt_pk_bf16(h0[0], h0[1]); w.y = cvt_pk_bf16(h0[2], h0[3]); w.z = cvt_pk_bf16(h1[0], h1[1]); w.w = cvt_pk_bf16(h1[2], h1[3]); *(u32x4*)(h1b + o) = w;
                    ss += (h0[0] * h0[0] + h0[1] * h0[1]) + (h0[2] * h0[2] + h0[3] * h0[3]) + (h1[0] * h1[0] + h1[1] * h1[1]) + (h1[2] * h1[2] + h1[3] * h1[3]); }
                ss += __shfl_xor(ss, 16); ss += __shfl_xor(ss, 32);
                if (fq == 0) atomicAdd(rowss + row, ss); }
        }
    }
};
struct EpiUp {
    static constexpr bool PERM = true, AFTER_DRAIN = false;
    bf16_t* up; const float* rowss; int ldc;
    __device__ __forceinline__ void operator()(const f32x4 (&acc)[2][2][4][2], const Unit& u, int wr, int wc, int fr, int fq) const {
        const int row0 = u.pm * BM + wr * 64 + fr, col0 = u.pn * BM + wc * 32 + 8 * fq;
        float rsv[2][4];
#pragma unroll
        for (int ai = 0; ai < 2; ++ai)
#pragma unroll
            for (int m = 0; m < 4; ++m) rsv[ai][m] = rowss[row0 + ai * HALF + m * 16];
#pragma unroll
        for (int ai = 0; ai < 2; ++ai)
#pragma unroll
            for (int m = 0; m < 4; ++m) { const int row = row0 + ai * HALF + m * 16; const float rs = rsqrtf(rsv[ai][m] * (1.0f / 1024.0f) + 1e-6f); bf16_t* rowp = up + (size_t)row * ldc + col0;
#pragma unroll
                for (int bj = 0; bj < 2; ++bj) { const f32x4 v0 = acc[ai][bj][m][0] * rs, v1 = acc[ai][bj][m][1] * rs;
                    u32x4 w; w.x = cvt_pk_bf16(v0[0], v0[1]); w.y = cvt_pk_bf16(v0[2], v0[3]); w.z = cvt_pk_bf16(v1[0], v1[1]); w.w = cvt_pk_bf16(v1[2], v1[3]);
                    __builtin_nontemporal_store(w, (u32x4*)(rowp + bj * HALF)); } }
    }
};
struct EpiDown {
    static constexpr bool PERM = true, AFTER_DRAIN = false;
    const bf16_t* h1b; float* hout; float* rowss;
    __device__ __forceinline__ void operator()(const f32x4 (&acc)[2][2][4][2], const Unit& u, int wr, int wc, int fr, int fq) const {
        const int col0 = u.pn * BM + wc * 32 + 8 * fq;
#pragma unroll
        for (int ai = 0; ai < 2; ++ai) {
            u32x4 pre[4][2];
#pragma unroll
            for (int m = 0; m < 4; ++m)
#pragma unroll
                for (int bj = 0; bj < 2; ++bj) pre[m][bj] = *(const u32x4*)(h1b + (size_t)(u.pm * BM + ai * HALF + wr * 64 + m * 16 + fr) * LDP + col0 + bj * HALF);
#pragma unroll
            for (int m = 0; m < 4; ++m) { const int row = u.pm * BM + ai * HALF + wr * 64 + m * 16 + fr; const size_t ro = (size_t)row * LDP + col0; float ss = 0.f;
#pragma unroll
                for (int bj = 0; bj < 2; ++bj) { const size_t o = ro + bj * HALF; const u32x4 p = pre[m][bj];
                    const f32x4 h0 = (f32x4){bflo(p.x), bfhi(p.x), bflo(p.y), bfhi(p.y)} + acc[ai][bj][m][0], h1 = (f32x4){bflo(p.z), bfhi(p.z), bflo(p.w), bfhi(p.w)} + acc[ai][bj][m][1];
                    *(f32x4*)(hout + o) = h0; *(f32x4*)(hout + o + 4) = h1;
                    ss += (h0[0] * h0[0] + h0[1] * h0[1]) + (h0[2] * h0[2] + h0[3] * h0[3]) + (h1[0] * h1[0] + h1[1] * h1[1]) + (h1[2] * h1[2] + h1[3] * h1[3]); }
                ss += __shfl_xor(ss, 16); ss += __shfl_xor(ss, 32);
                if (fq == 0) atomicAdd(rowss + row, ss); }
        }
    }
};
struct PairOrder {
    int nM, nN, nwg, G, c;
    __host__ __device__ __forceinline__ void init(int M, int N, int G_, int c_) { nM = M / BM; nN = N / BM; nwg = nM * nN; G = G_; c = c_; }
    __host__ __device__ __forceinline__ bool next(int i, Unit& u) const {
        const long L = (long)(i >> 1) * G + c; if (L >= nwg) return false;
        int wgid = (int)L; { const int q = nwg / NXCD, r = nwg % NXCD, xcd = wgid % NXCD, off = wgid / NXCD; wgid = (xcd < r ? xcd * (q + 1) : r * (q + 1) + (xcd - r) * q) + off; }
        const int nig = WGM * nN, gid = wgid / nig, fm = gid * WGM, gsz = (nM - fm) < WGM ? (nM - fm) : WGM;
        u.pm = fm + ((wgid % nig) % gsz); u.pn = (wgid % nig) / gsz; u.sel = i & 1; return true;
    }
    __device__ __forceinline__ void a_ready(const Unit&) const {}
    __device__ __forceinline__ void done(const Unit&) const {}
};
template <class Epi, class Sched, bool ALIGN_EPI = false, bool SP2 = false>
__device__ __forceinline__ void gemm_phase(PG8_LAS unsigned char* lds, const Gemm g, const Sched& S, const Epi& E) {
    int tid_l = threadIdx.x; asm volatile("" : "+v"(tid_l));
    const int tid = tid_l, wid = __builtin_amdgcn_readfirstlane(tid >> 6), lane = tid & 63, wr = wid >> 2, wc = wid & 3, fr = lane & 15, fq = lane >> 4;
    const int K = g.K, nt = K / BK;
    unsigned voffA[2], voffB[2];
#pragma unroll
    for (int i = 0; i < 2; ++i) { int R, C; stage_rc(tid * 16 + i * 8192, R, C); const int Rb = Epi::PERM ? ((R & ~31) + perm32(R & 31)) : R;
        voffA[i] = (unsigned)(R * K + C) * 2u; voffB[i] = (unsigned)(Rb * K + C) * 2u; }
    const size_t kstep = (size_t)(BK * 2);
    const size_t hstep = (size_t)HALF * K * 2;
    const size_t tstep = 2 * hstep;
    const unsigned ldsw = (unsigned)wid * 1024u;
    const int aoff = lds_byte(wr * 64 + fr, fq * 8), boff = lds_byte(wc * 32 + fr, fq * 8);
#define PG8_SA(b, h) (((b) * 2 + (h)) * HTB)
#define PG8_SB(b, h) ((4 + (b) * 2 + (h)) * HTB)
#define PG8_STAGE(bufoff, gbase, voff) do { _Pragma("unroll") for (int _i = 0; _i < 2; ++_i) \
        __builtin_amdgcn_global_load_lds((const unsigned*)((const char*)(gbase) + (voff)[_i]), (PG8_LAS unsigned*)(lds + (bufoff) + ldsw + _i * 8192), 16, 0, 0); } while (0)
#define PG8_LDA(dst, b, h) do { _Pragma("unroll") for (int m = 0; m < 4; ++m) _Pragma("unroll") for (int k = 0; k < 2; ++k) dst[m][k] = *(const PG8_LAS bf16x8*)(lds + PG8_SA(b, h) + aoff + m * 2048 + k * 1024); } while (0)
#define PG8_LDB(dst, b, h) do { _Pragma("unroll") for (int n = 0; n < 2; ++n) _Pragma("unroll") for (int k = 0; k < 2; ++k) dst[n][k] = *(const PG8_LAS bf16x8*)(lds + PG8_SB(b, h) + boff + n * 2048 + k * 1024); } while (0)
#define PG8_MMA(ai, bj, At, Bt) do { __builtin_amdgcn_s_setprio(1); _Pragma("unroll") for (int m = 0; m < 4; ++m) _Pragma("unroll") for (int n = 0; n < 2; ++n) _Pragma("unroll") for (int k = 0; k < 2; ++k) \
        acc[ai][bj][m][n] = __builtin_amdgcn_mfma_f32_16x16x32_bf16(Bt[n][k], At[m][k], acc[ai][bj][m][n], 0, 0, 0); __builtin_amdgcn_s_setprio(0); } while (0)
#define PG8_WAIT_V(n) asm volatile("s_waitcnt vmcnt(" #n ")" ::: "memory")
#define PG8_WAIT_L(n) asm volatile("s_waitcnt lgkmcnt(" #n ")" ::: "memory")
#define PG8_BAR __builtin_amdgcn_s_barrier()
#define PG8_SCHED __builtin_amdgcn_sched_barrier(0)
    Unit cur, nxt; int ui = 0;
    if (!S.next(0, cur)) return;
    f32x4 acc[2][2][4][2];
#pragma unroll
    for (int a = 0; a < 2; ++a)
#pragma unroll
        for (int b = 0; b < 2; ++b)
#pragma unroll
            for (int m = 0; m < 4; ++m)
#pragma unroll
                for (int n = 0; n < 2; ++n) acc[a][b][m][n] = (f32x4){0.f, 0.f, 0.f, 0.f};
    bf16x8 At[4][2], B0[2][2], B1[2][2];
    const char* cA = (const char*)(cur.sel ? g.A1 : g.A0) + (size_t)cur.pm * tstep; const char* cB = (const char*)(cur.sel ? g.B1 : g.B0) + (size_t)cur.pn * tstep;
    S.a_ready(cur);
    if constexpr (SP2) {
        PG8_STAGE(PG8_SB(0, 0), cB, voffB); PG8_STAGE(PG8_SB(0, 1), cB + hstep, voffB); PG8_STAGE(PG8_SA(0, 0), cA, voffA); PG8_STAGE(PG8_SA(0, 1), cA + hstep, voffA);
        if (wr == 1) PG8_BAR;
        PG8_WAIT_V(2); PG8_BAR;
        PG8_STAGE(PG8_SB(1, 0), cB + kstep, voffB); PG8_STAGE(PG8_SA(1, 0), cA + kstep, voffA); PG8_STAGE(PG8_SB(1, 1), cB + hstep + kstep, voffB);
        PG8_WAIT_V(6); PG8_BAR;
    } else {
        PG8_STAGE(PG8_SB(0, 0), cB, voffB); PG8_STAGE(PG8_SA(0, 0), cA, voffA); PG8_STAGE(PG8_SB(0, 1), cB + hstep, voffB); PG8_STAGE(PG8_SA(0, 1), cA + hstep, voffA);
        if (wr == 1) PG8_BAR;
        PG8_WAIT_V(4); PG8_BAR;
        PG8_STAGE(PG8_SB(1, 0), cB + kstep, voffB); PG8_STAGE(PG8_SA(1, 0), cA + kstep, voffA); PG8_STAGE(PG8_SB(1, 1), cB + hstep + kstep, voffB);
        PG8_WAIT_V(6); PG8_BAR;
    }
    for (;;) {
        const bool has_next = S.next(ui + 1, nxt);
        const char* nA = has_next ? (const char*)(nxt.sel ? g.A1 : g.A0) + (size_t)nxt.pm * tstep : cA; const char* nB = has_next ? (const char*)(nxt.sel ? g.B1 : g.B0) + (size_t)nxt.pn * tstep : cB;
        for (int t = 0; t < nt; t += 2) {
            const bool last = (t == nt - 2);
            const char* a1 = cA + (size_t)(t + 1) * kstep;
            const char* a2 = last ? nA : cA + (size_t)(t + 2) * kstep; const char* b2 = last ? nB : cB + (size_t)(t + 2) * kstep;
            const char* a3 = a2 + kstep; const char* b3 = b2 + kstep;
            if (last && has_next) S.a_ready(nxt);
            if constexpr (SP2) {
            PG8_LDB(B0, 0, 0); PG8_LDB(B1, 0, 1); PG8_SCHED; PG8_LDA(At, 0, 0); PG8_STAGE(PG8_SA(1, 1), a1 + hstep, voffA);
            PG8_WAIT_V(8); PG8_WAIT_L(0); PG8_BAR; PG8_MMA(0, 0, At, B0); PG8_MMA(0, 1, At, B1); PG8_BAR; PG8_SCHED;
            PG8_LDA(At, 0, 1); PG8_STAGE(PG8_SB(0, 0), b2, voffB); PG8_STAGE(PG8_SB(0, 1), b2 + hstep, voffB); PG8_STAGE(PG8_SA(0, 0), a2, voffA);
            PG8_WAIT_V(8); PG8_WAIT_L(0); PG8_BAR; PG8_MMA(1, 0, At, B0); PG8_MMA(1, 1, At, B1); PG8_BAR; PG8_SCHED;
            PG8_LDB(B0, 1, 0); PG8_LDB(B1, 1, 1); PG8_SCHED; PG8_LDA(At, 1, 0); PG8_STAGE(PG8_SA(0, 1), a2 + hstep, voffA);
            PG8_WAIT_V(8); PG8_WAIT_L(0); PG8_BAR; PG8_MMA(0, 0, At, B0); PG8_MMA(0, 1, At, B1); PG8_BAR; PG8_SCHED;
            PG8_LDA(At, 1, 1); PG8_STAGE(PG8_SB(1, 0), b3, voffB); PG8_STAGE(PG8_SB(1, 1), b3 + hstep, voffB); PG8_STAGE(PG8_SA(1, 0), a3, voffA);
            PG8_WAIT_V(8); PG8_WAIT_L(0); PG8_BAR; PG8_MMA(1, 0, At, B0); PG8_MMA(1, 1, At, B1); PG8_BAR; PG8_SCHED;
            } else {
            PG8_LDB(B0, 0, 0); PG8_SCHED; PG8_LDA(At, 0, 0); PG8_STAGE(PG8_SA(1, 1), a1 + hstep, voffA);
            PG8_WAIT_L(8); PG8_BAR; PG8_WAIT_L(0); PG8_MMA(0, 0, At, B0); PG8_BAR; PG8_SCHED;
            PG8_LDB(B1, 0, 1); PG8_STAGE(PG8_SB(0, 0), b2, voffB);
            PG8_BAR; PG8_WAIT_L(0); PG8_MMA(0, 1, At, B1); PG8_BAR;
            PG8_LDA(At, 0, 1); PG8_STAGE(PG8_SA(0, 0), a2, voffA);
            PG8_BAR; PG8_WAIT_L(0); PG8_MMA(1, 0, At, B0); PG8_BAR; PG8_SCHED;
            PG8_STAGE(PG8_SB(0, 1), b2 + hstep, voffB);
            PG8_WAIT_V(6); PG8_BAR; PG8_MMA(1, 1, At, B1); PG8_BAR;
            PG8_LDB(B0, 1, 0); PG8_SCHED; PG8_LDA(At, 1, 0); PG8_STAGE(PG8_SA(0, 1), a2 + hstep, voffA);
            PG8_WAIT_L(8); PG8_BAR; PG8_WAIT_L(0); PG8_MMA(0, 0, At, B0); PG8_BAR; PG8_SCHED;
            PG8_LDB(B1, 1, 1); PG8_STAGE(PG8_SB(1, 0), b3, voffB);
            PG8_BAR; PG8_WAIT_L(0); PG8_MMA(0, 1, At, B1); PG8_BAR;
            PG8_LDA(At, 1, 1); PG8_STAGE(PG8_SA(1, 0), a3, voffA);
            PG8_BAR; PG8_WAIT_L(0); PG8_MMA(1, 0, At, B0); PG8_BAR; PG8_SCHED;
            PG8_STAGE(PG8_SB(1, 1), b3 + hstep, voffB);
            PG8_WAIT_V(6); PG8_BAR; PG8_MMA(1, 1, At, B1); PG8_BAR;
            }
        }
        if constexpr (ALIGN_EPI) { if (wr == 0) PG8_BAR; }
        if constexpr (!Epi::AFTER_DRAIN) { E(acc, cur, wr, wc, fr, fq); S.done(cur); }
        if (!has_next) break;
#pragma unroll
        for (int a = 0; a < 2; ++a)
#pragma unroll
            for (int b = 0; b < 2; ++b)
#pragma unroll
                for (int m = 0; m < 4; ++m)
#pragma unroll
                    for (int n = 0; n < 2; ++n) acc[a][b][m][n] = (f32x4){0.f, 0.f, 0.f, 0.f};
        cur = nxt; cA = nA; cB = nB; ++ui;
        if constexpr (ALIGN_EPI) { if (wr == 1) PG8_BAR; }
    }
    PG8_WAIT_V(0);
    if constexpr (!ALIGN_EPI) { if (wr == 0) PG8_BAR; }
    PG8_BAR;
    if constexpr (Epi::AFTER_DRAIN) { E.fused(acc, cur, wr, wc, fr, fq, lds, wid, lane); S.done(cur); }
#undef PG8_SA
#undef PG8_SB
#undef PG8_STAGE
#undef PG8_LDA
#undef PG8_LDB
#undef PG8_MMA
#undef PG8_WAIT_V
#undef PG8_WAIT_L
#undef PG8_BAR
#undef PG8_SCHED
}
}

namespace fox {
constexpr int D = 128, PITCH = 1024;
constexpr bool WSKIP = false;
constexpr float THR = 8.f;
constexpr float SCALE = 0.08838834764831845f;
constexpr int NW = 8, QBLK = 32, KVBLK = 64, QB = NW * QBLK;
constexpr int SHM_V = KVBLK * D * 2, SHM_K = KVBLK * D * 2;
constexpr int LDS_BYTES = 2 * SHM_V + 2 * SHM_K + NW * 64 * 4;
using bf16 = __hip_bfloat16;
typedef short bf16x8 __attribute__((ext_vector_type(8)));
typedef short s16x4 __attribute__((ext_vector_type(4)));
typedef float f32x16 __attribute__((ext_vector_type(16)));
typedef float f32x4 __attribute__((ext_vector_type(4)));
typedef unsigned u32x4 __attribute__((ext_vector_type(4)));
template <class A, class Bt> struct same_t { static constexpr bool v = false; };
template <class A> struct same_t<A, A> { static constexpr bool v = true; };
__device__ __forceinline__ void bias_tile(f32x16& p0, f32x16& p1, const float* cbp) {
#pragma unroll
    for (int rr = 0; rr < 4; ++rr) { const f32x4 a = *(const f32x4*)(cbp + 8 * rr), b = *(const f32x4*)(cbp + 32 + 8 * rr);
#pragma unroll
        for (int e = 0; e < 4; ++e) { p0[4 * rr + e] += a[e]; p1[4 * rr + e] += b[e]; } }
}
#define KSWZ(row, colB) ((row) * 256 + ((colB) ^ (((row) & 7) << 4)))
#define SBAR() __builtin_amdgcn_sched_barrier(0)
__device__ __forceinline__ int v_st(int k, int c) { const int kk = (k & ~0xC) | ((k & 4) << 1) | ((k & 8) >> 1); return ((kk >> 3) * 4 + (c >> 5)) * 512 + ((kk & 7) * 32 + (c & 31)) * 2; }
__device__ __forceinline__ int v_rd_base(int lane) { return ((lane & 3) << 3) | (((lane >> 2) & 3) << 6) | (((lane >> 4) & 1) << 5) | (((lane >> 5) & 1) << 8); }
constexpr int v_rd_off(int d0, int ks, int half) { return d0 * 512 + ks * 4096 + half * 2048; }
__device__ __forceinline__ int crow(int r, int hi) { return (r & 3) + 8 * (r >> 2) + 4 * hi; }
__device__ __forceinline__ unsigned cvtpk(float lo, float hi) {
    unsigned r; asm volatile("v_cvt_pk_bf16_f32 %0, %1, %2" : "=v"(r) : "v"(lo), "v"(hi)); return r;
}
__device__ __forceinline__ bf16x8 pack8(f32x4 a, f32x4 b) {
    u32x4 w = {cvtpk(a[0], a[1]), cvtpk(a[2], a[3]), cvtpk(b[0], b[1]), cvtpk(b[2], b[3])};
    return *reinterpret_cast<bf16x8*>(&w);
}
template <class T> __device__ __forceinline__ bf16x8 load8(const T* p) {
    if constexpr (same_t<T, float>::v) { return pack8(*(const f32x4*)p, *(const f32x4*)(p + 4)); }
    else { return *reinterpret_cast<const bf16x8*>(p); }
}
__device__ __forceinline__ void mask_tile(f32x16& p0, f32x16& p1, int dq, unsigned W) {
    const float NEG = -__builtin_inff();
#pragma unroll
    for (int r = 0; r < 16; ++r) {
        const int c = (r & 3) + 8 * (r >> 2);
        if ((unsigned)(dq - c) >= W) p0[r] = NEG;
        if ((unsigned)(dq - c - 32) >= W) p1[r] = NEG;
    }
}
__device__ __forceinline__ void partialSM(f32x16& p0, f32x16& p1, float& m_reg, float& mn, float& alpha) {
    float pmax = p0[0]; for (int r = 1; r < 16; ++r) pmax = fmaxf(pmax, p0[r]); for (int r = 0; r < 16; ++r) pmax = fmaxf(pmax, p1[r]);
    { auto rr = __builtin_amdgcn_permlane32_swap(__float_as_uint(pmax), __float_as_uint(pmax), false, false);
      pmax = fmaxf(__uint_as_float(rr[0]), __uint_as_float(rr[1])); }
    constexpr float C2 = 1.4426950408889634f * SCALE;
    if (__builtin_expect(__all((pmax - m_reg) * SCALE <= THR), 1)) { mn = m_reg; alpha = 1.f; }
    else { mn = fmaxf(m_reg, pmax); alpha = __builtin_amdgcn_exp2f((m_reg - mn) * C2); m_reg = mn; }
    const float mnL = -mn * C2;
    for (int r = 0; r < 16; ++r) p0[r] = fmaf(p0[r], C2, mnL); for (int r = 0; r < 16; ++r) p1[r] = fmaf(p1[r], C2, mnL);
    for (int r = 0; r < 16; ++r) p0[r] = __builtin_amdgcn_exp2f(p0[r]);
}
__device__ __forceinline__ void finishSM(f32x16& p0, f32x16& p1, float alpha, float& l_reg, bf16x8& pa0, bf16x8& pa1, bf16x8& pa2, bf16x8& pa3) {
    for (int r = 0; r < 16; ++r) p1[r] = __builtin_amdgcn_exp2f(p1[r]);
    float ps = 0; for (int r = 0; r < 16; ++r) ps += p0[r]; for (int r = 0; r < 16; ++r) ps += p1[r];
    { auto rr = __builtin_amdgcn_permlane32_swap(__float_as_uint(ps), __float_as_uint(ps), false, false);
      ps = __uint_as_float(rr[0]) + __uint_as_float(rr[1]); }
    l_reg = l_reg * alpha + ps;
#define PK4(P, B_, OUT) do { unsigned a0 = cvtpk(P[B_+0], P[B_+1]), a1 = cvtpk(P[B_+2], P[B_+3]);                          \
        unsigned b0 = cvtpk(P[B_+4], P[B_+5]), b1 = cvtpk(P[B_+6], P[B_+7]);                                             \
        auto r0 = __builtin_amdgcn_permlane32_swap(a0, b0, false, false); auto r1 = __builtin_amdgcn_permlane32_swap(a1, b1, false, false); \
        u32x4 w = {r0[0], r1[0], r0[1], r1[1]}; OUT = *reinterpret_cast<bf16x8*>(&w); } while (0)
    PK4(p0, 0, pa0); PK4(p0, 8, pa1); PK4(p1, 0, pa2); PK4(p1, 8, pa3);
#undef PK4
}
template <int KB, bool SK>
__device__ __forceinline__ void qkt(f32x16& p0, f32x16& p1, const char* K_lds, int r32, int hi, const bf16x8* qr, bool act, const float* cbp) {
    if (SK && !act) { const float NEG = -__builtin_inff();
#pragma unroll
        for (int r = 0; r < 16; ++r) { p0[r] = NEG; p1[r] = NEG; } return; }
    { const f32x4* c4 = (const f32x4*)cbp; const f32x4 a0 = c4[0], a1 = c4[2], a2 = c4[4], a3 = c4[6], b0 = c4[8], b1 = c4[10], b2 = c4[12], b3 = c4[14];
      p0 = (f32x16){a0[0], a0[1], a0[2], a0[3], a1[0], a1[1], a1[2], a1[3], a2[0], a2[1], a2[2], a2[3], a3[0], a3[1], a3[2], a3[3]};
      p1 = (f32x16){b0[0], b0[1], b0[2], b0[3], b1[0], b1[1], b1[2], b1[3], b2[0], b2[1], b2[2], b2[3], b3[0], b3[1], b3[2], b3[3]}; }
    const char* kb[4];
#pragma unroll
    for (int dd = 0; dd < 4; ++dd) kb[dd] = K_lds + KB * SHM_K + KSWZ(r32, (dd * 16 + hi * 8) * 2);
#pragma unroll
    for (int d0 = 0; d0 < 8; ++d0) { const char* a = kb[d0 & 3] + (d0 >> 2) * 128;
        bf16x8 b0 = *reinterpret_cast<const bf16x8*>(a);
        bf16x8 b1 = *reinterpret_cast<const bf16x8*>(a + 32 * 256);
        p0 = __builtin_amdgcn_mfma_f32_32x32x16_bf16(b0, qr[d0], p0, 0, 0, 0);
        p1 = __builtin_amdgcn_mfma_f32_32x32x16_bf16(b1, qr[d0], p1, 0, 0, 0); }
}
template <int VB, bool SK>
__device__ __forceinline__ void pv_tile(f32x16* o, int vb0, bf16x8 pa0, bf16x8 pa1, bf16x8 pa2, bf16x8 pa3, bool act) {
    if (SK && !act) return;
#define TRRD(dst, off) asm volatile("ds_read_b64_tr_b16 %0, %1 offset:%2" : "=&v"(dst) : "v"(vb0), "i"(off) : "memory")
#define PV_D0(d0) do { s16x4 l0, l1, l2, l3, h0, h1, h2, h3; constexpr int b_ = VB * SHM_V + v_rd_off(d0, 0, 0);     \
        TRRD(l0, b_); TRRD(h0, b_ + 2048); TRRD(l1, b_ + 4096); TRRD(h1, b_ + 6144); TRRD(l2, b_ + 8192); TRRD(h2, b_ + 10240); TRRD(l3, b_ + 12288); TRRD(h3, b_ + 14336); \
        asm volatile("s_waitcnt lgkmcnt(0)" ::: "memory"); SBAR();                 \
        o[d0] = __builtin_amdgcn_mfma_f32_32x32x16_bf16(pa0, (bf16x8){l0[0], l0[1], l0[2], l0[3], h0[0], h0[1], h0[2], h0[3]}, o[d0], 0, 0, 0);   \
        o[d0] = __builtin_amdgcn_mfma_f32_32x32x16_bf16(pa1, (bf16x8){l1[0], l1[1], l1[2], l1[3], h1[0], h1[1], h1[2], h1[3]}, o[d0], 0, 0, 0);   \
        o[d0] = __builtin_amdgcn_mfma_f32_32x32x16_bf16(pa2, (bf16x8){l2[0], l2[1], l2[2], l2[3], h2[0], h2[1], h2[2], h2[3]}, o[d0], 0, 0, 0);   \
        o[d0] = __builtin_amdgcn_mfma_f32_32x32x16_bf16(pa3, (bf16x8){l3[0], l3[1], l3[2], l3[3], h3[0], h3[1], h3[2], h3[3]}, o[d0], 0, 0, 0); } while (0)
    PV_D0(0); PV_D0(1); PV_D0(2); PV_D0(3);
#undef PV_D0
#undef TRRD
}

template <class TIn, class TOut> struct BlockRef { const TIn* Q; const TIn* K; const TIn* V; TOut* O; int P0; };
template <class TIn> struct Seam {
    bf16x8 qr[8];
    bf16x8 st_v0, st_v1, st_k0, st_k1; f32x4 sf0, sf1, sf2, sf3;
    f32x4 tq[16];
};
__device__ __forceinline__ int swa_jlo(int P0, int W) { const int lowk = P0 - W + 1; return lowk > 0 ? lowk / KVBLK : 0; }
#define ROW(p, k0, rr) ((p) + (size_t)((k0) + (rr)) * PITCH + sc)
#define VMW() asm volatile("s_waitcnt vmcnt(0)" ::: "memory")
#define VMWN(n) asm volatile("s_waitcnt vmcnt(%0)" :: "i"(n) : "memory")
#define SLOAD_H(Kp, Vp, k0) do { S.st_v0 = load8<TIn>(ROW(Vp, k0, sr)); S.st_v1 = load8<TIn>(ROW(Vp, k0, 32 + sr));              \
                         S.st_k0 = load8<TIn>(ROW(Kp, k0, sr)); S.st_k1 = load8<TIn>(ROW(Kp, k0, 32 + sr)); } while (0)
#define SWRITE_HK(bf) do { *(bf16x8*)(K_lds + (bf) * SHM_K + kws) = S.st_k0; *(bf16x8*)(K_lds + (bf) * SHM_K + kws + 32 * 256) = S.st_k1; } while (0)
#define SWRITE_HV(bf) do { *(bf16x8*)(V_lds + (bf) * SHM_V + vst0) = S.st_v0; *(bf16x8*)(V_lds + (bf) * SHM_V + vst1) = S.st_v1; } while (0)
#define SWRITE_H(bf) do { SWRITE_HV(bf); SWRITE_HK(bf); } while (0)
#define SLOAD_F(p, k0) do { S.sf0 = *(const f32x4*)ROW(p, k0, sr); S.sf1 = *(const f32x4*)(ROW(p, k0, sr) + 4);                \
                            S.sf2 = *(const f32x4*)ROW(p, k0, 32 + sr); S.sf3 = *(const f32x4*)(ROW(p, k0, 32 + sr) + 4); } while (0)
#define SWRITE_KF(bf) do { *(bf16x8*)(K_lds + (bf) * SHM_K + kws) = pack8(S.sf0, S.sf1); *(bf16x8*)(K_lds + (bf) * SHM_K + kws + 32 * 256) = pack8(S.sf2, S.sf3); } while (0)
#define SWRITE_VF(bf) do { *(bf16x8*)(V_lds + (bf) * SHM_V + vst0) = pack8(S.sf0, S.sf1); *(bf16x8*)(V_lds + (bf) * SHM_V + vst1) = pack8(S.sf2, S.sf3); } while (0)
template <class TIn, class TOut>
__device__ __forceinline__ void causal_swa_prime(const BlockRef<TIn, TOut>& cur, int W, char* lds, Seam<TIn>& S) {
    constexpr bool F32 = same_t<TIn, float>::v;
    int tid_l = threadIdx.x; asm volatile("" : "+v"(tid_l));
    const int tid = tid_l, wid = __builtin_amdgcn_readfirstlane(tid >> 6), lane = tid & 63, r32 = lane & 31, hi = lane >> 5;
    const int sr = tid >> 4, sc = (tid & 15) * 8, kws = KSWZ(sr, sc * 2); char* K_lds = lds + 2 * SHM_V;
    const int kb0 = swa_jlo(cur.P0, W) * KVBLK;
    for (int d0 = 0; d0 < 8; ++d0) S.qr[d0] = load8<TIn>(cur.Q + (size_t)(wid * QBLK + r32) * PITCH + d0 * 16 + hi * 8);
    if constexpr (F32) { SLOAD_F((const float*)cur.K, kb0); VMW(); SWRITE_KF(0); SBAR(); SLOAD_F((const float*)cur.V, kb0); }
    else { SLOAD_H(cur.K, cur.V, kb0); VMW(); SWRITE_HK(0); }
    __syncthreads();
}
template <class TIn, class TOut>
__device__ __forceinline__ void causal_swa_block(const BlockRef<TIn, TOut>& cur, const BlockRef<TIn, TOut>& nxt, int skv, int W, char* lds, Seam<TIn>& S, const float* cbias) {
    constexpr bool F32 = same_t<TIn, float>::v;
    int tid_l = threadIdx.x; asm volatile("" : "+v"(tid_l));
    const int tid = tid_l, wid = __builtin_amdgcn_readfirstlane(tid >> 6), lane = tid & 63, r32 = lane & 31, hi = lane >> 5;
    const int j_lo = swa_jlo(cur.P0, W);
    int j_hi = (cur.P0 + QB - 1) / KVBLK + 1; if (j_hi > skv / KVBLK) j_hi = skv / KVBLK;
    const int NT = j_hi - j_lo;
    const int kbn = swa_jlo(nxt.P0, W) * KVBLK;
    const int qlo = cur.P0 + wid * QBLK, qm = qlo + r32 - 4 * hi;
    char* V_lds = lds; char* K_lds = lds + 2 * SHM_V;
    float* ws = (float*)(lds + 2 * SHM_V + 2 * SHM_K) + wid * 64; float* li_l = ws, * al_l = ws + 32;
    float m_reg = -1e30f, l_reg = 0; f32x16 o[4] = {};
    const int sr = tid >> 4, sc = (tid & 15) * 8, vst0 = v_st(sr, sc), vst1 = v_st(32 + sr, sc), kws = KSWZ(sr, sc * 2);
    const int vb0 = (int)(uintptr_t)V_lds + v_rd_base(lane);
    const TIn* Kh = cur.K; const TIn* Vh = cur.V;
#define RESC(a) do { if (__any((a) < 1.f)) { if (hi == 0) al_l[r32] = (a); asm volatile("s_waitcnt lgkmcnt(0)" ::: "memory");              \
                     for (int d_ = 0; d_ < 4; ++d_) for (int r = 0; r < 16; ++r) o[d_][r] *= al_l[crow(r, hi)]; } } while (0)
#define KBASE(t) ((j_lo + (t)) * KVBLK)
#define ACT(t) (KBASE(t) <= qlo + QBLK - 1 && KBASE(t) + KVBLK - 1 >= qlo - W + 1)
#define MASKT(P0_, P1_, t) do { const int kb_ = KBASE(t); if ((!SK || ACT(t)) && (kb_ + KVBLK - 1 > qlo || kb_ <= qlo + QBLK - 1 - W)) mask_tile(P0_, P1_, qm - kb_, (unsigned)W); } while (0)
    constexpr int NQL = F32 ? 16 : 8;
    constexpr bool SK = WSKIP && !F32;
#define SEAM_K0() do { VMWN(NQL); if constexpr (F32) { SWRITE_KF(0); SBAR(); SLOAD_F((const float*)nxt.V, kbn); } else { SWRITE_HK(0); } SBAR(); } while (0)
    f32x16 pA0, pA1, pB0, pB1; float mnA, mnB, alA, alB; bf16x8 pa0, pa1, pa2, pa3;
    if constexpr (F32) { VMW(); SWRITE_VF(0); SBAR(); } else { SWRITE_HV(0); SBAR(); }
    if (NT > 1) { if constexpr (F32) SLOAD_F((const float*)Kh, KBASE(1)); else SLOAD_H(Kh, Vh, KBASE(1)); }
    SBAR(); qkt<0, SK>(pA0, pA1, K_lds, r32, hi, S.qr, ACT(0), cbias + KBASE(0) + 4 * hi);
    if constexpr (F32) { if (NT > 1) { VMW(); SWRITE_KF(1); SBAR(); SLOAD_F((const float*)Vh, KBASE(1)); } }
    MASKT(pA0, pA1, 0); partialSM(pA0, pA1, m_reg, mnA, alA);
    if (NT > 1) { VMW(); if constexpr (F32) { SWRITE_VF(1); SBAR(); if (NT > 2) SLOAD_F((const float*)Kh, KBASE(2)); } else SWRITE_H(1); }
    __syncthreads();
#define HALF_STEP(PX0, PX1, mnX, alX, PY0, PY1, alY, t, KB, VB, SB) do {                                                      \
        SBAR(); qkt<KB, SK>(PX0, PX1, K_lds, r32, hi, S.qr, ACT(t), cbias + KBASE(t) + 4 * hi);                                             \
        finishSM(PY0, PY1, alY, l_reg, pa0, pa1, pa2, pa3); SBAR();                                                           \
        if ((t) + 1 < NT) { if constexpr (F32) { VMW(); SWRITE_KF(SB); SBAR(); SLOAD_F((const float*)Vh, KBASE((t) + 1)); }  \
                            else { SLOAD_H(Kh, Vh, KBASE((t) + 1)); } SBAR(); }                                               \
        pv_tile<VB, SK>(o, vb0, pa0, pa1, pa2, pa3, ACT((t) - 1)); MASKT(PX0, PX1, (t)); partialSM(PX0, PX1, m_reg, mnX, alX);                                        \
        __syncthreads();                                                                                                      \
        if ((t) + 1 < NT) { VMW(); if constexpr (F32) { SWRITE_VF(SB); SBAR(); if ((t) + 2 < NT) SLOAD_F((const float*)Kh, KBASE((t) + 2)); } \
                            else { SWRITE_H(SB); } }                                                                          \
        RESC(alX); __syncthreads(); } while (0)
    for (int t = 1; t + 1 < NT; t += 2) {
        HALF_STEP(pB0, pB1, mnB, alB, pA0, pA1, alA, t, 1, 0, 0);
        HALF_STEP(pA0, pA1, mnA, alA, pB0, pB1, alB, t + 1, 0, 1, 1);
    }
    const bool even = (NT & 1) == 0;
    if (even) { SBAR(); qkt<1, SK>(pB0, pB1, K_lds, r32, hi, S.qr, ACT(NT - 1), cbias + KBASE(NT - 1) + 4 * hi); SBAR(); }
#define QROW(e) (nxt.Q + (size_t)(wid * QBLK + r32) * PITCH + ((e) >> 1) * 16 + hi * 8 + ((e) & 1) * 4)
    if constexpr (F32) { SLOAD_F((const float*)nxt.K, kbn); SBAR();
#pragma unroll
        for (int e = 0; e < 8; ++e) S.tq[e] = *(const f32x4*)QROW(e); }
    else { SLOAD_H(nxt.K, nxt.V, kbn); SBAR();
#pragma unroll
        for (int d0 = 0; d0 < 8; ++d0) S.qr[d0] = load8<TIn>(nxt.Q + (size_t)(wid * QBLK + r32) * PITCH + d0 * 16 + hi * 8); }
    SBAR();
    finishSM(pA0, pA1, alA, l_reg, pa0, pa1, pa2, pa3); SBAR();
    if constexpr (F32) {
#pragma unroll
        for (int e = 8; e < 16; ++e) S.tq[e] = *(const f32x4*)QROW(e); SBAR(); }
#undef QROW
    pv_tile<0, SK>(o, vb0, pa0, pa1, pa2, pa3, ACT(even ? NT - 2 : NT - 1));
    if (even) { MASKT(pB0, pB1, NT - 1); partialSM(pB0, pB1, m_reg, mnB, alB); __syncthreads(); RESC(alB);
        finishSM(pB0, pB1, alB, l_reg, pa0, pa1, pa2, pa3); SBAR(); pv_tile<1, SK>(o, vb0, pa0, pa1, pa2, pa3, ACT(NT - 1)); }
    SBAR(); SEAM_K0();
    if (hi == 0) li_l[r32] = l_reg; asm volatile("s_waitcnt lgkmcnt(0)" ::: "memory");
    float rli[16];
#pragma unroll
    for (int r = 0; r < 16; ++r) rli[r] = __builtin_amdgcn_rcpf(li_l[crow(r, hi)]);
    TOut* Ow = cur.O + (size_t)(wid * QBLK) * PITCH;
#pragma unroll
    for (int r = 0; r < 16; ++r) { const int orow = crow(r, hi);
#pragma unroll
        for (int d0 = 0; d0 < 4; ++d0) { const float v = o[d0][r] * rli[r];
            if constexpr (same_t<TOut, float>::v) { Ow[(size_t)orow * PITCH + d0 * 32 + r32] = v; }
            else { const float vn = __shfl_xor(v, 1);
                   if ((r32 & 1) == 0) *(unsigned*)(Ow + (size_t)orow * PITCH + d0 * 32 + r32) = cvtpk(v, vn); } } }
    if constexpr (F32) {
#pragma unroll
        for (int d0 = 0; d0 < 8; ++d0) S.qr[d0] = pack8(S.tq[2 * d0], S.tq[2 * d0 + 1]); }
    __syncthreads();
#undef RESC
#undef KBASE
#undef ACT
#undef MASKT
#undef SEAM_K0
#undef HALF_STEP
}
#undef ROW
#undef VMW
#undef VMWN
#undef SLOAD_H
#undef SWRITE_HK
#undef SWRITE_HV
#undef SWRITE_H
#undef SLOAD_F
#undef SWRITE_KF
#undef SWRITE_VF
}

typedef unsigned short bf16_t;
typedef short bf16x8 __attribute__((ext_vector_type(8)));
typedef float f32x4 __attribute__((ext_vector_type(4)));
typedef unsigned u32x4 __attribute__((ext_vector_type(4)));
typedef unsigned u32x2 __attribute__((ext_vector_type(2)));
constexpr int DM = 1024, NB = 32, SEQ = 2048, NH = 8, HD = 128, DFF = 2816, NUP = 2 * DFF;
constexpr int MTOK = NB * SEQ;
constexpr int NG = 2, BG = NB / NG, GM = BG * SEQ;
constexpr int NIN = 37 * 256;
constexpr int NCH = BG * NH * 32;
static_assert(GM == pg8::GM, "group rows");
constexpr size_t MiB = 1u << 20;
constexpr size_t WS_CTL = 0;
constexpr size_t WS_WIN = 1 * MiB, WS_WBF = 20 * MiB, WS_WBG = 22 * MiB, WS_WOUT = 24 * MiB, WS_WUP = 26 * MiB, WS_WDN = 37 * MiB;
constexpr size_t WS_PROJ = 44 * MiB;
constexpr size_t WS_SMALL = 620 * MiB;
constexpr size_t WS_PREP = 624 * MiB;
constexpr size_t WS_END = 913 * MiB;
constexpr size_t PBUF = 64 * MiB;
constexpr size_t WS_H1B = WS_PROJ + 0 * PBUF;
constexpr size_t WS_T1 = WS_PROJ + 1 * PBUF;
constexpr size_t WS_Y = WS_PROJ + 2 * PBUF;
constexpr size_t WS_YGDN = WS_PROJ + 3 * PBUF;
constexpr size_t WS_YFOX = WS_PROJ + 5 * PBUF;
constexpr size_t WS_UP = WS_PROJ + 3 * PBUF;
constexpr size_t WS_ACT = WS_PREP;
constexpr size_t PROJ_STRIDE = (size_t)GM * 1024;
constexpr int LDS_BYTES = 163840;

__device__ __forceinline__ float bf2f(bf16_t b) { return __uint_as_float((unsigned)b << 16); }
__device__ __forceinline__ float bflo(unsigned w) { return __uint_as_float(w << 16); }
__device__ __forceinline__ float bfhi(unsigned w) { return __uint_as_float(w & 0xffff0000u); }
typedef float f32x2_t __attribute__((ext_vector_type(2))); typedef __bf16 bf16x2_t __attribute__((ext_vector_type(2)));
__device__ __forceinline__ unsigned pk2(float lo, float hi) { f32x2_t v = {lo, hi}; bf16x2_t b = __builtin_convertvector(v, bf16x2_t); return __builtin_bit_cast(unsigned, b); }
__device__ __forceinline__ bf16_t f2bf(float f) { return (bf16_t)(pk2(f, 0.f) & 0xffffu); }
__device__ __forceinline__ float siluf(float y) { return y * __builtin_amdgcn_rcpf(1.0f + __expf(-y)); }
__device__ __forceinline__ float wave_sum(float v) {
#pragma unroll
    for (int o = 1; o < 64; o <<= 1) v += __shfl_xor(v, o);
    return v;
}

struct Args { const float* in[16]; float* out; unsigned char* ws; int ph_lo, ph_hi; };
struct Ptrs {
    const float *x, *norm_mix, *w_in, *fox_f_bias, *gdn_conv_w, *gdn_a_log, *gdn_dt_bias, *gdn_norm, *w_bf, *w_bg, *w_out, *norm_ffn, *w_up, *ffn_conv_w, *w_down, *norm_final;
    float* out; unsigned char* ws;
};

template <int MODE> __device__ __forceinline__ int srccol(int n) {
    if (MODE == 0) return n;
    if (MODE == 1) {
        if (n < 3072) return n;
        if (n < 6144) return 3080 + (n - 3072);
        if (n < 9216) return 6168 + (n - 6144);
        const int s = n - 9216;
        if (s < 8) return 3072 + s;
        if (s < 16) return 6152 + (s - 8);
        if (s < 24) return 6160 + (s - 16);
        return -1;
    }
    { const int p = n >> 8, s = (n >> 7) & 1, i = n & 127; return s * DFF + 128 * p + i; }
}
template <int MODE> __device__ __forceinline__ void transpose_item(const float* W, int K, int N, const float* ksc, bf16_t* WT, float* scr, int item, int nblk, int lane) {
    const int kb = item / nblk, nb = item % nblk, k0 = 64 * kb, n0 = 32 * nb;
    const int sc = srccol<MODE>(n0 + (lane & 31));
    float tv[32];
    const int scc = sc >= 0 ? sc : 0;
#pragma unroll
    for (int i = 0; i < 32; ++i) tv[i] = W[(size_t)(k0 + 2 * i + (lane >> 5)) * N + scc];
    if (ksc) {
#pragma unroll
        for (int i = 0; i < 32; ++i) tv[i] *= ksc[k0 + 2 * i + (lane >> 5)]; }
#pragma unroll
    for (int i = 0; i < 32; ++i) scr[(2 * i + (lane >> 5)) * 33 + (lane & 31)] = (sc >= 0) ? tv[i] : 0.f;
    asm volatile("s_waitcnt lgkmcnt(0)" ::: "memory");
    const int c = lane & 7;
#pragma unroll
    for (int j = 0; j < 4; ++j) { const int n = (lane >> 3) + 8 * j; const float* s = scr + (8 * c) * 33 + n;
        u32x4 o; o.x = pk2(s[0 * 33], s[1 * 33]); o.y = pk2(s[2 * 33], s[3 * 33]); o.z = pk2(s[4 * 33], s[5 * 33]); o.w = pk2(s[6 * 33], s[7 * 33]);
        *(u32x4*)(WT + (size_t)(n0 + n) * K + k0 + 8 * c) = o; }
    asm volatile("s_waitcnt lgkmcnt(0)" ::: "memory");
}
__device__ __forceinline__ void phase_prologue(const Ptrs& P, char* lds, int tid, int cid) {
    const int lane = tid & 63, wave = tid >> 6;
    float* scr = (float*)(lds + wave * 16384);
    const int gw = cid * 8 + wave, NGW = 256 * 8;
    bf16_t* win_t = (bf16_t*)(P.ws + WS_WIN); bf16_t* wbf_t = (bf16_t*)(P.ws + WS_WBF); bf16_t* wbg_t = (bf16_t*)(P.ws + WS_WBG);
    bf16_t* wout_t = (bf16_t*)(P.ws + WS_WOUT); bf16_t* wup_t = (bf16_t*)(P.ws + WS_WUP); bf16_t* wdn_t = (bf16_t*)(P.ws + WS_WDN);
    constexpr int I_IN = 16 * (NIN / 32), I_SQ = 16 * 32, I_UP = 16 * (NUP / 32), I_DN = (DFF / 64) * 32;
    constexpr int NITEMS = I_IN + 3 * I_SQ + I_UP + I_DN;
    for (int it = gw; it < NITEMS; it += NGW) {
        int r = it;
        if (r < I_IN) { transpose_item<1>(P.w_in, DM, 9240, nullptr, win_t, scr, r, NIN / 32, lane); continue; } r -= I_IN;
        if (r < I_SQ) { transpose_item<0>(P.w_bf, DM, DM, nullptr, wbf_t, scr, r, 32, lane); continue; } r -= I_SQ;
        if (r < I_SQ) { transpose_item<0>(P.w_bg, DM, DM, nullptr, wbg_t, scr, r, 32, lane); continue; } r -= I_SQ;
        if (r < I_SQ) { transpose_item<0>(P.w_out, DM, DM, nullptr, wout_t, scr, r, 32, lane); continue; } r -= I_SQ;
        if (r < I_UP) { transpose_item<2>(P.w_up, DM, NUP, P.norm_ffn, wup_t, scr, r, NUP / 32, lane); continue; } r -= I_UP;
        transpose_item<0>(P.w_down, DFF, DM, nullptr, wdn_t, scr, r, 32, lane);
    }
    f32x4 gv[4];
#pragma unroll
    for (int j = 0; j < 4; ++j) gv[j] = ((const f32x4*)P.norm_mix)[lane + 64 * j];
    for (int m0 = gw; m0 < MTOK; m0 += 2 * NGW) {
        const int m1 = m0 + NGW;
        const f32x4* xr0 = (const f32x4*)(P.x + (size_t)m0 * DM) + lane; const f32x4* xr1 = (const f32x4*)(P.x + (size_t)m1 * DM) + lane;
        f32x4 v0[4], v1[4]; float s0 = 0.f, s1 = 0.f;
#pragma unroll
        for (int j = 0; j < 4; ++j) { v0[j] = __builtin_nontemporal_load(xr0 + 64 * j); v1[j] = __builtin_nontemporal_load(xr1 + 64 * j); }
#pragma unroll
        for (int j = 0; j < 4; ++j) { s0 += (v0[j][0] * v0[j][0] + v0[j][1] * v0[j][1]) + (v0[j][2] * v0[j][2] + v0[j][3] * v0[j][3]); s1 += (v1[j][0] * v1[j][0] + v1[j][1] * v1[j][1]) + (v1[j][2] * v1[j][2] + v1[j][3] * v1[j][3]); }
        const float rstd0 = rsqrtf(wave_sum(s0) * (1.f / DM) + 1e-6f), rstd1 = rsqrtf(wave_sum(s1) * (1.f / DM) + 1e-6f);
        if (lane == 0) { float* irx = (float*)(P.ws + WS_CTL + 512 * 1024); irx[m0] = __builtin_amdgcn_rcpf(rstd0); irx[m1] = __builtin_amdgcn_rcpf(rstd1); }
        const int g0 = m0 / GM, g1 = m1 / GM;
        u32x2* o0 = (u32x2*)((bf16_t*)(P.out + (size_t)g0 * GM * DM) + (size_t)(m0 - g0 * GM) * DM) + lane;
        u32x2* o1 = (u32x2*)((bf16_t*)(P.out + (size_t)g1 * GM * DM) + (size_t)(m1 - g1 * GM) * DM) + lane;
#pragma unroll
        for (int j = 0; j < 4; ++j) { const f32x4 t0 = v0[j] * rstd0 * gv[j], t1 = v1[j] * rstd1 * gv[j]; u32x2 w0, w1; w0.x = pk2(t0[0], t0[1]); w0.y = pk2(t0[2], t0[3]); w1.x = pk2(t1[0], t1[1]); w1.y = pk2(t1[2], t1[3]); o0[64 * j] = w0; o1[64 * j] = w1; }
    }
}

__device__ __forceinline__ f32x4 mma16(const bf16_t* A, int lda, const bf16_t* Bt, int ldb, int ksteps, f32x4 acc, int lane) {
    const int r = lane & 15, q = lane >> 4;
    const bf16_t* ap = A + r * lda + q * 8; const bf16_t* bp = Bt + r * ldb + q * 8;
    for (int ks = 0; ks < ksteps; ++ks) { const bf16x8 a = *(const bf16x8*)(ap + ks * 32); const bf16x8 b = *(const bf16x8*)(bp + ks * 32); acc = __builtin_amdgcn_mfma_f32_16x16x32_bf16(a, b, acc, 0, 0, 0); }
    return acc;
}
#define LBAR() do { asm volatile("s_waitcnt lgkmcnt(0)" ::: "memory"); __builtin_amdgcn_s_barrier(); asm volatile("" ::: "memory"); } while (0)
__device__ __forceinline__ f32x4 mma16s(const bf16_t* A, int lda, int sw, const bf16_t* Bt, int ldb, int ksteps, f32x4 acc, int lane) {
    const int r = lane & 15, q = lane >> 4;
    const bf16_t* ap = A + r * lda; const bf16_t* bp = Bt + r * ldb + q * 8;
    for (int ks = 0; ks < ksteps; ++ks) { const bf16x8 a = *(const bf16x8*)(ap + (((ks * 4 + q) ^ sw) << 3)); const bf16x8 b = *(const bf16x8*)(bp + ks * 32); acc = __builtin_amdgcn_mfma_f32_16x16x32_bf16(a, b, acc, 0, 0, 0); }
    return acc;
}
constexpr int PQ = 136, PC = 72;
struct PrepBufs { bf16_t *W, *QD, *KDT, *UHT, *AT; float* GL; };
__device__ __forceinline__ PrepBufs prep_bufs(unsigned char* ws) {
    PrepBufs b; b.W = (bf16_t*)(ws + WS_PREP); b.QD = (bf16_t*)(ws + WS_PREP + 64 * MiB); b.KDT = (bf16_t*)(ws + WS_PREP + 128 * MiB); b.UHT = (bf16_t*)(ws + WS_PREP + 192 * MiB);
    b.AT = (bf16_t*)(ws + WS_PREP + 256 * MiB); b.GL = (float*)(ws + WS_PREP + 288 * MiB); return b;
}
constexpr int PL_QS = 0, PL_KS = 17408, PL_KDT = 34816, PL_RAW = 53248, RAWP = 392  , PL_RT = PL_RAW + 67 * RAWP * 2, PL_GC = PL_RT + 256 * PC * 2, PL_CW = PL_GC + 512, PL_END = PL_CW + 6144;
constexpr int RAW_CHUNKS = 67 * 48;
#ifndef SEGSEL
#define SEGSEL 0
#endif
#define SEG_T0() unsigned long long seg_t0 = 0; if (SEGSEL && blockIdx.x == 0 && threadIdx.x == 0) seg_t0 = __builtin_amdgcn_s_memrealtime()
#define SEG_MARK(k) do { if (SEGSEL && blockIdx.x == 0 && threadIdx.x == 0) { const unsigned long long t_ = __builtin_amdgcn_s_memrealtime(); if (SEGSEL == (k)) atomicAdd((float*)(P.ws + WS_CTL + 768 * 1024), (float)(t_ - seg_t0) * 0.01f); seg_t0 = t_; } } while (0)
struct PrepStage { u32x4 raw[7]; float ga, gb; };
struct ConvW { f32x4 w[3][4]; };
struct PrepHold { u32x4 uh[2], w[2], at; int unit; };
__device__ __forceinline__ void prep_fetch(PrepStage& st, int unit, const Ptrs& P, int tid) {
    const int n = unit & 31, h = (unit >> 5) & 7, bl = unit >> 8;
    const int R0 = bl * SEQ + n * 64;
    const bf16_t* proj = (const bf16_t*)(P.ws + WS_PROJ); const float* small = (const float*)(P.ws + WS_SMALL);
#pragma unroll
    for (int i = 0; i < 7; ++i) { int c = tid + 512 * i; c = c < RAW_CHUNKS ? c : RAW_CHUNKS - 1; const int row = c / 48, c16 = c - row * 48, part = c16 >> 4, ch = (c16 & 15) * 8;
        const bool zero = (n == 0) && (row < 3);
        const int rr = zero ? 3 : row;
        u32x4 v = *(const u32x4*)(proj + (size_t)(3 + part) * PROJ_STRIDE + (size_t)(R0 - 3 + rr) * 1024 + h * HD + ch);
        if (zero) v = (u32x4){0u, 0u, 0u, 0u};
        st.raw[i] = v; }
    { const float* sm = small + (size_t)(R0 + (tid & 63)) * 32; st.ga = sm[8 + h]; st.gb = sm[16 + h]; }
}
__device__ __forceinline__ void prep_flush(const PrepHold& hd, const Ptrs& P, int tid) {
    const PrepBufs G = prep_bufs(P.ws);
#pragma unroll
    for (int i = 0; i < 2; ++i) { const int idx = tid + 512 * i; *(u32x4*)(G.UHT + (size_t)hd.unit * 8192 + idx * 8) = hd.uh[i]; *(u32x4*)(G.W + (size_t)hd.unit * 8192 + idx * 8) = hd.w[i]; }
    *(u32x4*)(G.AT + (size_t)hd.unit * 4096 + tid * 8) = hd.at;
}
__device__ __forceinline__ void gdn_prep_unit(char* lds, int unit, int unit_next, PrepStage& st, PrepHold& hd, const ConvW& cwr, const Ptrs& P, int tid_in, float neg_a, float dtb) {
    int tid = tid_in; asm volatile("" : "+v"(tid));
    const int lane = tid & 63, wid = tid >> 6, c16 = lane & 15, q4 = lane >> 4;
    const int h = (unit >> 5) & 7;
    bf16_t* Qs = (bf16_t*)(lds + PL_QS); bf16_t* Ks = (bf16_t*)(lds + PL_KS); bf16_t* KDTs = (bf16_t*)(lds + PL_KDT);
    bf16_t* RAW = (bf16_t*)(lds + PL_RAW);
    bf16_t* RT = (bf16_t*)(lds + PL_RT);
    float* gcs = (float*)(lds + PL_GC); float* bts = gcs + 64;
    bf16_t* UHs = (bf16_t*)(lds + PL_RAW + 4096); bf16_t* Wst = UHs + 8192; bf16_t* ATs = Wst + 64 * PQ;
    bf16_t* CH = (bf16_t*)lds;
    const PrepBufs G = prep_bufs(P.ws);
    SEG_T0();
#pragma unroll
    for (int i = 0; i < 7; ++i) { const int c = tid + 512 * i; const int row = c / 48, cc = c - row * 48; if (c < RAW_CHUNKS) *(u32x4*)(RAW + row * RAWP + cc * 8) = st.raw[i]; }
    if (wid == 0) {
        const float xx = st.ga + dtb;
        const float sp = xx > 20.f ? xx : log1pf(__expf(xx));
        float cum = neg_a * sp;
        const float beta = __builtin_amdgcn_rcpf(1.0f + __expf(-st.gb));
#pragma unroll
        for (int o = 1; o < 64; o <<= 1) { const float t = __shfl_up(cum, o); if (lane >= o) cum += t; }
        gcs[lane] = cum; bts[lane] = beta;
    }
    prep_flush(hd, P, tid);
    LBAR();
    SEG_MARK(1);
    prep_fetch(st, unit_next, P, tid);
    {
        const int cg = tid & 31, rg = tid >> 5, r0 = 4 * rg, c0 = 4 * cg;
        const f32x4 gc4 = *(const f32x4*)(gcs + r0), bt4 = *(const f32x4*)(bts + r0); const float glast = gcs[63];
        float eg[4], egl[4];
#pragma unroll
        for (int rr = 0; rr < 4; ++rr) { eg[rr] = __expf(gc4[rr]); egl[rr] = __expf(glast - gc4[rr]); }
        const int key = (cg >> 1) & 7;
        const int csw = ((((rg >> 1) ^ key) << 3) | ((rg & 1) << 2));
#pragma unroll
        for (int part = 0; part < 3; ++part) {
            float x[7][4];
#pragma unroll
            for (int i = 0; i < 7; ++i) { const u32x2 a = *(const u32x2*)(RAW + (r0 + i) * RAWP + part * 128 + c0); x[i][0] = bflo(a.x); x[i][1] = bfhi(a.x); x[i][2] = bflo(a.y); x[i][3] = bfhi(a.y); }
            float y[4][4]; float ss[4];
#pragma unroll
            for (int rr = 0; rr < 4; ++rr) { ss[rr] = 0.f;
#pragma unroll
                for (int e = 0; e < 4; ++e) { float v = cwr.w[part][0][e] * x[rr][e] + cwr.w[part][1][e] * x[rr + 1][e] + cwr.w[part][2][e] * x[rr + 2][e] + cwr.w[part][3][e] * x[rr + 3][e];
                    v = siluf(v); y[rr][e] = v; ss[rr] += v * v; } }
            if (part < 2) {
#pragma unroll
                for (int rr = 0; rr < 4; ++rr) { float t = ss[rr]; t += __shfl_xor(t, 1); t += __shfl_xor(t, 2); t += __shfl_xor(t, 4); t += __shfl_xor(t, 8); t += __shfl_xor(t, 16); ss[rr] = rsqrtf(t + 1e-6f); }
            }
            if (part == 0) {
#pragma unroll
                for (int rr = 0; rr < 4; ++rr) { const float sc = ss[rr] * 0.08838834764831845f; const float a0 = y[rr][0] * sc, a1 = y[rr][1] * sc, a2 = y[rr][2] * sc, a3 = y[rr][3] * sc;
                    u32x2 w; w.x = pk2(a0, a1); w.y = pk2(a2, a3); *(u32x2*)(Qs + (r0 + rr) * PQ + c0) = w;
                    u32x2 d; d.x = pk2(a0 * eg[rr], a1 * eg[rr]); d.y = pk2(a2 * eg[rr], a3 * eg[rr]); *(u32x2*)(G.QD + (size_t)unit * 8192 + (r0 + rr) * 128 + c0) = d; }
            } else if (part == 1) {
#pragma unroll
                for (int rr = 0; rr < 4; ++rr) {
#pragma unroll
                    for (int e = 0; e < 4; ++e) y[rr][e] *= ss[rr];
                    u32x2 w; w.x = pk2(y[rr][0], y[rr][1]); w.y = pk2(y[rr][2], y[rr][3]); *(u32x2*)(Ks + (r0 + rr) * PQ + c0) = w; }
#pragma unroll
                for (int e = 0; e < 4; ++e) { u32x2 w1, w2;
                    w1.x = pk2(y[0][e] * bt4[0] * eg[0], y[1][e] * bt4[1] * eg[1]); w1.y = pk2(y[2][e] * bt4[2] * eg[2], y[3][e] * bt4[3] * eg[3]);
                    w2.x = pk2(y[0][e] * egl[0], y[1][e] * egl[1]); w2.y = pk2(y[2][e] * egl[2], y[3][e] * egl[3]);
                    *(u32x2*)(RT + (128 + c0 + e) * PC + csw) = w1; *(u32x2*)(KDTs + (c0 + e) * PC + csw) = w2; }
            } else {
#pragma unroll
                for (int e = 0; e < 4; ++e) { u32x2 w1; w1.x = pk2(y[0][e] * bt4[0], y[1][e] * bt4[1]); w1.y = pk2(y[2][e] * bt4[2], y[3][e] * bt4[3]); *(u32x2*)(RT + (c0 + e) * PC + csw) = w1; }
            }
        }
    }
    LBAR();
    SEG_MARK(2);
    {
#pragma unroll
        for (int i = 0; i < 2; ++i) { const int idx = tid + 512 * i, row = idx >> 3, ch = idx & 7; *(u32x4*)(G.KDT + (size_t)unit * 8192 + row * 64 + ch * 8) = *(const u32x4*)(KDTs + row * PC + ((ch ^ ((row >> 3) & 7)) << 3)); }
    }
    const int mat = wid >> 2, ti = wid & 3;
    f32x4 res[4], res2[4];
#pragma unroll
    for (int tj = 0; tj < 4; ++tj) { f32x4 acc = {0.f, 0.f, 0.f, 0.f}, acc2 = {0.f, 0.f, 0.f, 0.f};
        if (tj <= ti) { if (mat == 0) acc = mma16(Ks + ti * 16 * PQ, PQ, Ks + tj * 16 * PQ, PQ, 4, acc, lane);
                        acc2 = mma16(Ks + tj * 16 * PQ, PQ, (mat ? Qs : Ks) + ti * 16 * PQ, PQ, 4, acc2, lane); }
        res[tj] = acc; res2[tj] = acc2; }
    LBAR();
    {
        const int iiL = ti * 16 + c16; const float gciL = gcs[iiL], btL = bts[iiL];
#pragma unroll
        for (int tj = 0; tj < 4; ++tj) {
            const int jc0 = tj * 16 + 4 * q4;
            const f32x4 gcj = *(const f32x4*)(gcs + jc0);
            float v[4];
#pragma unroll
            for (int jj = 0; jj < 4; ++jj) { const int jc = jc0 + jj; const float dec = (iiL >= jc) ? __expf(gciL - gcj[jj]) : 0.f;
                v[jj] = (mat == 0) ? ((iiL > jc) ? -res2[tj][jj] * dec * btL : 0.f) : ((iiL >= jc) ? res2[tj][jj] * dec : 0.f); }
            u32x2 w; w.x = pk2(v[0], v[1]); w.y = pk2(v[2], v[3]);
            if (mat == 0) *(u32x2*)(CH + iiL * PC + jc0) = w;
            else *(u32x2*)(ATs + iiL * PC + jc0) = w;
            if (mat == 0) {
                const int jcL = tj * 16 + c16, ii0 = ti * 16 + 4 * q4; const float gcjL = gcs[jcL];
                const f32x4 gci = *(const f32x4*)(gcs + ii0), bti = *(const f32x4*)(bts + ii0);
                float t[4];
#pragma unroll
                for (int jj = 0; jj < 4; ++jj) { const int ii = ii0 + jj; t[jj] = (ii > jcL) ? -res[tj][jj] * __expf(gci[jj] - gcjL) * bti[jj] : 0.f; }
                u32x2 w2; w2.x = pk2(t[0], t[1]); w2.y = pk2(t[2], t[3]);
                *(u32x2*)(CH + 2 * 64 * PC + jcL * PC + ii0) = w2; }
        }
    }
    LBAR();
    SEG_MARK(3);
    f32x4 pacc[4];
    if (wid >= 4) {
#pragma unroll
        for (int tj = 0; tj < 4; ++tj) { const u32x2 nw = *(const u32x2*)(CH + (ti * 16 + c16) * PC + tj * 16 + 4 * q4); const int ii = ti * 16 + c16, jc0 = tj * 16 + 4 * q4;
            pacc[tj][0] = bflo(nw.x) + (ii == jc0 ? 1.f : 0.f); pacc[tj][1] = bfhi(nw.x) + (ii == jc0 + 1 ? 1.f : 0.f); pacc[tj][2] = bflo(nw.y) + (ii == jc0 + 2 ? 1.f : 0.f); pacc[tj][3] = bfhi(nw.y) + (ii == jc0 + 3 ? 1.f : 0.f); }
    }
    for (int s = 0; s < 6; ++s) {
        const int cur = s & 1, nxt = cur ^ 1;
        bf16_t* Qr_c = CH + cur * 64 * PC; bf16_t* Qt_c = CH + (2 + cur) * 64 * PC; bf16_t* Qr_n = CH + nxt * 64 * PC; bf16_t* Qt_n = CH + (2 + nxt) * 64 * PC;
        bf16_t* Pr_c = CH + (4 + cur) * 64 * PC; bf16_t* Pr_p = CH + (4 + nxt) * 64 * PC;
        if (wid < 4) {
            if (s < 5) {
#pragma unroll
                for (int tj = 0; tj < 4; ++tj) { f32x4 a1 = {0.f, 0.f, 0.f, 0.f}, a2 = {0.f, 0.f, 0.f, 0.f};
                    const bf16_t* ap = Qr_c + (ti * 16 + c16) * PC + q4 * 8; const bf16_t* bp = Qt_c + (tj * 16 + c16) * PC + q4 * 8;
#pragma unroll
                    for (int ks = 0; ks < 2; ++ks) { const bf16x8 fa = *(const bf16x8*)(ap + ks * 32), fb = *(const bf16x8*)(bp + ks * 32);
                        a1 = __builtin_amdgcn_mfma_f32_16x16x32_bf16(fa, fb, a1, 0, 0, 0);
                        a2 = __builtin_amdgcn_mfma_f32_16x16x32_bf16(fb, fa, a2, 0, 0, 0); }
                    u32x2 w1, w2; w1.x = pk2(a1[0], a1[1]); w1.y = pk2(a1[2], a1[3]); w2.x = pk2(a2[0], a2[1]); w2.y = pk2(a2[2], a2[3]);
                    *(u32x2*)(Qt_n + (tj * 16 + c16) * PC + ti * 16 + 4 * q4) = w1;
                    *(u32x2*)(Qr_n + (ti * 16 + c16) * PC + tj * 16 + 4 * q4) = w2; }
            }
        } else {
#pragma unroll
            for (int tj = 0; tj < 4; ++tj) {
                if (s >= 1) { const bf16_t* ap = Qt_c + (tj * 16 + c16) * PC + q4 * 8; const bf16_t* bp = Pr_p + (ti * 16 + c16) * PC + q4 * 8;
#pragma unroll
                    for (int ks = 0; ks < 2; ++ks) { const bf16x8 fa = *(const bf16x8*)(ap + ks * 32), fb = *(const bf16x8*)(bp + ks * 32); pacc[tj] = __builtin_amdgcn_mfma_f32_16x16x32_bf16(fa, fb, pacc[tj], 0, 0, 0); } }
                u32x2 w; w.x = pk2(pacc[tj][0], pacc[tj][1]); w.y = pk2(pacc[tj][2], pacc[tj][3]);
                *(u32x2*)(Pr_c + (ti * 16 + c16) * PC + tj * 16 + 4 * q4) = w; }
        }
        LBAR();
    }
    SEG_MARK(4);
    {
        const bf16_t* Tm = CH + 5 * 64 * PC;
#pragma unroll
        for (int t2 = 0; t2 < 2; ++t2) { const int tch = 2 * wid + t2; const int swl = (2 * tch + (c16 >> 3)) & 7;
#pragma unroll
            for (int tj = 0; tj < 4; ++tj) { f32x4 acc = {0.f, 0.f, 0.f, 0.f};
#pragma unroll
                for (int ks = 0; ks < 2; ++ks) { const bf16x8 fr = *(const bf16x8*)(RT + (tch * 16 + c16) * PC + (((ks * 4 + q4) ^ swl) << 3)); const bf16x8 ft = *(const bf16x8*)(Tm + (tj * 16 + c16) * PC + ks * 32 + q4 * 8);
                    acc = (tch < 8) ? __builtin_amdgcn_mfma_f32_16x16x32_bf16(ft, fr, acc, 0, 0, 0) : __builtin_amdgcn_mfma_f32_16x16x32_bf16(fr, ft, acc, 0, 0, 0); }
                u32x2 w; w.x = pk2(acc[0], acc[1]); w.y = pk2(acc[2], acc[3]);
                if (tch < 8) *(u32x2*)(UHs + ((((tch * 4 + tj) * 4 + q4) * 16 + c16) * 4)) = w;
                else *(u32x2*)(Wst + (tj * 16 + c16) * PQ + (tch - 8) * 16 + 4 * q4) = w;
            } }
        G.GL[unit] = __expf(gcs[63]);
    }
    LBAR();
#pragma unroll
    for (int i = 0; i < 2; ++i) { const int idx = tid + 512 * i; hd.uh[i] = *(const u32x4*)(UHs + idx * 8); hd.w[i] = *(const u32x4*)(Wst + (idx >> 4) * PQ + (idx & 15) * 8); }
    hd.at = *(const u32x4*)(ATs + (tid >> 3) * PC + (tid & 7) * 8); hd.unit = unit;
    LBAR();
    SEG_MARK(5);
}

__device__ __forceinline__ void gdn_seq_unit(char* lds, int bh, const Ptrs& P, int tid) {
    const int lane = tid & 63, wid = tid >> 6, c16 = lane & 15, q4 = lane >> 4;
    const int bl = bh >> 3, h = bh & 7;
    bf16_t* ST = (bf16_t*)lds;
    bf16_t* Wl = ST + 128 * PQ;
    bf16_t* QDl = Wl + 64 * PQ;
    bf16_t* ATl = QDl + 64 * PQ;
    bf16_t* KDTl = ATl + 64 * PC;
    bf16_t* UTl = KDTl + 128 * PC;
    bf16_t* GZl = UTl + 128 * PC;
    float* SSl = (float*)(GZl + 64 * PQ);
    const PrepBufs G = prep_bufs(P.ws);
    const bf16_t* gz = (const bf16_t*)(P.ws + WS_PROJ) + 6 * PROJ_STRIDE + (size_t)(bl * SEQ) * 1024 + h * HD;
    bf16_t* yg = (bf16_t*)(P.ws + WS_YGDN) + (size_t)(bl * SEQ) * 1024 + h * HD;
    f32x4 Sacc[8];
#pragma unroll
    for (int t = 0; t < 8; ++t) Sacc[t] = (f32x4){0.f, 0.f, 0.f, 0.f};
    for (int i = lane; i < 16 * PQ / 2; i += 64) ((unsigned*)(ST + wid * 16 * PQ))[i] = 0u;
    const f32x4 gn = *(const f32x4*)(P.gdn_norm + 16 * wid + 4 * q4);
    const int r16 = tid >> 4, ch16 = (tid & 15) * 8;
    const int r8 = tid >> 3, ch8 = (tid & 7) * 8;
    u32x4 sW[2], sQ[2], sA, sK[2], sG[2]; u32x2 uhn[4]; float gln;
    {
        const size_t ub = (size_t)(bh * 32) * 8192;
#pragma unroll
        for (int i = 0; i < 2; ++i) { const int idx = tid + 512 * i; sW[i] = *(const u32x4*)(G.W + ub + idx * 8); sQ[i] = *(const u32x4*)(G.QD + ub + idx * 8); sK[i] = *(const u32x4*)(G.KDT + ub + idx * 8);
            sG[i] = *(const u32x4*)(gz + (size_t)(r16 + 32 * i) * 1024 + ch16); }
        sA = *(const u32x4*)(G.AT + (size_t)(bh * 32) * 4096 + tid * 8);
#pragma unroll
        for (int t = 0; t < 4; ++t) uhn[t] = *(const u32x2*)(G.UHT + ub + ((wid * 4 + t) * 64 + lane) * 4);
        gln = G.GL[bh * 32];
    }
    for (int n = 0; n < 32; ++n) {
        const int unit = bh * 32 + n;
        const size_t ub = (size_t)unit * 8192;
#pragma unroll
        for (int i = 0; i < 2; ++i) { const int idx = tid + 512 * i;
            *(u32x4*)(Wl + (idx >> 4) * PQ + (idx & 15) * 8) = sW[i]; *(u32x4*)(QDl + (idx >> 4) * PQ + (idx & 15) * 8) = sQ[i]; *(u32x4*)(KDTl + (idx >> 3) * PC + (idx & 7) * 8) = sK[i]; }
        *(u32x4*)(ATl + r8 * PC + ch8) = sA;
        const float gl = gln;
        u32x2 uh[4];
#pragma unroll
        for (int t = 0; t < 4; ++t) uh[t] = uhn[t];
        LBAR();
        const int nn = (n + 1 < 32) ? n + 1 : 31;
        { const size_t un = (size_t)(bh * 32 + nn) * 8192;
#pragma unroll
            for (int i = 0; i < 2; ++i) { const int idx = tid + 512 * i; sW[i] = *(const u32x4*)(G.W + un + idx * 8); sQ[i] = *(const u32x4*)(G.QD + un + idx * 8); sK[i] = *(const u32x4*)(G.KDT + un + idx * 8); }
            sA = *(const u32x4*)(G.AT + (size_t)(bh * 32 + nn) * 4096 + tid * 8);
#pragma unroll
            for (int t = 0; t < 4; ++t) uhn[t] = *(const u32x2*)(G.UHT + un + ((wid * 4 + t) * 64 + lane) * 4);
            gln = G.GL[bh * 32 + nn]; }
        { const int np = (n > 0) ? n - 1 : 0;
#pragma unroll
            for (int i = 0; i < 2; ++i) { const u32x4 v = *(const u32x4*)(GZl + (r16 + 32 * i) * PQ + ch16); *(u32x4*)(yg + (size_t)(np * 64 + r16 + 32 * i) * 1024 + ch16) = v; } }
        f32x4 ws[4], os[4];
#pragma unroll
        for (int t = 0; t < 4; ++t) { ws[t] = (f32x4){0.f, 0.f, 0.f, 0.f}; os[t] = (f32x4){0.f, 0.f, 0.f, 0.f}; }
#pragma unroll
        for (int ks = 0; ks < 4; ++ks) { const bf16x8 b = *(const bf16x8*)(ST + (16 * wid + c16) * PQ + ks * 32 + q4 * 8);
#pragma unroll
            for (int t = 0; t < 4; ++t) { const bf16x8 a = *(const bf16x8*)(Wl + (16 * t + c16) * PQ + ks * 32 + q4 * 8); ws[t] = __builtin_amdgcn_mfma_f32_16x16x32_bf16(a, b, ws[t], 0, 0, 0);
                const bf16x8 a2 = *(const bf16x8*)(QDl + (16 * t + c16) * PQ + ks * 32 + q4 * 8); os[t] = __builtin_amdgcn_mfma_f32_16x16x32_bf16(b, a2, os[t], 0, 0, 0); } }
#pragma unroll
        for (int t = 0; t < 4; ++t) { u32x2 w; w.x = pk2(bflo(uh[t].x) - ws[t][0], bfhi(uh[t].x) - ws[t][1]); w.y = pk2(bflo(uh[t].y) - ws[t][2], bfhi(uh[t].y) - ws[t][3]);
            *(u32x2*)(UTl + (16 * wid + c16) * PC + 16 * t + 4 * q4) = w; }
        LBAR();
#pragma unroll
        for (int i = 0; i < 2; ++i) *(u32x4*)(GZl + (r16 + 32 * i) * PQ + ch16) = sG[i];
#pragma unroll
        for (int i = 0; i < 2; ++i) sG[i] = *(const u32x4*)(gz + (size_t)(nn * 64 + r16 + 32 * i) * 1024 + ch16);
#pragma unroll
        for (int ks = 0; ks < 2; ++ks) { const bf16x8 b = *(const bf16x8*)(UTl + (16 * wid + c16) * PC + ks * 32 + q4 * 8);
#pragma unroll
            for (int t = 0; t < 4; ++t) { const bf16x8 a = *(const bf16x8*)(ATl + (16 * t + c16) * PC + ks * 32 + q4 * 8); os[t] = __builtin_amdgcn_mfma_f32_16x16x32_bf16(b, a, os[t], 0, 0, 0); } }
#pragma unroll
        for (int t = 0; t < 8; ++t) Sacc[t] = Sacc[t] * gl;
#pragma unroll
        for (int ks = 0; ks < 2; ++ks) { const bf16x8 a = *(const bf16x8*)(UTl + (16 * wid + c16) * PC + ks * 32 + q4 * 8);
#pragma unroll
            for (int t = 0; t < 8; ++t) { const bf16x8 b = *(const bf16x8*)(KDTl + (16 * t + c16) * PC + ks * 32 + q4 * 8); Sacc[t] = __builtin_amdgcn_mfma_f32_16x16x32_bf16(b, a, Sacc[t], 0, 0, 0); } }
#pragma unroll
        for (int t = 0; t < 8; ++t) { u32x2 w; w.x = pk2(Sacc[t][0], Sacc[t][1]); w.y = pk2(Sacc[t][2], Sacc[t][3]); *(u32x2*)(ST + (16 * wid + c16) * PQ + 16 * t + 4 * q4) = w; }
#pragma unroll
        for (int t = 0; t < 4; ++t) { float s = (os[t][0] * os[t][0] + os[t][1] * os[t][1]) + (os[t][2] * os[t][2] + os[t][3] * os[t][3]); s += __shfl_xor(s, 16); s += __shfl_xor(s, 32);
            if (q4 == 0) SSl[wid * 64 + 16 * t + c16] = s; }
        LBAR();
        float tot = 0.f;
#pragma unroll
        for (int w = 0; w < 8; ++w) tot += SSl[w * 64 + lane];
        const float rstd_l = rsqrtf(tot * (1.0f / 128.0f) + 1e-6f);
#pragma unroll
        for (int t = 0; t < 4; ++t) { const int row = 16 * t + c16; const float rs = __shfl(rstd_l, row);
            u32x2* gp = (u32x2*)(GZl + row * PQ + 16 * wid + 4 * q4); const u32x2 gw = *gp; u32x2 w;
            w.x = pk2(os[t][0] * rs * gn[0] * siluf(bflo(gw.x)), os[t][1] * rs * gn[1] * siluf(bfhi(gw.x)));
            w.y = pk2(os[t][2] * rs * gn[2] * siluf(bflo(gw.y)), os[t][3] * rs * gn[3] * siluf(bfhi(gw.y))); *gp = w; }
    }
    LBAR();
#pragma unroll
    for (int i = 0; i < 2; ++i) { const u32x4 v = *(const u32x4*)(GZl + (r16 + 32 * i) * PQ + ch16); *(u32x4*)(yg + (size_t)(31 * 64 + r16 + 32 * i) * 1024 + ch16) = v; }
    __syncthreads();
}

__device__ __forceinline__ void fox_item(char* lds, int item, const Ptrs& P, int tid, bool need_bias) {
    using bf = fox::bf16;
    const int lane = tid & 63, wid = tid >> 6;
    const int bh = item >> 2, xq = item & 3, bl = bh >> 3, h = bh & 7;
    float* cb = (float*)(lds + fox::LDS_BYTES);
    float* tmp = cb + SEQ;
    const float* small = (const float*)(P.ws + WS_SMALL);
    if (need_bias) {
        const float fb = P.fox_f_bias[h];
        float lf[4]; float run = 0.f;
#pragma unroll
        for (int e = 0; e < 4; ++e) { const float xv = small[(size_t)(bl * SEQ + 4 * tid + e) * 32 + h] + fb;
            const float l = (xv < -20.f) ? xv : -log1pf(__expf(-xv)); run += l; lf[e] = run; }
        float inc = run;
#pragma unroll
        for (int o = 1; o < 64; o <<= 1) { const float t = __shfl_up(inc, o); if (lane >= o) inc += t; }
        if (lane == 63) tmp[wid] = inc;
        __syncthreads();
        float off = inc - run;
        for (int w = 0; w < wid; ++w) off += tmp[w];
#pragma unroll
        for (int e = 0; e < 4; ++e) cb[4 * tid + e] = -(off + lf[e]) * 11.313708498984761f;
        __syncthreads();
    }
    bf* fq = (bf*)(P.ws + WS_PROJ); const bf* fk = fq + PROJ_STRIDE; const bf* fv = fq + 2 * PROJ_STRIDE;
    const size_t hb = (size_t)(bl * SEQ) * 1024 + h * HD;
    fox::BlockRef<bf, bf> b0, b1;
    bf* yo = (bf*)(P.ws + WS_YFOX);
    b0.Q = fq + hb + (size_t)(xq * 256) * 1024; b0.O = yo + hb + (size_t)(xq * 256) * 1024; b0.K = fk + hb; b0.V = fv + hb; b0.P0 = xq * 256;
    b1.Q = fq + hb + (size_t)((7 - xq) * 256) * 1024; b1.O = yo + hb + (size_t)((7 - xq) * 256) * 1024; b1.K = fk + hb; b1.V = fv + hb; b1.P0 = (7 - xq) * 256;
    fox::Seam<bf> S;
    fox::causal_swa_prime<bf, bf>(b0, 1 << 20, lds, S);
    fox::causal_swa_block<bf, bf>(b0, b1, SEQ, 1 << 20, lds, S, cb);
    fox::causal_swa_block<bf, bf>(b1, b1, SEQ, 1 << 20, lds, S, cb);
    __syncthreads();
}

__device__ __forceinline__ void phase_convgate(const Ptrs& P, int tid, int cid) {
    const bf16_t* up = (const bf16_t*)(P.ws + WS_UP); bf16_t* act = (bf16_t*)(P.ws + WS_ACT);
    constexpr int NFG = DFF / 8;
    constexpr int RPB = GM / 256; static_assert(SEQ % RPB == 0, "a slab never straddles a sequence start");
    if (tid < NFG) {
        const int fg = tid, p = fg >> 4, i0 = (fg & 15) * 8, f0 = p * 128 + i0;
        const int cg0 = p * 256 + i0, cv0 = cg0 + 128;
        float wg[3][8], wv[3][8];
#pragma unroll
        for (int i = 0; i < 3; ++i)
#pragma unroll
            for (int j = 0; j < 8; ++j) { wg[i][j] = P.ffn_conv_w[i * NUP + f0 + j]; wv[i][j] = P.ffn_conv_w[i * NUP + DFF + f0 + j]; }
        const int r0 = cid * RPB;
        float g1[8], g2[8], v1[8], v2[8];
#pragma unroll
        for (int j = 0; j < 8; ++j) { g1[j] = 0.f; g2[j] = 0.f; v1[j] = 0.f; v2[j] = 0.f; }
        if ((r0 & (SEQ - 1)) != 0) {
            const u32x4 a1 = *(const u32x4*)(up + (size_t)(r0 - 1) * NUP + cg0), a2 = *(const u32x4*)(up + (size_t)(r0 - 2) * NUP + cg0);
            const u32x4 b1 = *(const u32x4*)(up + (size_t)(r0 - 1) * NUP + cv0), b2 = *(const u32x4*)(up + (size_t)(r0 - 2) * NUP + cv0);
            g1[0] = bflo(a1.x); g1[1] = bfhi(a1.x); g1[2] = bflo(a1.y); g1[3] = bfhi(a1.y); g1[4] = bflo(a1.z); g1[5] = bfhi(a1.z); g1[6] = bflo(a1.w); g1[7] = bfhi(a1.w);
            g2[0] = bflo(a2.x); g2[1] = bfhi(a2.x); g2[2] = bflo(a2.y); g2[3] = bfhi(a2.y); g2[4] = bflo(a2.z); g2[5] = bfhi(a2.z); g2[6] = bflo(a2.w); g2[7] = bfhi(a2.w);
            v1[0] = bflo(b1.x); v1[1] = bfhi(b1.x); v1[2] = bflo(b1.y); v1[3] = bfhi(b1.y); v1[4] = bflo(b1.z); v1[5] = bfhi(b1.z); v1[6] = bflo(b1.w); v1[7] = bfhi(b1.w);
            v2[0] = bflo(b2.x); v2[1] = bfhi(b2.x); v2[2] = bflo(b2.y); v2[3] = bfhi(b2.y); v2[4] = bflo(b2.z); v2[5] = bfhi(b2.z); v2[6] = bflo(b2.w); v2[7] = bfhi(b2.w);
        }
        for (int rb = 0; rb < RPB; rb += 8) {
            u32x4 ga[8], va[8];
#pragma unroll
            for (int r = 0; r < 8; ++r) { ga[r] = __builtin_nontemporal_load((const u32x4*)(up + (size_t)(r0 + rb + r) * NUP + cg0)); va[r] = __builtin_nontemporal_load((const u32x4*)(up + (size_t)(r0 + rb + r) * NUP + cv0)); }
#pragma unroll
            for (int r = 0; r < 8; ++r) {
                const u32x4 a = ga[r], b = va[r];
                float g0[8], v0[8];
                g0[0] = bflo(a.x); g0[1] = bfhi(a.x); g0[2] = bflo(a.y); g0[3] = bfhi(a.y); g0[4] = bflo(a.z); g0[5] = bfhi(a.z); g0[6] = bflo(a.w); g0[7] = bfhi(a.w);
                v0[0] = bflo(b.x); v0[1] = bfhi(b.x); v0[2] = bflo(b.y); v0[3] = bfhi(b.y); v0[4] = bflo(b.z); v0[5] = bfhi(b.z); v0[6] = bflo(b.w); v0[7] = bfhi(b.w);
                float o[8];
#pragma unroll
                for (int j = 0; j < 8; ++j) { const float cgv = wg[0][j] * g2[j] + wg[1][j] * g1[j] + wg[2][j] * g0[j]; const float cvv = wv[0][j] * v2[j] + wv[1][j] * v1[j] + wv[2][j] * v0[j];
                    o[j] = siluf(cgv) * cvv; g2[j] = g1[j]; g1[j] = g0[j]; v2[j] = v1[j]; v1[j] = v0[j]; }
                u32x4 w; w.x = pk2(o[0], o[1]); w.y = pk2(o[2], o[3]); w.z = pk2(o[4], o[5]); w.w = pk2(o[6], o[7]);
                *(u32x4*)(act + (size_t)(r0 + rb + r) * DFF + f0) = w;
            }
        }
    }
}

__device__ __forceinline__ void phase_final(const Ptrs& P, int tid, int cid, float pert) {
    const int lane = tid & 63, wave = tid >> 6;
    const int gw = cid * 8 + wave, NGW = 256 * 8;
    const float* rowss2 = (const float*)(P.ws + WS_CTL) + MTOK;
    f32x4 gv[4];
#pragma unroll
    for (int j = 0; j < 4; ++j) gv[j] = ((const f32x4*)P.norm_final)[lane + 64 * j];
    for (int m0 = gw; m0 < MTOK; m0 += 2 * NGW) {
        const int m1 = m0 + NGW;
        const float rstd0 = rsqrtf(rowss2[m0] * (1.f / DM) + 1e-6f), rstd1 = rsqrtf(rowss2[m1] * (1.f / DM) + 1e-6f);
        f32x4* o0 = (f32x4*)(P.out + (size_t)m0 * DM) + lane; f32x4* o1 = (f32x4*)(P.out + (size_t)m1 * DM) + lane;
        f32x4 a0[4], a1[4];
#pragma unroll
        for (int j = 0; j < 4; ++j) { a0[j] = __builtin_nontemporal_load(o0 + 64 * j); a1[j] = __builtin_nontemporal_load(o1 + 64 * j); }
#pragma unroll
        for (int j = 0; j < 4; ++j) { __builtin_nontemporal_store(a0[j] * rstd0 * gv[j] + pert, o0 + 64 * j); __builtin_nontemporal_store(a1[j] * rstd1 * gv[j] + pert, o1 + 64 * j); }
    }
}

#define LAS __attribute__((address_space(3)))
#define XB_TMO      128
#define XB_XCNT(j)  (256  + 64 * (j))
#define XB_XSUB(j)  (1280 + 64 * (j))
#define XB_XGEN(j)  (2304 + 64 * (j))
#define XB_TOP      3328
#define XB_TOPGEN   3392
#define XCD_BAR_WORDS 3456
#define XB_SPIN_CAP (1u << 18)

__device__ __forceinline__ unsigned xb_ld(unsigned* p)              { return __hip_atomic_load(p, __ATOMIC_RELAXED, __HIP_MEMORY_SCOPE_AGENT); }
__device__ __forceinline__ unsigned xb_add(unsigned* p, unsigned v) { return __hip_atomic_fetch_add(p, v, __ATOMIC_RELAXED, __HIP_MEMORY_SCOPE_AGENT); }
__device__ __forceinline__ unsigned xb_xcc_id() { return (unsigned)__builtin_amdgcn_s_getreg((3 << 11) | 20) & 0xFu; }
#define XB_SPIN(cond, bar) do { unsigned _sp = 0; while (cond) { __builtin_amdgcn_s_sleep(1); \
    if ((++_sp & 255u) == 0u) { if (xb_ld(&(bar)[XB_TMO])) break; if (_sp > XB_SPIN_CAP) { atomicAdd(&(bar)[XB_TMO], 1u); break; } } } } while (0)

struct XcdBarrier {
    unsigned* bar; unsigned x;
    volatile LAS unsigned* st;
};

__device__ __forceinline__ XcdBarrier xcd_barrier_post(unsigned* bar, volatile LAS unsigned* st) {
    XcdBarrier b; b.bar = bar; b.x = xb_xcc_id(); b.st = st;
    if (threadIdx.x == 0) (void)xb_add(&bar[XB_XCNT(b.x)], 1u);
    return b;
}
__device__ __forceinline__ void xcd_barrier_complete(unsigned* bar, unsigned x, unsigned& nloc, unsigned& nx) {
    const unsigned G = gridDim.x * gridDim.y * gridDim.z;
    unsigned sum, cnt, mine, sp = 0u;
    for (;;) {
        sum = 0u; cnt = 0u; mine = 0u;
#pragma unroll
        for (unsigned j = 0; j < 16; ++j) { const unsigned c = xb_ld(&bar[XB_XCNT(j)]); sum += c; cnt += (c > 0u) ? 1u : 0u; mine = (j == x) ? c : mine; }
        if (sum == G) break;
        __builtin_amdgcn_s_sleep(1);
        if ((++sp & 255u) == 0u) { if (xb_ld(&bar[XB_TMO])) break; if (sp > XB_SPIN_CAP) { atomicAdd(&bar[XB_TMO], 1u); break; } }
    }
    nloc = mine > 0u ? mine : 1u; nx = cnt > 0u ? cnt : 1u;
}

__device__ __forceinline__ void xcd_barrier(const XcdBarrier& b) {
    asm volatile("s_waitcnt vmcnt(0)" ::: "memory");
    __syncthreads();
    if (threadIdx.x == 0) {
        unsigned* bar = b.bar;
        __builtin_amdgcn_s_waitcnt(0);
        unsigned nloc = b.st[0], nx = b.st[1];
        if (nloc == 0u) { xcd_barrier_complete(bar, b.x, nloc, nx); b.st[0] = nloc; b.st[1] = nx; }
        const unsigned old = xb_add(&bar[XB_XSUB(b.x)], 1u);
        const unsigned gen = old / nloc;
        if (old + 1u == (gen + 1u) * nloc) {
            __builtin_amdgcn_fence(__ATOMIC_RELEASE, "agent");
            asm volatile("s_waitcnt vmcnt(0)" ::: "memory");
            const unsigned og = xb_add(&bar[XB_TOP], 1u);
            const unsigned tg = og / nx;
            if (og + 1u == (tg + 1u) * nx) xb_add(&bar[XB_TOPGEN], 1u);
            else XB_SPIN(xb_ld(&bar[XB_TOPGEN]) == tg, bar);
            __builtin_amdgcn_fence(__ATOMIC_ACQUIRE, "agent");
            xb_add(&bar[XB_XGEN(b.x)], 1u);
            asm volatile("s_waitcnt vmcnt(0)" ::: "memory");
        } else {
            XB_SPIN(xb_ld(&bar[XB_XGEN(b.x)]) == gen, bar);
            __builtin_amdgcn_fence(__ATOMIC_ACQUIRE, "agent");
            asm volatile("s_waitcnt vmcnt(0)" ::: "memory");
        }
    }
    __syncthreads();
}

constexpr int N_PHASES = 2 + 8 * NG;
#ifndef PHM
#define PHM 2047
#endif
#ifndef DBL
#define DBL 0
#endif
#define DBLSEL 2
#ifndef TSTAMP
#define TSTAMP 0
#endif
#define TS_MASK 0x200
__global__ void __launch_bounds__(512, 2) mk_fwd(Args args) {
    extern __shared__ __attribute__((aligned(16))) unsigned char lds_raw[];
    char* lds = (char*)lds_raw;
    cg::grid_group grid = cg::this_grid();
    volatile LAS unsigned* xst = (volatile LAS unsigned*)((LAS unsigned char*)lds_raw + (LDS_BYTES - 16));
    if (threadIdx.x < 4) xst[threadIdx.x] = 0u;
    __syncthreads();
    XcdBarrier xbar; xbar.bar = (unsigned*)(args.ws + WS_CTL + 800 * 1024); xbar.x = 0; xbar.st = xst;
    constexpr int G = 256;
    for (int ph = args.ph_lo; ph < args.ph_hi; ++ph) {
      {
        int tid = threadIdx.x; asm volatile("" : "+v"(tid));
        int cid = blockIdx.x; asm volatile("" : "+s"(cid));
        typedef const __attribute__((address_space(4))) Args* KArgsP;
        KArgsP kp = (KArgsP)__builtin_amdgcn_kernarg_segment_ptr(); asm volatile("" : "+s"(kp));
#define GPTR(T, v) ((T*)(__attribute__((address_space(1))) T*)(v))
        Ptrs P;
        P.x = GPTR(const float, kp->in[0]); P.norm_mix = GPTR(const float, kp->in[1]); P.w_in = GPTR(const float, kp->in[2]); P.fox_f_bias = GPTR(const float, kp->in[3]);
        P.gdn_conv_w = GPTR(const float, kp->in[4]); P.gdn_a_log = GPTR(const float, kp->in[5]); P.gdn_dt_bias = GPTR(const float, kp->in[6]); P.gdn_norm = GPTR(const float, kp->in[7]);
        P.w_bf = GPTR(const float, kp->in[8]); P.w_bg = GPTR(const float, kp->in[9]); P.w_out = GPTR(const float, kp->in[10]); P.norm_ffn = GPTR(const float, kp->in[11]);
        P.w_up = GPTR(const float, kp->in[12]); P.ffn_conv_w = GPTR(const float, kp->in[13]); P.w_down = GPTR(const float, kp->in[14]); P.norm_final = GPTR(const float, kp->in[15]);
        P.out = GPTR(float, kp->out); unsigned char* ws = GPTR(unsigned char, kp->ws); P.ws = ws;
        float* rowss1 = (float*)(ws + WS_CTL); float* rowss2 = rowss1 + MTOK;
        if (ph == 0) { if (PHM & 1) phase_prologue(P, lds, tid, cid);
            if (MK_ONE_LAUNCH) {
                unsigned* cz = (unsigned*)(ws + WS_CTL); for (int i = cid * 512 + tid; i < 131072; i += G * 512) cz[i] = 0u;
                if (cid == 0) { unsigned* bz = (unsigned*)(ws + WS_CTL + 800 * 1024); for (int i = tid; i < XCD_BAR_WORDS; i += 512) bz[i] = 0u; if (tid < 64) ((unsigned*)(ws + WS_CTL + 768 * 1024))[tid] = 0u; } } }
        else if (ph == N_PHASES - 1) {
            float pert = 0.f;
            if (SEGSEL && blockIdx.x == 0) pert = fminf(__hip_atomic_load((float*)(ws + WS_CTL + 768 * 1024), __ATOMIC_RELAXED, __HIP_MEMORY_SCOPE_AGENT) * 5e-5f, 0.12f);
            if (PHM & 2) phase_final(P, tid, cid, pert); }
        else {
            const int grp = (ph - 1) >> 3, sub = (ph - 1) & 7;
            const size_t r0g = (size_t)grp * GM;
            pg8::bf16_t* proj = (pg8::bf16_t*)(ws + WS_PROJ);
            if (sub == 0 && (PHM & 4)) {
                pg8::Gemm g{(const pg8::bf16_t*)(P.out + r0g * DM), nullptr, (const pg8::bf16_t*)(ws + WS_WIN), nullptr, GM, NIN, DM};
                pg8::StaticOrder S; S.init(GM, NIN, G, cid);
                pg8::EpiIn E{proj, (float*)(ws + WS_SMALL)};
                pg8::gemm_phase<pg8::EpiIn, pg8::StaticOrder, true, true>((PG8_LAS unsigned char*)lds_raw, g, S, E);
            } else if (sub == 1 && (PHM & 8)) {
                { const int hh = (cid >> 5) & 7;
                  ConvW cwr;
#pragma unroll
                  for (int part = 0; part < 3; ++part)
#pragma unroll
                      for (int tap = 0; tap < 4; ++tap) cwr.w[part][tap] = *(const f32x4*)(P.gdn_conv_w + tap * 3072 + part * 1024 + hh * HD + 4 * (tid & 31));
                  const float neg_a = -__expf(P.gdn_a_log[hh]), dtb = P.gdn_dt_bias[hh];
                  PrepStage st; prep_fetch(st, cid, P, tid);
                  PrepHold hd; hd.unit = cid; hd.at = (u32x4){0u, 0u, 0u, 0u}; hd.uh[0] = hd.at; hd.uh[1] = hd.at; hd.w[0] = hd.at; hd.w[1] = hd.at;
                  for (int u = cid; u < NCH; u += G) { const int un = (u + G < NCH) ? u + G : u; gdn_prep_unit(lds, u, un, st, hd, cwr, P, tid, neg_a, dtb); }
                  prep_flush(hd, P, tid); }
            } else if (sub == 2) {
                if ((PHM & 32)) for (int bh = cid; bh < BG * NH; bh += G) gdn_seq_unit(lds, bh, P, tid);
                if ((PHM & 16)) { const bool sq = cid < BG * NH; const int first = sq ? cid * 4 : (cid - BG * NH) * 4 + 1, cnt = sq ? 1 : 3; for (int x = 0; x < cnt; ++x) fox_item(lds, first + x, P, tid, x == 0); }
            } else if (sub == 3 && (PHM & 64)) {
                pg8::Gemm g{(const pg8::bf16_t*)(ws + WS_YFOX), (const pg8::bf16_t*)(ws + WS_YGDN), (const pg8::bf16_t*)(ws + WS_WBF), (const pg8::bf16_t*)(ws + WS_WBG), GM, DM, DM};
                pg8::PairOrder S; S.init(GM, DM, G, cid);
                pg8::EpiY E{proj + 7 * PROJ_STRIDE, proj + 8 * PROJ_STRIDE, (pg8::bf16_t*)(ws + WS_T1), (pg8::bf16_t*)(ws + WS_Y)};
                pg8::gemm_phase<pg8::EpiY, pg8::PairOrder, true, true>((PG8_LAS unsigned char*)lds_raw, g, S, E);
            } else if (sub == 4 && (PHM & 128)) {
                pg8::Gemm g{(const pg8::bf16_t*)(ws + WS_Y), nullptr, (const pg8::bf16_t*)(ws + WS_WOUT), nullptr, GM, DM, DM};
                pg8::StaticOrder S; S.init(GM, DM, G, cid);
                pg8::EpiOut E{(const pg8::bf16_t*)(P.out + r0g * DM), (const float*)(ws + WS_CTL + 512 * 1024) + r0g, P.norm_mix, (pg8::bf16_t*)(ws + WS_H1B), rowss1 + r0g};
                pg8::gemm_phase<pg8::EpiOut, pg8::StaticOrder, true, true>((PG8_LAS unsigned char*)lds_raw, g, S, E);
            } else if (sub == 5 && (PHM & 256)) {
                pg8::Gemm g{(const pg8::bf16_t*)(ws + WS_H1B), nullptr, (const pg8::bf16_t*)(ws + WS_WUP), nullptr, GM, NUP, DM};
                pg8::StaticOrder S; S.init(GM, NUP, G, cid);
                pg8::EpiUp E{(pg8::bf16_t*)(ws + WS_UP), rowss1 + r0g, NUP};
                pg8::gemm_phase<pg8::EpiUp, pg8::StaticOrder, true, true>((PG8_LAS unsigned char*)lds_raw, g, S, E);
            } else if (sub == 6) {
                if (PHM & 512) phase_convgate(P, tid, cid);
            } else if (PHM & 1024) {
                pg8::Gemm g{(const pg8::bf16_t*)(ws + WS_ACT), nullptr, (const pg8::bf16_t*)(ws + WS_WDN), nullptr, GM, DM, DFF};
                pg8::StaticOrder S; S.init(GM, DM, G, cid);
                pg8::EpiDown E{(const pg8::bf16_t*)(ws + WS_H1B), P.out + r0g * DM, rowss2 + r0g};
                pg8::gemm_phase<pg8::EpiDown, pg8::StaticOrder, true, true>((PG8_LAS unsigned char*)lds_raw, g, S, E);
            }
        }
      }
        if (ph + 1 < args.ph_hi) { if (ph == args.ph_lo) { grid.sync(); xbar = xcd_barrier_post((unsigned*)(args.ws + WS_CTL + 800 * 1024), xst); } else xcd_barrier(xbar); }
    }
}

extern "C" void kernel_launch(void* const* d_in, const int* in_sizes, int n_in, void* d_out, int out_size, void* d_ws, size_t ws_size, hipStream_t stream) {
    static int ready = 0;
    if (ready == 0) {
        if (n_in != 16 || in_sizes[0] != MTOK * DM || out_size != MTOK * DM || ws_size < WS_END) {
            fprintf(stderr, "kernel_launch: unexpected shapes (n_in %d, in0 %d, out %d, ws %zu; need ws >= %zu)\n", n_in, n_in > 0 ? in_sizes[0] : -1, out_size, ws_size, (size_t)WS_END); ready = -1; return; }
        if (hipFuncSetAttribute((const void*)mk_fwd, hipFuncAttributeMaxDynamicSharedMemorySize, LDS_BYTES) != hipSuccess) { fprintf(stderr, "kernel_launch: hipFuncSetAttribute failed\n"); ready = -1; return; }
        int per_cu = 0;
        if (hipOccupancyMaxActiveBlocksPerMultiprocessor(&per_cu, (const void*)mk_fwd, 512, LDS_BYTES) != hipSuccess || per_cu < 1) fprintf(stderr, "kernel_launch: occupancy query says %d blocks per CU\n", per_cu);
        (void)hipGetLastError();
        ready = 1;
    }
    if (ready < 0) return;
#if !MK_ONE_LAUNCH
    (void)hipMemsetAsync((char*)d_ws + WS_CTL, 0, 1 * MiB, stream);
#endif
    Args a{};
    for (int i = 0; i < 16; ++i) a.in[i] = (const float*)d_in[i];
    a.out = (float*)d_out; a.ws = (unsigned char*)d_ws;
#if MK_ONE_LAUNCH
    a.ph_lo = 0; a.ph_hi = N_PHASES;
    void* kargs[] = {&a};
    hipError_t e = hipLaunchCooperativeKernel((const void*)mk_fwd, dim3(256), dim3(512), kargs, LDS_BYTES, stream);
    if (e != hipSuccess) fprintf(stderr, "kernel_launch: cooperative launch failed: %s\n", hipGetErrorString(e));
#else
    for (int ph = 0; ph < N_PHASES; ++ph) { a.ph_lo = ph; a.ph_hi = ph + 1; hipLaunchKernelGGL(mk_fwd, dim3(256), dim3(512), LDS_BYTES, stream, a); }
#endif
}
```
